# Optimizing an MI355X kernel written in HIP

```python
import math
import jax, jax.numpy as jnp
from jax import lax
import numpy as np


D_MODEL = 1024
BATCH = 8
SEQ = 4096
DEPTH = 2
DEC_BATCH = 16
DEC_SEQ = 4096
PAST_LEN = 128

GRID_W = 64
QBLK = 128
N_MEM = 256
EPS = 1e-6
ROPE_THETA = 10000.0
A_HEADS = 8
A_KV_HEADS = 2
A_GROUP = A_HEADS // A_KV_HEADS
A_DIM = 64
B_HEADS = 4
B_DIM = 64
B_VDIM = 2 * B_DIM
A_Q = A_HEADS * A_DIM
A_KV = A_KV_HEADS * A_DIM
B_QK = B_HEADS * 2 * B_DIM
B_V = B_HEADS * B_VDIM
EVEN_IN = A_Q + 2 * A_KV + 2 * B_QK + B_V
EVEN_MIX = A_HEADS * A_DIM + B_HEADS * B_VDIM
C_HEADS = 16
C_Q_RANK = 384
C_KV_RANK = 256
C_NOPE = 64
C_ROPE = 32
C_VDIM = 64
ODD_IN = C_Q_RANK + C_KV_RANK + C_ROPE
C_MIX = C_HEADS * C_VDIM
X_HEADS = 4
X_DIM = D_MODEL // X_HEADS
D_FF = ((-(-8 * D_MODEL // 3) + 255) // 256) * 256
N_EVEN = (DEPTH + 1) // 2
N_ODD = DEPTH // 2

kernel_name = 'hybrid_gqa_diff_mla_encoder'


def rms_norm(x, g):
    xf = x.astype(jnp.float32)
    y = xf * lax.rsqrt(jnp.mean(xf * xf, axis=-1, keepdims=True) + EPS)
    return (y * g.astype(jnp.float32)).astype(x.dtype)


def rope(x, ang):
    extra = x.ndim - 3
    c = jnp.cos(ang).reshape(ang.shape[0], *([1] * extra), -1).astype(x.dtype)
    s = jnp.sin(ang).reshape(ang.shape[0], *([1] * extra), -1).astype(x.dtype)
    x2 = x.reshape(*x.shape[:-1], -1, 2)
    x0, x1 = x2[..., 0], x2[..., 1]
    return jnp.stack([x0 * c - x1 * s, x0 * s + x1 * c], axis=-1).reshape(x.shape)


def rope_freqs(n_pairs):
    return ROPE_THETA ** (-jnp.arange(n_pairs, dtype=jnp.float32) / n_pairs)


def axial_angles(S):
    rows = S // GRID_W
    r = jnp.repeat(jnp.arange(rows, dtype=jnp.float32), GRID_W)
    c = jnp.tile(jnp.arange(GRID_W, dtype=jnp.float32), rows)
    f = rope_freqs(A_DIM // 4)
    return jnp.concatenate([r[:, None] * f, c[:, None] * f], axis=-1)


def linear_angles(S, dim):
    t = jnp.arange(S, dtype=jnp.float32)
    return t[:, None] * rope_freqs(dim // 2)


def alibi_slopes(n):
    return jnp.asarray(2.0 ** (-8.0 * np.arange(1, n + 1) / n), dtype=jnp.float32)


def query_block_sweep(fn, qs, S):
    nb = S // QBLK
    xs = tuple(jnp.swapaxes(q.reshape(q.shape[0], nb, QBLK, *q.shape[2:]), 0, 1) for q in qs)
    starts = jnp.arange(nb, dtype=jnp.int32) * QBLK
    out = lax.map(lambda a: fn(*a[0], a[1]), (xs, starts))
    return jnp.swapaxes(out, 0, 1).reshape(qs[0].shape[0], S, *out.shape[3:])


def gqa_axial(qa, ka, va, gq, gk, ang):
    B, S = qa.shape[:2]
    q = rope(rms_norm(qa.reshape(B, S, A_KV_HEADS, A_GROUP, A_DIM), gq), ang)
    k = rope(rms_norm(ka.reshape(B, S, A_KV_HEADS, A_DIM), gk), ang)
    v = va.reshape(B, S, A_KV_HEADS, A_DIM)
    scale = A_DIM ** -0.5

    def blk(qb, start):
        s = jnp.einsum('bqhgd,bkhd->bhgqk', qb, k).astype(jnp.float32) * scale
        p = jax.nn.softmax(s, axis=-1).astype(v.dtype)
        return jnp.einsum('bhgqk,bkhd->bqhgd', p, v)

    o = query_block_sweep(blk, (q,), S)
    return o.reshape(B, S, A_HEADS * A_DIM)


def diff_attn(qb_in, kb_in, vb_in, lq1, lk1, lq2, lk2, g_sub, lam_init):
    B, S = qb_in.shape[:2]
    q = qb_in.reshape(B, S, B_HEADS, 2, B_DIM)
    k = kb_in.reshape(B, S, B_HEADS, 2, B_DIM)
    v = vb_in.reshape(B, S, B_HEADS, B_VDIM)
    f32 = jnp.float32
    lam = (jnp.exp(jnp.sum(lq1.astype(f32) * lk1.astype(f32)))
           - jnp.exp(jnp.sum(lq2.astype(f32) * lk2.astype(f32))) + lam_init)
    slopes = alibi_slopes(B_HEADS)
    kpos = jnp.arange(S, dtype=f32)
    scale = B_DIM ** -0.5

    def blk(qblk, start):
        s = jnp.einsum('bqhcd,bkhcd->bhcqk', qblk, k).astype(f32) * scale
        qpos = start.astype(f32) + jnp.arange(QBLK, dtype=f32)
        bias = -slopes[:, None, None] * jnp.abs(qpos[:, None] - kpos[None, :])
        p = jax.nn.softmax(s + bias[None, :, None], axis=-1)
        a = (p[:, :, 0] - lam * p[:, :, 1]).astype(v.dtype)
        return jnp.einsum('bhqk,bkhe->bqhe', a, v)

    o = query_block_sweep(blk, (q,), S)
    o = rms_norm(o, g_sub) * (1.0 - lam_init)
    return o.reshape(B, S, B_V)


def mla(h, w_in, g_q, g_kv, w_uq, w_ukv, ang):
    B, S = h.shape[:2]
    a = h @ w_in
    cq, ckv, kr = jnp.split(a, [C_Q_RANK, C_Q_RANK + C_KV_RANK], axis=-1)
    q = (rms_norm(cq, g_q) @ w_uq).reshape(B, S, C_HEADS, C_NOPE + C_ROPE)
    qn, qr = q[..., :C_NOPE], rope(q[..., C_NOPE:], ang)
    kv = (rms_norm(ckv, g_kv) @ w_ukv).reshape(B, S, C_HEADS, C_NOPE + C_VDIM)
    kn, v = kv[..., :C_NOPE], kv[..., C_NOPE:]
    kr = rope(kr, ang)
    scale = (C_NOPE + C_ROPE) ** -0.5

    def blk(qnb, qrb, start):
        s = (jnp.einsum('bqhd,bkhd->bhqk', qnb, kn)
             + jnp.einsum('bqhd,bkd->bhqk', qrb, kr)).astype(jnp.float32) * scale
        p = jax.nn.softmax(s, axis=-1).astype(v.dtype)
        return jnp.einsum('bhqk,bkhd->bqhd', p, v)

    o = query_block_sweep(blk, (qn, qr), S)
    return o.reshape(B, S, C_MIX)


def memory_cross_attn(h, mem_n, w_q, w_kv, w_o):
    B, S = h.shape[:2]
    M = mem_n.shape[1]
    q = (h @ w_q).reshape(B, S, X_HEADS, X_DIM)
    kv = (mem_n @ w_kv).reshape(B, M, 2, X_HEADS, X_DIM)
    s = jnp.einsum('bqhd,bkhd->bhqk', q, kv[:, :, 0]).astype(jnp.float32) * (X_DIM ** -0.5)
    p = jax.nn.softmax(s, axis=-1).astype(h.dtype)
    o = jnp.einsum('bhqk,bkhd->bqhd', p, kv[:, :, 1]).reshape(B, S, X_HEADS * X_DIM)
    return o @ w_o


def swiglu(h, w_gu, w_down):
    g, u = jnp.split(h @ w_gu, 2, axis=-1)
    return (jax.nn.silu(g) * u) @ w_down


def trunk(x, mem, norm_mix, e_w_in, e_q_norm, e_k_norm, e_lam_q1, e_lam_k1, e_lam_q2,
          e_lam_k2, e_subln, e_w_out, o_w_in, o_q_norm, o_kv_norm, o_w_uq, o_w_ukv,
          o_w_out, norm_cross, norm_mem, w_cq, w_ckv, w_co, norm_ffn, w_gu, w_down,
          final_norm):
    S = x.shape[1]
    ang_axial = axial_angles(S)
    ang_lin = linear_angles(S, C_ROPE)
    splits = [A_Q, A_Q + A_KV, A_Q + 2 * A_KV, A_Q + 2 * A_KV + B_QK, A_Q + 2 * A_KV + 2 * B_QK]
    for layer in range(DEPTH):
        h = rms_norm(x, norm_mix[layer])
        if layer % 2 == 0:
            e = layer // 2
            qa, ka, va, qb, kb, vb = jnp.split(h @ e_w_in[e], splits, axis=-1)
            oa = gqa_axial(qa, ka, va, e_q_norm[e], e_k_norm[e], ang_axial)
            lam_init = 0.8 - 0.6 * math.exp(-0.3 * layer)
            ob = diff_attn(qb, kb, vb, e_lam_q1[e], e_lam_k1[e], e_lam_q2[e], e_lam_k2[e],
                           e_subln[e], lam_init)
            x = x + jnp.concatenate([oa, ob], axis=-1) @ e_w_out[e]
        else:
            o = layer // 2
            x = x + mla(h, o_w_in[o], o_q_norm[o], o_kv_norm[o], o_w_uq[o], o_w_ukv[o],
                        ang_lin) @ o_w_out[o]
        x = x + memory_cross_attn(rms_norm(x, norm_cross[layer]), rms_norm(mem, norm_mem[layer]),
                                  w_cq[layer], w_ckv[layer], w_co[layer])
        x = x + swiglu(rms_norm(x, norm_ffn[layer]), w_gu[layer], w_down[layer])
    return rms_norm(x, final_norm)


def setup_inputs(seed: int = 0) -> dict:
    key = jax.random.key(seed)
    ks = jax.random.split(key, 32)
    f32 = jnp.float32

    def w(k, shape, fan_in):
        return jax.random.normal(k, shape, f32) * (fan_in ** -0.5)

    def gain(k, shape):
        return 1.0 + 0.02 * jax.random.normal(k, shape, f32)

    def small(k, shape):
        return 0.1 * jax.random.normal(k, shape, f32)

    D = D_MODEL
    return {
        'x_prompt': jax.random.normal(ks[0], (BATCH, SEQ, D), f32),
        'x_sample': jax.random.normal(ks[1], (DEC_BATCH, DEC_SEQ, D), f32),
        'mem_prompt': jax.random.normal(ks[2], (BATCH, N_MEM, D), f32),
        'mem_sample': jax.random.normal(ks[3], (DEC_BATCH, N_MEM, D), f32),
        'norm_mix': gain(ks[4], (DEPTH, D)),
        'e_w_in': w(ks[5], (N_EVEN, D, EVEN_IN), D),
        'e_q_norm': gain(ks[6], (N_EVEN, A_DIM)),
        'e_k_norm': gain(ks[7], (N_EVEN, A_DIM)),
        'e_lam_q1': small(ks[8], (N_EVEN, B_DIM)),
        'e_lam_k1': small(ks[9], (N_EVEN, B_DIM)),
        'e_lam_q2': small(ks[10], (N_EVEN, B_DIM)),
        'e_lam_k2': small(ks[11], (N_EVEN, B_DIM)),
        'e_subln': gain(ks[12], (N_EVEN, B_VDIM)),
        'e_w_out': w(ks[13], (N_EVEN, EVEN_MIX, D), EVEN_MIX),
        'o_w_in': w(ks[14], (N_ODD, D, ODD_IN), D),
        'o_q_norm': gain(ks[15], (N_ODD, C_Q_RANK)),
        'o_kv_norm': gain(ks[16], (N_ODD, C_KV_RANK)),
        'o_w_uq': w(ks[17], (N_ODD, C_Q_RANK, C_HEADS * (C_NOPE + C_ROPE)), C_Q_RANK),
        'o_w_ukv': w(ks[18], (N_ODD, C_KV_RANK, C_HEADS * (C_NOPE + C_VDIM)), C_KV_RANK),
        'o_w_out': w(ks[19], (N_ODD, C_MIX, D), C_MIX),
        'norm_cross': gain(ks[20], (DEPTH, D)),
        'norm_mem': gain(ks[21], (DEPTH, D)),
        'w_cq': w(ks[22], (DEPTH, D, X_HEADS * X_DIM), D),
        'w_ckv': w(ks[23], (DEPTH, D, 2 * X_HEADS * X_DIM), D),
        'w_co': w(ks[24], (DEPTH, X_HEADS * X_DIM, D), X_HEADS * X_DIM),
        'norm_ffn': gain(ks[25], (DEPTH, D)),
        'w_gu': w(ks[26], (DEPTH, D, 2 * D_FF), D),
        'w_down': w(ks[27], (DEPTH, D_FF, D), D_FF),
        'final_norm': gain(ks[28], (D,)),
    }


def reference(x_prompt, x_sample, mem_prompt, mem_sample, norm_mix, e_w_in, e_q_norm,
              e_k_norm, e_lam_q1, e_lam_k1, e_lam_q2, e_lam_k2, e_subln, e_w_out, o_w_in,
              o_q_norm, o_kv_norm, o_w_uq, o_w_ukv, o_w_out, norm_cross, norm_mem, w_cq,
              w_ckv, w_co, norm_ffn, w_gu, w_down, final_norm):
    y_prompt = trunk(x_prompt, mem_prompt, norm_mix, e_w_in, e_q_norm, e_k_norm, e_lam_q1,
                     e_lam_k1, e_lam_q2, e_lam_k2, e_subln, e_w_out, o_w_in, o_q_norm,
                     o_kv_norm, o_w_uq, o_w_ukv, o_w_out, norm_cross, norm_mem, w_cq, w_ckv,
                     w_co, norm_ffn, w_gu, w_down, final_norm)
    y_sample = trunk(x_sample, mem_sample, norm_mix, e_w_in, e_q_norm, e_k_norm, e_lam_q1,
                     e_lam_k1, e_lam_q2, e_lam_k2, e_subln, e_w_out, o_w_in, o_q_norm,
                     o_kv_norm, o_w_uq, o_w_ukv, o_w_out, norm_cross, norm_mem, w_cq, w_ckv,
                     w_co, norm_ffn, w_gu, w_down, final_norm)
    return (y_prompt, y_sample)
```

```cpp
#include <hip/hip_runtime.h>
#include <hip/hip_cooperative_groups.h>
#include <cstdio>
#include <cstdint>
namespace cg = cooperative_groups;

typedef unsigned short bf16_t;
typedef short bf16x8 __attribute__((ext_vector_type(8)));
typedef float f32x16 __attribute__((ext_vector_type(16)));
typedef float f32x2 __attribute__((ext_vector_type(2)));
typedef unsigned u32x4 __attribute__((ext_vector_type(4)));
typedef __bf16 bf16x2_t __attribute__((ext_vector_type(2)));
#define DI __device__ __forceinline__
#define MFMA(a, b, c) __builtin_amdgcn_mfma_f32_32x32x16_bf16((a), (b), (c), 0, 0, 0)

constexpr int D = 1024, SEQ = 4096, NBATCH = 24, NB = 8  , NCHUNK = NBATCH / NB, TC = NB * SEQ;
constexpr int NMEM = 256, DFF = 2816, EVEN_IN = 2304, ODD_IN = 672, ODD_PAD = 768;
constexpr float EPS = 1e-6f, LOG2E = 1.4426950408889634f;
constexpr int THREADS = 256;
constexpr size_t LDS_BYTES = 73728;

constexpr size_t al(size_t x) { return (x + 255) & ~(size_t)255; }
constexpr size_t W_EIN = 0;
constexpr size_t W_EOUT = W_EIN + al((size_t)EVEN_IN * D * 2);
constexpr size_t W_OIN = W_EOUT + al((size_t)D * D * 2);
constexpr size_t W_UQ = W_OIN + al((size_t)ODD_PAD * D * 2);
constexpr size_t W_UKV = W_UQ + al((size_t)1536 * 384 * 2);
constexpr size_t W_OOUT = W_UKV + al((size_t)2048 * 256 * 2);
constexpr size_t W_CQ = W_OOUT + al((size_t)D * D * 2);
constexpr size_t W_CKV = W_CQ + 2 * al((size_t)D * D * 2);
constexpr size_t W_CO = W_CKV + 2 * al((size_t)2048 * D * 2);
constexpr size_t W_GU = W_CO + 2 * al((size_t)D * D * 2);
constexpr size_t W_DOWN = W_GU + 2 * al((size_t)2 * DFF * D * 2);
constexpr size_t T_AX = W_DOWN + 2 * al((size_t)D * DFF * 2);
constexpr size_t T_LIN = T_AX + al((size_t)SEQ * 32 * 8);
constexpr size_t B_MEMN = T_LIN + al((size_t)SEQ * 16 * 8);
constexpr size_t B_KX = B_MEMN + 2 * al((size_t)NBATCH * NMEM * D * 2);
constexpr size_t B_VXT = B_KX + 2 * al((size_t)NBATCH * NMEM * D * 2);
constexpr size_t B_H = B_VXT + 2 * al((size_t)NBATCH * NMEM * D * 2);
constexpr size_t B_MIX = B_H + al((size_t)TC * D * 2);
constexpr size_t B_BIG = B_MIX + al((size_t)TC * D * 2);
constexpr size_t E_QKV = B_BIG;
constexpr size_t E_VT = E_QKV + al((size_t)TC * 1664 * 2);
constexpr size_t E_PARK = E_VT + al((size_t)NB * 640 * SEQ * 2);
constexpr size_t O_A = B_BIG;
constexpr size_t O_Q = O_A + al((size_t)TC * ODD_PAD * 2);
constexpr size_t O_KN = O_Q + al((size_t)TC * 1536 * 2);
constexpr size_t O_VT = O_KN + al((size_t)TC * D * 2);
constexpr size_t O_END = O_VT + al((size_t)NB * D * SEQ * 2);
constexpr size_t X_Q = B_BIG;
constexpr size_t F_ACT = B_BIG;

struct Params {
    const float* in[29];
    float* out;
    char* ws;
};

DI unsigned pack2(float lo, float hi) { f32x2 v = {lo, hi}; bf16x2_t b = __builtin_convertvector(v, bf16x2_t); return __builtin_bit_cast(unsigned, b); }
DI float bflo(unsigned u) { return __uint_as_float(u << 16); }
DI float bfhi(unsigned u) { return __uint_as_float(u & 0xffff0000u); }
DI int crow(int i, int h) { return (i & 3) + 8 * (i >> 2) + 4 * h; }
DI int swap23(int x) { return (x & ~12) | ((x & 4) << 1) | ((x & 8) >> 1); }
DI int otid() { int t = threadIdx.x; asm volatile("" : "+v"(t)); return t; }
DI float wave_sum(float v) {
#pragma unroll
    for (int o = 32; o >= 1; o >>= 1) v += __shfl_xor(v, o);
    return v;
}

DI void convert_weight(const float* __restrict__ src, bf16_t* __restrict__ dst, int K, int N, int Npad, char* smem) {
    float* t = (float*)smem;
    const int tid = otid();
    const int nkt = K / 64, nnt = Npad / 64;
    for (int tile = blockIdx.x; tile < nkt * nnt; tile += gridDim.x) {
        const int k0 = (tile / nnt) * 64, n0 = (tile % nnt) * 64;
#pragma unroll
        for (int i = 0; i < 16; ++i) {
            const int k = i * 4 + (tid >> 6), n = tid & 63;
            t[k * 65 + n] = (n0 + n < N) ? src[(size_t)(k0 + k) * N + n0 + n] : 0.f;
        }
        __syncthreads();
#pragma unroll
        for (int i = 0; i < 8; ++i) {
            const int n = i * 8 + (tid >> 5), k = (tid & 31) * 2;
            *(unsigned*)(dst + (size_t)(n0 + n) * K + k0 + k) = pack2(t[k * 65 + n], t[(k + 1) * 65 + n]);
        }
        __syncthreads();
    }
}

__device__ const float kFreq[16] = {1.000000000e+00f, 5.623413324e-01f, 3.162277639e-01f, 1.778279394e-01f, 1.000000015e-01f, 5.623413250e-02f, 3.162277490e-02f, 1.778279431e-02f,
                                    9.999999776e-03f, 5.623413250e-03f, 3.162277630e-03f, 1.778279431e-03f, 1.000000047e-03f, 5.623413017e-04f, 3.162277571e-04f, 1.778279402e-04f};
DI float2 sincos_acc(float ang) {
    const double x = (double)ang;
    const double n = __builtin_rint(x * 0.15915494309189535);
    double r = __builtin_fma(-n, 6.283185307179586, x);
    r = __builtin_fma(-n, 2.4492935982947064e-16, r);
    const double r2 = r * r;
    double s = 1.0, c = 1.0;
#pragma unroll
    for (int k = 13; k >= 1; --k) {
        s = 1.0 - r2 * s * (1.0 / (double)((2 * k) * (2 * k + 1)));
        c = 1.0 - r2 * c * (1.0 / (double)((2 * k - 1) * (2 * k)));
    }
    return make_float2((float)c, (float)(r * s));
}
DI void build_tables(float2* ax, float2* lin) {
    const int gt = blockIdx.x * THREADS + otid(), gs = gridDim.x * THREADS;
    for (int e = gt; e < SEQ * 32; e += gs) {
        const int pos = e >> 5, p = e & 31;
        const float base = (p < 16) ? (float)(pos >> 6) : (float)(pos & 63);
        ax[e] = sincos_acc(base * kFreq[p & 15]);
    }
    for (int e = gt; e < SEQ * 16; e += gs) {
        const int pos = e >> 4, p = e & 15;
        lin[e] = sincos_acc((float)pos * kFreq[p]);
    }
}

DI void rmsnorm_rows(const float* __restrict__ src, const float* __restrict__ g, bf16_t* __restrict__ dst, int nrows) {
    const int tid_ = otid(), lane = tid_ & 63, wv = blockIdx.x * 4 + (tid_ >> 6), nw = gridDim.x * 4;
    for (int row = wv; row < nrows; row += nw) {
        const float4* s = (const float4*)(src + (size_t)row * D);
        float4 v[4]; float ss = 0.f;
#pragma unroll
        for (int i = 0; i < 4; ++i) { v[i] = s[i * 64 + lane]; ss += v[i].x * v[i].x + v[i].y * v[i].y + v[i].z * v[i].z + v[i].w * v[i].w; }
        ss = wave_sum(ss);
        const float rstd = rsqrtf(ss * (1.0f / D) + EPS);
#pragma unroll
        for (int i = 0; i < 4; ++i) {
            const float4 gg = ((const float4*)g)[i * 64 + lane];
            uint2 o; o.x = pack2(v[i].x * rstd * gg.x, v[i].y * rstd * gg.y); o.y = pack2(v[i].z * rstd * gg.z, v[i].w * rstd * gg.w);
            *(uint2*)(dst + (size_t)row * D + (i * 64 + lane) * 4) = o;
        }
    }
}
DI void rmsnorm_final(float* __restrict__ x, const float* __restrict__ g, int nrows) {
    const int tid_ = otid(), lane = tid_ & 63, wv = blockIdx.x * 4 + (tid_ >> 6), nw = gridDim.x * 4;
    for (int row = wv; row < nrows; row += nw) {
        float4* s = (float4*)(x + (size_t)row * D);
        float4 v[4]; float ss = 0.f;
#pragma unroll
        for (int i = 0; i < 4; ++i) { v[i] = s[i * 64 + lane]; ss += v[i].x * v[i].x + v[i].y * v[i].y + v[i].z * v[i].z + v[i].w * v[i].w; }
        ss = wave_sum(ss);
        const float rstd = rsqrtf(ss * (1.0f / D) + EPS);
#pragma unroll
        for (int i = 0; i < 4; ++i) {
            const float4 gg = ((const float4*)g)[i * 64 + lane];
            float4 o; o.x = v[i].x * rstd * gg.x; o.y = v[i].y * rstd * gg.y; o.z = v[i].z * rstd * gg.z; o.w = v[i].w * rstd * gg.w;
            s[i * 64 + lane] = o;
        }
    }
}

DI void kprep_even(bf16_t* __restrict__ qkv, const float* __restrict__ gk, const float2* __restrict__ ax) {
    const int tid_ = otid(), gt = blockIdx.x * THREADS + tid_, gs = gridDim.x * THREADS;
    const int p = tid_ & 31;
    for (int v = gt >> 5; v < TC * 2; v += gs >> 5) {
        const int tok = v >> 1, kvh = v & 1;
        unsigned* ptr = (unsigned*)(qkv + (size_t)tok * 1664 + 512 + kvh * 64 + 2 * p);
        const unsigned u = *ptr;
        const float x0 = bflo(u), x1 = bfhi(u);
        float ss = x0 * x0 + x1 * x1;
#pragma unroll
        for (int o = 16; o >= 1; o >>= 1) ss += __shfl_xor(ss, o);
        const float rstd = rsqrtf(ss * (1.0f / 64) + EPS);
        const float y0 = x0 * rstd * gk[2 * p], y1 = x1 * rstd * gk[2 * p + 1];
        const float2 cs = ax[(tok & (SEQ - 1)) * 32 + p];
        *ptr = pack2(y0 * cs.x - y1 * cs.y, y0 * cs.y + y1 * cs.x);
    }
}
DI void prep_odd(bf16_t* __restrict__ a, const float* __restrict__ gq, const float* __restrict__ gkv, const float2* __restrict__ lin) {
    const int tid_ = otid(), lane = tid_ & 63, wv = blockIdx.x * 4 + (tid_ >> 6), nw = gridDim.x * 4;
    for (int row = wv; row < TC; row += nw) {
        unsigned* base = (unsigned*)(a + (size_t)row * ODD_PAD);
        unsigned uq[3], uk[2]; float sq = 0.f, sk = 0.f;
#pragma unroll
        for (int i = 0; i < 3; ++i) { uq[i] = base[i * 64 + lane]; const float a0 = bflo(uq[i]), a1 = bfhi(uq[i]); sq += a0 * a0 + a1 * a1; }
#pragma unroll
        for (int i = 0; i < 2; ++i) { uk[i] = base[192 + i * 64 + lane]; const float a0 = bflo(uk[i]), a1 = bfhi(uk[i]); sk += a0 * a0 + a1 * a1; }
        sq = wave_sum(sq); sk = wave_sum(sk);
        const float rq = rsqrtf(sq * (1.0f / 384) + EPS), rk = rsqrtf(sk * (1.0f / 256) + EPS);
#pragma unroll
        for (int i = 0; i < 3; ++i) { const int c = (i * 64 + lane) * 2; base[i * 64 + lane] = pack2(bflo(uq[i]) * rq * gq[c], bfhi(uq[i]) * rq * gq[c + 1]); }
#pragma unroll
        for (int i = 0; i < 2; ++i) { const int c = (i * 64 + lane) * 2; base[192 + i * 64 + lane] = pack2(bflo(uk[i]) * rk * gkv[c], bfhi(uk[i]) * rk * gkv[c + 1]); }
        if (lane < 16) {
            const unsigned u = base[320 + lane];
            const float x0 = bflo(u), x1 = bfhi(u);
            const float2 cs = lin[(row & (SEQ - 1)) * 16 + lane];
            base[320 + lane] = pack2(x0 * cs.x - x1 * cs.y, x0 * cs.y + x1 * cs.x);
        }
    }
}

constexpr int G_ROW = 144, G_TILE = 128 * G_ROW, G_STAGE = 2 * G_TILE;
template <class Epi>
DI void gemm_phase(const bf16_t* __restrict__ A, int lda, const bf16_t* __restrict__ Bt, int ldb, int M, int NV, int K, const Epi& epi, char* smem) {
    const int tid = otid(), lane = tid & 63, w = tid >> 6, r = lane & 31, h = lane >> 5;
    const int wm = w >> 1, wn = w & 1;
    const int ntn = NV / 128, ntiles = (M / 128) * ntn, nk = K / 64;
    const int lrow = tid >> 3, kc = tid & 7;
    for (int t = blockIdx.x; t < ntiles; t += gridDim.x) {
        const int tm = t / ntn, tn = t - tm * ntn;
        const bf16_t* ap = A + (size_t)(tm * 128 + lrow) * lda + kc * 8;
        const bf16_t* bp[4];
#pragma unroll
        for (int i = 0; i < 4; ++i) bp[i] = Bt + (size_t)epi.brow(tn, lrow + 32 * i) * ldb + kc * 8;
        u32x4 ra[4], rb[4];
        f32x16 acc[2][2];
#pragma unroll
        for (int a = 0; a < 2; ++a)
#pragma unroll
            for (int b = 0; b < 2; ++b)
#pragma unroll
                for (int i = 0; i < 16; ++i) acc[a][b][i] = 0.f;
#pragma unroll
        for (int i = 0; i < 4; ++i) { ra[i] = *(const u32x4*)(ap + (size_t)(32 * i) * lda); rb[i] = *(const u32x4*)(bp[i]); }
#pragma unroll
        for (int i = 0; i < 4; ++i) {
            *(u32x4*)(smem + (lrow + 32 * i) * G_ROW + kc * 16) = ra[i];
            *(u32x4*)(smem + G_TILE + (lrow + 32 * i) * G_ROW + kc * 16) = rb[i];
        }
        __syncthreads();
        for (int kt = 0; kt < nk; ++kt) {
            const bool more = kt + 1 < nk;
            if (more) {
#pragma unroll
                for (int i = 0; i < 4; ++i) { ra[i] = *(const u32x4*)(ap + (size_t)(32 * i) * lda + (kt + 1) * 64); rb[i] = *(const u32x4*)(bp[i] + (kt + 1) * 64); }
            }
            const char* sa = smem + (kt & 1) * G_STAGE + (wm * 64 + r) * G_ROW + h * 16;
            const char* sb = smem + (kt & 1) * G_STAGE + G_TILE + (wn * 64 + r) * G_ROW + h * 16;
#pragma unroll
            for (int ks = 0; ks < 4; ++ks) {
                const bf16x8 a0 = *(const bf16x8*)(sa + ks * 32), a1 = *(const bf16x8*)(sa + 32 * G_ROW + ks * 32);
                const bf16x8 b0 = *(const bf16x8*)(sb + ks * 32), b1 = *(const bf16x8*)(sb + 32 * G_ROW + ks * 32);
                acc[0][0] = MFMA(a0, b0, acc[0][0]); acc[0][1] = MFMA(a0, b1, acc[0][1]);
                acc[1][0] = MFMA(a1, b0, acc[1][0]); acc[1][1] = MFMA(a1, b1, acc[1][1]);
            }
            if (more) {
                char* st = smem + ((kt + 1) & 1) * G_STAGE;
#pragma unroll
                for (int i = 0; i < 4; ++i) {
                    *(u32x4*)(st + (lrow + 32 * i) * G_ROW + kc * 16) = ra[i];
                    *(u32x4*)(st + G_TILE + (lrow + 32 * i) * G_ROW + kc * 16) = rb[i];
                }
            }
            __syncthreads();
        }
        epi(acc, tm, tn, wm, wn, r, h);
    }
}

struct EpiResid {
    const float* res; float* out;
    DI int brow(int tn, int j) const { return tn * 128 + j; }
    DI void operator()(f32x16 (&acc)[2][2], int tm, int tn, int wm, int wn, int r, int h) const {
#pragma unroll
        for (int mi = 0; mi < 2; ++mi)
#pragma unroll
            for (int ni = 0; ni < 2; ++ni) {
                const int col = tn * 128 + wn * 64 + ni * 32 + r;
#pragma unroll
                for (int i = 0; i < 16; ++i) {
                    const size_t idx = (size_t)(tm * 128 + wm * 64 + mi * 32 + crow(i, h)) * D + col;
                    out[idx] = res[idx] + acc[mi][ni][i];
                }
            }
    }
};
DI void store_rm(bf16_t* rm, int ld, int rowbase, int c, const f32x16& a, int h) {
#pragma unroll
    for (int i = 0; i < 16; i += 2) {
        const unsigned pk = pack2(a[i], a[i + 1]);
        const size_t idx = (size_t)(rowbase + crow(i, h)) * ld + c;
        rm[idx] = (bf16_t)(pk & 0xffffu); rm[idx + ld] = (bf16_t)(pk >> 16);
    }
}
DI void store_vt(bf16_t* vt, int nvc, int seqlen_log2, int rowbase, int cv, const f32x16& a, int h) {
#pragma unroll
    for (int g = 0; g < 4; ++g) {
        const int row = rowbase + 8 * g + 4 * h;
        const int b = row >> seqlen_log2, s = row & ((1 << seqlen_log2) - 1);
        uint2 o; o.x = pack2(a[4 * g], a[4 * g + 1]); o.y = pack2(a[4 * g + 2], a[4 * g + 3]);
        *(uint2*)(vt + (((size_t)b * nvc + cv) << seqlen_log2) + swap23(s)) = o;
    }
}
struct EpiBf16 {
    bf16_t* out; int ld;
    DI int brow(int tn, int j) const { return tn * 128 + j; }
    DI void operator()(f32x16 (&acc)[2][2], int tm, int tn, int wm, int wn, int r, int h) const {
#pragma unroll
        for (int mi = 0; mi < 2; ++mi)
#pragma unroll
            for (int ni = 0; ni < 2; ++ni) store_rm(out, ld, tm * 128 + wm * 64 + mi * 32, tn * 128 + wn * 64 + ni * 32 + r, acc[mi][ni], h);
    }
};
struct EpiEven {
    bf16_t* qkv; bf16_t* vt;
    DI int brow(int tn, int j) const { return tn * 128 + j; }
    DI void operator()(f32x16 (&acc)[2][2], int tm, int tn, int wm, int wn, int r, int h) const {
#pragma unroll
        for (int mi = 0; mi < 2; ++mi)
#pragma unroll
            for (int ni = 0; ni < 2; ++ni) {
                const int n = tn * 128 + wn * 64 + ni * 32 + r;
                const int rowbase = tm * 128 + wm * 64 + mi * 32;
                if (n < 640) store_rm(qkv, 1664, rowbase, n, acc[mi][ni], h);
                else if (n < 768) store_vt(vt, 640, 12, rowbase, n - 640, acc[mi][ni], h);
                else if (n < 1792) store_rm(qkv, 1664, rowbase, n - 128, acc[mi][ni], h);
                else store_vt(vt, 640, 12, rowbase, n - 1792 + 128, acc[mi][ni], h);
            }
    }
};
struct EpiMlaKV {
    bf16_t* kn; bf16_t* vt;
    DI int brow(int tn, int j) const { return tn * 128 + j; }
    DI void operator()(f32x16 (&acc)[2][2], int tm, int tn, int wm, int wn, int r, int h) const {
#pragma unroll
        for (int mi = 0; mi < 2; ++mi)
#pragma unroll
            for (int ni = 0; ni < 2; ++ni) {
                const int c = ni * 32 + r;
                const int rowbase = tm * 128 + wm * 64 + mi * 32;
                if (wn == 0) store_rm(kn, D, rowbase, tn * 64 + c, acc[mi][ni], h);
                else store_vt(vt, D, 12, rowbase, tn * 64 + c, acc[mi][ni], h);
            }
    }
};
struct EpiMemKV {
    bf16_t* kx; bf16_t* vxt;
    DI int brow(int tn, int j) const { return tn * 128 + j; }
    DI void operator()(f32x16 (&acc)[2][2], int tm, int tn, int wm, int wn, int r, int h) const {
#pragma unroll
        for (int mi = 0; mi < 2; ++mi)
#pragma unroll
            for (int ni = 0; ni < 2; ++ni) {
                const int n = tn * 128 + wn * 64 + ni * 32 + r;
                const int rowbase = tm * 128 + wm * 64 + mi * 32;
                if (n < D) store_rm(kx, D, rowbase, n, acc[mi][ni], h);
                else store_vt(vxt, D, 8, rowbase, n - D, acc[mi][ni], h);
            }
    }
};
struct EpiSwiglu {
    bf16_t* act;
    DI int brow(int tn, int j) const { return ((j & 32) ? DFF : 0) + tn * 64 + (j >> 6) * 32 + (j & 31); }
    DI void operator()(f32x16 (&acc)[2][2], int tm, int tn, int wm, int wn, int r, int h) const {
#pragma unroll
        for (int mi = 0; mi < 2; ++mi) {
            f32x16 v;
#pragma unroll
            for (int i = 0; i < 16; ++i) { const float g = acc[mi][0][i], u = acc[mi][1][i]; v[i] = g * u * __builtin_amdgcn_rcpf(1.0f + __builtin_amdgcn_exp2f(-g * LOG2E)); }
            store_rm(act, DFF, tm * 128 + wm * 64 + mi * 32, tn * 64 + wn * 32 + r, v, h);
        }
    }
};

template <int DQK, int DV, int KT, int QMODE, bool ALIBI>
DI void attn_core(const bf16_t* __restrict__ q, int ldq, const bf16_t* __restrict__ k, int ldk, const bf16_t* __restrict__ k2, int ldk2,
                  const bf16_t* __restrict__ vt, int ldv, int nkeys, int qpos0, float c, float slope2,
                  const float* __restrict__ qg, const float2* __restrict__ tab, char* smem, f32x16 (&o)[DV / 32], float& lsum) {
    constexpr int KROW = DQK * 2 + 16, VROW = KT * 2 + 16, KBYTES = KT * KROW, VBYTES = DV * VROW, STAGE = KBYTES + VBYTES;
    constexpr int KCPR = DQK / 8  , NKC = KT * KCPR / THREADS, VCPR = KT / 8, NVC = DV * VCPR / THREADS, NST = KT / 32, NKS = DQK / 16, NDT = DV / 32;
    static_assert(2 * STAGE <= (int)LDS_BYTES, "lds");
    static_assert(KT * KCPR % THREADS == 0 && DV * VCPR % THREADS == 0, "chunks");
    const int tid = otid(), lane = tid & 63, w = tid >> 6, r = lane & 31, h = lane >> 5;
    const int qpos = qpos0 + 32 * w + r;
    bf16x8 qf[NKS];
    {
        const bf16_t* qrow = q + (size_t)(32 * w + r) * ldq + 8 * h;
        u32x4 raw[NKS];
#pragma unroll
        for (int s = 0; s < NKS; ++s) raw[s] = *(const u32x4*)(qrow + 16 * s);
        if (QMODE == 1) {
            float ss = 0.f;
#pragma unroll
            for (int s = 0; s < NKS; ++s) {
                const unsigned u[4] = {raw[s].x, raw[s].y, raw[s].z, raw[s].w};
#pragma unroll
                for (int j = 0; j < 4; ++j) { const float a0 = bflo(u[j]), a1 = bfhi(u[j]); ss += a0 * a0 + a1 * a1; }
            }
            ss += __shfl_xor(ss, 32);
            const float rstd = rsqrtf(ss * (1.0f / 64) + EPS);
#pragma unroll
            for (int s = 0; s < NKS; ++s) {
                unsigned u[4] = {raw[s].x, raw[s].y, raw[s].z, raw[s].w};
#pragma unroll
                for (int j = 0; j < 4; ++j) {
                    const int d0 = 16 * s + 8 * h + 2 * j;
                    const float y0 = bflo(u[j]) * rstd * qg[d0], y1 = bfhi(u[j]) * rstd * qg[d0 + 1];
                    const float2 cs = tab[qpos * 32 + (d0 >> 1)];
                    u[j] = pack2(y0 * cs.x - y1 * cs.y, y0 * cs.y + y1 * cs.x);
                }
                raw[s] = u32x4{u[0], u[1], u[2], u[3]};
            }
        } else if (QMODE == 2) {
#pragma unroll
            for (int s = 4; s < NKS; ++s) {
                unsigned u[4] = {raw[s].x, raw[s].y, raw[s].z, raw[s].w};
#pragma unroll
                for (int j = 0; j < 4; ++j) {
                    const int p = 8 * (s - 4) + 4 * h + j;
                    const float y0 = bflo(u[j]), y1 = bfhi(u[j]);
                    const float2 cs = tab[qpos * 16 + p];
                    u[j] = pack2(y0 * cs.x - y1 * cs.y, y0 * cs.y + y1 * cs.x);
                }
                raw[s] = u32x4{u[0], u[1], u[2], u[3]};
            }
        }
#pragma unroll
        for (int s = 0; s < NKS; ++s) qf[s] = __builtin_bit_cast(bf16x8, raw[s]);
    }
    u32x4 rk[NKC], rv[NVC];
#define ATT_GLOAD(key0_)                                                                                              \
    {                                                                                                                 \
        _Pragma("unroll") for (int i = 0; i < NKC; ++i) {                                                             \
            const int cid = tid + THREADS * i, key = cid / KCPR, cc = cid - key * KCPR;                               \
            const bf16_t* src;                                                                                        \
            if (QMODE == 2 && cc >= 8) src = k2 + (size_t)((key0_) + key) * ldk2 + (cc - 8) * 8;                       \
            else src = k + (size_t)((key0_) + key) * ldk + cc * 8;                                                    \
            rk[i] = *(const u32x4*)src;                                                                               \
        }                                                                                                             \
        _Pragma("unroll") for (int i = 0; i < NVC; ++i) {                                                             \
            const int cid = tid + THREADS * i, d = cid / VCPR, cc = cid - d * VCPR;                                   \
            rv[i] = *(const u32x4*)(vt + (size_t)d * ldv + (key0_) + cc * 8);                                         \
        }                                                                                                             \
    }
#define ATT_LSTORE(buf_)                                                                                              \
    {                                                                                                                 \
        char* st_ = smem + (buf_) * STAGE;                                                                            \
        _Pragma("unroll") for (int i = 0; i < NKC; ++i) {                                                             \
            const int cid = tid + THREADS * i, key = cid / KCPR, cc = cid - key * KCPR;                               \
            *(u32x4*)(st_ + key * KROW + cc * 16) = rk[i];                                                            \
        }                                                                                                             \
        _Pragma("unroll") for (int i = 0; i < NVC; ++i) {                                                             \
            const int cid = tid + THREADS * i, d = cid / VCPR, cc = cid - d * VCPR;                                   \
            *(u32x4*)(st_ + KBYTES + d * VROW + cc * 16) = rv[i];                                                     \
        }                                                                                                             \
    }
    float m = -1e30f, l = 0.f;
#pragma unroll
    for (int dt = 0; dt < NDT; ++dt)
#pragma unroll
        for (int i = 0; i < 16; ++i) o[dt][i] = 0.f;
    const int ntiles = nkeys / KT;
    ATT_GLOAD(0) ATT_LSTORE(0) __syncthreads();
    for (int kt = 0; kt < ntiles; ++kt) {
        const bool more = kt + 1 < ntiles;
        if (more) ATT_GLOAD((kt + 1) * KT)
        const char* kb = smem + (kt & 1) * STAGE + r * KROW + h * 16;
        const char* vb = smem + (kt & 1) * STAGE + KBYTES + r * VROW + h * 16;
        f32x16 x[NST];
#pragma unroll
        for (int st = 0; st < NST; ++st) {
#pragma unroll
            for (int i = 0; i < 16; ++i) x[st][i] = 0.f;
#pragma unroll
            for (int ks = 0; ks < NKS; ++ks) {
                const bf16x8 kf = *(const bf16x8*)(kb + 32 * st * KROW + ks * 32);
                x[st] = MFMA(kf, qf[ks], x[st]);
                if ((ks & 3) == 3) __builtin_amdgcn_sched_barrier(0);
            }
            __builtin_amdgcn_sched_barrier(0);
        }
        float mx = -1e30f;
        const float dq = (float)(qpos - (kt * KT + 4 * h));
#pragma unroll
        for (int st = 0; st < NST; ++st)
#pragma unroll
            for (int i = 0; i < 16; ++i) {
                float t = x[st][i] * c;
                if (ALIBI) t -= slope2 * fabsf(dq - (float)(32 * st + (i & 3) + 8 * (i >> 2)));
                x[st][i] = t; mx = fmaxf(mx, t);
            }
        mx = fmaxf(mx, __shfl_xor(mx, 32));
        const float mn = fmaxf(m, mx);
        const float alpha = __builtin_amdgcn_exp2f(m - mn);
        m = mn;
        float rs = 0.f;
#pragma unroll
        for (int st = 0; st < NST; ++st)
#pragma unroll
            for (int i = 0; i < 16; ++i) { const float pe = __builtin_amdgcn_exp2f(x[st][i] - mn); x[st][i] = pe; rs += pe; }
        l = l * alpha + rs;
        if (__any(alpha != 1.0f)) {
#pragma unroll
            for (int dt = 0; dt < NDT; ++dt)
#pragma unroll
                for (int i = 0; i < 16; ++i) o[dt][i] *= alpha;
        }
#pragma unroll
        for (int st = 0; st < NST; ++st)
#pragma unroll
            for (int s = 0; s < 2; ++s) {
                u32x4 pk;
                pk.x = pack2(x[st][8 * s + 0], x[st][8 * s + 1]); pk.y = pack2(x[st][8 * s + 2], x[st][8 * s + 3]);
                pk.z = pack2(x[st][8 * s + 4], x[st][8 * s + 5]); pk.w = pack2(x[st][8 * s + 6], x[st][8 * s + 7]);
                const bf16x8 pb = __builtin_bit_cast(bf16x8, pk);
#pragma unroll
                for (int dt = 0; dt < NDT; ++dt) {
                    const bf16x8 vf = *(const bf16x8*)(vb + 32 * dt * VROW + (32 * st + 16 * s) * 2);
                    o[dt] = MFMA(vf, pb, o[dt]);
                }
                __builtin_amdgcn_sched_barrier(0);
            }
        if (more) ATT_LSTORE((kt + 1) & 1)
        __syncthreads();
    }
    lsum = l + __shfl_xor(l, 32);
}
template <int NDT>
DI void store_o(bf16_t* dst, int ld, f32x16 (&o)[NDT], float inv) {
    const int tid_ = otid(), lane = tid_ & 63, w = tid_ >> 6, r = lane & 31, h = lane >> 5;
    bf16_t* row = dst + (size_t)(32 * w + r) * ld + 4 * h;
#pragma unroll
    for (int dt = 0; dt < NDT; ++dt)
#pragma unroll
        for (int g = 0; g < 4; ++g) {
            uint2 v; v.x = pack2(o[dt][4 * g] * inv, o[dt][4 * g + 1] * inv); v.y = pack2(o[dt][4 * g + 2] * inv, o[dt][4 * g + 3] * inv);
            *(uint2*)(row + 32 * dt + 8 * g) = v;
        }
}
DI int swz_item(int base) {
    const int G = gridDim.x, i = blockIdx.x;
    if (G & 7) return base + i;
    return base + (i & 7) * (G >> 3) + (i >> 3);
}

DI void attn_even(const bf16_t* qkv, const bf16_t* vt, float* park, bf16_t* mix, const Params& p, const float2* ax, float lam_init, char* smem) {
    float d1 = 0.f, d2 = 0.f;
    for (int i = 0; i < 64; ++i) { d1 += p.in[8][i] * p.in[9][i]; d2 += p.in[10][i] * p.in[11][i]; }
    const float lam = __expf(d1) - __expf(d2) + lam_init;
    const int tid_ = otid(), lane = tid_ & 63, h = lane >> 5;
    float4* mypark = (float4*)(park + ((size_t)blockIdx.x * THREADS + tid_) * 64);
    constexpr int NDIFF = NB * 4 * 32, NGQA = NB * 8 * 32;
    for (int base = 0; base < NDIFF + NGQA; base += gridDim.x) {
        const int it = swz_item(base);
        if (it >= NDIFF + NGQA) continue;
        if (it < NDIFF) {
            const int b = it >> 7, hd = (it >> 5) & 3, qt = it & 31;
            const size_t row0 = (size_t)b * SEQ + qt * 128;
            const float slope2 = exp2f(-2.0f * (hd + 1)) * LOG2E;
            f32x16 o0[4]; float l0;
            attn_core<64, 128, 64, 0, true>(qkv + row0 * 1664 + 640 + hd * 128, 1664, qkv + (size_t)b * SEQ * 1664 + 1152 + hd * 128, 1664, nullptr, 0,
                                            vt + ((size_t)b * 640 + 128 + hd * 128) * SEQ, SEQ, SEQ, qt * 128, 0.125f * LOG2E, slope2, nullptr, nullptr, smem, o0, l0);
            const float i0 = 1.0f / l0;
#pragma unroll
            for (int dt = 0; dt < 4; ++dt)
#pragma unroll
                for (int g = 0; g < 4; ++g) mypark[dt * 4 + g] = make_float4(o0[dt][4 * g] * i0, o0[dt][4 * g + 1] * i0, o0[dt][4 * g + 2] * i0, o0[dt][4 * g + 3] * i0);
            asm volatile("" ::: "memory");
            attn_core<64, 128, 64, 0, true>(qkv + row0 * 1664 + 640 + hd * 128 + 64, 1664, qkv + (size_t)b * SEQ * 1664 + 1152 + hd * 128 + 64, 1664, nullptr, 0,
                                            vt + ((size_t)b * 640 + 128 + hd * 128) * SEQ, SEQ, SEQ, qt * 128, 0.125f * LOG2E, slope2, nullptr, nullptr, smem, o0, l0);
            const float i1 = lam / l0;
            float ss = 0.f;
            asm volatile("" ::: "memory");
#pragma unroll
            for (int dt = 0; dt < 4; ++dt)
#pragma unroll
                for (int g = 0; g < 4; ++g) {
                    const float4 pv = mypark[dt * 4 + g];
                    const float pa[4] = {pv.x, pv.y, pv.z, pv.w};
#pragma unroll
                    for (int e = 0; e < 4; ++e) { const float v = pa[e] - i1 * o0[dt][4 * g + e]; o0[dt][4 * g + e] = v; ss += v * v; }
                }
            ss += __shfl_xor(ss, 32);
            const float rstd = rsqrtf(ss * (1.0f / 128) + EPS) * (1.0f - lam_init);
#pragma unroll
            for (int dt = 0; dt < 4; ++dt)
#pragma unroll
                for (int i = 0; i < 16; ++i) o0[dt][i] *= p.in[12][32 * dt + crow(i, h)];
            store_o<4>(mix + row0 * D + 512 + hd * 128, D, o0, rstd);
        } else {
            const int j = it - NDIFF;
            const int b = j >> 8, hd = (j >> 5) & 7, qt = j & 31, kvh = hd >> 2;
            const size_t row0 = (size_t)b * SEQ + qt * 128;
            f32x16 o[2]; float l;
            attn_core<64, 64, 64, 1, false>(qkv + row0 * 1664 + hd * 64, 1664, qkv + (size_t)b * SEQ * 1664 + 512 + kvh * 64, 1664, nullptr, 0,
                                            vt + ((size_t)b * 640 + kvh * 64) * SEQ, SEQ, SEQ, qt * 128, 0.125f * LOG2E, 0.f, p.in[6], ax, smem, o, l);
            store_o<2>(mix + row0 * D + hd * 64, D, o, 1.0f / l);
        }
    }
}
DI void attn_mla(const bf16_t* qb, const bf16_t* kn, const bf16_t* a, const bf16_t* vt, bf16_t* mix, const float2* lin, char* smem) {
    constexpr int NIT = NB * 16 * 32;
    for (int base = 0; base < NIT; base += gridDim.x) {
        const int it = swz_item(base);
        if (it >= NIT) continue;
        const int b = it >> 9, hd = (it >> 5) & 15, qt = it & 31;
        const size_t row0 = (size_t)b * SEQ + qt * 128;
        f32x16 o[2]; float l;
        attn_core<96, 64, 64, 2, false>(qb + row0 * 1536 + hd * 96, 1536, kn + (size_t)b * SEQ * D + hd * 64, D, a + (size_t)b * SEQ * ODD_PAD + 640, ODD_PAD,
                                        vt + ((size_t)b * D + hd * 64) * SEQ, SEQ, SEQ, qt * 128, 0.10206207261596575f * LOG2E, 0.f, nullptr, lin, smem, o, l);
        store_o<2>(mix + row0 * D + hd * 64, D, o, 1.0f / l);
    }
}
DI void attn_cross(const bf16_t* qx, const bf16_t* kx, const bf16_t* vxt, bf16_t* mix, int seq0, char* smem) {
    constexpr int NIT = NB * 4 * 32 * 2;
    for (int base = 0; base < NIT; base += gridDim.x) {
        const int it = swz_item(base);
        if (it >= NIT) continue;
        const int b = it >> 8, hd = (it >> 6) & 3, qt = (it >> 1) & 31, half = it & 1;
        const size_t row0 = (size_t)b * SEQ + qt * 128;
        const int gs = seq0 + b;
        f32x16 o[4]; float l;
        attn_core<256, 128, 32, 0, false>(qx + row0 * D + hd * 256, D, kx + (size_t)gs * NMEM * D + hd * 256, D, nullptr, 0,
                                          vxt + ((size_t)gs * D + hd * 256 + half * 128) * NMEM, NMEM, NMEM, 0, 0.0625f * LOG2E, 0.f, nullptr, nullptr, smem, o, l);
        store_o<4>(mix + row0 * D + hd * 256 + half * 128, D, o, 1.0f / l);
    }
}

extern "C" __global__ void __launch_bounds__(THREADS, 2) fwd_mega(Params p) {
    extern __shared__ __attribute__((aligned(16))) char smem[];
    cg::grid_group grid = cg::this_grid();
    char* ws = p.ws;
    bf16_t* wEin = (bf16_t*)(ws + W_EIN); bf16_t* wEout = (bf16_t*)(ws + W_EOUT); bf16_t* wOin = (bf16_t*)(ws + W_OIN);
    bf16_t* wUq = (bf16_t*)(ws + W_UQ); bf16_t* wUkv = (bf16_t*)(ws + W_UKV); bf16_t* wOout = (bf16_t*)(ws + W_OOUT);
    float2* ax = (float2*)(ws + T_AX); float2* lin = (float2*)(ws + T_LIN);
    bf16_t* H = (bf16_t*)(ws + B_H); bf16_t* MIX = (bf16_t*)(ws + B_MIX);

    convert_weight(p.in[5], wEin, D, EVEN_IN, EVEN_IN, smem);
    convert_weight(p.in[13], wEout, D, D, D, smem);
    convert_weight(p.in[14], wOin, D, ODD_IN, ODD_PAD, smem);
    convert_weight(p.in[17], wUq, 384, 1536, 1536, smem);
    convert_weight(p.in[18], wUkv, 256, 2048, 2048, smem);
    convert_weight(p.in[19], wOout, D, D, D, smem);
    for (int l = 0; l < 2; ++l) {
        convert_weight(p.in[22] + (size_t)l * D * D, (bf16_t*)(ws + W_CQ) + (size_t)l * D * D, D, D, D, smem);
        convert_weight(p.in[23] + (size_t)l * D * 2048, (bf16_t*)(ws + W_CKV) + (size_t)l * 2048 * D, D, 2048, 2048, smem);
        convert_weight(p.in[24] + (size_t)l * D * D, (bf16_t*)(ws + W_CO) + (size_t)l * D * D, D, D, D, smem);
        convert_weight(p.in[26] + (size_t)l * D * 2 * DFF, (bf16_t*)(ws + W_GU) + (size_t)l * 2 * DFF * D, D, 2 * DFF, 2 * DFF, smem);
        convert_weight(p.in[27] + (size_t)l * DFF * D, (bf16_t*)(ws + W_DOWN) + (size_t)l * D * DFF, DFF, D, D, smem);
        rmsnorm_rows(p.in[2], p.in[21] + l * D, (bf16_t*)(ws + B_MEMN) + (size_t)l * NBATCH * NMEM * D, 8 * NMEM);
        rmsnorm_rows(p.in[3], p.in[21] + l * D, (bf16_t*)(ws + B_MEMN) + (size_t)l * NBATCH * NMEM * D + (size_t)8 * NMEM * D, 16 * NMEM);
    }
    build_tables(ax, lin);
    grid.sync();
    for (int l = 0; l < 2; ++l) {
        EpiMemKV e{(bf16_t*)(ws + B_KX) + (size_t)l * NBATCH * NMEM * D, (bf16_t*)(ws + B_VXT) + (size_t)l * NBATCH * NMEM * D};
        gemm_phase((const bf16_t*)(ws + B_MEMN) + (size_t)l * NBATCH * NMEM * D, D, (const bf16_t*)(ws + W_CKV) + (size_t)l * 2048 * D, D, NBATCH * NMEM, 2048, D, e, smem);
    }
    grid.sync();

    for (int ch = 0; ch < NCHUNK; ++ch) {
        const float* xin = (ch == 0) ? p.in[0] : p.in[1] + (size_t)(ch - 1) * TC * D;
        float* xo = p.out + (size_t)ch * TC * D;
        for (int layer = 0; layer < 2; ++layer) {
            const float* xcur = (layer == 0) ? xin : xo;
            rmsnorm_rows(xcur, p.in[4] + layer * D, H, TC);
            grid.sync();
            const bf16_t* wout;
            if (layer == 0) {
                bf16_t* qkv = (bf16_t*)(ws + E_QKV); bf16_t* vt = (bf16_t*)(ws + E_VT);
                { EpiEven e{qkv, vt}; gemm_phase(H, D, wEin, D, TC, EVEN_IN, D, e, smem); }
                grid.sync();
                kprep_even(qkv, p.in[7], ax);
                grid.sync();
                attn_even(qkv, vt, (float*)(ws + E_PARK), MIX, p, ax, 0.2f, smem);
                wout = wEout;
            } else {
                bf16_t* a = (bf16_t*)(ws + O_A); bf16_t* qb = (bf16_t*)(ws + O_Q); bf16_t* kn = (bf16_t*)(ws + O_KN); bf16_t* vt = (bf16_t*)(ws + O_VT);
                { EpiBf16 e{a, ODD_PAD}; gemm_phase(H, D, wOin, D, TC, ODD_PAD, D, e, smem); }
                grid.sync();
                prep_odd(a, p.in[15], p.in[16], lin);
                grid.sync();
                { EpiBf16 e{qb, 1536}; gemm_phase(a, ODD_PAD, wUq, 384, TC, 1536, 384, e, smem); }
                { EpiMlaKV e{kn, vt}; gemm_phase(a + 384, ODD_PAD, wUkv, 256, TC, 2048, 256, e, smem); }
                grid.sync();
                attn_mla(qb, kn, a, vt, MIX, lin, smem);
                wout = wOout;
            }
            grid.sync();
            { EpiResid e{xcur, xo}; gemm_phase(MIX, D, wout, D, TC, D, D, e, smem); }
            grid.sync();
            rmsnorm_rows(xo, p.in[20] + layer * D, H, TC);
            grid.sync();
            { EpiBf16 e{(bf16_t*)(ws + X_Q), D}; gemm_phase(H, D, (const bf16_t*)(ws + W_CQ) + (size_t)layer * D * D, D, TC, D, D, e, smem); }
            grid.sync();
            attn_cross((const bf16_t*)(ws + X_Q), (const bf16_t*)(ws + B_KX) + (size_t)layer * NBATCH * NMEM * D,
                       (const bf16_t*)(ws + B_VXT) + (size_t)layer * NBATCH * NMEM * D, MIX, ch * NB, smem);
            grid.sync();
            { EpiResid e{xo, xo}; gemm_phase(MIX, D, (const bf16_t*)(ws + W_CO) + (size_t)layer * D * D, D, TC, D, D, e, smem); }
            grid.sync();
            rmsnorm_rows(xo, p.in[25] + layer * D, H, TC);
            grid.sync();
            { EpiSwiglu e{(bf16_t*)(ws + F_ACT)}; gemm_phase(H, D, (const bf16_t*)(ws + W_GU) + (size_t)layer * 2 * DFF * D, D, TC, 2 * DFF, D, e, smem); }
            grid.sync();
            { EpiResid e{xo, xo}; gemm_phase((const bf16_t*)(ws + F_ACT), DFF, (const bf16_t*)(ws + W_DOWN) + (size_t)layer * D * DFF, DFF, TC, D, DFF, e, smem); }
            grid.sync();
        }
        rmsnorm_final(xo, p.in[28], TC);
    }
}

extern "C" void kernel_launch(void* const* d_in, const int* in_sizes, int n_in, void* d_out, int out_size, void* d_ws, size_t ws_size, hipStream_t stream) {
    static int grid_blocks = 0;
    if (!grid_blocks) {
        int dev = 0, cus = 0, per_cu = 0;
        (void)hipGetDevice(&dev);
        (void)hipDeviceGetAttribute(&cus, hipDeviceAttributeMultiprocessorCount, dev);
        (void)hipFuncSetAttribute((const void*)fwd_mega, hipFuncAttributeMaxDynamicSharedMemorySize, (int)LDS_BYTES);
        (void)hipOccupancyMaxActiveBlocksPerMultiprocessor(&per_cu, fwd_mega, THREADS, LDS_BYTES);
        if (per_cu > 2) per_cu = 2;
        if (per_cu < 1) per_cu = 1;
        grid_blocks = cus * per_cu;
    }
    static_assert(E_PARK + (size_t)1024 * 64 * THREADS * 4 <= O_END, "park");
    if (ws_size < O_END) { fprintf(stderr, "workspace too small: %zu < %zu\n", ws_size, (size_t)O_END); return; }
    Params p{};
    for (int i = 0; i < 29; ++i) p.in[i] = (const float*)d_in[i];
    p.out = (float*)d_out;
    p.ws = (char*)d_ws;
    void* args[] = {&p};
    hipError_t e = hipLaunchCooperativeKernel((void*)fwd_mega, dim3(grid_blocks), dim3(THREADS), args, LDS_BYTES, stream);
    if (e != hipSuccess) fprintf(stderr, "cooperative launch failed: %s (grid %d)\n", hipGetErrorString(e), grid_blocks);
}
```

```cpp
#include <hip/hip_runtime.h>
#include <hip/hip_cooperative_groups.h>
#include <cstdio>
#include <cstdint>
namespace cg = cooperative_groups;

typedef unsigned short bf16_t;
typedef short bf16x8 __attribute__((ext_vector_type(8)));
typedef float f32x16 __attribute__((ext_vector_type(16)));
typedef float f32x2 __attribute__((ext_vector_type(2)));
typedef unsigned u32x4 __attribute__((ext_vector_type(4)));
typedef float f32x4 __attribute__((ext_vector_type(4)));
typedef short s16x4 __attribute__((ext_vector_type(4)));
#define LDS_AS __attribute__((address_space(3)))
typedef __bf16 bf16x2_t __attribute__((ext_vector_type(2)));
#define DI __device__ __forceinline__
#define MFMA(a, b, c) __builtin_amdgcn_mfma_f32_32x32x16_bf16((a), (b), (c), 0, 0, 0)

constexpr int D = 1024, SEQ = 4096, NBATCH = 24, NB = 8  , NCHUNK = NBATCH / NB, TC = NB * SEQ;
constexpr int NMEM = 256, DFF = 2816, EVEN_IN = 2304, ODD_IN = 672, ODD_PAD = 768;
constexpr float EPS = 1e-6f, LOG2E = 1.4426950408889634f;
constexpr int THREADS = 512, NWAVE = THREADS / 64;
constexpr size_t LDS_BYTES = 131072;

constexpr size_t al(size_t x) { return (x + 255) & ~(size_t)255; }
constexpr size_t W_EIN = 0;
constexpr size_t W_EOUT = W_EIN + al((size_t)EVEN_IN * D * 2);
constexpr size_t W_OIN = W_EOUT + al((size_t)D * D * 2);
constexpr size_t W_UQ = W_OIN + al((size_t)ODD_PAD * D * 2);
constexpr size_t W_UKV = W_UQ + al((size_t)1536 * 384 * 2);
constexpr size_t W_OOUT = W_UKV + al((size_t)2048 * 256 * 2);
constexpr size_t W_CQ = W_OOUT + al((size_t)D * D * 2);
constexpr size_t W_CKV = W_CQ + 2 * al((size_t)D * D * 2);
constexpr size_t W_CO = W_CKV + 2 * al((size_t)2048 * D * 2);
constexpr size_t W_GU = W_CO + 2 * al((size_t)D * D * 2);
constexpr size_t W_DOWN = W_GU + 2 * al((size_t)2 * DFF * D * 2);
constexpr size_t T_AX = W_DOWN + 2 * al((size_t)D * DFF * 2);
constexpr size_t T_LIN = T_AX + al((size_t)SEQ * 32 * 8);
constexpr size_t B_MEMN = T_LIN + al((size_t)SEQ * 16 * 8);
constexpr size_t B_KX = B_MEMN + 2 * al((size_t)NBATCH * NMEM * D * 2);
constexpr size_t B_H = B_KX + 2 * al((size_t)NBATCH * NMEM * 2048 * 2);
constexpr size_t B_MIX = B_H + al((size_t)TC * D * 2);
constexpr size_t B_BIG = B_MIX + al((size_t)TC * D * 2);
constexpr size_t E_QKV = B_BIG;
constexpr size_t E_PARK = E_QKV + al((size_t)TC * EVEN_IN * 2);
constexpr size_t E_END = E_PARK + (size_t)256 * THREADS * 64 * 4;
constexpr size_t O_A = B_BIG;
constexpr size_t O_Q = O_A + al((size_t)TC * ODD_PAD * 2);
constexpr size_t O_KV = O_Q + al((size_t)TC * 1536 * 2);
constexpr size_t O_END = O_KV + al((size_t)TC * 2048 * 2);
constexpr size_t X_Q = B_BIG;
constexpr size_t F_ACT = B_BIG;

struct Params {
    const float* in[29];
    float* out;
    char* ws;
};

DI unsigned pack2(float lo, float hi) { f32x2 v = {lo, hi}; bf16x2_t b = __builtin_convertvector(v, bf16x2_t); return __builtin_bit_cast(unsigned, b); }
DI float bflo(unsigned u) { return __uint_as_float(u << 16); }
DI float bfhi(unsigned u) { return __uint_as_float(u & 0xffff0000u); }
DI int crow(int i, int h) { return (i & 3) + 8 * (i >> 2) + 4 * h; }
DI int swap23(int x) { return (x & ~12) | ((x & 4) << 1) | ((x & 8) >> 1); }
DI int otid() { int t = threadIdx.x; asm volatile("" : "+v"(t)); return t; }
DI float wave_sum(float v) {
#pragma unroll
    for (int o = 32; o >= 1; o >>= 1) v += __shfl_xor(v, o);
    return v;
}

DI void convert_weight(const float* __restrict__ src, bf16_t* __restrict__ dst, int K, int N, int Npad, char* smem) {
    float* t = (float*)smem;
    const int tid = otid();
    const int nkt = K / 64, nnt = Npad / 64;
    for (int tile = blockIdx.x; tile < nkt * nnt; tile += gridDim.x) {
        const int k0 = (tile / nnt) * 64, n0 = (tile % nnt) * 64;
#pragma unroll
        for (int i = 0; i < 8; ++i) {
            const int k = i * 8 + (tid >> 6), n = tid & 63;
            t[k * 65 + n] = (n0 + n < N) ? src[(size_t)(k0 + k) * N + n0 + n] : 0.f;
        }
        __syncthreads();
#pragma unroll
        for (int i = 0; i < 4; ++i) {
            const int n = i * 16 + (tid >> 5), k = (tid & 31) * 2;
            *(unsigned*)(dst + (size_t)(n0 + n) * K + k0 + k) = pack2(t[k * 65 + n], t[(k + 1) * 65 + n]);
        }
        __syncthreads();
    }
}

__device__ const float kFreq[16] = {1.000000000e+00f, 5.623413324e-01f, 3.162277639e-01f, 1.778279394e-01f, 1.000000015e-01f, 5.623413250e-02f, 3.162277490e-02f, 1.778279431e-02f,
                                    9.999999776e-03f, 5.623413250e-03f, 3.162277630e-03f, 1.778279431e-03f, 1.000000047e-03f, 5.623413017e-04f, 3.162277571e-04f, 1.778279402e-04f};
DI float2 sincos_acc(float ang) {
    const double x = (double)ang;
    const double n = __builtin_rint(x * 0.15915494309189535);
    double r = __builtin_fma(-n, 6.283185307179586, x);
    r = __builtin_fma(-n, 2.4492935982947064e-16, r);
    const double r2 = r * r;
    double s = 1.0, c = 1.0;
#pragma unroll
    for (int k = 13; k >= 1; --k) {
        s = 1.0 - r2 * s * (1.0 / (double)((2 * k) * (2 * k + 1)));
        c = 1.0 - r2 * c * (1.0 / (double)((2 * k - 1) * (2 * k)));
    }
    return make_float2((float)c, (float)(r * s));
}
DI void build_tables(float2* ax, float2* lin) {
    const int gt = blockIdx.x * THREADS + otid(), gs = gridDim.x * THREADS;
    for (int e = gt; e < SEQ * 32; e += gs) {
        const int pos = e >> 5, p = e & 31;
        const float base = (p < 16) ? (float)(pos >> 6) : (float)(pos & 63);
        ax[e] = sincos_acc(base * kFreq[p & 15]);
    }
    for (int e = gt; e < SEQ * 16; e += gs) {
        const int pos = e >> 4, p = e & 15;
        lin[e] = sincos_acc((float)pos * kFreq[p]);
    }
}

DI void rmsnorm_rows(const float* __restrict__ src, const float* __restrict__ g, bf16_t* __restrict__ dst, int nrows) {
    const int tid_ = otid(), lane = tid_ & 63, wv = blockIdx.x * NWAVE + (tid_ >> 6), nw = gridDim.x * NWAVE;
    for (int row = wv; row < nrows; row += nw) {
        const float4* s = (const float4*)(src + (size_t)row * D);
        float4 v[4]; float ss = 0.f;
#pragma unroll
        for (int i = 0; i < 4; ++i) { v[i] = s[i * 64 + lane]; ss += v[i].x * v[i].x + v[i].y * v[i].y + v[i].z * v[i].z + v[i].w * v[i].w; }
        ss = wave_sum(ss);
        const float rstd = rsqrtf(ss * (1.0f / D) + EPS);
#pragma unroll
        for (int i = 0; i < 4; ++i) {
            const float4 gg = ((const float4*)g)[i * 64 + lane];
            uint2 o; o.x = pack2(v[i].x * rstd * gg.x, v[i].y * rstd * gg.y); o.y = pack2(v[i].z * rstd * gg.z, v[i].w * rstd * gg.w);
            *(uint2*)(dst + (size_t)row * D + (i * 64 + lane) * 4) = o;
        }
    }
}
DI void rmsnorm_final(float* __restrict__ x, const float* __restrict__ g, int nrows) {
    const int tid_ = otid(), lane = tid_ & 63, wv = blockIdx.x * NWAVE + (tid_ >> 6), nw = gridDim.x * NWAVE;
    for (int row = wv; row < nrows; row += nw) {
        float4* s = (float4*)(x + (size_t)row * D);
        float4 v[4]; float ss = 0.f;
#pragma unroll
        for (int i = 0; i < 4; ++i) { v[i] = s[i * 64 + lane]; ss += v[i].x * v[i].x + v[i].y * v[i].y + v[i].z * v[i].z + v[i].w * v[i].w; }
        ss = wave_sum(ss);
        const float rstd = rsqrtf(ss * (1.0f / D) + EPS);
#pragma unroll
        for (int i = 0; i < 4; ++i) {
            const float4 gg = ((const float4*)g)[i * 64 + lane];
            float4 o; o.x = v[i].x * rstd * gg.x; o.y = v[i].y * rstd * gg.y; o.z = v[i].z * rstd * gg.z; o.w = v[i].w * rstd * gg.w;
            s[i * 64 + lane] = o;
        }
    }
}

DI void kprep_even(bf16_t* __restrict__ qkv, const float* __restrict__ gk, const float2* __restrict__ ax) {
    const int tid_ = otid(), gt = blockIdx.x * THREADS + tid_, gs = gridDim.x * THREADS;
    const int p = tid_ & 31;
    for (int v = gt >> 5; v < TC * 2; v += gs >> 5) {
        const int tok = v >> 1, kvh = v & 1;
        unsigned* ptr = (unsigned*)(qkv + (size_t)tok * EVEN_IN + 512 + kvh * 64 + 2 * p);
        const unsigned u = *ptr;
        const float x0 = bflo(u), x1 = bfhi(u);
        float ss = x0 * x0 + x1 * x1;
#pragma unroll
        for (int o = 16; o >= 1; o >>= 1) ss += __shfl_xor(ss, o);
        const float rstd = rsqrtf(ss * (1.0f / 64) + EPS);
        const float y0 = x0 * rstd * gk[2 * p], y1 = x1 * rstd * gk[2 * p + 1];
        const float2 cs = ax[(tok & (SEQ - 1)) * 32 + p];
        *ptr = pack2(y0 * cs.x - y1 * cs.y, y0 * cs.y + y1 * cs.x);
    }
}
DI void prep_odd(bf16_t* __restrict__ a, const float* __restrict__ gq, const float* __restrict__ gkv, const float2* __restrict__ lin) {
    const int tid_ = otid(), lane = tid_ & 63, wv = blockIdx.x * NWAVE + (tid_ >> 6), nw = gridDim.x * NWAVE;
    for (int row = wv; row < TC; row += nw) {
        unsigned* base = (unsigned*)(a + (size_t)row * ODD_PAD);
        unsigned uq[3], uk[2]; float sq = 0.f, sk = 0.f;
#pragma unroll
        for (int i = 0; i < 3; ++i) { uq[i] = base[i * 64 + lane]; const float a0 = bflo(uq[i]), a1 = bfhi(uq[i]); sq += a0 * a0 + a1 * a1; }
#pragma unroll
        for (int i = 0; i < 2; ++i) { uk[i] = base[192 + i * 64 + lane]; const float a0 = bflo(uk[i]), a1 = bfhi(uk[i]); sk += a0 * a0 + a1 * a1; }
        sq = wave_sum(sq); sk = wave_sum(sk);
        const float rq = rsqrtf(sq * (1.0f / 384) + EPS), rk = rsqrtf(sk * (1.0f / 256) + EPS);
#pragma unroll
        for (int i = 0; i < 3; ++i) { const int c = (i * 64 + lane) * 2; base[i * 64 + lane] = pack2(bflo(uq[i]) * rq * gq[c], bfhi(uq[i]) * rq * gq[c + 1]); }
#pragma unroll
        for (int i = 0; i < 2; ++i) { const int c = (i * 64 + lane) * 2; base[192 + i * 64 + lane] = pack2(bflo(uk[i]) * rk * gkv[c], bfhi(uk[i]) * rk * gkv[c + 1]); }
        if (lane < 16) {
            const unsigned u = base[320 + lane];
            const float x0 = bflo(u), x1 = bfhi(u);
            const float2 cs = lin[(row & (SEQ - 1)) * 16 + lane];
            base[320 + lane] = pack2(x0 * cs.x - x1 * cs.y, x0 * cs.y + x1 * cs.x);
        }
    }
}

namespace pg8 {
constexpr int BM = 256, BK = 64, HALF = 128, HTB = HALF * BK * 2, NXCD = 8, WGM = 8;
DI int lds_byte(int r, int c) { const int st = (r >> 4) * 2 + (c >> 5), rr = r & 15, cc = c & 31, ob = rr * 64 + cc * 2; return st * 1024 + (ob ^ (((ob >> 9) & 1) << 5)); }
DI void stage_rc(int b, int& R, int& C) { const int st = b / 1024, sb = b % 1024, swz = sb ^ (((sb >> 9) & 1) << 5); R = (st >> 1) * 16 + swz / 64; C = (st & 1) * 32 + (swz % 64) / 2; }
DI int perm32(int rho) { const int n = rho >> 4, i = rho & 15; return 8 * (i >> 2) + 4 * n + (i & 3); }
struct Unit { int pm, pn; };
struct Gemm { const bf16_t* A; const bf16_t* Bt; int M, NT, K, lda; size_t hstepB, tstepB; };
struct StaticOrder {
    int nM, nN, nwg, G, c;
    DI void init(int M, int NT, int G_, int c_) { nM = M / BM; nN = NT; nwg = nM * nN; G = G_; c = c_; }
    DI bool next(int i, Unit& u) const {
        const long L = (long)i * G + c; if (L >= nwg) return false;
        int wgid = (int)L; { const int q = nwg / NXCD, r = nwg % NXCD, xcd = wgid % NXCD, off = wgid / NXCD; wgid = (xcd < r ? xcd * (q + 1) : r * (q + 1) + (xcd - r) * q) + off; }
        const int nig = WGM * nN, gid = wgid / nig, fm = gid * WGM, gsz = (nM - fm) < WGM ? (nM - fm) : WGM;
        u.pm = fm + ((wgid % nig) % gsz); u.pn = (wgid % nig) / gsz; return true;
    }
};
template <class Epi>
DI void gemm_phase(LDS_AS unsigned char* lds, const Gemm g, const Epi& E) {
    StaticOrder S; S.init(g.M, g.NT, gridDim.x, blockIdx.x);
    const int tid = otid(), wid = __builtin_amdgcn_readfirstlane(tid >> 6), lane = tid & 63, wr = wid >> 2, wc = wid & 3, fr = lane & 15, fq = lane >> 4;
    const int K = g.K, nt = K / BK;
    unsigned voffA[2], voffB[2];
#pragma unroll
    for (int i = 0; i < 2; ++i) { int R, C; stage_rc(tid * 16 + i * 8192, R, C); const int Rb = Epi::PERM ? ((R & ~31) + perm32(R & 31)) : R;
        voffA[i] = (unsigned)(R * g.lda + C) * 2u; voffB[i] = (unsigned)(Rb * K + C) * 2u; }
    const size_t kstep = (size_t)(BK * 2);
    const size_t hstepA = (size_t)HALF * g.lda * 2, tstepA = 2 * hstepA, hstepB = g.hstepB, tstepB = g.tstepB;
    const unsigned ldsw = (unsigned)wid * 1024u;
    const int aoff = lds_byte(wr * 64 + fr, fq * 8), boff = lds_byte(wc * 32 + fr, fq * 8);
#define PG8_SA(b, h) (((b) * 2 + (h)) * HTB)
#define PG8_SB(b, h) ((4 + (b) * 2 + (h)) * HTB)
#define PG8_STAGE(bufoff, gbase, voff) do { _Pragma("unroll") for (int _i = 0; _i < 2; ++_i) \
        __builtin_amdgcn_global_load_lds((const unsigned*)((const char*)(gbase) + (voff)[_i]), (LDS_AS unsigned*)(lds + (bufoff) + ldsw + _i * 8192), 16, 0, 0); } while (0)
#define PG8_LDA(dst, b, h) do { _Pragma("unroll") for (int m = 0; m < 4; ++m) _Pragma("unroll") for (int k = 0; k < 2; ++k) dst[m][k] = *(const LDS_AS bf16x8*)(lds + PG8_SA(b, h) + aoff + m * 2048 + k * 1024); } while (0)
#define PG8_LDB(dst, b, h) do { _Pragma("unroll") for (int n = 0; n < 2; ++n) _Pragma("unroll") for (int k = 0; k < 2; ++k) dst[n][k] = *(const LDS_AS bf16x8*)(lds + PG8_SB(b, h) + boff + n * 2048 + k * 1024); } while (0)
#define PG8_MMA(ai, bj, At, Bt) do { __builtin_amdgcn_s_setprio(1); _Pragma("unroll") for (int m = 0; m < 4; ++m) _Pragma("unroll") for (int n = 0; n < 2; ++n) _Pragma("unroll") for (int k = 0; k < 2; ++k) \
        acc[ai][bj][m][n] = __builtin_amdgcn_mfma_f32_16x16x32_bf16(Bt[n][k], At[m][k], acc[ai][bj][m][n], 0, 0, 0); __builtin_amdgcn_s_setprio(0); } while (0)
#define PG8_WAIT_V(n) asm volatile("s_waitcnt vmcnt(" #n ")" ::: "memory")
#define PG8_WAIT_L(n) asm volatile("s_waitcnt lgkmcnt(" #n ")" ::: "memory")
#define PG8_BAR __builtin_amdgcn_s_barrier()
#define PG8_SCHED __builtin_amdgcn_sched_barrier(0)
    Unit cur, nxt; int ui = 0;
    if (!S.next(0, cur)) return;
    f32x4 acc[2][2][4][2];
#pragma unroll
    for (int a = 0; a < 2; ++a)
#pragma unroll
        for (int b = 0; b < 2; ++b)
#pragma unroll
            for (int m = 0; m < 4; ++m)
#pragma unroll
                for (int n = 0; n < 2; ++n) acc[a][b][m][n] = (f32x4){0.f, 0.f, 0.f, 0.f};
    bf16x8 At[4][2], B0[2][2], B1[2][2];
    const char* cA = (const char*)g.A + (size_t)cur.pm * tstepA; const char* cB = (const char*)g.Bt + (size_t)cur.pn * tstepB;
    PG8_STAGE(PG8_SB(0, 0), cB, voffB); PG8_STAGE(PG8_SA(0, 0), cA, voffA); PG8_STAGE(PG8_SB(0, 1), cB + hstepB, voffB); PG8_STAGE(PG8_SA(0, 1), cA + hstepA, voffA);
    if (wr == 1) PG8_BAR;
    PG8_WAIT_V(4); PG8_BAR;
    PG8_STAGE(PG8_SB(1, 0), cB + kstep, voffB); PG8_STAGE(PG8_SA(1, 0), cA + kstep, voffA); PG8_STAGE(PG8_SB(1, 1), cB + hstepB + kstep, voffB);
    PG8_WAIT_V(6); PG8_BAR;
    for (;;) {
        const bool has_next = S.next(ui + 1, nxt);
        const char* nA = has_next ? (const char*)g.A + (size_t)nxt.pm * tstepA : cA; const char* nB = has_next ? (const char*)g.Bt + (size_t)nxt.pn * tstepB : cB;
        for (int t = 0; t < nt; t += 2) {
            const bool last = (t == nt - 2);
            const char* a1 = cA + (size_t)(t + 1) * kstep;
            const char* a2 = last ? nA : cA + (size_t)(t + 2) * kstep; const char* b2 = last ? nB : cB + (size_t)(t + 2) * kstep;
            const char* a3 = a2 + kstep; const char* b3 = b2 + kstep;
            PG8_LDB(B0, 0, 0); PG8_SCHED; PG8_LDA(At, 0, 0); PG8_STAGE(PG8_SA(1, 1), a1 + hstepA, voffA);
            PG8_WAIT_L(8); PG8_BAR; PG8_WAIT_L(0); PG8_MMA(0, 0, At, B0); PG8_BAR; PG8_SCHED;
            PG8_LDB(B1, 0, 1); PG8_STAGE(PG8_SB(0, 0), b2, voffB);
            PG8_BAR; PG8_WAIT_L(0); PG8_MMA(0, 1, At, B1); PG8_BAR;
            PG8_LDA(At, 0, 1); PG8_STAGE(PG8_SA(0, 0), a2, voffA);
            PG8_BAR; PG8_WAIT_L(0); PG8_MMA(1, 0, At, B0); PG8_BAR; PG8_SCHED;
            PG8_STAGE(PG8_SB(0, 1), b2 + hstepB, voffB);
            PG8_WAIT_V(6); PG8_BAR; PG8_MMA(1, 1, At, B1); PG8_BAR;
            PG8_LDB(B0, 1, 0); PG8_SCHED; PG8_LDA(At, 1, 0); PG8_STAGE(PG8_SA(0, 1), a2 + hstepA, voffA);
            PG8_WAIT_L(8); PG8_BAR; PG8_WAIT_L(0); PG8_MMA(0, 0, At, B0); PG8_BAR; PG8_SCHED;
            PG8_LDB(B1, 1, 1); PG8_STAGE(PG8_SB(1, 0), b3, voffB);
            PG8_BAR; PG8_WAIT_L(0); PG8_MMA(0, 1, At, B1); PG8_BAR;
            PG8_LDA(At, 1, 1); PG8_STAGE(PG8_SA(1, 0), a3, voffA);
            PG8_BAR; PG8_WAIT_L(0); PG8_MMA(1, 0, At, B0); PG8_BAR; PG8_SCHED;
            PG8_STAGE(PG8_SB(1, 1), b3 + hstepB, voffB);
            PG8_WAIT_V(6); PG8_BAR; PG8_MMA(1, 1, At, B1); PG8_BAR;
        }
        E(acc, cur, wr, wc, fr, fq);
        if (!has_next) break;
#pragma unroll
        for (int a = 0; a < 2; ++a)
#pragma unroll
            for (int b = 0; b < 2; ++b)
#pragma unroll
                for (int m = 0; m < 4; ++m)
#pragma unroll
                    for (int n = 0; n < 2; ++n) acc[a][b][m][n] = (f32x4){0.f, 0.f, 0.f, 0.f};
        cur = nxt; cA = nA; cB = nB; ++ui;
    }
    PG8_WAIT_V(0);
    if (wr == 0) PG8_BAR;
    PG8_BAR;
#undef PG8_SA
#undef PG8_SB
#undef PG8_STAGE
#undef PG8_LDA
#undef PG8_LDB
#undef PG8_MMA
#undef PG8_WAIT_V
#undef PG8_WAIT_L
#undef PG8_BAR
#undef PG8_SCHED
}
struct EpiResid {
    static constexpr bool PERM = false;
    const float* res; float* out;
    DI void operator()(const f32x4 (&acc)[2][2][4][2], const Unit& u, int wr, int wc, int fr, int fq) const {
        const int row0 = u.pm * BM + wr * 64 + fr, col0 = u.pn * BM + wc * 32 + 4 * fq;
#pragma unroll
        for (int ai = 0; ai < 2; ++ai)
#pragma unroll
            for (int m = 0; m < 4; ++m) {
                const size_t rb = (size_t)(row0 + ai * HALF + m * 16) * D + col0;
#pragma unroll
                for (int bj = 0; bj < 2; ++bj)
#pragma unroll
                    for (int n = 0; n < 2; ++n) { const size_t idx = rb + bj * HALF + n * 16; *(f32x4*)(out + idx) = *(const f32x4*)(res + idx) + acc[ai][bj][m][n]; }
            }
    }
};
struct EpiBf16 {
    static constexpr bool PERM = true;
    bf16_t* out; int ld;
    DI void operator()(const f32x4 (&acc)[2][2][4][2], const Unit& u, int wr, int wc, int fr, int fq) const {
        const int row0 = u.pm * BM + wr * 64 + fr, col0 = u.pn * BM + wc * 32 + 8 * fq;
#pragma unroll
        for (int ai = 0; ai < 2; ++ai)
#pragma unroll
            for (int m = 0; m < 4; ++m) {
                bf16_t* rowp = out + (size_t)(row0 + ai * HALF + m * 16) * ld + col0;
#pragma unroll
                for (int bj = 0; bj < 2; ++bj) {
                    const f32x4 v0 = acc[ai][bj][m][0], v1 = acc[ai][bj][m][1];
                    u32x4 w; w.x = pack2(v0[0], v0[1]); w.y = pack2(v0[2], v0[3]); w.z = pack2(v1[0], v1[1]); w.w = pack2(v1[2], v1[3]);
                    *(u32x4*)(rowp + bj * HALF) = w;
                }
            }
    }
};
struct EpiSwiglu {
    static constexpr bool PERM = true;
    bf16_t* act;
    DI void operator()(const f32x4 (&acc)[2][2][4][2], const Unit& u, int wr, int wc, int fr, int fq) const {
        const int row0 = u.pm * BM + wr * 64 + fr, col0 = u.pn * HALF + wc * 32 + 8 * fq;
#pragma unroll
        for (int ai = 0; ai < 2; ++ai)
#pragma unroll
            for (int m = 0; m < 4; ++m) {
                float v[8];
#pragma unroll
                for (int n = 0; n < 2; ++n)
#pragma unroll
                    for (int j = 0; j < 4; ++j) { const float gg = acc[ai][0][m][n][j], uu = acc[ai][1][m][n][j]; v[4 * n + j] = gg * uu * __builtin_amdgcn_rcpf(1.0f + __builtin_amdgcn_exp2f(-gg * LOG2E)); }
                u32x4 w; w.x = pack2(v[0], v[1]); w.y = pack2(v[2], v[3]); w.z = pack2(v[4], v[5]); w.w = pack2(v[6], v[7]);
                *(u32x4*)(act + (size_t)(row0 + ai * HALF + m * 16) * DFF + col0) = w;
            }
    }
};
}
DI pg8::Gemm mk_gemm(const bf16_t* A, int lda, const bf16_t* Bt, int M, int N, int K) { return pg8::Gemm{A, Bt, M, N / 256, K, lda, (size_t)128 * K * 2, (size_t)256 * K * 2}; }

template <int DQK, int DV, int KT, int QMODE, bool ALIBI>
DI void attn_core(const bf16_t* __restrict__ q, int ldq, const bf16_t* __restrict__ k, int ldk, const bf16_t* __restrict__ k2, int ldk2,
                  const bf16_t* __restrict__ v, int ldv, int nkeys, int qpos0, float c, float slope2,
                  const float* __restrict__ qg, const float2* __restrict__ tab, char* smem, f32x16 (&o)[DV / 32], float& lsum) {
    constexpr int KROW = DQK * 2 + 16, VROW = DV * 2 + 16, KBYTES = KT * KROW, VBYTES = KT * VROW, STAGE = KBYTES + VBYTES;
    constexpr int KCPR = DQK / 8  , KTOT = KT * KCPR, NKC = (KTOT + THREADS - 1) / THREADS, VCPR = DV / 8, VTOT = KT * VCPR, NVC = (VTOT + THREADS - 1) / THREADS;
    constexpr int NST = KT / 32, NKS = DQK / 16, NDT = DV / 32;
    static_assert(2 * STAGE <= (int)LDS_BYTES, "lds");
    const int tid = otid(), lane = tid & 63, w = tid >> 6, r = lane & 31, h = lane >> 5;
    const int qpos = qpos0 + 32 * w + r;
    bf16x8 qf[NKS];
    {
        const bf16_t* qrow = q + (size_t)(32 * w + r) * ldq + 8 * h;
        u32x4 raw[NKS];
#pragma unroll
        for (int s = 0; s < NKS; ++s) raw[s] = *(const u32x4*)(qrow + 16 * s);
        if (QMODE == 1) {
            float ss = 0.f;
#pragma unroll
            for (int s = 0; s < NKS; ++s) {
                const unsigned u[4] = {raw[s].x, raw[s].y, raw[s].z, raw[s].w};
#pragma unroll
                for (int j = 0; j < 4; ++j) { const float a0 = bflo(u[j]), a1 = bfhi(u[j]); ss += a0 * a0 + a1 * a1; }
            }
            ss += __shfl_xor(ss, 32);
            const float rstd = rsqrtf(ss * (1.0f / 64) + EPS);
#pragma unroll
            for (int s = 0; s < NKS; ++s) {
                unsigned u[4] = {raw[s].x, raw[s].y, raw[s].z, raw[s].w};
#pragma unroll
                for (int j = 0; j < 4; ++j) {
                    const int d0 = 16 * s + 8 * h + 2 * j;
                    const float y0 = bflo(u[j]) * rstd * qg[d0], y1 = bfhi(u[j]) * rstd * qg[d0 + 1];
                    const float2 cs = tab[qpos * 32 + (d0 >> 1)];
                    u[j] = pack2(y0 * cs.x - y1 * cs.y, y0 * cs.y + y1 * cs.x);
                }
                raw[s] = u32x4{u[0], u[1], u[2], u[3]};
            }
        } else if (QMODE == 2) {
#pragma unroll
            for (int s = 4; s < NKS; ++s) {
                unsigned u[4] = {raw[s].x, raw[s].y, raw[s].z, raw[s].w};
#pragma unroll
                for (int j = 0; j < 4; ++j) {
                    const int p = 8 * (s - 4) + 4 * h + j;
                    const float y0 = bflo(u[j]), y1 = bfhi(u[j]);
                    const float2 cs = tab[qpos * 16 + p];
                    u[j] = pack2(y0 * cs.x - y1 * cs.y, y0 * cs.y + y1 * cs.x);
                }
                raw[s] = u32x4{u[0], u[1], u[2], u[3]};
            }
        }
#pragma unroll
        for (int s = 0; s < NKS; ++s) qf[s] = __builtin_bit_cast(bf16x8, raw[s]);
    }
    u32x4 rk[NKC], rv[NVC];
#define ATT_GLOAD(key0_)                                                                                              \
    {                                                                                                                 \
        _Pragma("unroll") for (int i = 0; i < NKC; ++i) {                                                             \
            const int cid = tid + THREADS * i, key = cid / KCPR, cc = cid - key * KCPR;                               \
            if (KTOT % THREADS == 0 || cid < KTOT) {                                                                  \
                const bf16_t* src;                                                                                    \
                if (QMODE == 2 && cc >= 8) src = k2 + (size_t)((key0_) + key) * ldk2 + (cc - 8) * 8;                   \
                else src = k + (size_t)((key0_) + key) * ldk + cc * 8;                                                \
                rk[i] = *(const u32x4*)src;                                                                           \
            }                                                                                                         \
        }                                                                                                             \
        _Pragma("unroll") for (int i = 0; i < NVC; ++i) {                                                             \
            const int cid = tid + THREADS * i, key = cid / VCPR, cc = cid - key * VCPR;                               \
            if (VTOT % THREADS == 0 || cid < VTOT) rv[i] = *(const u32x4*)(v + (size_t)((key0_) + key) * ldv + cc * 8); \
        }                                                                                                             \
    }
#define ATT_LSTORE(buf_)                                                                                              \
    {                                                                                                                 \
        char* st_ = smem + (buf_) * STAGE;                                                                            \
        _Pragma("unroll") for (int i = 0; i < NKC; ++i) {                                                             \
            const int cid = tid + THREADS * i, key = cid / KCPR, cc = cid - key * KCPR;                               \
            if (KTOT % THREADS == 0 || cid < KTOT) *(u32x4*)(st_ + key * KROW + cc * 16) = rk[i];                     \
        }                                                                                                             \
        _Pragma("unroll") for (int i = 0; i < NVC; ++i) {                                                             \
            const int cid = tid + THREADS * i, key = cid / VCPR, cc = cid - key * VCPR;                               \
            if (VTOT % THREADS == 0 || cid < VTOT) *(u32x4*)(st_ + KBYTES + key * VROW + cc * 16) = rv[i];            \
        }                                                                                                             \
    }
    float m = -1e30f, l = 0.f;
#pragma unroll
    for (int dt = 0; dt < NDT; ++dt)
#pragma unroll
        for (int i = 0; i < 16; ++i) o[dt][i] = 0.f;
    const int ntiles = nkeys / KT;
    const int vlane = (4 * h + ((lane & 15) >> 2)) * VROW + (16 * ((lane >> 4) & 1) + 4 * (lane & 3)) * 2;
    ATT_GLOAD(0) ATT_LSTORE(0) __syncthreads();
    for (int kt = 0; kt < ntiles; ++kt) {
        const bool more = kt + 1 < ntiles;
        if (more) ATT_GLOAD((kt + 1) * KT)
        const char* kb = smem + (kt & 1) * STAGE + r * KROW + h * 16;
        const char* vb = smem + (kt & 1) * STAGE + KBYTES + vlane;
        f32x16 x[NST];
#pragma unroll
        for (int st = 0; st < NST; ++st) {
#pragma unroll
            for (int i = 0; i < 16; ++i) x[st][i] = 0.f;
#pragma unroll
            for (int ks = 0; ks < NKS; ++ks) {
                const bf16x8 kf = *(const bf16x8*)(kb + 32 * st * KROW + ks * 32);
                x[st] = MFMA(kf, qf[ks], x[st]);
                if ((ks & 3) == 3) __builtin_amdgcn_sched_barrier(0);
            }
            __builtin_amdgcn_sched_barrier(0);
        }
        float mx = -1e30f;
        const float dq = (float)(qpos - (kt * KT + 4 * h));
#pragma unroll
        for (int st = 0; st < NST; ++st)
#pragma unroll
            for (int i = 0; i < 16; ++i) {
                float t = x[st][i] * c;
                if (ALIBI) t -= slope2 * fabsf(dq - (float)(32 * st + (i & 3) + 8 * (i >> 2)));
                x[st][i] = t; mx = fmaxf(mx, t);
            }
        mx = fmaxf(mx, __shfl_xor(mx, 32));
        const float mn = fmaxf(m, mx);
        const float alpha = __builtin_amdgcn_exp2f(m - mn);
        m = mn;
        float rs = 0.f;
#pragma unroll
        for (int st = 0; st < NST; ++st)
#pragma unroll
            for (int i = 0; i < 16; ++i) { const float pe = __builtin_amdgcn_exp2f(x[st][i] - mn); x[st][i] = pe; rs += pe; }
        l = l * alpha + rs;
        if (__any(alpha != 1.0f)) {
#pragma unroll
            for (int dt = 0; dt < NDT; ++dt)
#pragma unroll
                for (int i = 0; i < 16; ++i) o[dt][i] *= alpha;
        }
#pragma unroll
        for (int st = 0; st < NST; ++st)
#pragma unroll
            for (int s = 0; s < 2; ++s) {
                u32x4 pk;
                pk.x = pack2(x[st][8 * s + 0], x[st][8 * s + 1]); pk.y = pack2(x[st][8 * s + 2], x[st][8 * s + 3]);
                pk.z = pack2(x[st][8 * s + 4], x[st][8 * s + 5]); pk.w = pack2(x[st][8 * s + 6], x[st][8 * s + 7]);
                const bf16x8 pb = __builtin_bit_cast(bf16x8, pk);
#pragma unroll
                for (int dt = 0; dt < NDT; ++dt) {
                    const char* va = vb + (32 * st + 16 * s) * VROW + 64 * dt;
                    const s16x4 lo = __builtin_amdgcn_ds_read_tr16_b64_v4i16((LDS_AS s16x4*)(va));
                    const s16x4 hi = __builtin_amdgcn_ds_read_tr16_b64_v4i16((LDS_AS s16x4*)(va + 8 * VROW));
                    const bf16x8 vf = __builtin_shufflevector(lo, hi, 0, 1, 2, 3, 4, 5, 6, 7);
                    o[dt] = MFMA(vf, pb, o[dt]);
                }
                __builtin_amdgcn_sched_barrier(0);
            }
        if (more) ATT_LSTORE((kt + 1) & 1)
        __syncthreads();
    }
    lsum = l + __shfl_xor(l, 32);
}
template <int NDT>
DI void store_o(bf16_t* dst, int ld, f32x16 (&o)[NDT], float inv) {
    const int tid_ = otid(), lane = tid_ & 63, w = tid_ >> 6, r = lane & 31, h = lane >> 5;
    bf16_t* row = dst + (size_t)(32 * w + r) * ld + 4 * h;
#pragma unroll
    for (int dt = 0; dt < NDT; ++dt)
#pragma unroll
        for (int g = 0; g < 4; ++g) {
            uint2 vv; vv.x = pack2(o[dt][4 * g] * inv, o[dt][4 * g + 1] * inv); vv.y = pack2(o[dt][4 * g + 2] * inv, o[dt][4 * g + 3] * inv);
            *(uint2*)(row + 32 * dt + 8 * g) = vv;
        }
}
DI int swz_item(int base) {
    const int G = gridDim.x, i = blockIdx.x;
    if (G & 7) return base + i;
    return base + (i & 7) * (G >> 3) + (i >> 3);
}

constexpr int QT = SEQ / 256;
DI void attn_even(const bf16_t* qkv, float* park, bf16_t* mix, const Params& p, const float2* ax, float lam_init, char* smem) {
    float d1 = 0.f, d2 = 0.f;
    for (int i = 0; i < 64; ++i) { d1 += p.in[8][i] * p.in[9][i]; d2 += p.in[10][i] * p.in[11][i]; }
    const float lam = __expf(d1) - __expf(d2) + lam_init;
    const int tid_ = otid(), lane = tid_ & 63, h = lane >> 5;
    float4* mypark = (float4*)(park + ((size_t)blockIdx.x * THREADS + tid_) * 64);
    constexpr int NDIFF = NB * 4 * QT, NGQA = NB * 8 * QT;
    for (int base = 0; base < NDIFF + NGQA; base += gridDim.x) {
        const int it = swz_item(base);
        if (it >= NDIFF + NGQA) continue;
        if (it < NDIFF) {
            const int b = it / (4 * QT), hd = (it / QT) & 3, qt = it % QT;
            const size_t row0 = (size_t)b * SEQ + qt * 256;
            const float slope2 = exp2f(-2.0f * (hd + 1)) * LOG2E;
            const bf16_t* qp = qkv + row0 * EVEN_IN + 768 + hd * 128;
            const bf16_t* kp = qkv + (size_t)b * SEQ * EVEN_IN + 1280 + hd * 128;
            const bf16_t* vp = qkv + (size_t)b * SEQ * EVEN_IN + 1792 + hd * 128;
            f32x16 o0[4]; float l0;
            attn_core<64, 128, 64, 0, true>(qp, EVEN_IN, kp, EVEN_IN, nullptr, 0, vp, EVEN_IN, SEQ, qt * 256, 0.125f * LOG2E, slope2, nullptr, nullptr, smem, o0, l0);
            const float i0 = 1.0f / l0;
#pragma unroll
            for (int dt = 0; dt < 4; ++dt)
#pragma unroll
                for (int g = 0; g < 4; ++g) mypark[dt * 4 + g] = make_float4(o0[dt][4 * g] * i0, o0[dt][4 * g + 1] * i0, o0[dt][4 * g + 2] * i0, o0[dt][4 * g + 3] * i0);
            asm volatile("" ::: "memory");
            attn_core<64, 128, 64, 0, true>(qp + 64, EVEN_IN, kp + 64, EVEN_IN, nullptr, 0, vp, EVEN_IN, SEQ, qt * 256, 0.125f * LOG2E, slope2, nullptr, nullptr, smem, o0, l0);
            const float i1 = lam / l0;
            float ss = 0.f;
            asm volatile("" ::: "memory");
#pragma unroll
            for (int dt = 0; dt < 4; ++dt)
#pragma unroll
                for (int g = 0; g < 4; ++g) {
                    const float4 pv = mypark[dt * 4 + g];
                    const float pa[4] = {pv.x, pv.y, pv.z, pv.w};
#pragma unroll
                    for (int e = 0; e < 4; ++e) { const float vv = pa[e] - i1 * o0[dt][4 * g + e]; o0[dt][4 * g + e] = vv; ss += vv * vv; }
                }
            ss += __shfl_xor(ss, 32);
            const float rstd = rsqrtf(ss * (1.0f / 128) + EPS) * (1.0f - lam_init);
#pragma unroll
            for (int dt = 0; dt < 4; ++dt)
#pragma unroll
                for (int i = 0; i < 16; ++i) o0[dt][i] *= p.in[12][32 * dt + crow(i, h)];
            store_o<4>(mix + row0 * D + 512 + hd * 128, D, o0, rstd);
        } else {
            const int j = it - NDIFF;
            const int b = j / (8 * QT), hd = (j / QT) & 7, qt = j % QT, kvh = hd >> 2;
            const size_t row0 = (size_t)b * SEQ + qt * 256;
            f32x16 o[2]; float l;
            attn_core<64, 64, 64, 1, false>(qkv + row0 * EVEN_IN + hd * 64, EVEN_IN, qkv + (size_t)b * SEQ * EVEN_IN + 512 + kvh * 64, EVEN_IN, nullptr, 0,
                                            qkv + (size_t)b * SEQ * EVEN_IN + 640 + kvh * 64, EVEN_IN, SEQ, qt * 256, 0.125f * LOG2E, 0.f, p.in[6], ax, smem, o, l);
            store_o<2>(mix + row0 * D + hd * 64, D, o, 1.0f / l);
        }
    }
}
DI void attn_mla(const bf16_t* qb, const bf16_t* kv, const bf16_t* a, bf16_t* mix, const float2* lin, char* smem) {
    constexpr int NIT = NB * 16 * QT;
    for (int base = 0; base < NIT; base += gridDim.x) {
        const int it = swz_item(base);
        if (it >= NIT) continue;
        const int b = it / (16 * QT), hd = (it / QT) & 15, qt = it % QT;
        const size_t row0 = (size_t)b * SEQ + qt * 256;
        f32x16 o[2]; float l;
        attn_core<96, 64, 64, 2, false>(qb + row0 * 1536 + hd * 96, 1536, kv + (size_t)b * SEQ * 2048 + hd * 128, 2048, a + (size_t)b * SEQ * ODD_PAD + 640, ODD_PAD,
                                        kv + (size_t)b * SEQ * 2048 + hd * 128 + 64, 2048, SEQ, qt * 256, 0.10206207261596575f * LOG2E, 0.f, nullptr, lin, smem, o, l);
        store_o<2>(mix + row0 * D + hd * 64, D, o, 1.0f / l);
    }
}
DI void attn_cross(const bf16_t* qx, const bf16_t* kvx, bf16_t* mix, int seq0, char* smem) {
    constexpr int NIT = NB * 4 * QT * 2;
    for (int base = 0; base < NIT; base += gridDim.x) {
        const int it = swz_item(base);
        if (it >= NIT) continue;
        const int b = it / (8 * QT), hd = (it / (2 * QT)) & 3, qt = (it >> 1) % QT, half = it & 1;
        const size_t row0 = (size_t)b * SEQ + qt * 256;
        const bf16_t* kvb = kvx + (size_t)(seq0 + b) * NMEM * 2048;
        f32x16 o[4]; float l;
        attn_core<256, 128, 32, 0, false>(qx + row0 * D + hd * 256, D, kvb + hd * 256, 2048, nullptr, 0, kvb + 1024 + hd * 256 + half * 128, 2048, NMEM, 0,
                                          0.0625f * LOG2E, 0.f, nullptr, nullptr, smem, o, l);
        store_o<4>(mix + row0 * D + hd * 256 + half * 128, D, o, 1.0f / l);
    }
}

extern "C" __global__ void __launch_bounds__(THREADS, 2) fwd_mega(Params p) {
    extern __shared__ __attribute__((aligned(16))) char smem[];
    LDS_AS unsigned char* lds = (LDS_AS unsigned char*)smem;
    cg::grid_group grid = cg::this_grid();
    char* ws = p.ws;
    bf16_t* wEin = (bf16_t*)(ws + W_EIN); bf16_t* wEout = (bf16_t*)(ws + W_EOUT); bf16_t* wOin = (bf16_t*)(ws + W_OIN);
    bf16_t* wUq = (bf16_t*)(ws + W_UQ); bf16_t* wUkv = (bf16_t*)(ws + W_UKV); bf16_t* wOout = (bf16_t*)(ws + W_OOUT);
    float2* ax = (float2*)(ws + T_AX); float2* lin = (float2*)(ws + T_LIN);
    bf16_t* H = (bf16_t*)(ws + B_H); bf16_t* MIX = (bf16_t*)(ws + B_MIX);

    convert_weight(p.in[5], wEin, D, EVEN_IN, EVEN_IN, smem);
    convert_weight(p.in[13], wEout, D, D, D, smem);
    convert_weight(p.in[14], wOin, D, ODD_IN, ODD_PAD, smem);
    convert_weight(p.in[17], wUq, 384, 1536, 1536, smem);
    convert_weight(p.in[18], wUkv, 256, 2048, 2048, smem);
    convert_weight(p.in[19], wOout, D, D, D, smem);
    for (int l = 0; l < 2; ++l) {
        convert_weight(p.in[22] + (size_t)l * D * D, (bf16_t*)(ws + W_CQ) + (size_t)l * D * D, D, D, D, smem);
        convert_weight(p.in[23] + (size_t)l * D * 2048, (bf16_t*)(ws + W_CKV) + (size_t)l * 2048 * D, D, 2048, 2048, smem);
        convert_weight(p.in[24] + (size_t)l * D * D, (bf16_t*)(ws + W_CO) + (size_t)l * D * D, D, D, D, smem);
        convert_weight(p.in[26] + (size_t)l * D * 2 * DFF, (bf16_t*)(ws + W_GU) + (size_t)l * 2 * DFF * D, D, 2 * DFF, 2 * DFF, smem);
        convert_weight(p.in[27] + (size_t)l * DFF * D, (bf16_t*)(ws + W_DOWN) + (size_t)l * D * DFF, DFF, D, D, smem);
        rmsnorm_rows(p.in[2], p.in[21] + l * D, (bf16_t*)(ws + B_MEMN) + (size_t)l * NBATCH * NMEM * D, 8 * NMEM);
        rmsnorm_rows(p.in[3], p.in[21] + l * D, (bf16_t*)(ws + B_MEMN) + (size_t)l * NBATCH * NMEM * D + (size_t)8 * NMEM * D, 16 * NMEM);
    }
    build_tables(ax, lin);
    grid.sync();
    for (int l = 0; l < 2; ++l) {
        pg8::EpiBf16 e{(bf16_t*)(ws + B_KX) + (size_t)l * NBATCH * NMEM * 2048, 2048};
        pg8::gemm_phase(lds, mk_gemm((const bf16_t*)(ws + B_MEMN) + (size_t)l * NBATCH * NMEM * D, D, (const bf16_t*)(ws + W_CKV) + (size_t)l * 2048 * D, NBATCH * NMEM, 2048, D), e);
    }
    grid.sync();

    for (int ch = 0; ch < NCHUNK; ++ch) {
        const float* xin = (ch == 0) ? p.in[0] : p.in[1] + (size_t)(ch - 1) * TC * D;
        float* xo = p.out + (size_t)ch * TC * D;
        for (int layer = 0; layer < 2; ++layer) {
            const float* xcur = (layer == 0) ? xin : xo;
            rmsnorm_rows(xcur, p.in[4] + layer * D, H, TC);
            grid.sync();
            const bf16_t* wout;
            if (layer == 0) {
                bf16_t* qkv = (bf16_t*)(ws + E_QKV);
                { pg8::EpiBf16 e{qkv, EVEN_IN}; pg8::gemm_phase(lds, mk_gemm(H, D, wEin, TC, EVEN_IN, D), e); }
                grid.sync();
                kprep_even(qkv, p.in[7], ax);
                grid.sync();
                attn_even(qkv, (float*)(ws + E_PARK), MIX, p, ax, 0.2f, smem);
                wout = wEout;
            } else {
                bf16_t* a = (bf16_t*)(ws + O_A); bf16_t* qb = (bf16_t*)(ws + O_Q); bf16_t* kv = (bf16_t*)(ws + O_KV);
                { pg8::EpiBf16 e{a, ODD_PAD}; pg8::gemm_phase(lds, mk_gemm(H, D, wOin, TC, ODD_PAD, D), e); }
                grid.sync();
                prep_odd(a, p.in[15], p.in[16], lin);
                grid.sync();
                { pg8::EpiBf16 e{qb, 1536}; pg8::gemm_phase(lds, mk_gemm(a, ODD_PAD, wUq, TC, 1536, 384), e); }
                { pg8::EpiBf16 e{kv, 2048}; pg8::gemm_phase(lds, mk_gemm(a + 384, ODD_PAD, wUkv, TC, 2048, 256), e); }
                grid.sync();
                attn_mla(qb, kv, a, MIX, lin, smem);
                wout = wOout;
            }
            grid.sync();
            { pg8::EpiResid e{xcur, xo}; pg8::gemm_phase(lds, mk_gemm(MIX, D, wout, TC, D, D), e); }
            grid.sync();
            rmsnorm_rows(xo, p.in[20] + layer * D, H, TC);
            grid.sync();
            { pg8::EpiBf16 e{(bf16_t*)(ws + X_Q), D}; pg8::gemm_phase(lds, mk_gemm(H, D, (const bf16_t*)(ws + W_CQ) + (size_t)layer * D * D, TC, D, D), e); }
            grid.sync();
            attn_cross((const bf16_t*)(ws + X_Q), (const bf16_t*)(ws + B_KX) + (size_t)layer * NBATCH * NMEM * 2048, MIX, ch * NB, smem);
            grid.sync();
            { pg8::EpiResid e{xo, xo}; pg8::gemm_phase(lds, mk_gemm(MIX, D, (const bf16_t*)(ws + W_CO) + (size_t)layer * D * D, TC, D, D), e); }
            grid.sync();
            rmsnorm_rows(xo, p.in[25] + layer * D, H, TC);
            grid.sync();
            { pg8::EpiSwiglu e{(bf16_t*)(ws + F_ACT)};
              pg8::Gemm g{H, (const bf16_t*)(ws + W_GU) + (size_t)layer * 2 * DFF * D, TC, DFF / 128, D, D, (size_t)DFF * D * 2, (size_t)128 * D * 2};
              pg8::gemm_phase(lds, g, e); }
            grid.sync();
            { pg8::EpiResid e{xo, xo}; pg8::gemm_phase(lds, mk_gemm((const bf16_t*)(ws + F_ACT), DFF, (const bf16_t*)(ws + W_DOWN) + (size_t)layer * D * DFF, TC, D, DFF), e); }
            grid.sync();
        }
        rmsnorm_final(xo, p.in[28], TC);
    }
}

extern "C" void kernel_launch(void* const* d_in, const int* in_sizes, int n_in, void* d_out, int out_size, void* d_ws, size_t ws_size, hipStream_t stream) {
    static int grid_blocks = 0;
    if (!grid_blocks) {
        int dev = 0, cus = 0, per_cu = 0;
        (void)hipGetDevice(&dev);
        (void)hipDeviceGetAttribute(&cus, hipDeviceAttributeMultiprocessorCount, dev);
        (void)hipFuncSetAttribute((const void*)fwd_mega, hipFuncAttributeMaxDynamicSharedMemorySize, (int)LDS_BYTES);
        (void)hipOccupancyMaxActiveBlocksPerMultiprocessor(&per_cu, fwd_mega, THREADS, LDS_BYTES);
        if (per_cu > 1) per_cu = 1;
        if (per_cu < 1) per_cu = 1;
        grid_blocks = cus * per_cu;
    }
    constexpr size_t WS_END = (O_END > E_END ? O_END : E_END) > (F_ACT + (size_t)TC * DFF * 2) ? (O_END > E_END ? O_END : E_END) : (F_ACT + (size_t)TC * DFF * 2);
    if (ws_size < WS_END) { fprintf(stderr, "workspace too small: %zu < %zu\n", ws_size, (size_t)WS_END); return; }
    if (grid_blocks > 256) grid_blocks = 256;
    Params p{};
    for (int i = 0; i < 29; ++i) p.in[i] = (const float*)d_in[i];
    p.out = (float*)d_out;
    p.ws = (char*)d_ws;
    void* args[] = {&p};
    hipError_t e = hipLaunchCooperativeKernel((void*)fwd_mega, dim3(grid_blocks), dim3(THREADS), args, LDS_BYTES, stream);
    if (e != hipSuccess) fprintf(stderr, "cooperative launch failed: %s (grid %d)\n", hipGetErrorString(e), grid_blocks);
}
```

```cpp
#include <hip/hip_runtime.h>
#include <hip/hip_cooperative_groups.h>
#include <cstdio>
#include <cstdint>
namespace cg = cooperative_groups;
#ifndef PROBE_GEMM
#define PROBE_GEMM 1
#endif
#ifndef PROBE_NORM
#define PROBE_NORM 1
#endif
#ifndef PROBE_CROSS
#define PROBE_CROSS 1
#endif
#ifndef PROBE_ATTN
#define PROBE_ATTN 1
#endif

typedef unsigned short bf16_t;
typedef short bf16x8 __attribute__((ext_vector_type(8)));
typedef float f32x16 __attribute__((ext_vector_type(16)));
typedef float f32x2 __attribute__((ext_vector_type(2)));
typedef unsigned u32x4 __attribute__((ext_vector_type(4)));
typedef float f32x4 __attribute__((ext_vector_type(4)));
typedef short s16x4 __attribute__((ext_vector_type(4)));
#define LDS_AS __attribute__((address_space(3)))
typedef __bf16 bf16x2_t __attribute__((ext_vector_type(2)));
#define DI __device__ __forceinline__
#define MFMA(a, b, c) __builtin_amdgcn_mfma_f32_32x32x16_bf16((a), (b), (c), 0, 0, 0)

constexpr int D = 1024, SEQ = 4096, NBATCH = 24, NB = 8  , NCHUNK = NBATCH / NB, TC = NB * SEQ;
constexpr int NMEM = 256, DFF = 2816, EVEN_IN = 2304, ODD_IN = 672, ODD_PAD = 768;
constexpr float EPS = 1e-6f, LOG2E = 1.4426950408889634f;
constexpr int THREADS = 512, NWAVE = THREADS / 64;
constexpr size_t LDS_BYTES = 131072;

constexpr size_t al(size_t x) { return (x + 255) & ~(size_t)255; }
constexpr size_t B_BAR = 0;
constexpr size_t W_EIN = 16384;
constexpr size_t W_EOUT = W_EIN + al((size_t)EVEN_IN * D * 2);
constexpr size_t W_OIN = W_EOUT + al((size_t)D * D * 2);
constexpr size_t W_UQ = W_OIN + al((size_t)ODD_PAD * D * 2);
constexpr size_t W_UKV = W_UQ + al((size_t)1536 * 384 * 2);
constexpr size_t W_OOUT = W_UKV + al((size_t)2048 * 256 * 2);
constexpr size_t W_CQ = W_OOUT + al((size_t)D * D * 2);
constexpr size_t W_CKV = W_CQ + 2 * al((size_t)D * D * 2);
constexpr size_t W_CO = W_CKV + 2 * al((size_t)2048 * D * 2);
constexpr size_t W_GU = W_CO + 2 * al((size_t)D * D * 2);
constexpr size_t W_DOWN = W_GU + 2 * al((size_t)2 * DFF * D * 2);
constexpr size_t T_AX = W_DOWN + 2 * al((size_t)D * DFF * 2);
constexpr size_t T_LIN = T_AX + al((size_t)SEQ * 32 * 8);
constexpr size_t B_MEMN = T_LIN + al((size_t)SEQ * 16 * 8);
constexpr size_t B_KX = B_MEMN + 2 * al((size_t)NBATCH * NMEM * D * 2);
constexpr size_t B_H = B_KX + 2 * al((size_t)NBATCH * NMEM * 2048 * 2);
constexpr size_t B_MIX = B_H + al((size_t)TC * D * 2);
constexpr size_t B_BIG = B_MIX + al((size_t)TC * D * 2);
constexpr size_t E_QKV = B_BIG;
constexpr size_t E_PARK = E_QKV + al((size_t)TC * EVEN_IN * 2);
constexpr size_t E_END = E_PARK + (size_t)256 * THREADS * 64 * 4;
constexpr size_t O_A = B_BIG;
constexpr size_t O_Q = O_A + al((size_t)TC * ODD_PAD * 2);
constexpr size_t O_KV = O_Q + al((size_t)TC * 1536 * 2);
constexpr size_t O_END = O_KV + al((size_t)TC * 2048 * 2);
constexpr size_t X_Q = B_BIG;
constexpr size_t F_ACT = B_BIG;

struct Params {
    const float* in[29];
    float* out;
    char* ws;
};

DI unsigned pack2(float lo, float hi) { f32x2 v = {lo, hi}; bf16x2_t b = __builtin_convertvector(v, bf16x2_t); return __builtin_bit_cast(unsigned, b); }
DI float bflo(unsigned u) { return __uint_as_float(u << 16); }
DI float bfhi(unsigned u) { return __uint_as_float(u & 0xffff0000u); }
DI int crow(int i, int h) { return (i & 3) + 8 * (i >> 2) + 4 * h; }
DI int swap23(int x) { return (x & ~12) | ((x & 4) << 1) | ((x & 8) >> 1); }
DI int otid() { int t = threadIdx.x; asm volatile("" : "+v"(t)); return t; }
DI float wave_sum(float v) {
#pragma unroll
    for (int o = 32; o >= 1; o >>= 1) v += __shfl_xor(v, o);
    return v;
}


#define XB_TMO      128
#define XB_XCNT(j)  (256  + 64 * (j))
#define XB_XSUB(j)  (1280 + 64 * (j))
#define XB_XGEN(j)  (2304 + 64 * (j))
#define XB_TOP      3328
#define XB_TOPGEN   3392
#define XCD_BAR_WORDS 3456
#define XB_SPIN_CAP (1u << 18)
DI unsigned xb_ld(unsigned* p) { return __hip_atomic_load(p, __ATOMIC_RELAXED, __HIP_MEMORY_SCOPE_AGENT); }
DI unsigned xb_add(unsigned* p, unsigned v) { return __hip_atomic_fetch_add(p, v, __ATOMIC_RELAXED, __HIP_MEMORY_SCOPE_AGENT); }
DI unsigned xb_xcc_id() { return (unsigned)__builtin_amdgcn_s_getreg((3 << 11) | 20) & 0xFu; }
#define XB_SPIN(cond, bar) do { unsigned _sp = 0; while (cond) { __builtin_amdgcn_s_sleep(1); \
    if ((++_sp & 255u) == 0u) { if (xb_ld(&(bar)[XB_TMO])) break; if (_sp > XB_SPIN_CAP) { atomicAdd(&(bar)[XB_TMO], 1u); break; } } } } while (0)
struct XcdBarrier { unsigned* bar; unsigned x; volatile LDS_AS unsigned* st; };
DI XcdBarrier xcd_barrier_post(unsigned* bar, volatile LDS_AS unsigned* st) {
    XcdBarrier b; b.bar = bar; b.x = xb_xcc_id(); b.st = st;
    if (threadIdx.x == 0) (void)xb_add(&bar[XB_XCNT(b.x)], 1u);
    return b;
}
DI void xcd_barrier_complete(unsigned* bar, unsigned x, unsigned& nloc, unsigned& nx) {
    const unsigned G = gridDim.x * gridDim.y * gridDim.z;
    unsigned sum, cnt, mine, sp = 0u;
    for (;;) {
        sum = 0u; cnt = 0u; mine = 0u;
#pragma unroll
        for (unsigned j = 0; j < 16; ++j) { const unsigned c = xb_ld(&bar[XB_XCNT(j)]); sum += c; cnt += (c > 0u) ? 1u : 0u; mine = (j == x) ? c : mine; }
        if (sum == G) break;
        __builtin_amdgcn_s_sleep(1);
        if ((++sp & 255u) == 0u) { if (xb_ld(&bar[XB_TMO])) break; if (sp > XB_SPIN_CAP) { atomicAdd(&bar[XB_TMO], 1u); break; } }
    }
    nloc = mine > 0u ? mine : 1u; nx = cnt > 0u ? cnt : 1u;
}
DI void xcd_barrier(const XcdBarrier& b) {
    asm volatile("s_waitcnt vmcnt(0)" ::: "memory");
    __syncthreads();
    if (threadIdx.x == 0) {
        unsigned* bar = b.bar;
        __builtin_amdgcn_s_waitcnt(0);
        unsigned nloc = b.st[0], nx = b.st[1];
        if (nloc == 0u) { xcd_barrier_complete(bar, b.x, nloc, nx); b.st[0] = nloc; b.st[1] = nx; }
        const unsigned old = xb_add(&bar[XB_XSUB(b.x)], 1u);
        const unsigned gen = old / nloc;
        if (old + 1u == (gen + 1u) * nloc) {
            __builtin_amdgcn_fence(__ATOMIC_RELEASE, "agent");
            asm volatile("s_waitcnt vmcnt(0)" ::: "memory");
            const unsigned og = xb_add(&bar[XB_TOP], 1u);
            const unsigned tg = og / nx;
            if (og + 1u == (tg + 1u) * nx) xb_add(&bar[XB_TOPGEN], 1u);
            else XB_SPIN(xb_ld(&bar[XB_TOPGEN]) == tg, bar);
            __builtin_amdgcn_fence(__ATOMIC_ACQUIRE, "agent");
            xb_add(&bar[XB_XGEN(b.x)], 1u);
            asm volatile("s_waitcnt vmcnt(0)" ::: "memory");
        } else {
            XB_SPIN(xb_ld(&bar[XB_XGEN(b.x)]) == gen, bar);
            __builtin_amdgcn_fence(__ATOMIC_ACQUIRE, "agent");
            asm volatile("s_waitcnt vmcnt(0)" ::: "memory");
        }
    }
    __syncthreads();
}

DI void convert_weight(const float* __restrict__ src, bf16_t* __restrict__ dst, int K, int N, int Npad, char* smem, int slo = 0, int shi = 0, float scale = 1.0f) {
    float* t = (float*)smem;
    const int tid = otid();
    const int nkt = K / 64, nnt = Npad / 64;
    for (int tile = blockIdx.x; tile < nkt * nnt; tile += gridDim.x) {
        const int k0 = (tile / nnt) * 64, n0 = (tile % nnt) * 64;
#pragma unroll
        for (int i = 0; i < 8; ++i) {
            const int k = i * 8 + (tid >> 6), n = tid & 63;
            const float sc_ = (n0 + n >= slo && n0 + n < shi) ? scale : 1.0f;
            t[k * 65 + n] = (n0 + n < N) ? src[(size_t)(k0 + k) * N + n0 + n] * sc_ : 0.f;
        }
        __syncthreads();
#pragma unroll
        for (int i = 0; i < 4; ++i) {
            const int n = i * 16 + (tid >> 5), k = (tid & 31) * 2;
            *(unsigned*)(dst + (size_t)(n0 + n) * K + k0 + k) = pack2(t[k * 65 + n], t[(k + 1) * 65 + n]);
        }
        __syncthreads();
    }
}

__device__ const float kFreq[16] = {1.000000000e+00f, 5.623413324e-01f, 3.162277639e-01f, 1.778279394e-01f, 1.000000015e-01f, 5.623413250e-02f, 3.162277490e-02f, 1.778279431e-02f,
                                    9.999999776e-03f, 5.623413250e-03f, 3.162277630e-03f, 1.778279431e-03f, 1.000000047e-03f, 5.623413017e-04f, 3.162277571e-04f, 1.778279402e-04f};
DI float2 sincos_acc(float ang) {
    const double x = (double)ang;
    const double n = __builtin_rint(x * 0.15915494309189535);
    double r = __builtin_fma(-n, 6.283185307179586, x);
    r = __builtin_fma(-n, 2.4492935982947064e-16, r);
    const double r2 = r * r;
    double s = 1.0, c = 1.0;
#pragma unroll
    for (int k = 13; k >= 1; --k) {
        s = 1.0 - r2 * s * (1.0 / (double)((2 * k) * (2 * k + 1)));
        c = 1.0 - r2 * c * (1.0 / (double)((2 * k - 1) * (2 * k)));
    }
    return make_float2((float)c, (float)(r * s));
}
DI void build_tables(float2* ax, float2* lin) {
    const int gt = blockIdx.x * THREADS + otid(), gs = gridDim.x * THREADS;
    for (int e = gt; e < SEQ * 32; e += gs) {
        const int pos = e >> 5, p = e & 31;
        const float base = (p < 16) ? (float)(pos >> 6) : (float)(pos & 63);
        ax[e] = sincos_acc(base * kFreq[p & 15]);
    }
    for (int e = gt; e < SEQ * 16; e += gs) {
        const int pos = e >> 4, p = e & 15;
        lin[e] = sincos_acc((float)pos * kFreq[p]);
    }
}

DI void rmsnorm_rows(const float* __restrict__ src, const float* __restrict__ g, bf16_t* __restrict__ dst, int nrows) {
    const int tid_ = otid(), lane = tid_ & 63, wv = blockIdx.x * NWAVE + (tid_ >> 6), nw = gridDim.x * NWAVE;
    for (int row = wv; row < nrows; row += nw) {
        const float4* s = (const float4*)(src + (size_t)row * D);
        float4 v[4]; float ss = 0.f;
#pragma unroll
        for (int i = 0; i < 4; ++i) { v[i] = s[i * 64 + lane]; ss += v[i].x * v[i].x + v[i].y * v[i].y + v[i].z * v[i].z + v[i].w * v[i].w; }
        ss = wave_sum(ss);
        const float rstd = rsqrtf(ss * (1.0f / D) + EPS);
#pragma unroll
        for (int i = 0; i < 4; ++i) {
            const float4 gg = ((const float4*)g)[i * 64 + lane];
            uint2 o; o.x = pack2(v[i].x * rstd * gg.x, v[i].y * rstd * gg.y); o.y = pack2(v[i].z * rstd * gg.z, v[i].w * rstd * gg.w);
            *(uint2*)(dst + (size_t)row * D + (i * 64 + lane) * 4) = o;
        }
    }
}
DI void rmsnorm_final(float* __restrict__ x, const float* __restrict__ g, int nrows) {
    const int tid_ = otid(), lane = tid_ & 63, wv = blockIdx.x * NWAVE + (tid_ >> 6), nw = gridDim.x * NWAVE;
    for (int row = wv; row < nrows; row += nw) {
        float4* s = (float4*)(x + (size_t)row * D);
        float4 v[4]; float ss = 0.f;
#pragma unroll
        for (int i = 0; i < 4; ++i) { v[i] = s[i * 64 + lane]; ss += v[i].x * v[i].x + v[i].y * v[i].y + v[i].z * v[i].z + v[i].w * v[i].w; }
        ss = wave_sum(ss);
        const float rstd = rsqrtf(ss * (1.0f / D) + EPS);
#pragma unroll
        for (int i = 0; i < 4; ++i) {
            const float4 gg = ((const float4*)g)[i * 64 + lane];
            float4 o; o.x = v[i].x * rstd * gg.x; o.y = v[i].y * rstd * gg.y; o.z = v[i].z * rstd * gg.z; o.w = v[i].w * rstd * gg.w;
            s[i * 64 + lane] = o;
        }
    }
}

DI void kprep_even(bf16_t* __restrict__ qkv, const float* __restrict__ gk, const float2* __restrict__ ax) {
    const int tid_ = otid(), gt = blockIdx.x * THREADS + tid_, gs = gridDim.x * THREADS;
    const int p = tid_ & 31;
    for (int v = gt >> 5; v < TC * 2; v += gs >> 5) {
        const int tok = v >> 1, kvh = v & 1;
        unsigned* ptr = (unsigned*)(qkv + (size_t)tok * EVEN_IN + 512 + kvh * 64 + 2 * p);
        const unsigned u = *ptr;
        const float x0 = bflo(u), x1 = bfhi(u);
        float ss = x0 * x0 + x1 * x1;
#pragma unroll
        for (int o = 16; o >= 1; o >>= 1) ss += __shfl_xor(ss, o);
        const float rstd = rsqrtf(ss * (1.0f / 64) + EPS);
        const float y0 = x0 * rstd * gk[2 * p], y1 = x1 * rstd * gk[2 * p + 1];
        const float2 cs = ax[(tok & (SEQ - 1)) * 32 + p];
        *ptr = pack2(y0 * cs.x - y1 * cs.y, y0 * cs.y + y1 * cs.x);
    }
}
DI void prep_odd(bf16_t* __restrict__ a, const float* __restrict__ gq, const float* __restrict__ gkv, const float2* __restrict__ lin) {
    const int tid_ = otid(), lane = tid_ & 63, wv = blockIdx.x * NWAVE + (tid_ >> 6), nw = gridDim.x * NWAVE;
    for (int row = wv; row < TC; row += nw) {
        unsigned* base = (unsigned*)(a + (size_t)row * ODD_PAD);
        unsigned uq[3], uk[2]; float sq = 0.f, sk = 0.f;
#pragma unroll
        for (int i = 0; i < 3; ++i) { uq[i] = base[i * 64 + lane]; const float a0 = bflo(uq[i]), a1 = bfhi(uq[i]); sq += a0 * a0 + a1 * a1; }
#pragma unroll
        for (int i = 0; i < 2; ++i) { uk[i] = base[192 + i * 64 + lane]; const float a0 = bflo(uk[i]), a1 = bfhi(uk[i]); sk += a0 * a0 + a1 * a1; }
        sq = wave_sum(sq); sk = wave_sum(sk);
        const float rq = rsqrtf(sq * (1.0f / 384) + EPS), rk = rsqrtf(sk * (1.0f / 256) + EPS);
#pragma unroll
        for (int i = 0; i < 3; ++i) { const int c = (i * 64 + lane) * 2; base[i * 64 + lane] = pack2(bflo(uq[i]) * rq * gq[c], bfhi(uq[i]) * rq * gq[c + 1]); }
#pragma unroll
        for (int i = 0; i < 2; ++i) { const int c = (i * 64 + lane) * 2; base[192 + i * 64 + lane] = pack2(bflo(uk[i]) * rk * gkv[c], bfhi(uk[i]) * rk * gkv[c + 1]); }
        if (lane < 16) {
            const unsigned u = base[320 + lane];
            const float x0 = bflo(u), x1 = bfhi(u);
            const float2 cs = lin[(row & (SEQ - 1)) * 16 + lane];
            base[320 + lane] = pack2(x0 * cs.x - x1 * cs.y, x0 * cs.y + x1 * cs.x);
        }
    }
}

namespace pg8 {
constexpr int BM = 256, BK = 64, HALF = 128, HTB = HALF * BK * 2, NXCD = 8, WGM = 8;
DI int lds_byte(int r, int c) { const int st = (r >> 4) * 2 + (c >> 5), rr = r & 15, cc = c & 31, ob = rr * 64 + cc * 2; return st * 1024 + (ob ^ (((ob >> 9) & 1) << 5)); }
DI void stage_rc(int b, int& R, int& C) { const int st = b / 1024, sb = b % 1024, swz = sb ^ (((sb >> 9) & 1) << 5); R = (st >> 1) * 16 + swz / 64; C = (st & 1) * 32 + (swz % 64) / 2; }
DI int perm32(int rho) { const int n = rho >> 4, i = rho & 15; return 8 * (i >> 2) + 4 * n + (i & 3); }
struct Unit { int pm, pn; };
struct Gemm { const bf16_t* A; const bf16_t* Bt; int M, NT, K, lda; size_t hstepB, tstepB; };
struct StaticOrder {
    int nM, nN, nwg, G, c;
    DI void init(int M, int NT, int G_, int c_) { nM = M / BM; nN = NT; nwg = nM * nN; G = G_; c = c_; }
    DI bool next(int i, Unit& u) const {
        const long L = (long)i * G + c; if (L >= nwg) return false;
        int wgid = (int)L; { const int q = nwg / NXCD, r = nwg % NXCD, xcd = wgid % NXCD, off = wgid / NXCD; wgid = (xcd < r ? xcd * (q + 1) : r * (q + 1) + (xcd - r) * q) + off; }
        const int nig = WGM * nN, gid = wgid / nig, fm = gid * WGM, gsz = (nM - fm) < WGM ? (nM - fm) : WGM;
        u.pm = fm + ((wgid % nig) % gsz); u.pn = (wgid % nig) / gsz; return true;
    }
};
template <class Epi>
DI void gemm_phase(LDS_AS unsigned char* lds, const Gemm g, const Epi& E) {
    StaticOrder S; S.init(g.M, g.NT, gridDim.x, blockIdx.x);
    const int tid = otid(), wid = __builtin_amdgcn_readfirstlane(tid >> 6), lane = tid & 63, wr = wid >> 2, wc = wid & 3, fr = lane & 15, fq = lane >> 4;
    const int K = g.K, nt = K / BK;
    unsigned voffA[2], voffB[2];
#pragma unroll
    for (int i = 0; i < 2; ++i) { int R, C; stage_rc(tid * 16 + i * 8192, R, C); const int Rb = Epi::PERM ? ((R & ~31) + perm32(R & 31)) : R;
        voffA[i] = (unsigned)(R * g.lda + C) * 2u; voffB[i] = (unsigned)(Rb * K + C) * 2u; }
    const size_t kstep = (size_t)(BK * 2);
    const size_t hstepA = (size_t)HALF * g.lda * 2, tstepA = 2 * hstepA, hstepB = g.hstepB, tstepB = g.tstepB;
    const unsigned ldsw = (unsigned)wid * 1024u;
    const int aoff = lds_byte(wr * 64 + fr, fq * 8), boff = lds_byte(wc * 32 + fr, fq * 8);
#define PG8_SA(b, h) (((b) * 2 + (h)) * HTB)
#define PG8_SB(b, h) ((4 + (b) * 2 + (h)) * HTB)
#define PG8_STAGE(bufoff, gbase, voff) do { _Pragma("unroll") for (int _i = 0; _i < 2; ++_i) \
        __builtin_amdgcn_global_load_lds((const unsigned*)((const char*)(gbase) + (voff)[_i]), (LDS_AS unsigned*)(lds + (bufoff) + ldsw + _i * 8192), 16, 0, 0); } while (0)
#define PG8_LDA(dst, b, h) do { _Pragma("unroll") for (int m = 0; m < 4; ++m) _Pragma("unroll") for (int k = 0; k < 2; ++k) dst[m][k] = *(const LDS_AS bf16x8*)(lds + PG8_SA(b, h) + aoff + m * 2048 + k * 1024); } while (0)
#define PG8_LDB(dst, b, h) do { _Pragma("unroll") for (int n = 0; n < 2; ++n) _Pragma("unroll") for (int k = 0; k < 2; ++k) dst[n][k] = *(const LDS_AS bf16x8*)(lds + PG8_SB(b, h) + boff + n * 2048 + k * 1024); } while (0)
#define PG8_MMA(ai, bj, At, Bt) do { __builtin_amdgcn_s_setprio(1); _Pragma("unroll") for (int m = 0; m < 4; ++m) _Pragma("unroll") for (int n = 0; n < 2; ++n) _Pragma("unroll") for (int k = 0; k < 2; ++k) \
        acc[ai][bj][m][n] = __builtin_amdgcn_mfma_f32_16x16x32_bf16(Bt[n][k], At[m][k], acc[ai][bj][m][n], 0, 0, 0); __builtin_amdgcn_s_setprio(0); } while (0)
#define PG8_WAIT_V(n) asm volatile("s_waitcnt vmcnt(" #n ")" ::: "memory")
#define PG8_WAIT_L(n) asm volatile("s_waitcnt lgkmcnt(" #n ")" ::: "memory")
#define PG8_BAR __builtin_amdgcn_s_barrier()
#define PG8_SCHED __builtin_amdgcn_sched_barrier(0)
    Unit cur, nxt; int ui = 0;
    if (!S.next(0, cur)) return;
    f32x4 acc[2][2][4][2];
#pragma unroll
    for (int a = 0; a < 2; ++a)
#pragma unroll
        for (int b = 0; b < 2; ++b)
#pragma unroll
            for (int m = 0; m < 4; ++m)
#pragma unroll
                for (int n = 0; n < 2; ++n) acc[a][b][m][n] = (f32x4){0.f, 0.f, 0.f, 0.f};
    bf16x8 At[4][2], B0[2][2], B1[2][2];
    const char* cA = (const char*)g.A + (size_t)cur.pm * tstepA; const char* cB = (const char*)g.Bt + (size_t)cur.pn * tstepB;
    PG8_STAGE(PG8_SB(0, 0), cB, voffB); PG8_STAGE(PG8_SA(0, 0), cA, voffA); PG8_STAGE(PG8_SB(0, 1), cB + hstepB, voffB); PG8_STAGE(PG8_SA(0, 1), cA + hstepA, voffA);
    if (wr == 1) PG8_BAR;
    PG8_WAIT_V(4); PG8_BAR;
    PG8_STAGE(PG8_SB(1, 0), cB + kstep, voffB); PG8_STAGE(PG8_SA(1, 0), cA + kstep, voffA); PG8_STAGE(PG8_SB(1, 1), cB + hstepB + kstep, voffB);
    PG8_WAIT_V(6); PG8_BAR;
    for (;;) {
        const bool has_next = S.next(ui + 1, nxt);
        const char* nA = has_next ? (const char*)g.A + (size_t)nxt.pm * tstepA : cA; const char* nB = has_next ? (const char*)g.Bt + (size_t)nxt.pn * tstepB : cB;
        for (int t = 0; t < nt; t += 2) {
            const bool last = (t == nt - 2);
            const char* a1 = cA + (size_t)(t + 1) * kstep;
            const char* a2 = last ? nA : cA + (size_t)(t + 2) * kstep; const char* b2 = last ? nB : cB + (size_t)(t + 2) * kstep;
            const char* a3 = a2 + kstep; const char* b3 = b2 + kstep;
            PG8_LDB(B0, 0, 0); PG8_SCHED; PG8_LDA(At, 0, 0); PG8_STAGE(PG8_SA(1, 1), a1 + hstepA, voffA);
            PG8_WAIT_L(8); PG8_BAR; PG8_WAIT_L(0); PG8_MMA(0, 0, At, B0); PG8_BAR; PG8_SCHED;
            PG8_LDB(B1, 0, 1); PG8_STAGE(PG8_SB(0, 0), b2, voffB);
            PG8_BAR; PG8_WAIT_L(0); PG8_MMA(0, 1, At, B1); PG8_BAR;
            PG8_LDA(At, 0, 1); PG8_STAGE(PG8_SA(0, 0), a2, voffA);
            PG8_BAR; PG8_WAIT_L(0); PG8_MMA(1, 0, At, B0); PG8_BAR; PG8_SCHED;
            PG8_STAGE(PG8_SB(0, 1), b2 + hstepB, voffB);
            PG8_WAIT_V(6); PG8_BAR; PG8_MMA(1, 1, At, B1); PG8_BAR;
            PG8_LDB(B0, 1, 0); PG8_SCHED; PG8_LDA(At, 1, 0); PG8_STAGE(PG8_SA(0, 1), a2 + hstepA, voffA);
            PG8_WAIT_L(8); PG8_BAR; PG8_WAIT_L(0); PG8_MMA(0, 0, At, B0); PG8_BAR; PG8_SCHED;
            PG8_LDB(B1, 1, 1); PG8_STAGE(PG8_SB(1, 0), b3, voffB);
            PG8_BAR; PG8_WAIT_L(0); PG8_MMA(0, 1, At, B1); PG8_BAR;
            PG8_LDA(At, 1, 1); PG8_STAGE(PG8_SA(1, 0), a3, voffA);
            PG8_BAR; PG8_WAIT_L(0); PG8_MMA(1, 0, At, B0); PG8_BAR; PG8_SCHED;
            PG8_STAGE(PG8_SB(1, 1), b3 + hstepB, voffB);
            PG8_WAIT_V(6); PG8_BAR; PG8_MMA(1, 1, At, B1); PG8_BAR;
        }
        E(acc, cur, wr, wc, fr, fq);
        if (!has_next) break;
#pragma unroll
        for (int a = 0; a < 2; ++a)
#pragma unroll
            for (int b = 0; b < 2; ++b)
#pragma unroll
                for (int m = 0; m < 4; ++m)
#pragma unroll
                    for (int n = 0; n < 2; ++n) acc[a][b][m][n] = (f32x4){0.f, 0.f, 0.f, 0.f};
        cur = nxt; cA = nA; cB = nB; ++ui;
    }
    PG8_WAIT_V(0);
    if (wr == 0) PG8_BAR;
    PG8_BAR;
#undef PG8_SA
#undef PG8_SB
#undef PG8_STAGE
#undef PG8_LDA
#undef PG8_LDB
#undef PG8_MMA
#undef PG8_WAIT_V
#undef PG8_WAIT_L
#undef PG8_BAR
#undef PG8_SCHED
}
struct EpiResid {
    static constexpr bool PERM = false;
    const float* res; float* out;
    DI void operator()(const f32x4 (&acc)[2][2][4][2], const Unit& u, int wr, int wc, int fr, int fq) const {
        const int row0 = u.pm * BM + wr * 64 + fr, col0 = u.pn * BM + wc * 32 + 4 * fq;
#pragma unroll
        for (int ai = 0; ai < 2; ++ai)
#pragma unroll
            for (int m = 0; m < 4; ++m) {
                const size_t rb = (size_t)(row0 + ai * HALF + m * 16) * D + col0;
#pragma unroll
                for (int bj = 0; bj < 2; ++bj)
#pragma unroll
                    for (int n = 0; n < 2; ++n) { const size_t idx = rb + bj * HALF + n * 16; *(f32x4*)(out + idx) = *(const f32x4*)(res + idx) + acc[ai][bj][m][n]; }
            }
    }
};
struct EpiBf16 {
    static constexpr bool PERM = true;
    bf16_t* out; int ld;
    DI void operator()(const f32x4 (&acc)[2][2][4][2], const Unit& u, int wr, int wc, int fr, int fq) const {
        const int row0 = u.pm * BM + wr * 64 + fr, col0 = u.pn * BM + wc * 32 + 8 * fq;
#pragma unroll
        for (int ai = 0; ai < 2; ++ai)
#pragma unroll
            for (int m = 0; m < 4; ++m) {
                bf16_t* rowp = out + (size_t)(row0 + ai * HALF + m * 16) * ld + col0;
#pragma unroll
                for (int bj = 0; bj < 2; ++bj) {
                    const f32x4 v0 = acc[ai][bj][m][0], v1 = acc[ai][bj][m][1];
                    u32x4 w; w.x = pack2(v0[0], v0[1]); w.y = pack2(v0[2], v0[3]); w.z = pack2(v1[0], v1[1]); w.w = pack2(v1[2], v1[3]);
                    *(u32x4*)(rowp + bj * HALF) = w;
                }
            }
    }
};
struct EpiSwiglu {
    static constexpr bool PERM = true;
    bf16_t* act;
    DI void operator()(const f32x4 (&acc)[2][2][4][2], const Unit& u, int wr, int wc, int fr, int fq) const {
        const int row0 = u.pm * BM + wr * 64 + fr, col0 = u.pn * HALF + wc * 32 + 8 * fq;
#pragma unroll
        for (int ai = 0; ai < 2; ++ai)
#pragma unroll
            for (int m = 0; m < 4; ++m) {
                float v[8];
#pragma unroll
                for (int n = 0; n < 2; ++n)
#pragma unroll
                    for (int j = 0; j < 4; ++j) { const float gg = acc[ai][0][m][n][j], uu = acc[ai][1][m][n][j]; v[4 * n + j] = gg * uu * __builtin_amdgcn_rcpf(1.0f + __builtin_amdgcn_exp2f(-gg * LOG2E)); }
                u32x4 w; w.x = pack2(v[0], v[1]); w.y = pack2(v[2], v[3]); w.z = pack2(v[4], v[5]); w.w = pack2(v[6], v[7]);
                *(u32x4*)(act + (size_t)(row0 + ai * HALF + m * 16) * DFF + col0) = w;
            }
    }
};
}
DI pg8::Gemm mk_gemm(const bf16_t* A, int lda, const bf16_t* Bt, int M, int N, int K) { return pg8::Gemm{A, Bt, M, N / 256, K, lda, (size_t)128 * K * 2, (size_t)256 * K * 2}; }

template <int DQK, int DV, int KT, int QMODE, bool ALIBI, bool NOMAX>
DI void attn_core(const bf16_t* __restrict__ q, int ldq, const bf16_t* __restrict__ k, int ldk, const bf16_t* __restrict__ k2, int ldk2,
                  const bf16_t* __restrict__ v, int ldv, int nkeys, int qpos0, float qscale, float slope2,
                  const float* __restrict__ qg, const float2* __restrict__ tab, char* smem, f32x16 (&o)[DV / 32], float& lsum) {
    constexpr int KROW = DQK * 2 + 16, VROW = DV * 2 + 16, KBYTES = KT * KROW, VBYTES = KT * VROW;
    constexpr int KCPR = DQK / 8  , KTOT = KT * KCPR, NKC = (KTOT + THREADS - 1) / THREADS, VCPR = DV / 8, VTOT = KT * VCPR, NVC = (VTOT + THREADS - 1) / THREADS;
    constexpr int NST = KT / 32, NKS = DQK / 16, NDT = DV / 32;
    static_assert(2 * (KBYTES + VBYTES) <= (int)LDS_BYTES, "lds");
    const int tid = otid(), lane = tid & 63, w = tid >> 6, r = lane & 31, h = lane >> 5;
    const int qpos = qpos0 + 32 * w + r;
    bf16x8 qf[NKS];
    {
        const bf16_t* qrow = q + (size_t)(32 * w + r) * ldq + 8 * h;
        u32x4 raw[NKS];
#pragma unroll
        for (int s = 0; s < NKS; ++s) raw[s] = *(const u32x4*)(qrow + 16 * s);
        if (QMODE == 1) {
            float ss = 0.f;
#pragma unroll
            for (int s = 0; s < NKS; ++s) {
                const unsigned u[4] = {raw[s].x, raw[s].y, raw[s].z, raw[s].w};
#pragma unroll
                for (int j = 0; j < 4; ++j) { const float a0 = bflo(u[j]), a1 = bfhi(u[j]); ss += a0 * a0 + a1 * a1; }
            }
            ss += __shfl_xor(ss, 32);
            const float rstd = rsqrtf(ss * (1.0f / 64) + EPS) * qscale;
#pragma unroll
            for (int s = 0; s < NKS; ++s) {
                unsigned u[4] = {raw[s].x, raw[s].y, raw[s].z, raw[s].w};
#pragma unroll
                for (int j = 0; j < 4; ++j) {
                    const int d0 = 16 * s + 8 * h + 2 * j;
                    const float y0 = bflo(u[j]) * rstd * qg[d0], y1 = bfhi(u[j]) * rstd * qg[d0 + 1];
                    const float2 cs = tab[qpos * 32 + (d0 >> 1)];
                    u[j] = pack2(y0 * cs.x - y1 * cs.y, y0 * cs.y + y1 * cs.x);
                }
                raw[s] = u32x4{u[0], u[1], u[2], u[3]};
            }
        } else if (QMODE == 2) {
#pragma unroll
            for (int s = 4; s < NKS; ++s) {
                unsigned u[4] = {raw[s].x, raw[s].y, raw[s].z, raw[s].w};
#pragma unroll
                for (int j = 0; j < 4; ++j) {
                    const int p = 8 * (s - 4) + 4 * h + j;
                    const float y0 = bflo(u[j]), y1 = bfhi(u[j]);
                    const float2 cs = tab[qpos * 16 + p];
                    u[j] = pack2(y0 * cs.x - y1 * cs.y, y0 * cs.y + y1 * cs.x);
                }
                raw[s] = u32x4{u[0], u[1], u[2], u[3]};
            }
        }
#pragma unroll
        for (int s = 0; s < NKS; ++s) qf[s] = __builtin_bit_cast(bf16x8, raw[s]);
    }
    u32x4 rk[NKC], rv[NVC];
    char* const kbuf = smem;
    char* const vbuf = smem + 2 * KBYTES;
#define ATT_GLOADK(key0_)                                                                                             \
    {                                                                                                                 \
        _Pragma("unroll") for (int i = 0; i < NKC; ++i) {                                                             \
            const int cid = tid + THREADS * i, key = cid / KCPR, cc = cid - key * KCPR;                               \
            if (KTOT % THREADS == 0 || cid < KTOT) {                                                                  \
                const bf16_t* src;                                                                                    \
                if (QMODE == 2 && cc >= 8) src = k2 + (size_t)((key0_) + key) * ldk2 + (cc - 8) * 8;                   \
                else src = k + (size_t)((key0_) + key) * ldk + cc * 8;                                                \
                rk[i] = *(const u32x4*)src;                                                                           \
            }                                                                                                         \
        }                                                                                                             \
    }
#define ATT_GLOADV(key0_)                                                                                             \
    {                                                                                                                 \
        _Pragma("unroll") for (int i = 0; i < NVC; ++i) {                                                             \
            const int cid = tid + THREADS * i, key = cid / VCPR, cc = cid - key * VCPR;                               \
            if (VTOT % THREADS == 0 || cid < VTOT) rv[i] = *(const u32x4*)(v + (size_t)((key0_) + key) * ldv + cc * 8); \
        }                                                                                                             \
    }
#define ATT_LSTOREK(buf_)                                                                                             \
    {                                                                                                                 \
        _Pragma("unroll") for (int i = 0; i < NKC; ++i) {                                                             \
            const int cid = tid + THREADS * i, key = cid / KCPR, cc = cid - key * KCPR;                               \
            if (KTOT % THREADS == 0 || cid < KTOT) *(u32x4*)(kbuf + (buf_) * KBYTES + key * KROW + cc * 16) = rk[i];  \
        }                                                                                                             \
    }
#define ATT_LSTOREV(buf_)                                                                                             \
    {                                                                                                                 \
        _Pragma("unroll") for (int i = 0; i < NVC; ++i) {                                                             \
            const int cid = tid + THREADS * i, key = cid / VCPR, cc = cid - key * VCPR;                               \
            if (VTOT % THREADS == 0 || cid < VTOT) *(u32x4*)(vbuf + (buf_) * VBYTES + key * VROW + cc * 16) = rv[i];  \
        }                                                                                                             \
    }
#define ATT_QK(buf_, X_)                                                                                              \
    {                                                                                                                 \
        const char* kb_ = kbuf + (buf_) * KBYTES + r * KROW + h * 16;                                                 \
        _Pragma("unroll") for (int st = 0; st < NST; ++st) {                                                          \
            X_[st] = MFMA(*(const bf16x8*)(kb_ + 32 * st * KROW), qf[0], zero16);                                     \
            _Pragma("unroll") for (int ks = 1; ks < NKS; ++ks) X_[st] = MFMA(*(const bf16x8*)(kb_ + 32 * st * KROW + ks * 32), qf[ks], X_[st]); \
        }                                                                                                             \
    }
#define ATT_SMPV(t_, vb_, X_)                                                                                         \
    {                                                                                                                 \
        if (NOMAX) {                                                                                                  \
            _Pragma("unroll") for (int st = 0; st < NST; ++st)                                                        \
                _Pragma("unroll") for (int i = 0; i < 16; ++i) X_[st][i] = __builtin_amdgcn_exp2f(X_[st][i]);         \
        } else {                                                                                                      \
            float mx = -1e30f;                                                                                        \
            const float dq = (float)(qpos - ((t_) * KT + 4 * h));                                                     \
            _Pragma("unroll") for (int st = 0; st < NST; ++st)                                                        \
                _Pragma("unroll") for (int i = 0; i < 16; ++i) {                                                      \
                    if (ALIBI) X_[st][i] = __builtin_fmaf(-slope2, fabsf(dq - (float)(32 * st + (i & 3) + 8 * (i >> 2))), X_[st][i]); \
                    mx = fmaxf(mx, X_[st][i]);                                                                        \
                }                                                                                                     \
            mx = fmaxf(mx, __shfl_xor(mx, 32));                                                                       \
            const float mn = fmaxf(m, mx);                                                                            \
            const float alpha = __builtin_amdgcn_exp2f(m - mn);                                                       \
            m = mn;                                                                                                   \
            _Pragma("unroll") for (int st = 0; st < NST; ++st)                                                        \
                _Pragma("unroll") for (int i = 0; i < 16; ++i) X_[st][i] = __builtin_amdgcn_exp2f(X_[st][i] - mn);    \
            if (__any(alpha != 1.0f)) {                                                                               \
                _Pragma("unroll") for (int dt = 0; dt < NDT; ++dt)                                                    \
                    _Pragma("unroll") for (int i = 0; i < 16; ++i) o[dt][i] *= alpha;                                 \
                _Pragma("unroll") for (int i = 0; i < 16; ++i) ol[i] *= alpha;                                        \
            }                                                                                                         \
        }                                                                                                             \
        const char* vbp_ = vbuf + (vb_) * VBYTES + vlane;                                                             \
        _Pragma("unroll") for (int st = 0; st < NST; ++st)                                                            \
            _Pragma("unroll") for (int s = 0; s < 2; ++s) {                                                           \
                u32x4 pk;                                                                                             \
                pk.x = pack2(X_[st][8 * s + 0], X_[st][8 * s + 1]); pk.y = pack2(X_[st][8 * s + 2], X_[st][8 * s + 3]); \
                pk.z = pack2(X_[st][8 * s + 4], X_[st][8 * s + 5]); pk.w = pack2(X_[st][8 * s + 6], X_[st][8 * s + 7]); \
                const bf16x8 pb = __builtin_bit_cast(bf16x8, pk);                                                     \
                ol = MFMA(ones8, pb, ol);                                                                             \
                _Pragma("unroll") for (int dt = 0; dt < NDT; ++dt) {                                                  \
                    const char* va = vbp_ + (32 * st + 16 * s) * VROW + 64 * dt;                                      \
                    const s16x4 lo = __builtin_amdgcn_ds_read_tr16_b64_v4i16((LDS_AS s16x4*)(va));                    \
                    const s16x4 hi = __builtin_amdgcn_ds_read_tr16_b64_v4i16((LDS_AS s16x4*)(va + 8 * VROW));        \
                    o[dt] = MFMA(__builtin_shufflevector(lo, hi, 0, 1, 2, 3, 4, 5, 6, 7), pb, o[dt]);                 \
                }                                                                                                     \
            }                                                                                                         \
    }
#define ATT_STEP(t_, PAR_, CUR_, NXT_)                                                                                \
    {                                                                                                                 \
        const bool m1_ = (t_) + 1 < ntiles, m2_ = (t_) + 2 < ntiles;                                                  \
        if (m2_) ATT_GLOADK(((t_) + 2) * KT)                                                                          \
        if (m1_) ATT_GLOADV(((t_) + 1) * KT)                                                                          \
        if (m1_) ATT_QK(1 - (PAR_), NXT_)                                                                             \
        ATT_SMPV(t_, PAR_, CUR_)                                                                                      \
        if (m2_) ATT_LSTOREK(PAR_)                                                                                    \
        if (m1_) ATT_LSTOREV(1 - (PAR_))                                                                              \
        __syncthreads();                                                                                              \
    }
    const f32x16 zero16 = {0.f, 0.f, 0.f, 0.f, 0.f, 0.f, 0.f, 0.f, 0.f, 0.f, 0.f, 0.f, 0.f, 0.f, 0.f, 0.f};
    const bf16x8 ones8 = {0x3F80, 0x3F80, 0x3F80, 0x3F80, 0x3F80, 0x3F80, 0x3F80, 0x3F80};
    float m = -1e30f;
    f32x16 ol = zero16;
#pragma unroll
    for (int dt = 0; dt < NDT; ++dt) o[dt] = zero16;
    const int ntiles = nkeys / KT;
    const int vlane = (4 * h + ((lane & 15) >> 2)) * VROW + (16 * ((lane >> 4) & 1) + 4 * (lane & 3)) * 2;
    f32x16 xa[NST], xb[NST];
    ATT_GLOADK(0) ATT_LSTOREK(0)
    ATT_GLOADK(KT) ATT_GLOADV(0)
    __syncthreads();
    ATT_QK(0, xa)
    ATT_LSTOREK(1) ATT_LSTOREV(0)
    __syncthreads();
    for (int t = 0; t < ntiles; t += 2) {
        ATT_STEP(t, 0, xa, xb)
        ATT_STEP(t + 1, 1, xb, xa)
    }
    lsum = ol[0];
#undef ATT_GLOADK
#undef ATT_GLOADV
#undef ATT_LSTOREK
#undef ATT_LSTOREV
#undef ATT_QK
#undef ATT_SMPV
#undef ATT_STEP
}
template <int NDT>
DI void store_o(bf16_t* dst, int ld, f32x16 (&o)[NDT], float inv) {
    const int tid_ = otid(), lane = tid_ & 63, w = tid_ >> 6, r = lane & 31, h = lane >> 5;
    bf16_t* row = dst + (size_t)(32 * w + r) * ld + 4 * h;
#pragma unroll
    for (int dt = 0; dt < NDT; ++dt)
#pragma unroll
        for (int g = 0; g < 4; ++g) {
            uint2 vv; vv.x = pack2(o[dt][4 * g] * inv, o[dt][4 * g + 1] * inv); vv.y = pack2(o[dt][4 * g + 2] * inv, o[dt][4 * g + 3] * inv);
            *(uint2*)(row + 32 * dt + 8 * g) = vv;
        }
}
DI int swz_item(int base) {
    const int G = gridDim.x, i = blockIdx.x;
    if (G & 7) return base + i;
    return base + (i & 7) * (G >> 3) + (i >> 3);
}

constexpr int QT = SEQ / 256;
DI void attn_even(const bf16_t* qkv, float* park, bf16_t* mix, const Params& p, const float2* ax, float lam_init, char* smem) {
    float d1 = 0.f, d2 = 0.f;
    for (int i = 0; i < 64; ++i) { d1 += p.in[8][i] * p.in[9][i]; d2 += p.in[10][i] * p.in[11][i]; }
    const float lam = __expf(d1) - __expf(d2) + lam_init;
    const int tid_ = otid(), lane = tid_ & 63, h = lane >> 5;
    float4* mypark = (float4*)(park + ((size_t)blockIdx.x * THREADS + tid_) * 64);
    constexpr int NDIFF = NB * 4 * QT, NGQA = NB * 8 * QT;
    for (int base = 0; base < NDIFF + NGQA; base += gridDim.x) {
        const int it = swz_item(base);
        if (it >= NDIFF + NGQA) continue;
        if (it < NDIFF) {
            const int b = it / (4 * QT), hd = (it / QT) & 3, qt = it % QT;
            const size_t row0 = (size_t)b * SEQ + qt * 256;
            const float slope2 = exp2f(-2.0f * (hd + 1)) * LOG2E;
            const bf16_t* qp = qkv + row0 * EVEN_IN + 768 + hd * 128;
            const bf16_t* kp = qkv + (size_t)b * SEQ * EVEN_IN + 1280 + hd * 128;
            const bf16_t* vp = qkv + (size_t)b * SEQ * EVEN_IN + 1792 + hd * 128;
            f32x16 o0[4]; float l0;
            attn_core<64, 128, 64, 0, true, false>(qp, EVEN_IN, kp, EVEN_IN, nullptr, 0, vp, EVEN_IN, SEQ, qt * 256, 1.0f, slope2, nullptr, nullptr, smem, o0, l0);
            const float i0 = 1.0f / l0;
#pragma unroll
            for (int dt = 0; dt < 4; ++dt)
#pragma unroll
                for (int g = 0; g < 4; ++g) mypark[dt * 4 + g] = make_float4(o0[dt][4 * g] * i0, o0[dt][4 * g + 1] * i0, o0[dt][4 * g + 2] * i0, o0[dt][4 * g + 3] * i0);
            asm volatile("" ::: "memory");
            attn_core<64, 128, 64, 0, true, false>(qp + 64, EVEN_IN, kp + 64, EVEN_IN, nullptr, 0, vp, EVEN_IN, SEQ, qt * 256, 1.0f, slope2, nullptr, nullptr, smem, o0, l0);
            const float i1 = lam / l0;
            float ss = 0.f;
            asm volatile("" ::: "memory");
#pragma unroll
            for (int dt = 0; dt < 4; ++dt)
#pragma unroll
                for (int g = 0; g < 4; ++g) {
                    const float4 pv = mypark[dt * 4 + g];
                    const float pa[4] = {pv.x, pv.y, pv.z, pv.w};
#pragma unroll
                    for (int e = 0; e < 4; ++e) { const float vv = pa[e] - i1 * o0[dt][4 * g + e]; o0[dt][4 * g + e] = vv; ss += vv * vv; }
                }
            ss += __shfl_xor(ss, 32);
            const float rstd = rsqrtf(ss * (1.0f / 128) + EPS) * (1.0f - lam_init);
#pragma unroll
            for (int dt = 0; dt < 4; ++dt)
#pragma unroll
                for (int i = 0; i < 16; ++i) o0[dt][i] *= p.in[12][32 * dt + crow(i, h)];
            store_o<4>(mix + row0 * D + 512 + hd * 128, D, o0, rstd);
        } else {
            const int j = it - NDIFF;
            const int b = j / (8 * QT), hd = (j / QT) & 7, qt = j % QT, kvh = hd >> 2;
            const size_t row0 = (size_t)b * SEQ + qt * 256;
            f32x16 o[2]; float l;
            attn_core<64, 64, 64, 1, false, true>(qkv + row0 * EVEN_IN + hd * 64, EVEN_IN, qkv + (size_t)b * SEQ * EVEN_IN + 512 + kvh * 64, EVEN_IN, nullptr, 0,
                                            qkv + (size_t)b * SEQ * EVEN_IN + 640 + kvh * 64, EVEN_IN, SEQ, qt * 256, 0.125f * LOG2E, 0.f, p.in[6], ax, smem, o, l);
            store_o<2>(mix + row0 * D + hd * 64, D, o, 1.0f / l);
        }
    }
}
DI void attn_mla(const bf16_t* qb, const bf16_t* kv, const bf16_t* a, bf16_t* mix, const float2* lin, char* smem) {
    constexpr int NIT = NB * 16 * QT;
    for (int base = 0; base < NIT; base += gridDim.x) {
        const int it = swz_item(base);
        if (it >= NIT) continue;
        const int b = it / (16 * QT), hd = (it / QT) & 15, qt = it % QT;
        const size_t row0 = (size_t)b * SEQ + qt * 256;
        f32x16 o[2]; float l;
        attn_core<96, 64, 64, 2, false, false>(qb + row0 * 1536 + hd * 96, 1536, kv + (size_t)b * SEQ * 2048 + hd * 128, 2048, a + (size_t)b * SEQ * ODD_PAD + 640, ODD_PAD,
                                        kv + (size_t)b * SEQ * 2048 + hd * 128 + 64, 2048, SEQ, qt * 256, 1.0f, 0.f, nullptr, lin, smem, o, l);
        store_o<2>(mix + row0 * D + hd * 64, D, o, 1.0f / l);
    }
}
DI void attn_cross(const bf16_t* qx, const bf16_t* kvx, bf16_t* mix, int seq0, char* smem) {
    constexpr int NIT = NB * 4 * QT * 2;
    for (int base = 0; base < NIT; base += gridDim.x) {
        const int it = swz_item(base);
        if (it >= NIT) continue;
        const int b = it / (8 * QT), hd = (it / (2 * QT)) & 3, qt = (it >> 1) % QT, half = it & 1;
        const size_t row0 = (size_t)b * SEQ + qt * 256;
        const bf16_t* kvb = kvx + (size_t)(seq0 + b) * NMEM * 2048;
        f32x16 o[4]; float l;
        attn_core<256, 128, 32, 0, false, false>(qx + row0 * D + hd * 256, D, kvb + hd * 256, 2048, nullptr, 0, kvb + 1024 + hd * 256 + half * 128, 2048, NMEM, 0,
                                          1.0f, 0.f, nullptr, nullptr, smem, o, l);
        store_o<4>(mix + row0 * D + hd * 256 + half * 128, D, o, 1.0f / l);
    }
}

extern "C" __global__ void __launch_bounds__(THREADS, 2) fwd_mega(Params p) {
    extern __shared__ __attribute__((aligned(16))) char smem[];
    LDS_AS unsigned char* lds = (LDS_AS unsigned char*)smem;
    cg::grid_group grid = cg::this_grid();
    char* ws = p.ws;
    __shared__ uint4 xb_words;
    if (threadIdx.x == 0) xb_words = make_uint4(0u, 0u, 0u, 0u);
    __syncthreads();
    const XcdBarrier xb = xcd_barrier_post((unsigned*)(ws + B_BAR), (volatile LDS_AS unsigned*)&xb_words);
    bf16_t* wEin = (bf16_t*)(ws + W_EIN); bf16_t* wEout = (bf16_t*)(ws + W_EOUT); bf16_t* wOin = (bf16_t*)(ws + W_OIN);
    bf16_t* wUq = (bf16_t*)(ws + W_UQ); bf16_t* wUkv = (bf16_t*)(ws + W_UKV); bf16_t* wOout = (bf16_t*)(ws + W_OOUT);
    float2* ax = (float2*)(ws + T_AX); float2* lin = (float2*)(ws + T_LIN);
    bf16_t* H = (bf16_t*)(ws + B_H); bf16_t* MIX = (bf16_t*)(ws + B_MIX);

    convert_weight(p.in[5], wEin, D, EVEN_IN, EVEN_IN, smem, 768, 1280, 0.125f * LOG2E);
    convert_weight(p.in[13], wEout, D, D, D, smem);
    convert_weight(p.in[14], wOin, D, ODD_IN, ODD_PAD, smem);
    convert_weight(p.in[17], wUq, 384, 1536, 1536, smem, 0, 1536, 0.10206207261596575f * LOG2E);
    convert_weight(p.in[18], wUkv, 256, 2048, 2048, smem);
    convert_weight(p.in[19], wOout, D, D, D, smem);
    for (int l = 0; l < 2; ++l) {
        convert_weight(p.in[22] + (size_t)l * D * D, (bf16_t*)(ws + W_CQ) + (size_t)l * D * D, D, D, D, smem, 0, D, 0.0625f * LOG2E);
        convert_weight(p.in[23] + (size_t)l * D * 2048, (bf16_t*)(ws + W_CKV) + (size_t)l * 2048 * D, D, 2048, 2048, smem);
        convert_weight(p.in[24] + (size_t)l * D * D, (bf16_t*)(ws + W_CO) + (size_t)l * D * D, D, D, D, smem);
        convert_weight(p.in[26] + (size_t)l * D * 2 * DFF, (bf16_t*)(ws + W_GU) + (size_t)l * 2 * DFF * D, D, 2 * DFF, 2 * DFF, smem);
        convert_weight(p.in[27] + (size_t)l * DFF * D, (bf16_t*)(ws + W_DOWN) + (size_t)l * D * DFF, DFF, D, D, smem);
        rmsnorm_rows(p.in[2], p.in[21] + l * D, (bf16_t*)(ws + B_MEMN) + (size_t)l * NBATCH * NMEM * D, 8 * NMEM);
        rmsnorm_rows(p.in[3], p.in[21] + l * D, (bf16_t*)(ws + B_MEMN) + (size_t)l * NBATCH * NMEM * D + (size_t)8 * NMEM * D, 16 * NMEM);
    }
    build_tables(ax, lin);
    xcd_barrier(xb);
    for (int l = 0; l < 2; ++l) {
        pg8::EpiBf16 e{(bf16_t*)(ws + B_KX) + (size_t)l * NBATCH * NMEM * 2048, 2048};
        pg8::gemm_phase(lds, mk_gemm((const bf16_t*)(ws + B_MEMN) + (size_t)l * NBATCH * NMEM * D, D, (const bf16_t*)(ws + W_CKV) + (size_t)l * 2048 * D, NBATCH * NMEM, 2048, D), e);
    }
    xcd_barrier(xb);

    for (int ch = 0; ch < NCHUNK; ++ch) {
        const float* xin = (ch == 0) ? p.in[0] : p.in[1] + (size_t)(ch - 1) * TC * D;
        float* xo = p.out + (size_t)ch * TC * D;
        for (int layer = 0; layer < 2; ++layer) {
            const float* xcur = (layer == 0) ? xin : xo;
            for (int rep_ = 0; rep_ < PROBE_NORM; ++rep_) rmsnorm_rows(xcur, p.in[4] + layer * D, H, TC);
            xcd_barrier(xb);
            const bf16_t* wout;
            if (layer == 0) {
                bf16_t* qkv = (bf16_t*)(ws + E_QKV);
                for (int rep_ = 0; rep_ < PROBE_GEMM; ++rep_) { pg8::EpiBf16 e{qkv, EVEN_IN}; pg8::gemm_phase(lds, mk_gemm(H, D, wEin, TC, EVEN_IN, D), e); }
                xcd_barrier(xb);
                kprep_even(qkv, p.in[7], ax);
                xcd_barrier(xb);
                for (int rep_ = 0; rep_ < PROBE_ATTN; ++rep_) attn_even(qkv, (float*)(ws + E_PARK), MIX, p, ax, 0.2f, smem);
                wout = wEout;
            } else {
                bf16_t* a = (bf16_t*)(ws + O_A); bf16_t* qb = (bf16_t*)(ws + O_Q); bf16_t* kv = (bf16_t*)(ws + O_KV);
                for (int rep_ = 0; rep_ < PROBE_GEMM; ++rep_) { pg8::EpiBf16 e{a, ODD_PAD}; pg8::gemm_phase(lds, mk_gemm(H, D, wOin, TC, ODD_PAD, D), e); }
                xcd_barrier(xb);
                prep_odd(a, p.in[15], p.in[16], lin);
                xcd_barrier(xb);
                for (int rep_ = 0; rep_ < PROBE_GEMM; ++rep_) { pg8::EpiBf16 e{qb, 1536}; pg8::gemm_phase(lds, mk_gemm(a, ODD_PAD, wUq, TC, 1536, 384), e); }
                for (int rep_ = 0; rep_ < PROBE_GEMM; ++rep_) { pg8::EpiBf16 e{kv, 2048}; pg8::gemm_phase(lds, mk_gemm(a + 384, ODD_PAD, wUkv, TC, 2048, 256), e); }
                xcd_barrier(xb);
                for (int rep_ = 0; rep_ < PROBE_ATTN; ++rep_) attn_mla(qb, kv, a, MIX, lin, smem);
                wout = wOout;
            }
            xcd_barrier(xb);
            { pg8::EpiResid e{xcur, xo}; pg8::gemm_phase(lds, mk_gemm(MIX, D, wout, TC, D, D), e); }
            xcd_barrier(xb);
            for (int rep_ = 0; rep_ < PROBE_NORM; ++rep_) rmsnorm_rows(xo, p.in[20] + layer * D, H, TC);
            xcd_barrier(xb);
            for (int rep_ = 0; rep_ < PROBE_GEMM; ++rep_) { pg8::EpiBf16 e{(bf16_t*)(ws + X_Q), D}; pg8::gemm_phase(lds, mk_gemm(H, D, (const bf16_t*)(ws + W_CQ) + (size_t)layer * D * D, TC, D, D), e); }
            xcd_barrier(xb);
            for (int rep_ = 0; rep_ < PROBE_CROSS; ++rep_) attn_cross((const bf16_t*)(ws + X_Q), (const bf16_t*)(ws + B_KX) + (size_t)layer * NBATCH * NMEM * 2048, MIX, ch * NB, smem);
            xcd_barrier(xb);
            { pg8::EpiResid e{xo, xo}; pg8::gemm_phase(lds, mk_gemm(MIX, D, (const bf16_t*)(ws + W_CO) + (size_t)layer * D * D, TC, D, D), e); }
            xcd_barrier(xb);
            for (int rep_ = 0; rep_ < PROBE_NORM; ++rep_) rmsnorm_rows(xo, p.in[25] + layer * D, H, TC);
            xcd_barrier(xb);
            for (int rep_ = 0; rep_ < PROBE_GEMM; ++rep_) { pg8::EpiSwiglu e{(bf16_t*)(ws + F_ACT)};
              pg8::Gemm g{H, (const bf16_t*)(ws + W_GU) + (size_t)layer * 2 * DFF * D, TC, DFF / 128, D, D, (size_t)DFF * D * 2, (size_t)128 * D * 2};
              pg8::gemm_phase(lds, g, e); }
            xcd_barrier(xb);
            { pg8::EpiResid e{xo, xo}; pg8::gemm_phase(lds, mk_gemm((const bf16_t*)(ws + F_ACT), DFF, (const bf16_t*)(ws + W_DOWN) + (size_t)layer * D * DFF, TC, D, DFF), e); }
            xcd_barrier(xb);
        }
        rmsnorm_final(xo, p.in[28], TC);
    }
}

extern "C" void kernel_launch(void* const* d_in, const int* in_sizes, int n_in, void* d_out, int out_size, void* d_ws, size_t ws_size, hipStream_t stream) {
    static int grid_blocks = 0;
    if (!grid_blocks) {
        int dev = 0, cus = 0, per_cu = 0;
        (void)hipGetDevice(&dev);
        (void)hipDeviceGetAttribute(&cus, hipDeviceAttributeMultiprocessorCount, dev);
        (void)hipFuncSetAttribute((const void*)fwd_mega, hipFuncAttributeMaxDynamicSharedMemorySize, (int)LDS_BYTES);
        (void)hipOccupancyMaxActiveBlocksPerMultiprocessor(&per_cu, fwd_mega, THREADS, LDS_BYTES);
        if (per_cu > 1) per_cu = 1;
        if (per_cu < 1) per_cu = 1;
        grid_blocks = cus * per_cu;
    }
    constexpr size_t WS_END = (O_END > E_END ? O_END : E_END) > (F_ACT + (size_t)TC * DFF * 2) ? (O_END > E_END ? O_END : E_END) : (F_ACT + (size_t)TC * DFF * 2);
    if (ws_size < WS_END) { fprintf(stderr, "workspace too small: %zu < %zu\n", ws_size, (size_t)WS_END); return; }
    if (grid_blocks > 256) grid_blocks = 256;
    Params p{};
    for (int i = 0; i < 29; ++i) p.in[i] = (const float*)d_in[i];
    p.out = (float*)d_out;
    p.ws = (char*)d_ws;
    (void)hipMemsetAsync(d_ws, 0, 16384, stream);
    void* args[] = {&p};
    hipError_t e = hipLaunchCooperativeKernel((void*)fwd_mega, dim3(grid_blocks), dim3(THREADS), args, LDS_BYTES, stream);
    if (e != hipSuccess) fprintf(stderr, "cooperative launch failed: %s (grid %d)\n", hipGetErrorString(e), grid_blocks);
}
```

```cpp
#include <hip/hip_runtime.h>
#include <hip/hip_cooperative_groups.h>
#include <cstdio>
#include <cstdint>
namespace cg = cooperative_groups;
#ifndef PROBE_GEMM
#define PROBE_GEMM 1
#endif
#ifndef PROBE_NORM
#define PROBE_NORM 1
#endif
#ifndef PROBE_CROSS
#define PROBE_CROSS 1
#endif
#ifndef PROBE_ATTN
#define PROBE_ATTN 1
#endif

typedef unsigned short bf16_t;
typedef short bf16x8 __attribute__((ext_vector_type(8)));
typedef float f32x16 __attribute__((ext_vector_type(16)));
typedef float f32x2 __attribute__((ext_vector_type(2)));
typedef unsigned u32x4 __attribute__((ext_vector_type(4)));
typedef float f32x4 __attribute__((ext_vector_type(4)));
typedef short s16x4 __attribute__((ext_vector_type(4)));
#define LDS_AS __attribute__((address_space(3)))
typedef __bf16 bf16x2_t __attribute__((ext_vector_type(2)));
#define DI __device__ __forceinline__
#define MFMA(a, b, c) __builtin_amdgcn_mfma_f32_32x32x16_bf16((a), (b), (c), 0, 0, 0)

constexpr int D = 1024, SEQ = 4096, NBATCH = 24, NB = 8  , NCHUNK = NBATCH / NB, TC = NB * SEQ;
constexpr int NMEM = 256, DFF = 2816, EVEN_IN = 2304, ODD_IN = 672, ODD_PAD = 768;
constexpr float EPS = 1e-6f, LOG2E = 1.4426950408889634f;
constexpr int THREADS = 512, NWAVE = THREADS / 64;
constexpr size_t LDS_BYTES = 131072;

constexpr size_t al(size_t x) { return (x + 255) & ~(size_t)255; }
constexpr size_t B_BAR = 0;
constexpr size_t W_EIN = 16384;
constexpr size_t W_EOUT = W_EIN + al((size_t)EVEN_IN * D * 2);
constexpr size_t W_OIN = W_EOUT + al((size_t)D * D * 2);
constexpr size_t W_UQ = W_OIN + al((size_t)ODD_PAD * D * 2);
constexpr size_t W_UKV = W_UQ + al((size_t)1536 * 384 * 2);
constexpr size_t W_OOUT = W_UKV + al((size_t)2048 * 256 * 2);
constexpr size_t W_CQ = W_OOUT + al((size_t)D * D * 2);
constexpr size_t W_CKV = W_CQ + 2 * al((size_t)D * D * 2);
constexpr size_t W_CO = W_CKV + 2 * al((size_t)2048 * D * 2);
constexpr size_t W_GU = W_CO + 2 * al((size_t)D * D * 2);
constexpr size_t W_DOWN = W_GU + 2 * al((size_t)2 * DFF * D * 2);
constexpr size_t T_AX = W_DOWN + 2 * al((size_t)D * DFF * 2);
constexpr size_t T_LIN = T_AX + al((size_t)SEQ * 32 * 8);
constexpr size_t B_MEMN = T_LIN + al((size_t)SEQ * 16 * 8);
constexpr size_t B_KX = B_MEMN + 2 * al((size_t)NBATCH * NMEM * D * 2);
constexpr size_t B_H = B_KX + 2 * al((size_t)NBATCH * NMEM * 2048 * 2);
constexpr size_t B_MIX = B_H + al((size_t)TC * D * 2);
constexpr size_t B_BIG = B_MIX + al((size_t)TC * D * 2);
constexpr size_t E_QKV = B_BIG;
constexpr size_t E_PARK = E_QKV + al((size_t)TC * EVEN_IN * 2);
constexpr size_t E_END = E_PARK + (size_t)256 * THREADS * 64 * 4;
constexpr size_t O_A = B_BIG;
constexpr size_t O_Q = O_A + al((size_t)TC * ODD_PAD * 2);
constexpr size_t O_KV = O_Q + al((size_t)TC * 1536 * 2);
constexpr size_t O_END = O_KV + al((size_t)TC * 2048 * 2);
constexpr size_t X_Q = B_BIG;
constexpr size_t F_ACT = B_BIG;

struct Params {
    const float* in[29];
    float* out;
    char* ws;
};

DI unsigned pack2(float lo, float hi) { f32x2 v = {lo, hi}; bf16x2_t b = __builtin_convertvector(v, bf16x2_t); return __builtin_bit_cast(unsigned, b); }
DI float bflo(unsigned u) { return __uint_as_float(u << 16); }
DI float bfhi(unsigned u) { return __uint_as_float(u & 0xffff0000u); }
DI int crow(int i, int h) { return (i & 3) + 8 * (i >> 2) + 4 * h; }
DI int swap23(int x) { return (x & ~12) | ((x & 4) << 1) | ((x & 8) >> 1); }
DI int otid() { int t = threadIdx.x; asm volatile("" : "+v"(t)); return t; }
DI float wave_sum(float v) {
#pragma unroll
    for (int o = 32; o >= 1; o >>= 1) v += __shfl_xor(v, o);
    return v;
}


#define XB_TMO      128
#define XB_XCNT(j)  (256  + 64 * (j))
#define XB_XSUB(j)  (1280 + 64 * (j))
#define XB_XGEN(j)  (2304 + 64 * (j))
#define XB_TOP      3328
#define XB_TOPGEN   3392
#define XCD_BAR_WORDS 3456
#define XB_SPIN_CAP (1u << 18)
DI unsigned xb_ld(unsigned* p) { return __hip_atomic_load(p, __ATOMIC_RELAXED, __HIP_MEMORY_SCOPE_AGENT); }
DI unsigned xb_add(unsigned* p, unsigned v) { return __hip_atomic_fetch_add(p, v, __ATOMIC_RELAXED, __HIP_MEMORY_SCOPE_AGENT); }
DI unsigned xb_xcc_id() { return (unsigned)__builtin_amdgcn_s_getreg((3 << 11) | 20) & 0xFu; }
#define XB_SPIN(cond, bar) do { unsigned _sp = 0; while (cond) { __builtin_amdgcn_s_sleep(1); \
    if ((++_sp & 255u) == 0u) { if (xb_ld(&(bar)[XB_TMO])) break; if (_sp > XB_SPIN_CAP) { atomicAdd(&(bar)[XB_TMO], 1u); break; } } } } while (0)
struct XcdBarrier { unsigned* bar; unsigned x; volatile LDS_AS unsigned* st; };
DI XcdBarrier xcd_barrier_post(unsigned* bar, volatile LDS_AS unsigned* st) {
    XcdBarrier b; b.bar = bar; b.x = xb_xcc_id(); b.st = st;
    if (threadIdx.x == 0) (void)xb_add(&bar[XB_XCNT(b.x)], 1u);
    return b;
}
DI void xcd_barrier_complete(unsigned* bar, unsigned x, unsigned& nloc, unsigned& nx) {
    const unsigned G = gridDim.x * gridDim.y * gridDim.z;
    unsigned sum, cnt, mine, sp = 0u;
    for (;;) {
        sum = 0u; cnt = 0u; mine = 0u;
#pragma unroll
        for (unsigned j = 0; j < 16; ++j) { const unsigned c = xb_ld(&bar[XB_XCNT(j)]); sum += c; cnt += (c > 0u) ? 1u : 0u; mine = (j == x) ? c : mine; }
        if (sum == G) break;
        __builtin_amdgcn_s_sleep(1);
        if ((++sp & 255u) == 0u) { if (xb_ld(&bar[XB_TMO])) break; if (sp > XB_SPIN_CAP) { atomicAdd(&bar[XB_TMO], 1u); break; } }
    }
    nloc = mine > 0u ? mine : 1u; nx = cnt > 0u ? cnt : 1u;
}
DI void xcd_barrier(const XcdBarrier& b) {
    asm volatile("s_waitcnt vmcnt(0)" ::: "memory");
    __syncthreads();
    if (threadIdx.x == 0) {
        unsigned* bar = b.bar;
        __builtin_amdgcn_s_waitcnt(0);
        unsigned nloc = b.st[0], nx = b.st[1];
        if (nloc == 0u) { xcd_barrier_complete(bar, b.x, nloc, nx); b.st[0] = nloc; b.st[1] = nx; }
        const unsigned old = xb_add(&bar[XB_XSUB(b.x)], 1u);
        const unsigned gen = old / nloc;
        if (old + 1u == (gen + 1u) * nloc) {
            __builtin_amdgcn_fence(__ATOMIC_RELEASE, "agent");
            asm volatile("s_waitcnt vmcnt(0)" ::: "memory");
            const unsigned og = xb_add(&bar[XB_TOP], 1u);
            const unsigned tg = og / nx;
            if (og + 1u == (tg + 1u) * nx) xb_add(&bar[XB_TOPGEN], 1u);
            else XB_SPIN(xb_ld(&bar[XB_TOPGEN]) == tg, bar);
            __builtin_amdgcn_fence(__ATOMIC_ACQUIRE, "agent");
            xb_add(&bar[XB_XGEN(b.x)], 1u);
            asm volatile("s_waitcnt vmcnt(0)" ::: "memory");
        } else {
            XB_SPIN(xb_ld(&bar[XB_XGEN(b.x)]) == gen, bar);
            __builtin_amdgcn_fence(__ATOMIC_ACQUIRE, "agent");
            asm volatile("s_waitcnt vmcnt(0)" ::: "memory");
        }
    }
    __syncthreads();
}

DI void convert_weight(const float* __restrict__ src, bf16_t* __restrict__ dst, int K, int N, int Npad, char* smem, int slo = 0, int shi = 0, float scale = 1.0f) {
    float* t = (float*)smem;
    const int tid = otid();
    const int nkt = K / 64, nnt = Npad / 64;
    for (int tile = blockIdx.x; tile < nkt * nnt; tile += gridDim.x) {
        const int k0 = (tile / nnt) * 64, n0 = (tile % nnt) * 64;
#pragma unroll
        for (int i = 0; i < 8; ++i) {
            const int k = i * 8 + (tid >> 6), n = tid & 63;
            const float sc_ = (n0 + n >= slo && n0 + n < shi) ? scale : 1.0f;
            t[k * 65 + n] = (n0 + n < N) ? src[(size_t)(k0 + k) * N + n0 + n] * sc_ : 0.f;
        }
        __syncthreads();
#pragma unroll
        for (int i = 0; i < 4; ++i) {
            const int n = i * 16 + (tid >> 5), k = (tid & 31) * 2;
            *(unsigned*)(dst + (size_t)(n0 + n) * K + k0 + k) = pack2(t[k * 65 + n], t[(k + 1) * 65 + n]);
        }
        __syncthreads();
    }
}

__device__ const float kFreq[16] = {1.000000000e+00f, 5.623413324e-01f, 3.162277639e-01f, 1.778279394e-01f, 1.000000015e-01f, 5.623413250e-02f, 3.162277490e-02f, 1.778279431e-02f,
                                    9.999999776e-03f, 5.623413250e-03f, 3.162277630e-03f, 1.778279431e-03f, 1.000000047e-03f, 5.623413017e-04f, 3.162277571e-04f, 1.778279402e-04f};
DI float2 sincos_acc(float ang) {
    const double x = (double)ang;
    const double n = __builtin_rint(x * 0.15915494309189535);
    double r = __builtin_fma(-n, 6.283185307179586, x);
    r = __builtin_fma(-n, 2.4492935982947064e-16, r);
    const double r2 = r * r;
    double s = 1.0, c = 1.0;
#pragma unroll
    for (int k = 13; k >= 1; --k) {
        s = 1.0 - r2 * s * (1.0 / (double)((2 * k) * (2 * k + 1)));
        c = 1.0 - r2 * c * (1.0 / (double)((2 * k - 1) * (2 * k)));
    }
    return make_float2((float)c, (float)(r * s));
}
DI void build_tables(float2* ax, float2* lin) {
    const int gt = blockIdx.x * THREADS + otid(), gs = gridDim.x * THREADS;
    for (int e = gt; e < SEQ * 32; e += gs) {
        const int pos = e >> 5, p = e & 31;
        const float base = (p < 16) ? (float)(pos >> 6) : (float)(pos & 63);
        ax[e] = sincos_acc(base * kFreq[p & 15]);
    }
    for (int e = gt; e < SEQ * 16; e += gs) {
        const int pos = e >> 4, p = e & 15;
        lin[e] = sincos_acc((float)pos * kFreq[p]);
    }
}

DI void rmsnorm_rows(const float* __restrict__ src, const float* __restrict__ g, bf16_t* __restrict__ dst, int nrows) {
    const int tid_ = otid(), lane = tid_ & 63, wv = blockIdx.x * NWAVE + (tid_ >> 6), nw = gridDim.x * NWAVE;
    for (int row = wv; row < nrows; row += nw) {
        const float4* s = (const float4*)(src + (size_t)row * D);
        float4 v[4]; float ss = 0.f;
#pragma unroll
        for (int i = 0; i < 4; ++i) { v[i] = s[i * 64 + lane]; ss += v[i].x * v[i].x + v[i].y * v[i].y + v[i].z * v[i].z + v[i].w * v[i].w; }
        ss = wave_sum(ss);
        const float rstd = rsqrtf(ss * (1.0f / D) + EPS);
#pragma unroll
        for (int i = 0; i < 4; ++i) {
            const float4 gg = ((const float4*)g)[i * 64 + lane];
            uint2 o; o.x = pack2(v[i].x * rstd * gg.x, v[i].y * rstd * gg.y); o.y = pack2(v[i].z * rstd * gg.z, v[i].w * rstd * gg.w);
            *(uint2*)(dst + (size_t)row * D + (i * 64 + lane) * 4) = o;
        }
    }
}
DI void rmsnorm_final(float* __restrict__ x, const float* __restrict__ g, int nrows) {
    const int tid_ = otid(), lane = tid_ & 63, wv = blockIdx.x * NWAVE + (tid_ >> 6), nw = gridDim.x * NWAVE;
    for (int row = wv; row < nrows; row += nw) {
        float4* s = (float4*)(x + (size_t)row * D);
        float4 v[4]; float ss = 0.f;
#pragma unroll
        for (int i = 0; i < 4; ++i) { v[i] = s[i * 64 + lane]; ss += v[i].x * v[i].x + v[i].y * v[i].y + v[i].z * v[i].z + v[i].w * v[i].w; }
        ss = wave_sum(ss);
        const float rstd = rsqrtf(ss * (1.0f / D) + EPS);
#pragma unroll
        for (int i = 0; i < 4; ++i) {
            const float4 gg = ((const float4*)g)[i * 64 + lane];
            float4 o; o.x = v[i].x * rstd * gg.x; o.y = v[i].y * rstd * gg.y; o.z = v[i].z * rstd * gg.z; o.w = v[i].w * rstd * gg.w;
            s[i * 64 + lane] = o;
        }
    }
}

DI void kprep_even(bf16_t* __restrict__ qkv, const float* __restrict__ gk, const float2* __restrict__ ax) {
    const int tid_ = otid(), gt = blockIdx.x * THREADS + tid_, gs = gridDim.x * THREADS;
    const int p = tid_ & 31;
    for (int v = gt >> 5; v < TC * 2; v += gs >> 5) {
        const int tok = v >> 1, kvh = v & 1;
        unsigned* ptr = (unsigned*)(qkv + (size_t)tok * EVEN_IN + 512 + kvh * 64 + 2 * p);
        const unsigned u = *ptr;
        const float x0 = bflo(u), x1 = bfhi(u);
        float ss = x0 * x0 + x1 * x1;
#pragma unroll
        for (int o = 16; o >= 1; o >>= 1) ss += __shfl_xor(ss, o);
        const float rstd = rsqrtf(ss * (1.0f / 64) + EPS);
        const float y0 = x0 * rstd * gk[2 * p], y1 = x1 * rstd * gk[2 * p + 1];
        const float2 cs = ax[(tok & (SEQ - 1)) * 32 + p];
        *ptr = pack2(y0 * cs.x - y1 * cs.y, y0 * cs.y + y1 * cs.x);
    }
}
DI void prep_odd(bf16_t* __restrict__ a, const float* __restrict__ gq, const float* __restrict__ gkv, const float2* __restrict__ lin) {
    const int tid_ = otid(), lane = tid_ & 63, wv = blockIdx.x * NWAVE + (tid_ >> 6), nw = gridDim.x * NWAVE;
    for (int row = wv; row < TC; row += nw) {
        unsigned* base = (unsigned*)(a + (size_t)row * ODD_PAD);
        unsigned uq[3], uk[2]; float sq = 0.f, sk = 0.f;
#pragma unroll
        for (int i = 0; i < 3; ++i) { uq[i] = base[i * 64 + lane]; const float a0 = bflo(uq[i]), a1 = bfhi(uq[i]); sq += a0 * a0 + a1 * a1; }
#pragma unroll
        for (int i = 0; i < 2; ++i) { uk[i] = base[192 + i * 64 + lane]; const float a0 = bflo(uk[i]), a1 = bfhi(uk[i]); sk += a0 * a0 + a1 * a1; }
        sq = wave_sum(sq); sk = wave_sum(sk);
        const float rq = rsqrtf(sq * (1.0f / 384) + EPS), rk = rsqrtf(sk * (1.0f / 256) + EPS);
#pragma unroll
        for (int i = 0; i < 3; ++i) { const int c = (i * 64 + lane) * 2; base[i * 64 + lane] = pack2(bflo(uq[i]) * rq * gq[c], bfhi(uq[i]) * rq * gq[c + 1]); }
#pragma unroll
        for (int i = 0; i < 2; ++i) { const int c = (i * 64 + lane) * 2; base[192 + i * 64 + lane] = pack2(bflo(uk[i]) * rk * gkv[c], bfhi(uk[i]) * rk * gkv[c + 1]); }
        if (lane < 16) {
            const unsigned u = base[320 + lane];
            const float x0 = bflo(u), x1 = bfhi(u);
            const float2 cs = lin[(row & (SEQ - 1)) * 16 + lane];
            base[320 + lane] = pack2(x0 * cs.x - x1 * cs.y, x0 * cs.y + x1 * cs.x);
        }
    }
}

namespace pg8 {
constexpr int BM = 256, BK = 64, HALF = 128, HTB = HALF * BK * 2, NXCD = 8, WGM = 8;
DI int lds_byte(int r, int c) { const int st = (r >> 4) * 2 + (c >> 5), rr = r & 15, cc = c & 31, ob = rr * 64 + cc * 2; return st * 1024 + (ob ^ (((ob >> 9) & 1) << 5)); }
DI void stage_rc(int b, int& R, int& C) { const int st = b / 1024, sb = b % 1024, swz = sb ^ (((sb >> 9) & 1) << 5); R = (st >> 1) * 16 + swz / 64; C = (st & 1) * 32 + (swz % 64) / 2; }
DI int perm32(int rho) { const int n = rho >> 4, i = rho & 15; return 8 * (i >> 2) + 4 * n + (i & 3); }
struct Unit { int pm, pn; };
struct Gemm { const bf16_t* A; const bf16_t* Bt; int M, NT, K, lda; size_t hstepB, tstepB; };
struct StaticOrder {
    int nM, nN, nwg, G, c;
    DI void init(int M, int NT, int G_, int c_) { nM = M / BM; nN = NT; nwg = nM * nN; G = G_; c = c_; }
    DI bool next(int i, Unit& u) const {
        const long L = (long)i * G + c; if (L >= nwg) return false;
        int wgid = (int)L; { const int q = nwg / NXCD, r = nwg % NXCD, xcd = wgid % NXCD, off = wgid / NXCD; wgid = (xcd < r ? xcd * (q + 1) : r * (q + 1) + (xcd - r) * q) + off; }
        const int nig = WGM * nN, gid = wgid / nig, fm = gid * WGM, gsz = (nM - fm) < WGM ? (nM - fm) : WGM;
        u.pm = fm + ((wgid % nig) % gsz); u.pn = (wgid % nig) / gsz; return true;
    }
};
template <class Epi>
DI void gemm_phase(LDS_AS unsigned char* lds, const Gemm g, const Epi& E) {
    StaticOrder S; S.init(g.M, g.NT, gridDim.x, blockIdx.x);
    const int tid = otid(), wid = __builtin_amdgcn_readfirstlane(tid >> 6), lane = tid & 63, wr = wid >> 2, wc = wid & 3, fr = lane & 15, fq = lane >> 4;
    const int K = g.K, nt = K / BK;
    unsigned voffA[2], voffB[2];
#pragma unroll
    for (int i = 0; i < 2; ++i) { int R, C; stage_rc(tid * 16 + i * 8192, R, C); const int Rb = Epi::PERM ? ((R & ~31) + perm32(R & 31)) : R;
        voffA[i] = (unsigned)(R * g.lda + C) * 2u; voffB[i] = (unsigned)(Rb * K + C) * 2u; }
    const size_t kstep = (size_t)(BK * 2);
    const size_t hstepA = (size_t)HALF * g.lda * 2, tstepA = 2 * hstepA, hstepB = g.hstepB, tstepB = g.tstepB;
    const unsigned ldsw = (unsigned)wid * 1024u;
    const int aoff = lds_byte(wr * 64 + fr, fq * 8), boff = lds_byte(wc * 32 + fr, fq * 8);
#define PG8_SA(b, h) (((b) * 2 + (h)) * HTB)
#define PG8_SB(b, h) ((4 + (b) * 2 + (h)) * HTB)
#define PG8_STAGE(bufoff, gbase, voff) do { _Pragma("unroll") for (int _i = 0; _i < 2; ++_i) \
        __builtin_amdgcn_global_load_lds((const unsigned*)((const char*)(gbase) + (voff)[_i]), (LDS_AS unsigned*)(lds + (bufoff) + ldsw + _i * 8192), 16, 0, 0); } while (0)
#define PG8_LDA(dst, b, h) do { _Pragma("unroll") for (int m = 0; m < 4; ++m) _Pragma("unroll") for (int k = 0; k < 2; ++k) dst[m][k] = *(const LDS_AS bf16x8*)(lds + PG8_SA(b, h) + aoff + m * 2048 + k * 1024); } while (0)
#define PG8_LDB(dst, b, h) do { _Pragma("unroll") for (int n = 0; n < 2; ++n) _Pragma("unroll") for (int k = 0; k < 2; ++k) dst[n][k] = *(const LDS_AS bf16x8*)(lds + PG8_SB(b, h) + boff + n * 2048 + k * 1024); } while (0)
#define PG8_MMA(ai, bj, At, Bt) do { __builtin_amdgcn_s_setprio(1); _Pragma("unroll") for (int m = 0; m < 4; ++m) _Pragma("unroll") for (int n = 0; n < 2; ++n) _Pragma("unroll") for (int k = 0; k < 2; ++k) \
        acc[ai][bj][m][n] = __builtin_amdgcn_mfma_f32_16x16x32_bf16(Bt[n][k], At[m][k], acc[ai][bj][m][n], 0, 0, 0); __builtin_amdgcn_s_setprio(0); } while (0)
#define PG8_WAIT_V(n) asm volatile("s_waitcnt vmcnt(" #n ")" ::: "memory")
#define PG8_WAIT_L(n) asm volatile("s_waitcnt lgkmcnt(" #n ")" ::: "memory")
#define PG8_BAR __builtin_amdgcn_s_barrier()
#define PG8_SCHED __builtin_amdgcn_sched_barrier(0)
    Unit cur, nxt; int ui = 0;
    if (!S.next(0, cur)) return;
    f32x4 acc[2][2][4][2];
#pragma unroll
    for (int a = 0; a < 2; ++a)
#pragma unroll
        for (int b = 0; b < 2; ++b)
#pragma unroll
            for (int m = 0; m < 4; ++m)
#pragma unroll
                for (int n = 0; n < 2; ++n) acc[a][b][m][n] = (f32x4){0.f, 0.f, 0.f, 0.f};
    bf16x8 At[4][2], B0[2][2], B1[2][2];
    const char* cA = (const char*)g.A + (size_t)cur.pm * tstepA; const char* cB = (const char*)g.Bt + (size_t)cur.pn * tstepB;
    PG8_STAGE(PG8_SB(0, 0), cB, voffB); PG8_STAGE(PG8_SA(0, 0), cA, voffA); PG8_STAGE(PG8_SB(0, 1), cB + hstepB, voffB); PG8_STAGE(PG8_SA(0, 1), cA + hstepA, voffA);
    if (wr == 1) PG8_BAR;
    PG8_WAIT_V(4); PG8_BAR;
    PG8_STAGE(PG8_SB(1, 0), cB + kstep, voffB); PG8_STAGE(PG8_SA(1, 0), cA + kstep, voffA); PG8_STAGE(PG8_SB(1, 1), cB + hstepB + kstep, voffB);
    PG8_WAIT_V(6); PG8_BAR;
    for (;;) {
        const bool has_next = S.next(ui + 1, nxt);
        const char* nA = has_next ? (const char*)g.A + (size_t)nxt.pm * tstepA : cA; const char* nB = has_next ? (const char*)g.Bt + (size_t)nxt.pn * tstepB : cB;
        for (int t = 0; t < nt; t += 2) {
            const bool last = (t == nt - 2);
            const char* a1 = cA + (size_t)(t + 1) * kstep;
            const char* a2 = last ? nA : cA + (size_t)(t + 2) * kstep; const char* b2 = last ? nB : cB + (size_t)(t + 2) * kstep;
            const char* a3 = a2 + kstep; const char* b3 = b2 + kstep;
            PG8_LDB(B0, 0, 0); PG8_SCHED; PG8_LDA(At, 0, 0); PG8_STAGE(PG8_SA(1, 1), a1 + hstepA, voffA);
            PG8_WAIT_L(8); PG8_BAR; PG8_WAIT_L(0); PG8_MMA(0, 0, At, B0); PG8_BAR; PG8_SCHED;
            PG8_LDB(B1, 0, 1); PG8_STAGE(PG8_SB(0, 0), b2, voffB);
            PG8_BAR; PG8_WAIT_L(0); PG8_MMA(0, 1, At, B1); PG8_BAR;
            PG8_LDA(At, 0, 1); PG8_STAGE(PG8_SA(0, 0), a2, voffA);
            PG8_BAR; PG8_WAIT_L(0); PG8_MMA(1, 0, At, B0); PG8_BAR; PG8_SCHED;
            PG8_STAGE(PG8_SB(0, 1), b2 + hstepB, voffB);
            PG8_WAIT_V(6); PG8_BAR; PG8_MMA(1, 1, At, B1); PG8_BAR;
            PG8_LDB(B0, 1, 0); PG8_SCHED; PG8_LDA(At, 1, 0); PG8_STAGE(PG8_SA(0, 1), a2 + hstepA, voffA);
            PG8_WAIT_L(8); PG8_BAR; PG8_WAIT_L(0); PG8_MMA(0, 0, At, B0); PG8_BAR; PG8_SCHED;
            PG8_LDB(B1, 1, 1); PG8_STAGE(PG8_SB(1, 0), b3, voffB);
            PG8_BAR; PG8_WAIT_L(0); PG8_MMA(0, 1, At, B1); PG8_BAR;
            PG8_LDA(At, 1, 1); PG8_STAGE(PG8_SA(1, 0), a3, voffA);
            PG8_BAR; PG8_WAIT_L(0); PG8_MMA(1, 0, At, B0); PG8_BAR; PG8_SCHED;
            PG8_STAGE(PG8_SB(1, 1), b3 + hstepB, voffB);
            PG8_WAIT_V(6); PG8_BAR; PG8_MMA(1, 1, At, B1); PG8_BAR;
        }
        E(acc, cur, wr, wc, fr, fq);
        if (!has_next) break;
#pragma unroll
        for (int a = 0; a < 2; ++a)
#pragma unroll
            for (int b = 0; b < 2; ++b)
#pragma unroll
                for (int m = 0; m < 4; ++m)
#pragma unroll
                    for (int n = 0; n < 2; ++n) acc[a][b][m][n] = (f32x4){0.f, 0.f, 0.f, 0.f};
        cur = nxt; cA = nA; cB = nB; ++ui;
    }
    PG8_WAIT_V(0);
    if (wr == 0) PG8_BAR;
    PG8_BAR;
#undef PG8_SA
#undef PG8_SB
#undef PG8_STAGE
#undef PG8_LDA
#undef PG8_LDB
#undef PG8_MMA
#undef PG8_WAIT_V
#undef PG8_WAIT_L
#undef PG8_BAR
#undef PG8_SCHED
}
struct EpiResid {
    static constexpr bool PERM = false;
    const float* res; float* out;
    DI void operator()(const f32x4 (&acc)[2][2][4][2], const Unit& u, int wr, int wc, int fr, int fq) const {
        const int row0 = u.pm * BM + wr * 64 + fr, col0 = u.pn * BM + wc * 32 + 4 * fq;
#pragma unroll
        for (int ai = 0; ai < 2; ++ai)
#pragma unroll
            for (int m = 0; m < 4; ++m) {
                const size_t rb = (size_t)(row0 + ai * HALF + m * 16) * D + col0;
#pragma unroll
                for (int bj = 0; bj < 2; ++bj)
#pragma unroll
                    for (int n = 0; n < 2; ++n) { const size_t idx = rb + bj * HALF + n * 16; *(f32x4*)(out + idx) = *(const f32x4*)(res + idx) + acc[ai][bj][m][n]; }
            }
    }
};
struct EpiBf16 {
    static constexpr bool PERM = true;
    bf16_t* out; int ld;
    DI void operator()(const f32x4 (&acc)[2][2][4][2], const Unit& u, int wr, int wc, int fr, int fq) const {
        const int row0 = u.pm * BM + wr * 64 + fr, col0 = u.pn * BM + wc * 32 + 8 * fq;
#pragma unroll
        for (int ai = 0; ai < 2; ++ai)
#pragma unroll
            for (int m = 0; m < 4; ++m) {
                bf16_t* rowp = out + (size_t)(row0 + ai * HALF + m * 16) * ld + col0;
#pragma unroll
                for (int bj = 0; bj < 2; ++bj) {
                    const f32x4 v0 = acc[ai][bj][m][0], v1 = acc[ai][bj][m][1];
                    u32x4 w; w.x = pack2(v0[0], v0[1]); w.y = pack2(v0[2], v0[3]); w.z = pack2(v1[0], v1[1]); w.w = pack2(v1[2], v1[3]);
                    *(u32x4*)(rowp + bj * HALF) = w;
                }
            }
    }
};
struct EpiSwiglu {
    static constexpr bool PERM = true;
    bf16_t* act;
    DI void operator()(const f32x4 (&acc)[2][2][4][2], const Unit& u, int wr, int wc, int fr, int fq) const {
        const int row0 = u.pm * BM + wr * 64 + fr, col0 = u.pn * HALF + wc * 32 + 8 * fq;
#pragma unroll
        for (int ai = 0; ai < 2; ++ai)
#pragma unroll
            for (int m = 0; m < 4; ++m) {
                float v[8];
#pragma unroll
                for (int n = 0; n < 2; ++n)
#pragma unroll
                    for (int j = 0; j < 4; ++j) { const float gg = acc[ai][0][m][n][j], uu = acc[ai][1][m][n][j]; v[4 * n + j] = gg * uu * __builtin_amdgcn_rcpf(1.0f + __builtin_amdgcn_exp2f(-gg * LOG2E)); }
                u32x4 w; w.x = pack2(v[0], v[1]); w.y = pack2(v[2], v[3]); w.z = pack2(v[4], v[5]); w.w = pack2(v[6], v[7]);
                *(u32x4*)(act + (size_t)(row0 + ai * HALF + m * 16) * DFF + col0) = w;
            }
    }
};
}
DI pg8::Gemm mk_gemm(const bf16_t* A, int lda, const bf16_t* Bt, int M, int N, int K) { return pg8::Gemm{A, Bt, M, N / 256, K, lda, (size_t)128 * K * 2, (size_t)256 * K * 2}; }

template <int DQK, int DV, int KT, int QMODE, bool ALIBI, bool NOMAX>
DI void attn_core(const bf16_t* __restrict__ q, int ldq, const bf16_t* __restrict__ k, int ldk, const bf16_t* __restrict__ k2, int ldk2,
                  const bf16_t* __restrict__ v, int ldv, int nkeys, int qpos0, float qscale, float slope2,
                  const float* __restrict__ qg, const float2* __restrict__ tab, char* smem, f32x16 (&o)[DV / 32], float& lsum) {
    constexpr int KROW = DQK * 2 + 16, VROW = DV * 2 + 16, KBYTES = KT * KROW, VBYTES = KT * VROW;
    constexpr int KCPR = DQK / 8  , KTOT = KT * KCPR, NKC = (KTOT + THREADS - 1) / THREADS, VCPR = DV / 8, VTOT = KT * VCPR, NVC = (VTOT + THREADS - 1) / THREADS;
    constexpr int NST = KT / 32, NKS = DQK / 16, NDT = DV / 32;
    static_assert(2 * (KBYTES + VBYTES) <= (int)LDS_BYTES, "lds");
    const int tid = otid(), lane = tid & 63, w = tid >> 6, r = lane & 31, h = lane >> 5;
    const int qpos = qpos0 + 32 * w + r;
    bf16x8 qf[NKS];
    {
        const bf16_t* qrow = q + (size_t)(32 * w + r) * ldq + 8 * h;
        u32x4 raw[NKS];
#pragma unroll
        for (int s = 0; s < NKS; ++s) raw[s] = *(const u32x4*)(qrow + 16 * s);
        if (QMODE == 1) {
            float ss = 0.f;
#pragma unroll
            for (int s = 0; s < NKS; ++s) {
                const unsigned u[4] = {raw[s].x, raw[s].y, raw[s].z, raw[s].w};
#pragma unroll
                for (int j = 0; j < 4; ++j) { const float a0 = bflo(u[j]), a1 = bfhi(u[j]); ss += a0 * a0 + a1 * a1; }
            }
            ss += __shfl_xor(ss, 32);
            const float rstd = rsqrtf(ss * (1.0f / 64) + EPS) * qscale;
#pragma unroll
            for (int s = 0; s < NKS; ++s) {
                unsigned u[4] = {raw[s].x, raw[s].y, raw[s].z, raw[s].w};
#pragma unroll
                for (int j = 0; j < 4; ++j) {
                    const int d0 = 16 * s + 8 * h + 2 * j;
                    const float y0 = bflo(u[j]) * rstd * qg[d0], y1 = bfhi(u[j]) * rstd * qg[d0 + 1];
                    const float2 cs = tab[qpos * 32 + (d0 >> 1)];
                    u[j] = pack2(y0 * cs.x - y1 * cs.y, y0 * cs.y + y1 * cs.x);
                }
                raw[s] = u32x4{u[0], u[1], u[2], u[3]};
            }
        } else if (QMODE == 2) {
#pragma unroll
            for (int s = 4; s < NKS; ++s) {
                unsigned u[4] = {raw[s].x, raw[s].y, raw[s].z, raw[s].w};
#pragma unroll
                for (int j = 0; j < 4; ++j) {
                    const int p = 8 * (s - 4) + 4 * h + j;
                    const float y0 = bflo(u[j]), y1 = bfhi(u[j]);
                    const float2 cs = tab[qpos * 16 + p];
                    u[j] = pack2(y0 * cs.x - y1 * cs.y, y0 * cs.y + y1 * cs.x);
                }
                raw[s] = u32x4{u[0], u[1], u[2], u[3]};
            }
        }
#pragma unroll
        for (int s = 0; s < NKS; ++s) qf[s] = __builtin_bit_cast(bf16x8, raw[s]);
    }
    u32x4 rk[NKC], rv[NVC];
    char* const kbuf = smem;
    char* const vbuf = smem + 2 * KBYTES;
#define ATT_GLOADK(key0_)                                                                                             \
    {                                                                                                                 \
        _Pragma("unroll") for (int i = 0; i < NKC; ++i) {                                                             \
            const int cid = tid + THREADS * i, key = cid / KCPR, cc = cid - key * KCPR;                               \
            if (KTOT % THREADS == 0 || cid < KTOT) {                                                                  \
                const bf16_t* src;                                                                                    \
                if (QMODE == 2 && cc >= 8) src = k2 + (size_t)((key0_) + key) * ldk2 + (cc - 8) * 8;                   \
                else src = k + (size_t)((key0_) + key) * ldk + cc * 8;                                                \
                rk[i] = *(const u32x4*)src;                                                                           \
            }                                                                                                         \
        }                                                                                                             \
    }
#define ATT_GLOADV(key0_)                                                                                             \
    {                                                                                                                 \
        _Pragma("unroll") for (int i = 0; i < NVC; ++i) {                                                             \
            const int cid = tid + THREADS * i, key = cid / VCPR, cc = cid - key * VCPR;                               \
            if (VTOT % THREADS == 0 || cid < VTOT) rv[i] = *(const u32x4*)(v + (size_t)((key0_) + key) * ldv + cc * 8); \
        }                                                                                                             \
    }
#define ATT_LSTOREK(buf_)                                                                                             \
    {                                                                                                                 \
        _Pragma("unroll") for (int i = 0; i < NKC; ++i) {                                                             \
            const int cid = tid + THREADS * i, key = cid / KCPR, cc = cid - key * KCPR;                               \
            if (KTOT % THREADS == 0 || cid < KTOT) *(u32x4*)(kbuf + (buf_) * KBYTES + key * KROW + cc * 16) = rk[i];  \
        }                                                                                                             \
    }
#define ATT_LSTOREV(buf_)                                                                                             \
    {                                                                                                                 \
        _Pragma("unroll") for (int i = 0; i < NVC; ++i) {                                                             \
            const int cid = tid + THREADS * i, key = cid / VCPR, cc = cid - key * VCPR;                               \
            if (VTOT % THREADS == 0 || cid < VTOT) *(u32x4*)(vbuf + (buf_) * VBYTES + key * VROW + cc * 16) = rv[i];  \
        }                                                                                                             \
    }
#define ATT_QK(buf_, X_)                                                                                              \
    {                                                                                                                 \
        const char* kb_ = kbuf + (buf_) * KBYTES + r * KROW + h * 16;                                                 \
        _Pragma("unroll") for (int st = 0; st < NST; ++st) {                                                          \
            X_[st] = MFMA(*(const bf16x8*)(kb_ + 32 * st * KROW), qf[0], zero16);                                     \
            _Pragma("unroll") for (int ks = 1; ks < NKS; ++ks) X_[st] = MFMA(*(const bf16x8*)(kb_ + 32 * st * KROW + ks * 32), qf[ks], X_[st]); \
        }                                                                                                             \
    }
#define ATT_SMPV(t_, vb_, X_)                                                                                         \
    {                                                                                                                 \
        if (NOMAX) {                                                                                                  \
            _Pragma("unroll") for (int st = 0; st < NST; ++st)                                                        \
                _Pragma("unroll") for (int i = 0; i < 16; ++i) X_[st][i] = __builtin_amdgcn_exp2f(X_[st][i]);         \
        } else {                                                                                                      \
            float mx = -1e30f;                                                                                        \
            const float dq = (float)(qpos - ((t_) * KT + 4 * h));                                                     \
            _Pragma("unroll") for (int st = 0; st < NST; ++st)                                                        \
                _Pragma("unroll") for (int i = 0; i < 16; ++i) {                                                      \
                    if (ALIBI) X_[st][i] = __builtin_fmaf(-slope2, fabsf(dq - (float)(32 * st + (i & 3) + 8 * (i >> 2))), X_[st][i]); \
                    mx = fmaxf(mx, X_[st][i]);                                                                        \
                }                                                                                                     \
            mx = fmaxf(mx, __shfl_xor(mx, 32));                                                                       \
            const float mn = fmaxf(m, mx);                                                                            \
            const float alpha = __builtin_amdgcn_exp2f(m - mn);                                                       \
            m = mn;                                                                                                   \
            _Pragma("unroll") for (int st = 0; st < NST; ++st)                                                        \
                _Pragma("unroll") for (int i = 0; i < 16; ++i) X_[st][i] = __builtin_amdgcn_exp2f(X_[st][i] - mn);    \
            if (__any(alpha != 1.0f)) {                                                                               \
                _Pragma("unroll") for (int dt = 0; dt < NDT; ++dt)                                                    \
                    _Pragma("unroll") for (int i = 0; i < 16; ++i) o[dt][i] *= alpha;                                 \
                _Pragma("unroll") for (int i = 0; i < 16; ++i) ol[i] *= alpha;                                        \
            }                                                                                                         \
        }                                                                                                             \
        const char* vbp_ = vbuf + (vb_) * VBYTES + vlane;                                                             \
        _Pragma("unroll") for (int st = 0; st < NST; ++st)                                                            \
            _Pragma("unroll") for (int s = 0; s < 2; ++s) {                                                           \
                u32x4 pk;                                                                                             \
                pk.x = pack2(X_[st][8 * s + 0], X_[st][8 * s + 1]); pk.y = pack2(X_[st][8 * s + 2], X_[st][8 * s + 3]); \
                pk.z = pack2(X_[st][8 * s + 4], X_[st][8 * s + 5]); pk.w = pack2(X_[st][8 * s + 6], X_[st][8 * s + 7]); \
                const bf16x8 pb = __builtin_bit_cast(bf16x8, pk);                                                     \
                ol = MFMA(ones8, pb, ol);                                                                             \
                _Pragma("unroll") for (int dt = 0; dt < NDT; ++dt) {                                                  \
                    const char* va = vbp_ + (32 * st + 16 * s) * VROW + 64 * dt;                                      \
                    const s16x4 lo = __builtin_amdgcn_ds_read_tr16_b64_v4i16((LDS_AS s16x4*)(va));                    \
                    const s16x4 hi = __builtin_amdgcn_ds_read_tr16_b64_v4i16((LDS_AS s16x4*)(va + 8 * VROW));        \
                    o[dt] = MFMA(__builtin_shufflevector(lo, hi, 0, 1, 2, 3, 4, 5, 6, 7), pb, o[dt]);                 \
                }                                                                                                     \
            }                                                                                                         \
    }
#define ATT_STEP(t_, PAR_, CUR_, NXT_)                                                                                \
    {                                                                                                                 \
        const int tk_ = ((t_) + 2 < ntiles) ? (t_) + 2 : ntiles - 1, tv_ = ((t_) + 1 < ntiles) ? (t_) + 1 : ntiles - 1; \
        ATT_GLOADK(tk_ * KT)                                                                                          \
        ATT_GLOADV(tv_ * KT)                                                                                          \
        __builtin_amdgcn_sched_barrier(0);                                                                            \
        ATT_QK(1 - (PAR_), NXT_)                                                                                      \
        ATT_SMPV(t_, PAR_, CUR_)                                                                                      \
        __builtin_amdgcn_sched_barrier(0);                                                                            \
        ATT_LSTOREK(PAR_)                                                                                             \
        ATT_LSTOREV(1 - (PAR_))                                                                                       \
        __syncthreads();                                                                                              \
    }
    const f32x16 zero16 = {0.f, 0.f, 0.f, 0.f, 0.f, 0.f, 0.f, 0.f, 0.f, 0.f, 0.f, 0.f, 0.f, 0.f, 0.f, 0.f};
    const bf16x8 ones8 = {0x3F80, 0x3F80, 0x3F80, 0x3F80, 0x3F80, 0x3F80, 0x3F80, 0x3F80};
    float m = -1e30f;
    f32x16 ol = zero16;
#pragma unroll
    for (int dt = 0; dt < NDT; ++dt) o[dt] = zero16;
    const int ntiles = nkeys / KT;
    const int vlane = (4 * h + ((lane & 15) >> 2)) * VROW + (16 * ((lane >> 4) & 1) + 4 * (lane & 3)) * 2;
    f32x16 xa[NST], xb[NST];
    ATT_GLOADK(0) ATT_LSTOREK(0)
    ATT_GLOADK(KT) ATT_GLOADV(0)
    __syncthreads();
    ATT_QK(0, xa)
    ATT_LSTOREK(1) ATT_LSTOREV(0)
    __syncthreads();
    for (int t = 0; t < ntiles; t += 2) {
        ATT_STEP(t, 0, xa, xb)
        ATT_STEP(t + 1, 1, xb, xa)
    }
    lsum = ol[0];
#undef ATT_GLOADK
#undef ATT_GLOADV
#undef ATT_LSTOREK
#undef ATT_LSTOREV
#undef ATT_QK
#undef ATT_SMPV
#undef ATT_STEP
}
template <int NDT>
DI void store_o(bf16_t* dst, int ld, f32x16 (&o)[NDT], float inv) {
    const int tid_ = otid(), lane = tid_ & 63, w = tid_ >> 6, r = lane & 31, h = lane >> 5;
    bf16_t* row = dst + (size_t)(32 * w + r) * ld + 4 * h;
#pragma unroll
    for (int dt = 0; dt < NDT; ++dt)
#pragma unroll
        for (int g = 0; g < 4; ++g) {
            uint2 vv; vv.x = pack2(o[dt][4 * g] * inv, o[dt][4 * g + 1] * inv); vv.y = pack2(o[dt][4 * g + 2] * inv, o[dt][4 * g + 3] * inv);
            *(uint2*)(row + 32 * dt + 8 * g) = vv;
        }
}
DI int swz_item(int base) {
    const int G = gridDim.x, i = blockIdx.x;
    if (G & 7) return base + i;
    return base + (i & 7) * (G >> 3) + (i >> 3);
}

constexpr int QT = SEQ / 256;
DI void attn_even(const bf16_t* qkv, float* park, bf16_t* mix, const Params& p, const float2* ax, float lam_init, char* smem) {
    float d1 = 0.f, d2 = 0.f;
    for (int i = 0; i < 64; ++i) { d1 += p.in[8][i] * p.in[9][i]; d2 += p.in[10][i] * p.in[11][i]; }
    const float lam = __expf(d1) - __expf(d2) + lam_init;
    const int tid_ = otid(), lane = tid_ & 63, h = lane >> 5;
    float4* mypark = (float4*)(park + ((size_t)blockIdx.x * THREADS + tid_) * 64);
    constexpr int NDIFF = NB * 4 * QT, NGQA = NB * 8 * QT;
    for (int base = 0; base < NDIFF + NGQA; base += gridDim.x) {
        const int it = swz_item(base);
        if (it >= NDIFF + NGQA) continue;
        if (it < NDIFF) {
            const int b = it / (4 * QT), hd = (it / QT) & 3, qt = it % QT;
            const size_t row0 = (size_t)b * SEQ + qt * 256;
            const float slope2 = exp2f(-2.0f * (hd + 1)) * LOG2E;
            const bf16_t* qp = qkv + row0 * EVEN_IN + 768 + hd * 128;
            const bf16_t* kp = qkv + (size_t)b * SEQ * EVEN_IN + 1280 + hd * 128;
            const bf16_t* vp = qkv + (size_t)b * SEQ * EVEN_IN + 1792 + hd * 128;
            f32x16 o0[4]; float l0;
            attn_core<64, 128, 64, 0, true, false>(qp, EVEN_IN, kp, EVEN_IN, nullptr, 0, vp, EVEN_IN, SEQ, qt * 256, 1.0f, slope2, nullptr, nullptr, smem, o0, l0);
            const float i0 = 1.0f / l0;
#pragma unroll
            for (int dt = 0; dt < 4; ++dt)
#pragma unroll
                for (int g = 0; g < 4; ++g) mypark[dt * 4 + g] = make_float4(o0[dt][4 * g] * i0, o0[dt][4 * g + 1] * i0, o0[dt][4 * g + 2] * i0, o0[dt][4 * g + 3] * i0);
            asm volatile("" ::: "memory");
            attn_core<64, 128, 64, 0, true, false>(qp + 64, EVEN_IN, kp + 64, EVEN_IN, nullptr, 0, vp, EVEN_IN, SEQ, qt * 256, 1.0f, slope2, nullptr, nullptr, smem, o0, l0);
            const float i1 = lam / l0;
            float ss = 0.f;
            asm volatile("" ::: "memory");
#pragma unroll
            for (int dt = 0; dt < 4; ++dt)
#pragma unroll
                for (int g = 0; g < 4; ++g) {
                    const float4 pv = mypark[dt * 4 + g];
                    const float pa[4] = {pv.x, pv.y, pv.z, pv.w};
#pragma unroll
                    for (int e = 0; e < 4; ++e) { const float vv = pa[e] - i1 * o0[dt][4 * g + e]; o0[dt][4 * g + e] = vv; ss += vv * vv; }
                }
            ss += __shfl_xor(ss, 32);
            const float rstd = rsqrtf(ss * (1.0f / 128) + EPS) * (1.0f - lam_init);
#pragma unroll
            for (int dt = 0; dt < 4; ++dt)
#pragma unroll
                for (int i = 0; i < 16; ++i) o0[dt][i] *= p.in[12][32 * dt + crow(i, h)];
            store_o<4>(mix + row0 * D + 512 + hd * 128, D, o0, rstd);
        } else {
            const int j = it - NDIFF;
            const int b = j / (8 * QT), hd = (j / QT) & 7, qt = j % QT, kvh = hd >> 2;
            const size_t row0 = (size_t)b * SEQ + qt * 256;
            f32x16 o[2]; float l;
            attn_core<64, 64, 64, 1, false, true>(qkv + row0 * EVEN_IN + hd * 64, EVEN_IN, qkv + (size_t)b * SEQ * EVEN_IN + 512 + kvh * 64, EVEN_IN, nullptr, 0,
                                            qkv + (size_t)b * SEQ * EVEN_IN + 640 + kvh * 64, EVEN_IN, SEQ, qt * 256, 0.125f * LOG2E, 0.f, p.in[6], ax, smem, o, l);
            store_o<2>(mix + row0 * D + hd * 64, D, o, 1.0f / l);
        }
    }
}
DI void attn_mla(const bf16_t* qb, const bf16_t* kv, const bf16_t* a, bf16_t* mix, const float2* lin, char* smem) {
    constexpr int NIT = NB * 16 * QT;
    for (int base = 0; base < NIT; base += gridDim.x) {
        const int it = swz_item(base);
        if (it >= NIT) continue;
        const int b = it / (16 * QT), hd = (it / QT) & 15, qt = it % QT;
        const size_t row0 = (size_t)b * SEQ + qt * 256;
        f32x16 o[2]; float l;
        attn_core<96, 64, 64, 2, false, false>(qb + row0 * 1536 + hd * 96, 1536, kv + (size_t)b * SEQ * 2048 + hd * 128, 2048, a + (size_t)b * SEQ * ODD_PAD + 640, ODD_PAD,
                                        kv + (size_t)b * SEQ * 2048 + hd * 128 + 64, 2048, SEQ, qt * 256, 1.0f, 0.f, nullptr, lin, smem, o, l);
        store_o<2>(mix + row0 * D + hd * 64, D, o, 1.0f / l);
    }
}
DI void attn_cross(const bf16_t* qx, const bf16_t* kvx, bf16_t* mix, int seq0, char* smem) {
    constexpr int NIT = NB * 4 * QT * 2;
    for (int base = 0; base < NIT; base += gridDim.x) {
        const int it = swz_item(base);
        if (it >= NIT) continue;
        const int b = it / (8 * QT), hd = (it / (2 * QT)) & 3, qt = (it >> 1) % QT, half = it & 1;
        const size_t row0 = (size_t)b * SEQ + qt * 256;
        const bf16_t* kvb = kvx + (size_t)(seq0 + b) * NMEM * 2048;
        f32x16 o[4]; float l;
        attn_core<256, 128, 32, 0, false, false>(qx + row0 * D + hd * 256, D, kvb + hd * 256, 2048, nullptr, 0, kvb + 1024 + hd * 256 + half * 128, 2048, NMEM, 0,
                                          1.0f, 0.f, nullptr, nullptr, smem, o, l);
        store_o<4>(mix + row0 * D + hd * 256 + half * 128, D, o, 1.0f / l);
    }
}

extern "C" __global__ void __launch_bounds__(THREADS, 2) fwd_mega(Params p) {
    extern __shared__ __attribute__((aligned(16))) char smem[];
    LDS_AS unsigned char* lds = (LDS_AS unsigned char*)smem;
    cg::grid_group grid = cg::this_grid();
    char* ws = p.ws;
    __shared__ uint4 xb_words;
    if (threadIdx.x == 0) xb_words = make_uint4(0u, 0u, 0u, 0u);
    __syncthreads();
    const XcdBarrier xb = xcd_barrier_post((unsigned*)(ws + B_BAR), (volatile LDS_AS unsigned*)&xb_words);
    bf16_t* wEin = (bf16_t*)(ws + W_EIN); bf16_t* wEout = (bf16_t*)(ws + W_EOUT); bf16_t* wOin = (bf16_t*)(ws + W_OIN);
    bf16_t* wUq = (bf16_t*)(ws + W_UQ); bf16_t* wUkv = (bf16_t*)(ws + W_UKV); bf16_t* wOout = (bf16_t*)(ws + W_OOUT);
    float2* ax = (float2*)(ws + T_AX); float2* lin = (float2*)(ws + T_LIN);
    bf16_t* H = (bf16_t*)(ws + B_H); bf16_t* MIX = (bf16_t*)(ws + B_MIX);

    convert_weight(p.in[5], wEin, D, EVEN_IN, EVEN_IN, smem, 768, 1280, 0.125f * LOG2E);
    convert_weight(p.in[13], wEout, D, D, D, smem);
    convert_weight(p.in[14], wOin, D, ODD_IN, ODD_PAD, smem);
    convert_weight(p.in[17], wUq, 384, 1536, 1536, smem, 0, 1536, 0.10206207261596575f * LOG2E);
    convert_weight(p.in[18], wUkv, 256, 2048, 2048, smem);
    convert_weight(p.in[19], wOout, D, D, D, smem);
    for (int l = 0; l < 2; ++l) {
        convert_weight(p.in[22] + (size_t)l * D * D, (bf16_t*)(ws + W_CQ) + (size_t)l * D * D, D, D, D, smem, 0, D, 0.0625f * LOG2E);
        convert_weight(p.in[23] + (size_t)l * D * 2048, (bf16_t*)(ws + W_CKV) + (size_t)l * 2048 * D, D, 2048, 2048, smem);
        convert_weight(p.in[24] + (size_t)l * D * D, (bf16_t*)(ws + W_CO) + (size_t)l * D * D, D, D, D, smem);
        convert_weight(p.in[26] + (size_t)l * D * 2 * DFF, (bf16_t*)(ws + W_GU) + (size_t)l * 2 * DFF * D, D, 2 * DFF, 2 * DFF, smem);
        convert_weight(p.in[27] + (size_t)l * DFF * D, (bf16_t*)(ws + W_DOWN) + (size_t)l * D * DFF, DFF, D, D, smem);
        rmsnorm_rows(p.in[2], p.in[21] + l * D, (bf16_t*)(ws + B_MEMN) + (size_t)l * NBATCH * NMEM * D, 8 * NMEM);
        rmsnorm_rows(p.in[3], p.in[21] + l * D, (bf16_t*)(ws + B_MEMN) + (size_t)l * NBATCH * NMEM * D + (size_t)8 * NMEM * D, 16 * NMEM);
    }
    build_tables(ax, lin);
    xcd_barrier(xb);
    for (int l = 0; l < 2; ++l) {
        pg8::EpiBf16 e{(bf16_t*)(ws + B_KX) + (size_t)l * NBATCH * NMEM * 2048, 2048};
        pg8::gemm_phase(lds, mk_gemm((const bf16_t*)(ws + B_MEMN) + (size_t)l * NBATCH * NMEM * D, D, (const bf16_t*)(ws + W_CKV) + (size_t)l * 2048 * D, NBATCH * NMEM, 2048, D), e);
    }
    xcd_barrier(xb);

    for (int ch = 0; ch < NCHUNK; ++ch) {
        const float* xin = (ch == 0) ? p.in[0] : p.in[1] + (size_t)(ch - 1) * TC * D;
        float* xo = p.out + (size_t)ch * TC * D;
        for (int layer = 0; layer < 2; ++layer) {
            const float* xcur = (layer == 0) ? xin : xo;
            for (int rep_ = 0; rep_ < PROBE_NORM; ++rep_) rmsnorm_rows(xcur, p.in[4] + layer * D, H, TC);
            xcd_barrier(xb);
            const bf16_t* wout;
            if (layer == 0) {
                bf16_t* qkv = (bf16_t*)(ws + E_QKV);
                for (int rep_ = 0; rep_ < PROBE_GEMM; ++rep_) { pg8::EpiBf16 e{qkv, EVEN_IN}; pg8::gemm_phase(lds, mk_gemm(H, D, wEin, TC, EVEN_IN, D), e); }
                xcd_barrier(xb);
                kprep_even(qkv, p.in[7], ax);
                xcd_barrier(xb);
                for (int rep_ = 0; rep_ < PROBE_ATTN; ++rep_) attn_even(qkv, (float*)(ws + E_PARK), MIX, p, ax, 0.2f, smem);
                wout = wEout;
            } else {
                bf16_t* a = (bf16_t*)(ws + O_A); bf16_t* qb = (bf16_t*)(ws + O_Q); bf16_t* kv = (bf16_t*)(ws + O_KV);
                for (int rep_ = 0; rep_ < PROBE_GEMM; ++rep_) { pg8::EpiBf16 e{a, ODD_PAD}; pg8::gemm_phase(lds, mk_gemm(H, D, wOin, TC, ODD_PAD, D), e); }
                xcd_barrier(xb);
                prep_odd(a, p.in[15], p.in[16], lin);
                xcd_barrier(xb);
                for (int rep_ = 0; rep_ < PROBE_GEMM; ++rep_) { pg8::EpiBf16 e{qb, 1536}; pg8::gemm_phase(lds, mk_gemm(a, ODD_PAD, wUq, TC, 1536, 384), e); }
                for (int rep_ = 0; rep_ < PROBE_GEMM; ++rep_) { pg8::EpiBf16 e{kv, 2048}; pg8::gemm_phase(lds, mk_gemm(a + 384, ODD_PAD, wUkv, TC, 2048, 256), e); }
                xcd_barrier(xb);
                for (int rep_ = 0; rep_ < PROBE_ATTN; ++rep_) attn_mla(qb, kv, a, MIX, lin, smem);
                wout = wOout;
            }
            xcd_barrier(xb);
            { pg8::EpiResid e{xcur, xo}; pg8::gemm_phase(lds, mk_gemm(MIX, D, wout, TC, D, D), e); }
            xcd_barrier(xb);
            for (int rep_ = 0; rep_ < PROBE_NORM; ++rep_) rmsnorm_rows(xo, p.in[20] + layer * D, H, TC);
            xcd_barrier(xb);
            for (int rep_ = 0; rep_ < PROBE_GEMM; ++rep_) { pg8::EpiBf16 e{(bf16_t*)(ws + X_Q), D}; pg8::gemm_phase(lds, mk_gemm(H, D, (const bf16_t*)(ws + W_CQ) + (size_t)layer * D * D, TC, D, D), e); }
            xcd_barrier(xb);
            for (int rep_ = 0; rep_ < PROBE_CROSS; ++rep_) attn_cross((const bf16_t*)(ws + X_Q), (const bf16_t*)(ws + B_KX) + (size_t)layer * NBATCH * NMEM * 2048, MIX, ch * NB, smem);
            xcd_barrier(xb);
            { pg8::EpiResid e{xo, xo}; pg8::gemm_phase(lds, mk_gemm(MIX, D, (const bf16_t*)(ws + W_CO) + (size_t)layer * D * D, TC, D, D), e); }
            xcd_barrier(xb);
            for (int rep_ = 0; rep_ < PROBE_NORM; ++rep_) rmsnorm_rows(xo, p.in[25] + layer * D, H, TC);
            xcd_barrier(xb);
            for (int rep_ = 0; rep_ < PROBE_GEMM; ++rep_) { pg8::EpiSwiglu e{(bf16_t*)(ws + F_ACT)};
              pg8::Gemm g{H, (const bf16_t*)(ws + W_GU) + (size_t)layer * 2 * DFF * D, TC, DFF / 128, D, D, (size_t)DFF * D * 2, (size_t)128 * D * 2};
              pg8::gemm_phase(lds, g, e); }
            xcd_barrier(xb);
            { pg8::EpiResid e{xo, xo}; pg8::gemm_phase(lds, mk_gemm((const bf16_t*)(ws + F_ACT), DFF, (const bf16_t*)(ws + W_DOWN) + (size_t)layer * D * DFF, TC, D, DFF), e); }
            xcd_barrier(xb);
        }
        rmsnorm_final(xo, p.in[28], TC);
    }
}

extern "C" void kernel_launch(void* const* d_in, const int* in_sizes, int n_in, void* d_out, int out_size, void* d_ws, size_t ws_size, hipStream_t stream) {
    static int grid_blocks = 0;
    if (!grid_blocks) {
        int dev = 0, cus = 0, per_cu = 0;
        (void)hipGetDevice(&dev);
        (void)hipDeviceGetAttribute(&cus, hipDeviceAttributeMultiprocessorCount, dev);
        (void)hipFuncSetAttribute((const void*)fwd_mega, hipFuncAttributeMaxDynamicSharedMemorySize, (int)LDS_BYTES);
        (void)hipOccupancyMaxActiveBlocksPerMultiprocessor(&per_cu, fwd_mega, THREADS, LDS_BYTES);
        if (per_cu > 1) per_cu = 1;
        if (per_cu < 1) per_cu = 1;
        grid_blocks = cus * per_cu;
    }
    constexpr size_t WS_END = (O_END > E_END ? O_END : E_END) > (F_ACT + (size_t)TC * DFF * 2) ? (O_END > E_END ? O_END : E_END) : (F_ACT + (size_t)TC * DFF * 2);
    if (ws_size < WS_END) { fprintf(stderr, "workspace too small: %zu < %zu\n", ws_size, (size_t)WS_END); return; }
    if (grid_blocks > 256) grid_blocks = 256;
    Params p{};
    for (int i = 0; i < 29; ++i) p.in[i] = (const float*)d_in[i];
    p.out = (float*)d_out;
    p.ws = (char*)d_ws;
    (void)hipMemsetAsync(d_ws, 0, 16384, stream);
    void* args[] = {&p};
    hipError_t e = hipLaunchCooperativeKernel((void*)fwd_mega, dim3(grid_blocks), dim3(THREADS), args, LDS_BYTES, stream);
    if (e != hipSuccess) fprintf(stderr, "cooperative launch failed: %s (grid %d)\n", hipGetErrorString(e), grid_blocks);
}
```

```cpp
#include <hip/hip_runtime.h>
#include <hip/hip_cooperative_groups.h>
#include <cstdio>
#include <cstdint>
namespace cg = cooperative_groups;
#ifndef PROBE_GEMM
#define PROBE_GEMM 1
#endif
#ifndef PROBE_NORM
#define PROBE_NORM 1
#endif
#ifndef PROBE_CROSS
#define PROBE_CROSS 1
#endif
#ifndef PROBE_ATTN
#define PROBE_ATTN 1
#endif

typedef unsigned short bf16_t;
typedef short bf16x8 __attribute__((ext_vector_type(8)));
typedef float f32x16 __attribute__((ext_vector_type(16)));
typedef float f32x2 __attribute__((ext_vector_type(2)));
typedef unsigned u32x4 __attribute__((ext_vector_type(4)));
typedef float f32x4 __attribute__((ext_vector_type(4)));
typedef short s16x4 __attribute__((ext_vector_type(4)));
#define LDS_AS __attribute__((address_space(3)))
typedef __bf16 bf16x2_t __attribute__((ext_vector_type(2)));
#define DI __device__ __forceinline__
#define MFMA(a, b, c) __builtin_amdgcn_mfma_f32_32x32x16_bf16((a), (b), (c), 0, 0, 0)

constexpr int D = 1024, SEQ = 4096, NBATCH = 24, NB = 8  , NCHUNK = NBATCH / NB, TC = NB * SEQ;
constexpr int NMEM = 256, DFF = 2816, EVEN_IN = 2304, ODD_IN = 672, ODD_PAD = 768;
constexpr float EPS = 1e-6f, LOG2E = 1.4426950408889634f;
constexpr int THREADS = 512, NWAVE = THREADS / 64;
constexpr size_t LDS_BYTES = 131072;

constexpr size_t al(size_t x) { return (x + 255) & ~(size_t)255; }
constexpr size_t B_BAR = 0;
constexpr size_t B_NORMS = 16384;
constexpr size_t W_EIN = 32768;
constexpr size_t W_EOUT = W_EIN + al((size_t)EVEN_IN * D * 2);
constexpr size_t W_OIN = W_EOUT + al((size_t)D * D * 2);
constexpr size_t W_UQ = W_OIN + al((size_t)ODD_PAD * D * 2);
constexpr size_t W_UKV = W_UQ + al((size_t)1536 * 384 * 2);
constexpr size_t W_OOUT = W_UKV + al((size_t)2048 * 256 * 2);
constexpr size_t W_CQ = W_OOUT + al((size_t)D * D * 2);
constexpr size_t W_CKV = W_CQ + 2 * al((size_t)D * D * 2);
constexpr size_t W_CO = W_CKV + 2 * al((size_t)2048 * D * 2);
constexpr size_t W_GU = W_CO + 2 * al((size_t)D * D * 2);
constexpr size_t W_DOWN = W_GU + 2 * al((size_t)2 * DFF * D * 2);
constexpr size_t T_AX = W_DOWN + 2 * al((size_t)D * DFF * 2);
constexpr size_t T_LIN = T_AX + al((size_t)SEQ * 32 * 8);
constexpr size_t B_MEMN = T_LIN + al((size_t)SEQ * 16 * 8);
constexpr size_t B_KX = B_MEMN + 2 * al((size_t)NBATCH * NMEM * D * 2);
constexpr size_t B_H = B_KX + 2 * al((size_t)NBATCH * NMEM * 2048 * 2);
constexpr size_t B_MIX = B_H + al((size_t)TC * D * 2);
constexpr size_t B_BIG = B_MIX + al((size_t)TC * D * 2);
constexpr size_t E_QKV = B_BIG;
constexpr size_t E_PARK = E_QKV + al((size_t)TC * EVEN_IN * 2);
constexpr size_t E_END = E_PARK + (size_t)256 * THREADS * 64 * 4;
constexpr size_t O_A = B_BIG;
constexpr size_t O_Q = O_A + al((size_t)TC * ODD_PAD * 2);
constexpr size_t O_KV = O_Q + al((size_t)TC * 1536 * 2);
constexpr size_t O_END = O_KV + al((size_t)TC * 2048 * 2);
constexpr size_t X_Q = B_BIG;
constexpr size_t F_ACT = B_BIG;

struct Params {
    const float* in[29];
    float* out;
    char* ws;
};

DI unsigned pack2(float lo, float hi) { f32x2 v = {lo, hi}; bf16x2_t b = __builtin_convertvector(v, bf16x2_t); return __builtin_bit_cast(unsigned, b); }
DI float bflo(unsigned u) { return __uint_as_float(u << 16); }
DI float bfhi(unsigned u) { return __uint_as_float(u & 0xffff0000u); }
DI int crow(int i, int h) { return (i & 3) + 8 * (i >> 2) + 4 * h; }
DI int swap23(int x) { return (x & ~12) | ((x & 4) << 1) | ((x & 8) >> 1); }
DI int otid() { int t = threadIdx.x; asm volatile("" : "+v"(t)); return t; }
DI float wave_sum(float v) {
#pragma unroll
    for (int o = 32; o >= 1; o >>= 1) v += __shfl_xor(v, o);
    return v;
}


#define XB_TMO      128
#define XB_XCNT(j)  (256  + 64 * (j))
#define XB_XSUB(j)  (1280 + 64 * (j))
#define XB_XGEN(j)  (2304 + 64 * (j))
#define XB_TOP      3328
#define XB_TOPGEN   3392
#define XCD_BAR_WORDS 3456
#define XB_SPIN_CAP (1u << 18)
DI unsigned xb_ld(unsigned* p) { return __hip_atomic_load(p, __ATOMIC_RELAXED, __HIP_MEMORY_SCOPE_AGENT); }
DI unsigned xb_add(unsigned* p, unsigned v) { return __hip_atomic_fetch_add(p, v, __ATOMIC_RELAXED, __HIP_MEMORY_SCOPE_AGENT); }
DI unsigned xb_xcc_id() { return (unsigned)__builtin_amdgcn_s_getreg((3 << 11) | 20) & 0xFu; }
#define XB_SPIN(cond, bar) do { unsigned _sp = 0; while (cond) { __builtin_amdgcn_s_sleep(1); \
    if ((++_sp & 255u) == 0u) { if (xb_ld(&(bar)[XB_TMO])) break; if (_sp > XB_SPIN_CAP) { atomicAdd(&(bar)[XB_TMO], 1u); break; } } } } while (0)
struct XcdBarrier { unsigned* bar; unsigned x; volatile LDS_AS unsigned* st; };
DI XcdBarrier xcd_barrier_post(unsigned* bar, volatile LDS_AS unsigned* st) {
    XcdBarrier b; b.bar = bar; b.x = xb_xcc_id(); b.st = st;
    if (threadIdx.x == 0) (void)xb_add(&bar[XB_XCNT(b.x)], 1u);
    return b;
}
DI void xcd_barrier_complete(unsigned* bar, unsigned x, unsigned& nloc, unsigned& nx) {
    const unsigned G = gridDim.x * gridDim.y * gridDim.z;
    unsigned sum, cnt, mine, sp = 0u;
    for (;;) {
        sum = 0u; cnt = 0u; mine = 0u;
#pragma unroll
        for (unsigned j = 0; j < 16; ++j) { const unsigned c = xb_ld(&bar[XB_XCNT(j)]); sum += c; cnt += (c > 0u) ? 1u : 0u; mine = (j == x) ? c : mine; }
        if (sum == G) break;
        __builtin_amdgcn_s_sleep(1);
        if ((++sp & 255u) == 0u) { if (xb_ld(&bar[XB_TMO])) break; if (sp > XB_SPIN_CAP) { atomicAdd(&bar[XB_TMO], 1u); break; } }
    }
    nloc = mine > 0u ? mine : 1u; nx = cnt > 0u ? cnt : 1u;
}
DI void xcd_barrier(const XcdBarrier& b) {
    asm volatile("s_waitcnt vmcnt(0)" ::: "memory");
    __syncthreads();
    if (threadIdx.x == 0) {
        unsigned* bar = b.bar;
        __builtin_amdgcn_s_waitcnt(0);
        unsigned nloc = b.st[0], nx = b.st[1];
        if (nloc == 0u) { xcd_barrier_complete(bar, b.x, nloc, nx); b.st[0] = nloc; b.st[1] = nx; }
        const unsigned old = xb_add(&bar[XB_XSUB(b.x)], 1u);
        const unsigned gen = old / nloc;
        if (old + 1u == (gen + 1u) * nloc) {
            __builtin_amdgcn_fence(__ATOMIC_RELEASE, "agent");
            asm volatile("s_waitcnt vmcnt(0)" ::: "memory");
            const unsigned og = xb_add(&bar[XB_TOP], 1u);
            const unsigned tg = og / nx;
            if (og + 1u == (tg + 1u) * nx) xb_add(&bar[XB_TOPGEN], 1u);
            else XB_SPIN(xb_ld(&bar[XB_TOPGEN]) == tg, bar);
            __builtin_amdgcn_fence(__ATOMIC_ACQUIRE, "agent");
            xb_add(&bar[XB_XGEN(b.x)], 1u);
            asm volatile("s_waitcnt vmcnt(0)" ::: "memory");
        } else {
            XB_SPIN(xb_ld(&bar[XB_XGEN(b.x)]) == gen, bar);
            __builtin_amdgcn_fence(__ATOMIC_ACQUIRE, "agent");
            asm volatile("s_waitcnt vmcnt(0)" ::: "memory");
        }
    }
    __syncthreads();
}

DI void convert_weight(const float* __restrict__ src, bf16_t* __restrict__ dst, int K, int N, int Npad, char* smem, int slo = 0, int shi = 0, float scale = 1.0f) {
    float* t = (float*)smem;
    const int tid = otid();
    const int nkt = K / 64, nnt = Npad / 64;
    for (int tile = blockIdx.x; tile < nkt * nnt; tile += gridDim.x) {
        const int k0 = (tile / nnt) * 64, n0 = (tile % nnt) * 64;
#pragma unroll
        for (int i = 0; i < 8; ++i) {
            const int k = i * 8 + (tid >> 6), n = tid & 63;
            const float sc_ = (n0 + n >= slo && n0 + n < shi) ? scale : 1.0f;
            t[k * 65 + n] = (n0 + n < N) ? src[(size_t)(k0 + k) * N + n0 + n] * sc_ : 0.f;
        }
        __syncthreads();
#pragma unroll
        for (int i = 0; i < 4; ++i) {
            const int n = i * 16 + (tid >> 5), k = (tid & 31) * 2;
            *(unsigned*)(dst + (size_t)(n0 + n) * K + k0 + k) = pack2(t[k * 65 + n], t[(k + 1) * 65 + n]);
        }
        __syncthreads();
    }
}

__device__ const float kFreq[16] = {1.000000000e+00f, 5.623413324e-01f, 3.162277639e-01f, 1.778279394e-01f, 1.000000015e-01f, 5.623413250e-02f, 3.162277490e-02f, 1.778279431e-02f,
                                    9.999999776e-03f, 5.623413250e-03f, 3.162277630e-03f, 1.778279431e-03f, 1.000000047e-03f, 5.623413017e-04f, 3.162277571e-04f, 1.778279402e-04f};
DI float2 sincos_acc(float ang) {
    const double x = (double)ang;
    const double n = __builtin_rint(x * 0.15915494309189535);
    double r = __builtin_fma(-n, 6.283185307179586, x);
    r = __builtin_fma(-n, 2.4492935982947064e-16, r);
    const double r2 = r * r;
    double s = 1.0, c = 1.0;
#pragma unroll
    for (int k = 13; k >= 1; --k) {
        s = 1.0 - r2 * s * (1.0 / (double)((2 * k) * (2 * k + 1)));
        c = 1.0 - r2 * c * (1.0 / (double)((2 * k - 1) * (2 * k)));
    }
    return make_float2((float)c, (float)(r * s));
}
DI void build_tables(float2* ax, float2* lin) {
    const int gt = blockIdx.x * THREADS + otid(), gs = gridDim.x * THREADS;
    for (int e = gt; e < SEQ * 32; e += gs) {
        const int pos = e >> 5, p = e & 31;
        const float base = (p < 16) ? (float)(pos >> 6) : (float)(pos & 63);
        ax[e] = sincos_acc(base * kFreq[p & 15]);
    }
    for (int e = gt; e < SEQ * 16; e += gs) {
        const int pos = e >> 4, p = e & 15;
        lin[e] = sincos_acc((float)pos * kFreq[p]);
    }
}

DI void rmsnorm_rows(const float* __restrict__ src, const float* __restrict__ g, bf16_t* __restrict__ dst, int nrows) {
    const int tid_ = otid(), lane = tid_ & 63, wv = blockIdx.x * NWAVE + (tid_ >> 6), nw = gridDim.x * NWAVE;
    for (int row = wv; row < nrows; row += nw) {
        const float4* s = (const float4*)(src + (size_t)row * D);
        float4 v[4]; float ss = 0.f;
#pragma unroll
        for (int i = 0; i < 4; ++i) { v[i] = s[i * 64 + lane]; ss += v[i].x * v[i].x + v[i].y * v[i].y + v[i].z * v[i].z + v[i].w * v[i].w; }
        ss = wave_sum(ss);
        const float rstd = rsqrtf(ss * (1.0f / D) + EPS);
#pragma unroll
        for (int i = 0; i < 4; ++i) {
            const float4 gg = ((const float4*)g)[i * 64 + lane];
            uint2 o; o.x = pack2(v[i].x * rstd * gg.x, v[i].y * rstd * gg.y); o.y = pack2(v[i].z * rstd * gg.z, v[i].w * rstd * gg.w);
            *(uint2*)(dst + (size_t)row * D + (i * 64 + lane) * 4) = o;
        }
    }
}
DI void rmsnorm_final(float* __restrict__ x, const float* __restrict__ g, int nrows) {
    const int tid_ = otid(), lane = tid_ & 63, wv = blockIdx.x * NWAVE + (tid_ >> 6), nw = gridDim.x * NWAVE;
    for (int row = wv; row < nrows; row += nw) {
        float4* s = (float4*)(x + (size_t)row * D);
        float4 v[4]; float ss = 0.f;
#pragma unroll
        for (int i = 0; i < 4; ++i) { v[i] = s[i * 64 + lane]; ss += v[i].x * v[i].x + v[i].y * v[i].y + v[i].z * v[i].z + v[i].w * v[i].w; }
        ss = wave_sum(ss);
        const float rstd = rsqrtf(ss * (1.0f / D) + EPS);
#pragma unroll
        for (int i = 0; i < 4; ++i) {
            const float4 gg = ((const float4*)g)[i * 64 + lane];
            float4 o; o.x = v[i].x * rstd * gg.x; o.y = v[i].y * rstd * gg.y; o.z = v[i].z * rstd * gg.z; o.w = v[i].w * rstd * gg.w;
            s[i * 64 + lane] = o;
        }
    }
}

DI void kprep_even(bf16_t* __restrict__ qkv, const float* __restrict__ gk, const float2* __restrict__ ax) {
    const int tid_ = otid(), gt = blockIdx.x * THREADS + tid_, gs = gridDim.x * THREADS;
    const int p = tid_ & 31;
    for (int v = gt >> 5; v < TC * 2; v += gs >> 5) {
        const int tok = v >> 1, kvh = v & 1;
        unsigned* ptr = (unsigned*)(qkv + (size_t)tok * EVEN_IN + 512 + kvh * 64 + 2 * p);
        const unsigned u = *ptr;
        const float x0 = bflo(u), x1 = bfhi(u);
        float ss = x0 * x0 + x1 * x1;
#pragma unroll
        for (int o = 16; o >= 1; o >>= 1) ss += __shfl_xor(ss, o);
        const float rstd = rsqrtf(ss * (1.0f / 64) + EPS);
        const float y0 = x0 * rstd * gk[2 * p], y1 = x1 * rstd * gk[2 * p + 1];
        const float2 cs = ax[(tok & (SEQ - 1)) * 32 + p];
        *ptr = pack2(y0 * cs.x - y1 * cs.y, y0 * cs.y + y1 * cs.x);
    }
}
DI void prep_odd(bf16_t* __restrict__ a, const float* __restrict__ gq, const float* __restrict__ gkv, const float2* __restrict__ lin) {
    const int tid_ = otid(), lane = tid_ & 63, wv = blockIdx.x * NWAVE + (tid_ >> 6), nw = gridDim.x * NWAVE;
    for (int row = wv; row < TC; row += nw) {
        unsigned* base = (unsigned*)(a + (size_t)row * ODD_PAD);
        unsigned uq[3], uk[2]; float sq = 0.f, sk = 0.f;
#pragma unroll
        for (int i = 0; i < 3; ++i) { uq[i] = base[i * 64 + lane]; const float a0 = bflo(uq[i]), a1 = bfhi(uq[i]); sq += a0 * a0 + a1 * a1; }
#pragma unroll
        for (int i = 0; i < 2; ++i) { uk[i] = base[192 + i * 64 + lane]; const float a0 = bflo(uk[i]), a1 = bfhi(uk[i]); sk += a0 * a0 + a1 * a1; }
        sq = wave_sum(sq); sk = wave_sum(sk);
        const float rq = rsqrtf(sq * (1.0f / 384) + EPS), rk = rsqrtf(sk * (1.0f / 256) + EPS);
#pragma unroll
        for (int i = 0; i < 3; ++i) { const int c = (i * 64 + lane) * 2; base[i * 64 + lane] = pack2(bflo(uq[i]) * rq * gq[c], bfhi(uq[i]) * rq * gq[c + 1]); }
#pragma unroll
        for (int i = 0; i < 2; ++i) { const int c = (i * 64 + lane) * 2; base[192 + i * 64 + lane] = pack2(bflo(uk[i]) * rk * gkv[c], bfhi(uk[i]) * rk * gkv[c + 1]); }
        if (lane < 16) {
            const unsigned u = base[320 + lane];
            const float x0 = bflo(u), x1 = bfhi(u);
            const float2 cs = lin[(row & (SEQ - 1)) * 16 + lane];
            base[320 + lane] = pack2(x0 * cs.x - x1 * cs.y, x0 * cs.y + x1 * cs.x);
        }
    }
}


DI void normmax_even(const bf16_t* __restrict__ qkv, unsigned* __restrict__ nd, char* smem) {
    const int tid = otid(), lane = tid & 63, w = tid >> 6;
    float* red = (float*)smem;
    for (int item = blockIdx.x; item < NB * 32; item += gridDim.x) {
        const int b = item & 7, slab = item >> 3;
        float mq = 0.f, mk = 0.f;
        for (int i = 0; i < 16; ++i) {
            const bf16_t* row = qkv + ((size_t)b * SEQ + slab * 128 + w * 16 + i) * EVEN_IN;
            const u32x4 uq = *(const u32x4*)(row + 768 + 8 * lane), uk = *(const u32x4*)(row + 1280 + 8 * lane);
            float sq = 0.f, sk = 0.f;
#pragma unroll
            for (int j = 0; j < 4; ++j) { const float a0 = bflo(uq[j]), a1 = bfhi(uq[j]), b0 = bflo(uk[j]), b1 = bfhi(uk[j]); sq += a0 * a0 + a1 * a1; sk += b0 * b0 + b1 * b1; }
#pragma unroll
            for (int o = 1; o <= 4; o <<= 1) { sq += __shfl_xor(sq, o); sk += __shfl_xor(sk, o); }
            mq = fmaxf(mq, sq); mk = fmaxf(mk, sk);
        }
        if ((lane & 7) == 0) { red[(w * 8 + (lane >> 3)) * 2] = mq; red[(w * 8 + (lane >> 3)) * 2 + 1] = mk; }
        __syncthreads();
        if (tid < 16) {
            float m = 0.f;
#pragma unroll
            for (int ww = 0; ww < NWAVE; ++ww) m = fmaxf(m, red[ww * 16 + tid]);
            atomicMax(nd + b * 16 + tid, __float_as_uint(m));
        }
        __syncthreads();
    }
}
DI void normmax_mla(const bf16_t* __restrict__ qb, const bf16_t* __restrict__ kv, const bf16_t* __restrict__ a, unsigned* __restrict__ nmx, char* smem) {
    const int tid = otid(), lane = tid & 63, w = tid >> 6;
    float* red = (float*)smem;
    for (int item = blockIdx.x; item < NB * 32; item += gridDim.x) {
        const int b = item & 7, slab = item >> 3;
        float mq = 0.f, mk = 0.f;
        for (int i = 0; i < 16; ++i) {
            const size_t r = (size_t)b * SEQ + slab * 128 + w * 16 + i;
            float sq = 0.f, sk = 0.f, sr = 0.f;
#pragma unroll
            for (int c = 0; c < 3; ++c) {
                const u32x4 u = *(const u32x4*)(qb + r * 1536 + 24 * lane + 8 * c);
#pragma unroll
                for (int j = 0; j < 4; ++j) { const float a0 = bflo(u[j]), a1 = bfhi(u[j]); sq += a0 * a0 + a1 * a1; }
            }
#pragma unroll
            for (int c = 0; c < 4; ++c) {
                const u32x4 u = *(const u32x4*)(kv + r * 2048 + 32 * lane + 8 * c);
#pragma unroll
                for (int j = 0; j < 4; ++j) { const float a0 = bflo(u[j]), a1 = bfhi(u[j]); sk += a0 * a0 + a1 * a1; }
            }
#pragma unroll
            for (int c = 0; c < 4; ++c) {
                const u32x4 u = *(const u32x4*)(a + r * ODD_PAD + 640 + 8 * c);
#pragma unroll
                for (int j = 0; j < 4; ++j) { const float a0 = bflo(u[j]), a1 = bfhi(u[j]); sr += a0 * a0 + a1 * a1; }
            }
            sq += __shfl_xor(sq, 1); sq += __shfl_xor(sq, 2);
            sk += __shfl_xor(sk, 1);
            mq = fmaxf(mq, sq); mk = fmaxf(mk, sk + sr);
        }
        if ((lane & 3) == 0) { red[(w * 16 + (lane >> 2)) * 2] = mq; red[(w * 16 + (lane >> 2)) * 2 + 1] = mk; }
        __syncthreads();
        if (tid < 32) {
            float m = 0.f;
#pragma unroll
            for (int ww = 0; ww < NWAVE; ++ww) m = fmaxf(m, red[ww * 32 + tid]);
            atomicMax(nmx + b * 32 + tid, __float_as_uint(m));
        }
        __syncthreads();
    }
}

namespace pg8 {
constexpr int BM = 256, BK = 64, HALF = 128, HTB = HALF * BK * 2, NXCD = 8, WGM = 8;
DI int lds_byte(int r, int c) { const int st = (r >> 4) * 2 + (c >> 5), rr = r & 15, cc = c & 31, ob = rr * 64 + cc * 2; return st * 1024 + (ob ^ (((ob >> 9) & 1) << 5)); }
DI void stage_rc(int b, int& R, int& C) { const int st = b / 1024, sb = b % 1024, swz = sb ^ (((sb >> 9) & 1) << 5); R = (st >> 1) * 16 + swz / 64; C = (st & 1) * 32 + (swz % 64) / 2; }
DI int perm32(int rho) { const int n = rho >> 4, i = rho & 15; return 8 * (i >> 2) + 4 * n + (i & 3); }
struct Unit { int pm, pn; };
struct Gemm { const bf16_t* A; const bf16_t* Bt; int M, NT, K, lda; size_t hstepB, tstepB; };
struct StaticOrder {
    int nM, nN, nwg, G, c;
    DI void init(int M, int NT, int G_, int c_) { nM = M / BM; nN = NT; nwg = nM * nN; G = G_; c = c_; }
    DI bool next(int i, Unit& u) const {
        const long L = (long)i * G + c; if (L >= nwg) return false;
        int wgid = (int)L; { const int q = nwg / NXCD, r = nwg % NXCD, xcd = wgid % NXCD, off = wgid / NXCD; wgid = (xcd < r ? xcd * (q + 1) : r * (q + 1) + (xcd - r) * q) + off; }
        const int nig = WGM * nN, gid = wgid / nig, fm = gid * WGM, gsz = (nM - fm) < WGM ? (nM - fm) : WGM;
        u.pm = fm + ((wgid % nig) % gsz); u.pn = (wgid % nig) / gsz; return true;
    }
};
template <class Epi>
DI void gemm_phase(LDS_AS unsigned char* lds, const Gemm g, const Epi& E) {
    StaticOrder S; S.init(g.M, g.NT, gridDim.x, blockIdx.x);
    const int tid = otid(), wid = __builtin_amdgcn_readfirstlane(tid >> 6), lane = tid & 63, wr = wid >> 2, wc = wid & 3, fr = lane & 15, fq = lane >> 4;
    const int K = g.K, nt = K / BK;
    unsigned voffA[2], voffB[2];
#pragma unroll
    for (int i = 0; i < 2; ++i) { int R, C; stage_rc(tid * 16 + i * 8192, R, C); const int Rb = Epi::PERM ? ((R & ~31) + perm32(R & 31)) : R;
        voffA[i] = (unsigned)(R * g.lda + C) * 2u; voffB[i] = (unsigned)(Rb * K + C) * 2u; }
    const size_t kstep = (size_t)(BK * 2);
    const size_t hstepA = (size_t)HALF * g.lda * 2, tstepA = 2 * hstepA, hstepB = g.hstepB, tstepB = g.tstepB;
    const unsigned ldsw = (unsigned)wid * 1024u;
    const int aoff = lds_byte(wr * 64 + fr, fq * 8), boff = lds_byte(wc * 32 + fr, fq * 8);
#define PG8_SA(b, h) (((b) * 2 + (h)) * HTB)
#define PG8_SB(b, h) ((4 + (b) * 2 + (h)) * HTB)
#define PG8_STAGE(bufoff, gbase, voff) do { _Pragma("unroll") for (int _i = 0; _i < 2; ++_i) \
        __builtin_amdgcn_global_load_lds((const unsigned*)((const char*)(gbase) + (voff)[_i]), (LDS_AS unsigned*)(lds + (bufoff) + ldsw + _i * 8192), 16, 0, 0); } while (0)
#define PG8_LDA(dst, b, h) do { _Pragma("unroll") for (int m = 0; m < 4; ++m) _Pragma("unroll") for (int k = 0; k < 2; ++k) dst[m][k] = *(const LDS_AS bf16x8*)(lds + PG8_SA(b, h) + aoff + m * 2048 + k * 1024); } while (0)
#define PG8_LDB(dst, b, h) do { _Pragma("unroll") for (int n = 0; n < 2; ++n) _Pragma("unroll") for (int k = 0; k < 2; ++k) dst[n][k] = *(const LDS_AS bf16x8*)(lds + PG8_SB(b, h) + boff + n * 2048 + k * 1024); } while (0)
#define PG8_MMA(ai, bj, At, Bt) do { __builtin_amdgcn_s_setprio(1); _Pragma("unroll") for (int m = 0; m < 4; ++m) _Pragma("unroll") for (int n = 0; n < 2; ++n) _Pragma("unroll") for (int k = 0; k < 2; ++k) \
        acc[ai][bj][m][n] = __builtin_amdgcn_mfma_f32_16x16x32_bf16(Bt[n][k], At[m][k], acc[ai][bj][m][n], 0, 0, 0); __builtin_amdgcn_s_setprio(0); } while (0)
#define PG8_WAIT_V(n) asm volatile("s_waitcnt vmcnt(" #n ")" ::: "memory")
#define PG8_WAIT_L(n) asm volatile("s_waitcnt lgkmcnt(" #n ")" ::: "memory")
#define PG8_BAR __builtin_amdgcn_s_barrier()
#define PG8_SCHED __builtin_amdgcn_sched_barrier(0)
    Unit cur, nxt; int ui = 0;
    if (!S.next(0, cur)) return;
    f32x4 acc[2][2][4][2];
#pragma unroll
    for (int a = 0; a < 2; ++a)
#pragma unroll
        for (int b = 0; b < 2; ++b)
#pragma unroll
            for (int m = 0; m < 4; ++m)
#pragma unroll
                for (int n = 0; n < 2; ++n) acc[a][b][m][n] = (f32x4){0.f, 0.f, 0.f, 0.f};
    bf16x8 At[4][2], B0[2][2], B1[2][2];
    const char* cA = (const char*)g.A + (size_t)cur.pm * tstepA; const char* cB = (const char*)g.Bt + (size_t)cur.pn * tstepB;
    PG8_STAGE(PG8_SB(0, 0), cB, voffB); PG8_STAGE(PG8_SA(0, 0), cA, voffA); PG8_STAGE(PG8_SB(0, 1), cB + hstepB, voffB); PG8_STAGE(PG8_SA(0, 1), cA + hstepA, voffA);
    if (wr == 1) PG8_BAR;
    PG8_WAIT_V(4); PG8_BAR;
    PG8_STAGE(PG8_SB(1, 0), cB + kstep, voffB); PG8_STAGE(PG8_SA(1, 0), cA + kstep, voffA); PG8_STAGE(PG8_SB(1, 1), cB + hstepB + kstep, voffB);
    PG8_WAIT_V(6); PG8_BAR;
    for (;;) {
        const bool has_next = S.next(ui + 1, nxt);
        const char* nA = has_next ? (const char*)g.A + (size_t)nxt.pm * tstepA : cA; const char* nB = has_next ? (const char*)g.Bt + (size_t)nxt.pn * tstepB : cB;
        for (int t = 0; t < nt; t += 2) {
            const bool last = (t == nt - 2);
            const char* a1 = cA + (size_t)(t + 1) * kstep;
            const char* a2 = last ? nA : cA + (size_t)(t + 2) * kstep; const char* b2 = last ? nB : cB + (size_t)(t + 2) * kstep;
            const char* a3 = a2 + kstep; const char* b3 = b2 + kstep;
            PG8_LDB(B0, 0, 0); PG8_SCHED; PG8_LDA(At, 0, 0); PG8_STAGE(PG8_SA(1, 1), a1 + hstepA, voffA);
            PG8_WAIT_L(8); PG8_BAR; PG8_WAIT_L(0); PG8_MMA(0, 0, At, B0); PG8_BAR; PG8_SCHED;
            PG8_LDB(B1, 0, 1); PG8_STAGE(PG8_SB(0, 0), b2, voffB);
            PG8_BAR; PG8_WAIT_L(0); PG8_MMA(0, 1, At, B1); PG8_BAR;
            PG8_LDA(At, 0, 1); PG8_STAGE(PG8_SA(0, 0), a2, voffA);
            PG8_BAR; PG8_WAIT_L(0); PG8_MMA(1, 0, At, B0); PG8_BAR; PG8_SCHED;
            PG8_STAGE(PG8_SB(0, 1), b2 + hstepB, voffB);
            PG8_WAIT_V(6); PG8_BAR; PG8_MMA(1, 1, At, B1); PG8_BAR;
            PG8_LDB(B0, 1, 0); PG8_SCHED; PG8_LDA(At, 1, 0); PG8_STAGE(PG8_SA(0, 1), a2 + hstepA, voffA);
            PG8_WAIT_L(8); PG8_BAR; PG8_WAIT_L(0); PG8_MMA(0, 0, At, B0); PG8_BAR; PG8_SCHED;
            PG8_LDB(B1, 1, 1); PG8_STAGE(PG8_SB(1, 0), b3, voffB);
            PG8_BAR; PG8_WAIT_L(0); PG8_MMA(0, 1, At, B1); PG8_BAR;
            PG8_LDA(At, 1, 1); PG8_STAGE(PG8_SA(1, 0), a3, voffA);
            PG8_BAR; PG8_WAIT_L(0); PG8_MMA(1, 0, At, B0); PG8_BAR; PG8_SCHED;
            PG8_STAGE(PG8_SB(1, 1), b3 + hstepB, voffB);
            PG8_WAIT_V(6); PG8_BAR; PG8_MMA(1, 1, At, B1); PG8_BAR;
        }
        E(acc, cur, wr, wc, fr, fq);
        if (!has_next) break;
#pragma unroll
        for (int a = 0; a < 2; ++a)
#pragma unroll
            for (int b = 0; b < 2; ++b)
#pragma unroll
                for (int m = 0; m < 4; ++m)
#pragma unroll
                    for (int n = 0; n < 2; ++n) acc[a][b][m][n] = (f32x4){0.f, 0.f, 0.f, 0.f};
        cur = nxt; cA = nA; cB = nB; ++ui;
    }
    PG8_WAIT_V(0);
    if (wr == 0) PG8_BAR;
    PG8_BAR;
#undef PG8_SA
#undef PG8_SB
#undef PG8_STAGE
#undef PG8_LDA
#undef PG8_LDB
#undef PG8_MMA
#undef PG8_WAIT_V
#undef PG8_WAIT_L
#undef PG8_BAR
#undef PG8_SCHED
}
struct EpiResid {
    static constexpr bool PERM = false;
    const float* res; float* out;
    DI void operator()(const f32x4 (&acc)[2][2][4][2], const Unit& u, int wr, int wc, int fr, int fq) const {
        const int row0 = u.pm * BM + wr * 64 + fr, col0 = u.pn * BM + wc * 32 + 4 * fq;
#pragma unroll
        for (int ai = 0; ai < 2; ++ai)
#pragma unroll
            for (int m = 0; m < 4; ++m) {
                const size_t rb = (size_t)(row0 + ai * HALF + m * 16) * D + col0;
#pragma unroll
                for (int bj = 0; bj < 2; ++bj)
#pragma unroll
                    for (int n = 0; n < 2; ++n) { const size_t idx = rb + bj * HALF + n * 16; *(f32x4*)(out + idx) = *(const f32x4*)(res + idx) + acc[ai][bj][m][n]; }
            }
    }
};
struct EpiBf16 {
    static constexpr bool PERM = true;
    bf16_t* out; int ld;
    DI void operator()(const f32x4 (&acc)[2][2][4][2], const Unit& u, int wr, int wc, int fr, int fq) const {
        const int row0 = u.pm * BM + wr * 64 + fr, col0 = u.pn * BM + wc * 32 + 8 * fq;
#pragma unroll
        for (int ai = 0; ai < 2; ++ai)
#pragma unroll
            for (int m = 0; m < 4; ++m) {
                bf16_t* rowp = out + (size_t)(row0 + ai * HALF + m * 16) * ld + col0;
#pragma unroll
                for (int bj = 0; bj < 2; ++bj) {
                    const f32x4 v0 = acc[ai][bj][m][0], v1 = acc[ai][bj][m][1];
                    u32x4 w; w.x = pack2(v0[0], v0[1]); w.y = pack2(v0[2], v0[3]); w.z = pack2(v1[0], v1[1]); w.w = pack2(v1[2], v1[3]);
                    *(u32x4*)(rowp + bj * HALF) = w;
                }
            }
    }
};
struct EpiSwiglu {
    static constexpr bool PERM = true;
    bf16_t* act;
    DI void operator()(const f32x4 (&acc)[2][2][4][2], const Unit& u, int wr, int wc, int fr, int fq) const {
        const int row0 = u.pm * BM + wr * 64 + fr, col0 = u.pn * HALF + wc * 32 + 8 * fq;
#pragma unroll
        for (int ai = 0; ai < 2; ++ai)
#pragma unroll
            for (int m = 0; m < 4; ++m) {
                float v[8];
#pragma unroll
                for (int n = 0; n < 2; ++n)
#pragma unroll
                    for (int j = 0; j < 4; ++j) { const float gg = acc[ai][0][m][n][j], uu = acc[ai][1][m][n][j]; v[4 * n + j] = gg * uu * __builtin_amdgcn_rcpf(1.0f + __builtin_amdgcn_exp2f(-gg * LOG2E)); }
                u32x4 w; w.x = pack2(v[0], v[1]); w.y = pack2(v[2], v[3]); w.z = pack2(v[4], v[5]); w.w = pack2(v[6], v[7]);
                *(u32x4*)(act + (size_t)(row0 + ai * HALF + m * 16) * DFF + col0) = w;
            }
    }
};
}
DI pg8::Gemm mk_gemm(const bf16_t* A, int lda, const bf16_t* Bt, int M, int N, int K) { return pg8::Gemm{A, Bt, M, N / 256, K, lda, (size_t)128 * K * 2, (size_t)256 * K * 2}; }

template <int DQK, int DV, int KT, int QMODE, bool ALIBI, bool NOMAX>
DI void attn_core(const bf16_t* __restrict__ q, int ldq, const bf16_t* __restrict__ k, int ldk, const bf16_t* __restrict__ k2, int ldk2,
                  const bf16_t* __restrict__ v, int ldv, int nkeys, int qpos0, float qscale, float slope2,
                  const float* __restrict__ qg, const float2* __restrict__ tab, char* smem, f32x16 (&o)[DV / 32], float& lsum) {
    constexpr int KROW = DQK * 2 + 16, VROW = DV * 2 + 64  , KBYTES = KT * KROW, VBYTES = KT * VROW;
    constexpr int KCPR = DQK / 8  , KTOT = KT * KCPR, NKC = (KTOT + THREADS - 1) / THREADS, VCPR = DV / 8, VTOT = KT * VCPR, NVC = (VTOT + THREADS - 1) / THREADS;
    constexpr int NST = KT / 32, NKS = DQK / 16, NDT = DV / 32;
    static_assert(2 * (KBYTES + VBYTES) <= (int)LDS_BYTES, "lds");
    const int tid = otid(), lane = tid & 63, w = tid >> 6, r = lane & 31, h = lane >> 5;
    const int qpos = qpos0 + 32 * w + r;
    bf16x8 qf[NKS];
    {
        const bf16_t* qrow = q + (size_t)(32 * w + r) * ldq + 8 * h;
        u32x4 raw[NKS];
#pragma unroll
        for (int s = 0; s < NKS; ++s) raw[s] = *(const u32x4*)(qrow + 16 * s);
        if (QMODE == 1) {
            float ss = 0.f;
#pragma unroll
            for (int s = 0; s < NKS; ++s) {
                const unsigned u[4] = {raw[s].x, raw[s].y, raw[s].z, raw[s].w};
#pragma unroll
                for (int j = 0; j < 4; ++j) { const float a0 = bflo(u[j]), a1 = bfhi(u[j]); ss += a0 * a0 + a1 * a1; }
            }
            ss += __shfl_xor(ss, 32);
            const float rstd = rsqrtf(ss * (1.0f / 64) + EPS) * qscale;
#pragma unroll
            for (int s = 0; s < NKS; ++s) {
                unsigned u[4] = {raw[s].x, raw[s].y, raw[s].z, raw[s].w};
#pragma unroll
                for (int j = 0; j < 4; ++j) {
                    const int d0 = 16 * s + 8 * h + 2 * j;
                    const float y0 = bflo(u[j]) * rstd * qg[d0], y1 = bfhi(u[j]) * rstd * qg[d0 + 1];
                    const float2 cs = tab[qpos * 32 + (d0 >> 1)];
                    u[j] = pack2(y0 * cs.x - y1 * cs.y, y0 * cs.y + y1 * cs.x);
                }
                raw[s] = u32x4{u[0], u[1], u[2], u[3]};
            }
        } else if (QMODE == 2) {
#pragma unroll
            for (int s = 4; s < NKS; ++s) {
                unsigned u[4] = {raw[s].x, raw[s].y, raw[s].z, raw[s].w};
#pragma unroll
                for (int j = 0; j < 4; ++j) {
                    const int p = 8 * (s - 4) + 4 * h + j;
                    const float y0 = bflo(u[j]), y1 = bfhi(u[j]);
                    const float2 cs = tab[qpos * 16 + p];
                    u[j] = pack2(y0 * cs.x - y1 * cs.y, y0 * cs.y + y1 * cs.x);
                }
                raw[s] = u32x4{u[0], u[1], u[2], u[3]};
            }
        }
#pragma unroll
        for (int s = 0; s < NKS; ++s) qf[s] = __builtin_bit_cast(bf16x8, raw[s]);
    }
    u32x4 rk[NKC], rv[NVC];
    char* const kbuf = smem;
    char* const vbuf = smem + 2 * KBYTES;
#define ATT_GLOADK(key0_)                                                                                             \
    {                                                                                                                 \
        _Pragma("unroll") for (int i = 0; i < NKC; ++i) {                                                             \
            const int cid = tid + THREADS * i, key = cid / KCPR, cc = cid - key * KCPR;                               \
            if (KTOT % THREADS == 0 || cid < KTOT) {                                                                  \
                const bf16_t* src;                                                                                    \
                if (QMODE == 2 && cc >= 8) src = k2 + (size_t)((key0_) + key) * ldk2 + (cc - 8) * 8;                   \
                else src = k + (size_t)((key0_) + key) * ldk + cc * 8;                                                \
                rk[i] = *(const u32x4*)src;                                                                           \
            }                                                                                                         \
        }                                                                                                             \
    }
#define ATT_GLOADV(key0_)                                                                                             \
    {                                                                                                                 \
        _Pragma("unroll") for (int i = 0; i < NVC; ++i) {                                                             \
            const int cid = tid + THREADS * i, key = cid / VCPR, cc = cid - key * VCPR;                               \
            if (VTOT % THREADS == 0 || cid < VTOT) rv[i] = *(const u32x4*)(v + (size_t)((key0_) + key) * ldv + cc * 8); \
        }                                                                                                             \
    }
#define ATT_LSTOREK(buf_)                                                                                             \
    {                                                                                                                 \
        _Pragma("unroll") for (int i = 0; i < NKC; ++i) {                                                             \
            const int cid = tid + THREADS * i, key = cid / KCPR, cc = cid - key * KCPR;                               \
            if (KTOT % THREADS == 0 || cid < KTOT) *(u32x4*)(kbuf + (buf_) * KBYTES + key * KROW + cc * 16) = rk[i];  \
        }                                                                                                             \
    }
#define ATT_LSTOREV(buf_)                                                                                             \
    {                                                                                                                 \
        _Pragma("unroll") for (int i = 0; i < NVC; ++i) {                                                             \
            const int cid = tid + THREADS * i, key = cid / VCPR, cc = cid - key * VCPR;                               \
            if (VTOT % THREADS == 0 || cid < VTOT) *(u32x4*)(vbuf + (buf_) * VBYTES + key * VROW + cc * 16) = rv[i];  \
        }                                                                                                             \
    }
#define ATT_QK(buf_, X_)                                                                                              \
    {                                                                                                                 \
        const char* kb_ = kbuf + (buf_) * KBYTES + r * KROW + h * 16;                                                 \
        _Pragma("unroll") for (int st = 0; st < NST; ++st) {                                                          \
            X_[st] = MFMA(*(const bf16x8*)(kb_ + 32 * st * KROW), qf[0], zero16);                                     \
            _Pragma("unroll") for (int ks = 1; ks < NKS; ++ks) X_[st] = MFMA(*(const bf16x8*)(kb_ + 32 * st * KROW + ks * 32), qf[ks], X_[st]); \
        }                                                                                                             \
    }
#define ATT_SMPV(t_, vb_, X_)                                                                                         \
    {                                                                                                                 \
        if (NOMAX) {                                                                                                  \
            const float dqn = (float)(qpos - ((t_) * KT + 4 * h));                                                    \
            _Pragma("unroll") for (int st = 0; st < NST; ++st)                                                        \
                _Pragma("unroll") for (int i = 0; i < 16; ++i) {                                                      \
                    float xv_ = X_[st][i];                                                                            \
                    if (ALIBI) xv_ = __builtin_fmaf(-slope2, fabsf(dqn - (float)(32 * st + (i & 3) + 8 * (i >> 2))), xv_); \
                    X_[st][i] = __builtin_amdgcn_exp2f(xv_);                                                          \
                }                                                                                                     \
        } else {                                                                                                      \
            float mx = -1e30f;                                                                                        \
            const float dq = (float)(qpos - ((t_) * KT + 4 * h));                                                     \
            _Pragma("unroll") for (int st = 0; st < NST; ++st)                                                        \
                _Pragma("unroll") for (int i = 0; i < 16; ++i) {                                                      \
                    if (ALIBI) X_[st][i] = __builtin_fmaf(-slope2, fabsf(dq - (float)(32 * st + (i & 3) + 8 * (i >> 2))), X_[st][i]); \
                    mx = fmaxf(mx, X_[st][i]);                                                                        \
                }                                                                                                     \
            mx = fmaxf(mx, __shfl_xor(mx, 32));                                                                       \
            const float mn = fmaxf(m, mx);                                                                            \
            const float alpha = __builtin_amdgcn_exp2f(m - mn);                                                       \
            m = mn;                                                                                                   \
            _Pragma("unroll") for (int st = 0; st < NST; ++st)                                                        \
                _Pragma("unroll") for (int i = 0; i < 16; ++i) X_[st][i] = __builtin_amdgcn_exp2f(X_[st][i] - mn);    \
            if (__any(alpha != 1.0f)) {                                                                               \
                _Pragma("unroll") for (int dt = 0; dt < NDT; ++dt)                                                    \
                    _Pragma("unroll") for (int i = 0; i < 16; ++i) o[dt][i] *= alpha;                                 \
                _Pragma("unroll") for (int i = 0; i < 16; ++i) ol[i] *= alpha;                                        \
            }                                                                                                         \
        }                                                                                                             \
        const char* vbp_ = vbuf + (vb_) * VBYTES + vlane;                                                             \
        _Pragma("unroll") for (int st = 0; st < NST; ++st)                                                            \
            _Pragma("unroll") for (int s = 0; s < 2; ++s) {                                                           \
                u32x4 pk;                                                                                             \
                pk.x = pack2(X_[st][8 * s + 0], X_[st][8 * s + 1]); pk.y = pack2(X_[st][8 * s + 2], X_[st][8 * s + 3]); \
                pk.z = pack2(X_[st][8 * s + 4], X_[st][8 * s + 5]); pk.w = pack2(X_[st][8 * s + 6], X_[st][8 * s + 7]); \
                const bf16x8 pb = __builtin_bit_cast(bf16x8, pk);                                                     \
                ol = MFMA(ones8, pb, ol);                                                                             \
                _Pragma("unroll") for (int dt = 0; dt < NDT; ++dt) {                                                  \
                    const char* va = vbp_ + (32 * st + 16 * s) * VROW + 64 * dt;                                      \
                    const s16x4 lo = __builtin_amdgcn_ds_read_tr16_b64_v4i16((LDS_AS s16x4*)(va));                    \
                    const s16x4 hi = __builtin_amdgcn_ds_read_tr16_b64_v4i16((LDS_AS s16x4*)(va + 8 * VROW));        \
                    o[dt] = MFMA(__builtin_shufflevector(lo, hi, 0, 1, 2, 3, 4, 5, 6, 7), pb, o[dt]);                 \
                }                                                                                                     \
            }                                                                                                         \
    }
#define ATT_STEP(t_, PAR_, CUR_, NXT_)                                                                                \
    {                                                                                                                 \
        const int tk_ = ((t_) + 2 < ntiles) ? (t_) + 2 : ntiles - 1, tv_ = ((t_) + 1 < ntiles) ? (t_) + 1 : ntiles - 1; \
        ATT_GLOADK(tk_ * KT)                                                                                          \
        ATT_GLOADV(tv_ * KT)                                                                                          \
        __builtin_amdgcn_sched_barrier(0);                                                                            \
        ATT_QK(1 - (PAR_), NXT_)                                                                                      \
        ATT_SMPV(t_, PAR_, CUR_)                                                                                      \
        __builtin_amdgcn_sched_barrier(0);                                                                            \
        ATT_LSTOREK(PAR_)                                                                                             \
        ATT_LSTOREV(1 - (PAR_))                                                                                       \
        __syncthreads();                                                                                              \
    }
    const f32x16 zero16 = {0.f, 0.f, 0.f, 0.f, 0.f, 0.f, 0.f, 0.f, 0.f, 0.f, 0.f, 0.f, 0.f, 0.f, 0.f, 0.f};
    const bf16x8 ones8 = {0x3F80, 0x3F80, 0x3F80, 0x3F80, 0x3F80, 0x3F80, 0x3F80, 0x3F80};
    float m = -1e30f;
    f32x16 ol = zero16;
#pragma unroll
    for (int dt = 0; dt < NDT; ++dt) o[dt] = zero16;
    const int ntiles = nkeys / KT;
    const int vlane = (4 * h + ((lane & 15) >> 2)) * VROW + (16 * ((lane >> 4) & 1) + 4 * (lane & 3)) * 2;
    f32x16 xa[NST], xb[NST];
    ATT_GLOADK(0) ATT_LSTOREK(0)
    ATT_GLOADK(KT) ATT_GLOADV(0)
    __syncthreads();
    ATT_QK(0, xa)
    ATT_LSTOREK(1) ATT_LSTOREV(0)
    __syncthreads();
    for (int t = 0; t < ntiles; t += 2) {
        ATT_STEP(t, 0, xa, xb)
        ATT_STEP(t + 1, 1, xb, xa)
    }
    lsum = ol[0];
#undef ATT_GLOADK
#undef ATT_GLOADV
#undef ATT_LSTOREK
#undef ATT_LSTOREV
#undef ATT_QK
#undef ATT_SMPV
#undef ATT_STEP
}
template <int NDT>
DI void store_o(bf16_t* dst, int ld, f32x16 (&o)[NDT], float inv) {
    const int tid_ = otid(), lane = tid_ & 63, w = tid_ >> 6, r = lane & 31, h = lane >> 5;
    bf16_t* row = dst + (size_t)(32 * w + r) * ld + 4 * h;
#pragma unroll
    for (int dt = 0; dt < NDT; ++dt)
#pragma unroll
        for (int g = 0; g < 4; ++g) {
            uint2 vv; vv.x = pack2(o[dt][4 * g] * inv, o[dt][4 * g + 1] * inv); vv.y = pack2(o[dt][4 * g + 2] * inv, o[dt][4 * g + 3] * inv);
            *(uint2*)(row + 32 * dt + 8 * g) = vv;
        }
}
DI int swz_item(int base) {
    const int G = gridDim.x, i = blockIdx.x;
    if (G & 7) return base + i;
    return base + (i & 7) * (G >> 3) + (i >> 3);
}

constexpr int QT = SEQ / 256;
constexpr float NOMAX_BOUND = 90.f;
DI void attn_even(const bf16_t* qkv, float* park, bf16_t* mix, const Params& p, const float2* ax, const unsigned* nd, float lam_init, char* smem) {
    float d1 = 0.f, d2 = 0.f, gq = 0.f, gk = 0.f;
    for (int i = 0; i < 64; ++i) { d1 += p.in[8][i] * p.in[9][i]; d2 += p.in[10][i] * p.in[11][i]; gq = fmaxf(gq, fabsf(p.in[6][i])); gk = fmaxf(gk, fabsf(p.in[7][i])); }
    const float lam = __expf(d1) - __expf(d2) + lam_init;
    const float bound_gqa = 64.f * 0.125f * LOG2E * gq * gk * 1.03f;
    const int tid_ = otid(), lane = tid_ & 63, h = lane >> 5;
    float4* mypark = (float4*)(park + ((size_t)blockIdx.x * THREADS + tid_) * 64);
    constexpr int NDIFF = NB * 4 * QT, NGQA = NB * 8 * QT;
    for (int base = 0; base < NDIFF + NGQA; base += gridDim.x) {
        const int it = swz_item(base);
        if (it >= NDIFF + NGQA) continue;
        if (it < NDIFF) {
            const int b = it / (4 * QT), hd = (it / QT) & 3, qt = it % QT;
            const size_t row0 = (size_t)b * SEQ + qt * 256;
            const float slope2 = exp2f(-2.0f * (hd + 1)) * LOG2E;
            const bf16_t* qp = qkv + row0 * EVEN_IN + 768 + hd * 128;
            const bf16_t* kp = qkv + (size_t)b * SEQ * EVEN_IN + 1280 + hd * 128;
            const bf16_t* vp = qkv + (size_t)b * SEQ * EVEN_IN + 1792 + hd * 128;
            f32x16 o0[4]; float l0 = 1.f;
#pragma unroll 1
            for (int c = 0; c < 2; ++c) {
                const unsigned* nn = nd + (b * 8 + hd * 2 + c) * 2;
                const float bound = sqrtf(__uint_as_float(nn[0]) * __uint_as_float(nn[1])) * 1.03f;
                if (bound < NOMAX_BOUND) attn_core<64, 128, 64, 0, true, true>(qp + 64 * c, EVEN_IN, kp + 64 * c, EVEN_IN, nullptr, 0, vp, EVEN_IN, SEQ, qt * 256, 1.0f, slope2, nullptr, nullptr, smem, o0, l0);
                else attn_core<64, 128, 64, 0, true, false>(qp + 64 * c, EVEN_IN, kp + 64 * c, EVEN_IN, nullptr, 0, vp, EVEN_IN, SEQ, qt * 256, 1.0f, slope2, nullptr, nullptr, smem, o0, l0);
                if (c == 0) {
                    const float i0 = 1.0f / l0;
#pragma unroll
                    for (int dt = 0; dt < 4; ++dt)
#pragma unroll
                        for (int g = 0; g < 4; ++g) mypark[dt * 4 + g] = make_float4(o0[dt][4 * g] * i0, o0[dt][4 * g + 1] * i0, o0[dt][4 * g + 2] * i0, o0[dt][4 * g + 3] * i0);
                    asm volatile("" ::: "memory");
                }
            }
            const float i1 = lam / l0;
            float ss = 0.f;
            asm volatile("" ::: "memory");
#pragma unroll
            for (int dt = 0; dt < 4; ++dt)
#pragma unroll
                for (int g = 0; g < 4; ++g) {
                    const float4 pv = mypark[dt * 4 + g];
                    const float pa[4] = {pv.x, pv.y, pv.z, pv.w};
#pragma unroll
                    for (int e = 0; e < 4; ++e) { const float vv = pa[e] - i1 * o0[dt][4 * g + e]; o0[dt][4 * g + e] = vv; ss += vv * vv; }
                }
            ss += __shfl_xor(ss, 32);
            const float rstd = rsqrtf(ss * (1.0f / 128) + EPS) * (1.0f - lam_init);
#pragma unroll
            for (int dt = 0; dt < 4; ++dt)
#pragma unroll
                for (int i = 0; i < 16; ++i) o0[dt][i] *= p.in[12][32 * dt + crow(i, h)];
            store_o<4>(mix + row0 * D + 512 + hd * 128, D, o0, rstd);
        } else {
            const int j = it - NDIFF;
            const int b = j / (8 * QT), hd = (j / QT) & 7, qt = j % QT, kvh = hd >> 2;
            const size_t row0 = (size_t)b * SEQ + qt * 256;
            const bf16_t* qp = qkv + row0 * EVEN_IN + hd * 64;
            const bf16_t* kp = qkv + (size_t)b * SEQ * EVEN_IN + 512 + kvh * 64;
            const bf16_t* vp = qkv + (size_t)b * SEQ * EVEN_IN + 640 + kvh * 64;
            f32x16 o[2]; float l;
            if (bound_gqa < NOMAX_BOUND) attn_core<64, 64, 64, 1, false, true>(qp, EVEN_IN, kp, EVEN_IN, nullptr, 0, vp, EVEN_IN, SEQ, qt * 256, 0.125f * LOG2E, 0.f, p.in[6], ax, smem, o, l);
            else attn_core<64, 64, 64, 1, false, false>(qp, EVEN_IN, kp, EVEN_IN, nullptr, 0, vp, EVEN_IN, SEQ, qt * 256, 0.125f * LOG2E, 0.f, p.in[6], ax, smem, o, l);
            store_o<2>(mix + row0 * D + hd * 64, D, o, 1.0f / l);
        }
    }
}
DI void attn_mla(const bf16_t* qb, const bf16_t* kv, const bf16_t* a, bf16_t* mix, const float2* lin, const unsigned* nmx, char* smem) {
    constexpr int NIT = NB * 16 * QT;
    for (int base = 0; base < NIT; base += gridDim.x) {
        const int it = swz_item(base);
        if (it >= NIT) continue;
        const int b = it / (16 * QT), hd = (it / QT) & 15, qt = it % QT;
        const size_t row0 = (size_t)b * SEQ + qt * 256;
        const unsigned* nn = nmx + (b * 16 + hd) * 2;
        const float bound = sqrtf(__uint_as_float(nn[0]) * __uint_as_float(nn[1])) * 1.03f;
        const bf16_t* kb_ = kv + (size_t)b * SEQ * 2048 + hd * 128;
        f32x16 o[2]; float l;
        if (bound < NOMAX_BOUND) attn_core<96, 64, 64, 2, false, true>(qb + row0 * 1536 + hd * 96, 1536, kb_, 2048, a + (size_t)b * SEQ * ODD_PAD + 640, ODD_PAD, kb_ + 64, 2048, SEQ, qt * 256, 1.0f, 0.f, nullptr, lin, smem, o, l);
        else attn_core<96, 64, 64, 2, false, false>(qb + row0 * 1536 + hd * 96, 1536, kb_, 2048, a + (size_t)b * SEQ * ODD_PAD + 640, ODD_PAD, kb_ + 64, 2048, SEQ, qt * 256, 1.0f, 0.f, nullptr, lin, smem, o, l);
        store_o<2>(mix + row0 * D + hd * 64, D, o, 1.0f / l);
    }
}
DI void attn_cross(const bf16_t* qx, const bf16_t* kvx, bf16_t* mix, int seq0, char* smem) {
    constexpr int NIT = NB * 4 * QT * 2;
    for (int base = 0; base < NIT; base += gridDim.x) {
        const int it = swz_item(base);
        if (it >= NIT) continue;
        const int b = it / (8 * QT), hd = (it / (2 * QT)) & 3, qt = (it >> 1) % QT, half = it & 1;
        const size_t row0 = (size_t)b * SEQ + qt * 256;
        const bf16_t* kvb = kvx + (size_t)(seq0 + b) * NMEM * 2048;
        f32x16 o[4]; float l;
        attn_core<256, 128, 32, 0, false, false>(qx + row0 * D + hd * 256, D, kvb + hd * 256, 2048, nullptr, 0, kvb + 1024 + hd * 256 + half * 128, 2048, NMEM, 0,
                                          1.0f, 0.f, nullptr, nullptr, smem, o, l);
        store_o<4>(mix + row0 * D + hd * 256 + half * 128, D, o, 1.0f / l);
    }
}

extern "C" __global__ void __launch_bounds__(THREADS, 2) fwd_mega(Params p) {
    extern __shared__ __attribute__((aligned(16))) char smem[];
    LDS_AS unsigned char* lds = (LDS_AS unsigned char*)smem;
    cg::grid_group grid = cg::this_grid();
    char* ws = p.ws;
    __shared__ uint4 xb_words;
    if (threadIdx.x == 0) xb_words = make_uint4(0u, 0u, 0u, 0u);
    __syncthreads();
    const XcdBarrier xb = xcd_barrier_post((unsigned*)(ws + B_BAR), (volatile LDS_AS unsigned*)&xb_words);
    bf16_t* wEin = (bf16_t*)(ws + W_EIN); bf16_t* wEout = (bf16_t*)(ws + W_EOUT); bf16_t* wOin = (bf16_t*)(ws + W_OIN);
    bf16_t* wUq = (bf16_t*)(ws + W_UQ); bf16_t* wUkv = (bf16_t*)(ws + W_UKV); bf16_t* wOout = (bf16_t*)(ws + W_OOUT);
    float2* ax = (float2*)(ws + T_AX); float2* lin = (float2*)(ws + T_LIN);
    bf16_t* H = (bf16_t*)(ws + B_H); bf16_t* MIX = (bf16_t*)(ws + B_MIX);

    convert_weight(p.in[5], wEin, D, EVEN_IN, EVEN_IN, smem, 768, 1280, 0.125f * LOG2E);
    convert_weight(p.in[13], wEout, D, D, D, smem);
    convert_weight(p.in[14], wOin, D, ODD_IN, ODD_PAD, smem);
    convert_weight(p.in[17], wUq, 384, 1536, 1536, smem, 0, 1536, 0.10206207261596575f * LOG2E);
    convert_weight(p.in[18], wUkv, 256, 2048, 2048, smem);
    convert_weight(p.in[19], wOout, D, D, D, smem);
    for (int l = 0; l < 2; ++l) {
        convert_weight(p.in[22] + (size_t)l * D * D, (bf16_t*)(ws + W_CQ) + (size_t)l * D * D, D, D, D, smem, 0, D, 0.0625f * LOG2E);
        convert_weight(p.in[23] + (size_t)l * D * 2048, (bf16_t*)(ws + W_CKV) + (size_t)l * 2048 * D, D, 2048, 2048, smem);
        convert_weight(p.in[24] + (size_t)l * D * D, (bf16_t*)(ws + W_CO) + (size_t)l * D * D, D, D, D, smem);
        convert_weight(p.in[26] + (size_t)l * D * 2 * DFF, (bf16_t*)(ws + W_GU) + (size_t)l * 2 * DFF * D, D, 2 * DFF, 2 * DFF, smem);
        convert_weight(p.in[27] + (size_t)l * DFF * D, (bf16_t*)(ws + W_DOWN) + (size_t)l * D * DFF, DFF, D, D, smem);
        rmsnorm_rows(p.in[2], p.in[21] + l * D, (bf16_t*)(ws + B_MEMN) + (size_t)l * NBATCH * NMEM * D, 8 * NMEM);
        rmsnorm_rows(p.in[3], p.in[21] + l * D, (bf16_t*)(ws + B_MEMN) + (size_t)l * NBATCH * NMEM * D + (size_t)8 * NMEM * D, 16 * NMEM);
    }
    build_tables(ax, lin);
    if (blockIdx.x == 0) for (int i = threadIdx.x; i < 4096; i += THREADS) ((unsigned*)(ws + B_NORMS))[i] = 0u;
    xcd_barrier(xb);
    for (int l = 0; l < 2; ++l) {
        pg8::EpiBf16 e{(bf16_t*)(ws + B_KX) + (size_t)l * NBATCH * NMEM * 2048, 2048};
        pg8::gemm_phase(lds, mk_gemm((const bf16_t*)(ws + B_MEMN) + (size_t)l * NBATCH * NMEM * D, D, (const bf16_t*)(ws + W_CKV) + (size_t)l * 2048 * D, NBATCH * NMEM, 2048, D), e);
    }
    xcd_barrier(xb);

    for (int ch = 0; ch < NCHUNK; ++ch) {
        const float* xin = (ch == 0) ? p.in[0] : p.in[1] + (size_t)(ch - 1) * TC * D;
        float* xo = p.out + (size_t)ch * TC * D;
        for (int layer = 0; layer < 2; ++layer) {
            const float* xcur = (layer == 0) ? xin : xo;
            for (int rep_ = 0; rep_ < PROBE_NORM; ++rep_) rmsnorm_rows(xcur, p.in[4] + layer * D, H, TC);
            xcd_barrier(xb);
            const bf16_t* wout;
            if (layer == 0) {
                bf16_t* qkv = (bf16_t*)(ws + E_QKV);
                for (int rep_ = 0; rep_ < PROBE_GEMM; ++rep_) { pg8::EpiBf16 e{qkv, EVEN_IN}; pg8::gemm_phase(lds, mk_gemm(H, D, wEin, TC, EVEN_IN, D), e); }
                xcd_barrier(xb);
                kprep_even(qkv, p.in[7], ax);
                normmax_even(qkv, (unsigned*)(ws + B_NORMS) + ch * 128, smem);
                xcd_barrier(xb);
                for (int rep_ = 0; rep_ < PROBE_ATTN; ++rep_) attn_even(qkv, (float*)(ws + E_PARK), MIX, p, ax, (const unsigned*)(ws + B_NORMS) + ch * 128, 0.2f, smem);
                wout = wEout;
            } else {
                bf16_t* a = (bf16_t*)(ws + O_A); bf16_t* qb = (bf16_t*)(ws + O_Q); bf16_t* kv = (bf16_t*)(ws + O_KV);
                for (int rep_ = 0; rep_ < PROBE_GEMM; ++rep_) { pg8::EpiBf16 e{a, ODD_PAD}; pg8::gemm_phase(lds, mk_gemm(H, D, wOin, TC, ODD_PAD, D), e); }
                xcd_barrier(xb);
                prep_odd(a, p.in[15], p.in[16], lin);
                xcd_barrier(xb);
                for (int rep_ = 0; rep_ < PROBE_GEMM; ++rep_) { pg8::EpiBf16 e{qb, 1536}; pg8::gemm_phase(lds, mk_gemm(a, ODD_PAD, wUq, TC, 1536, 384), e); }
                for (int rep_ = 0; rep_ < PROBE_GEMM; ++rep_) { pg8::EpiBf16 e{kv, 2048}; pg8::gemm_phase(lds, mk_gemm(a + 384, ODD_PAD, wUkv, TC, 2048, 256), e); }
                xcd_barrier(xb);
                normmax_mla(qb, kv, a, (unsigned*)(ws + B_NORMS) + 384 + ch * 256, smem);
                xcd_barrier(xb);
                for (int rep_ = 0; rep_ < PROBE_ATTN; ++rep_) attn_mla(qb, kv, a, MIX, lin, (const unsigned*)(ws + B_NORMS) + 384 + ch * 256, smem);
                wout = wOout;
            }
            xcd_barrier(xb);
            { pg8::EpiResid e{xcur, xo}; pg8::gemm_phase(lds, mk_gemm(MIX, D, wout, TC, D, D), e); }
            xcd_barrier(xb);
            for (int rep_ = 0; rep_ < PROBE_NORM; ++rep_) rmsnorm_rows(xo, p.in[20] + layer * D, H, TC);
            xcd_barrier(xb);
            for (int rep_ = 0; rep_ < PROBE_GEMM; ++rep_) { pg8::EpiBf16 e{(bf16_t*)(ws + X_Q), D}; pg8::gemm_phase(lds, mk_gemm(H, D, (const bf16_t*)(ws + W_CQ) + (size_t)layer * D * D, TC, D, D), e); }
            xcd_barrier(xb);
            for (int rep_ = 0; rep_ < PROBE_CROSS; ++rep_) attn_cross((const bf16_t*)(ws + X_Q), (const bf16_t*)(ws + B_KX) + (size_t)layer * NBATCH * NMEM * 2048, MIX, ch * NB, smem);
            xcd_barrier(xb);
            { pg8::EpiResid e{xo, xo}; pg8::gemm_phase(lds, mk_gemm(MIX, D, (const bf16_t*)(ws + W_CO) + (size_t)layer * D * D, TC, D, D), e); }
            xcd_barrier(xb);
            for (int rep_ = 0; rep_ < PROBE_NORM; ++rep_) rmsnorm_rows(xo, p.in[25] + layer * D, H, TC);
            xcd_barrier(xb);
            for (int rep_ = 0; rep_ < PROBE_GEMM; ++rep_) { pg8::EpiSwiglu e{(bf16_t*)(ws + F_ACT)};
              pg8::Gemm g{H, (const bf16_t*)(ws + W_GU) + (size_t)layer * 2 * DFF * D, TC, DFF / 128, D, D, (size_t)DFF * D * 2, (size_t)128 * D * 2};
              pg8::gemm_phase(lds, g, e); }
            xcd_barrier(xb);
            { pg8::EpiResid e{xo, xo}; pg8::gemm_phase(lds, mk_gemm((const bf16_t*)(ws + F_ACT), DFF, (const bf16_t*)(ws + W_DOWN) + (size_t)layer * D * DFF, TC, D, DFF), e); }
            xcd_barrier(xb);
        }
        rmsnorm_final(xo, p.in[28], TC);
    }
}

extern "C" void kernel_launch(void* const* d_in, const int* in_sizes, int n_in, void* d_out, int out_size, void* d_ws, size_t ws_size, hipStream_t stream) {
    static int grid_blocks = 0;
    if (!grid_blocks) {
        int dev = 0, cus = 0, per_cu = 0;
        (void)hipGetDevice(&dev);
        (void)hipDeviceGetAttribute(&cus, hipDeviceAttributeMultiprocessorCount, dev);
        (void)hipFuncSetAttribute((const void*)fwd_mega, hipFuncAttributeMaxDynamicSharedMemorySize, (int)LDS_BYTES);
        (void)hipOccupancyMaxActiveBlocksPerMultiprocessor(&per_cu, fwd_mega, THREADS, LDS_BYTES);
        if (per_cu > 1) per_cu = 1;
        if (per_cu < 1) per_cu = 1;
        grid_blocks = cus * per_cu;
    }
    constexpr size_t WS_END = (O_END > E_END ? O_END : E_END) > (F_ACT + (size_t)TC * DFF * 2) ? (O_END > E_END ? O_END : E_END) : (F_ACT + (size_t)TC * DFF * 2);
    if (ws_size < WS_END) { fprintf(stderr, "workspace too small: %zu < %zu\n", ws_size, (size_t)WS_END); return; }
    if (grid_blocks > 256) grid_blocks = 256;
    Params p{};
    for (int i = 0; i < 29; ++i) p.in[i] = (const float*)d_in[i];
    p.out = (float*)d_out;
    p.ws = (char*)d_ws;
    (void)hipMemsetAsync(d_ws, 0, 16384, stream);
    void* args[] = {&p};
    hipError_t e = hipLaunchCooperativeKernel((void*)fwd_mega, dim3(grid_blocks), dim3(THREADS), args, LDS_BYTES, stream);
    if (e != hipSuccess) fprintf(stderr, "cooperative launch failed: %s (grid %d)\n", hipGetErrorString(e), grid_blocks);
}
```

```cpp
#include <hip/hip_runtime.h>
#include <hip/hip_cooperative_groups.h>
#include <cstdio>
#include <cstdint>
namespace cg = cooperative_groups;
#ifndef PROBE_GEMM
#define PROBE_GEMM 1
#endif
#ifndef PROBE_NORM
#define PROBE_NORM 1
#endif
#ifndef PROBE_CROSS
#define PROBE_CROSS 1
#endif
#ifndef PROBE_ATTN
#define PROBE_ATTN 1
#endif

typedef unsigned short bf16_t;
typedef short bf16x8 __attribute__((ext_vector_type(8)));
typedef float f32x16 __attribute__((ext_vector_type(16)));
typedef float f32x2 __attribute__((ext_vector_type(2)));
typedef unsigned u32x4 __attribute__((ext_vector_type(4)));
typedef float f32x4 __attribute__((ext_vector_type(4)));
typedef short s16x4 __attribute__((ext_vector_type(4)));
#define LDS_AS __attribute__((address_space(3)))
typedef __bf16 bf16x2_t __attribute__((ext_vector_type(2)));
#define DI __device__ __forceinline__
#define MFMA(a, b, c) __builtin_amdgcn_mfma_f32_32x32x16_bf16((a), (b), (c), 0, 0, 0)

constexpr int D = 1024, SEQ = 4096, NBATCH = 24, NB = 8  , NCHUNK = NBATCH / NB, TC = NB * SEQ;
constexpr int NMEM = 256, DFF = 2816, EVEN_IN = 2304, ODD_IN = 672, ODD_PAD = 768;
constexpr float EPS = 1e-6f, LOG2E = 1.4426950408889634f;
constexpr int THREADS = 512, NWAVE = THREADS / 64;
constexpr size_t LDS_BYTES = 131072;

constexpr size_t al(size_t x) { return (x + 255) & ~(size_t)255; }
constexpr size_t B_BAR = 0;
constexpr size_t B_NORMS = 16384;
constexpr size_t W_EIN = 32768;
constexpr size_t W_EOUT = W_EIN + al((size_t)EVEN_IN * D * 2);
constexpr size_t W_OIN = W_EOUT + al((size_t)D * D * 2);
constexpr size_t W_UQ = W_OIN + al((size_t)ODD_PAD * D * 2);
constexpr size_t W_UKV = W_UQ + al((size_t)1536 * 384 * 2);
constexpr size_t W_OOUT = W_UKV + al((size_t)2048 * 256 * 2);
constexpr size_t W_CQ = W_OOUT + al((size_t)D * D * 2);
constexpr size_t W_CKV = W_CQ + 2 * al((size_t)D * D * 2);
constexpr size_t W_CO = W_CKV + 2 * al((size_t)2048 * D * 2);
constexpr size_t W_GU = W_CO + 2 * al((size_t)D * D * 2);
constexpr size_t W_DOWN = W_GU + 2 * al((size_t)2 * DFF * D * 2);
constexpr size_t T_AX = W_DOWN + 2 * al((size_t)D * DFF * 2);
constexpr size_t T_LIN = T_AX + al((size_t)SEQ * 32 * 8);
constexpr size_t B_MEMN = T_LIN + al((size_t)SEQ * 16 * 8);
constexpr size_t B_KX = B_MEMN + 2 * al((size_t)NBATCH * NMEM * D * 2);
constexpr size_t B_H = B_KX + 2 * al((size_t)NBATCH * NMEM * 2048 * 2);
constexpr size_t B_MIX = B_H + al((size_t)TC * D * 2);
constexpr size_t B_BIG = B_MIX + al((size_t)TC * D * 2);
constexpr size_t E_QKV = B_BIG;
constexpr size_t E_PARK = E_QKV + al((size_t)TC * EVEN_IN * 2);
constexpr size_t E_END = E_PARK + (size_t)256 * THREADS * 64 * 4;
constexpr size_t O_A = B_BIG;
constexpr size_t O_Q = O_A + al((size_t)TC * ODD_PAD * 2);
constexpr size_t O_KV = O_Q + al((size_t)TC * 1536 * 2);
constexpr size_t O_END = O_KV + al((size_t)TC * 2048 * 2);
constexpr size_t X_Q = B_BIG;
constexpr size_t F_ACT = B_BIG;

struct Params {
    const float* in[29];
    float* out;
    char* ws;
};

DI unsigned pack2(float lo, float hi) { f32x2 v = {lo, hi}; bf16x2_t b = __builtin_convertvector(v, bf16x2_t); return __builtin_bit_cast(unsigned, b); }
DI float bflo(unsigned u) { return __uint_as_float(u << 16); }
DI float bfhi(unsigned u) { return __uint_as_float(u & 0xffff0000u); }
DI int crow(int i, int h) { return (i & 3) + 8 * (i >> 2) + 4 * h; }
DI int swap23(int x) { return (x & ~12) | ((x & 4) << 1) | ((x & 8) >> 1); }
DI int otid() { int t = threadIdx.x; asm volatile("" : "+v"(t)); return t; }
DI float wave_sum(float v) {
#pragma unroll
    for (int o = 32; o >= 1; o >>= 1) v += __shfl_xor(v, o);
    return v;
}


#define XB_TMO      128
#define XB_XCNT(j)  (256  + 64 * (j))
#define XB_XSUB(j)  (1280 + 64 * (j))
#define XB_XGEN(j)  (2304 + 64 * (j))
#define XB_TOP      3328
#define XB_TOPGEN   3392
#define XCD_BAR_WORDS 3456
#define XB_SPIN_CAP (1u << 18)
DI unsigned xb_ld(unsigned* p) { return __hip_atomic_load(p, __ATOMIC_RELAXED, __HIP_MEMORY_SCOPE_AGENT); }
DI unsigned xb_add(unsigned* p, unsigned v) { return __hip_atomic_fetch_add(p, v, __ATOMIC_RELAXED, __HIP_MEMORY_SCOPE_AGENT); }
DI unsigned xb_xcc_id() { return (unsigned)__builtin_amdgcn_s_getreg((3 << 11) | 20) & 0xFu; }
#define XB_SPIN(cond, bar) do { unsigned _sp = 0; while (cond) { __builtin_amdgcn_s_sleep(1); \
    if ((++_sp & 255u) == 0u) { if (xb_ld(&(bar)[XB_TMO])) break; if (_sp > XB_SPIN_CAP) { atomicAdd(&(bar)[XB_TMO], 1u); break; } } } } while (0)
struct XcdBarrier { unsigned* bar; unsigned x; volatile LDS_AS unsigned* st; };
DI XcdBarrier xcd_barrier_post(unsigned* bar, volatile LDS_AS unsigned* st) {
    XcdBarrier b; b.bar = bar; b.x = xb_xcc_id(); b.st = st;
    if (threadIdx.x == 0) (void)xb_add(&bar[XB_XCNT(b.x)], 1u);
    return b;
}
DI void xcd_barrier_complete(unsigned* bar, unsigned x, unsigned& nloc, unsigned& nx) {
    const unsigned G = gridDim.x * gridDim.y * gridDim.z;
    unsigned sum, cnt, mine, sp = 0u;
    for (;;) {
        sum = 0u; cnt = 0u; mine = 0u;
#pragma unroll
        for (unsigned j = 0; j < 16; ++j) { const unsigned c = xb_ld(&bar[XB_XCNT(j)]); sum += c; cnt += (c > 0u) ? 1u : 0u; mine = (j == x) ? c : mine; }
        if (sum == G) break;
        __builtin_amdgcn_s_sleep(1);
        if ((++sp & 255u) == 0u) { if (xb_ld(&bar[XB_TMO])) break; if (sp > XB_SPIN_CAP) { atomicAdd(&bar[XB_TMO], 1u); break; } }
    }
    nloc = mine > 0u ? mine : 1u; nx = cnt > 0u ? cnt : 1u;
}
DI void xcd_barrier(const XcdBarrier& b) {
    asm volatile("s_waitcnt vmcnt(0)" ::: "memory");
    __syncthreads();
    if (threadIdx.x == 0) {
        unsigned* bar = b.bar;
        __builtin_amdgcn_s_waitcnt(0);
        unsigned nloc = b.st[0], nx = b.st[1];
        if (nloc == 0u) { xcd_barrier_complete(bar, b.x, nloc, nx); b.st[0] = nloc; b.st[1] = nx; }
        const unsigned old = xb_add(&bar[XB_XSUB(b.x)], 1u);
        const unsigned gen = old / nloc;
        if (old + 1u == (gen + 1u) * nloc) {
            __builtin_amdgcn_fence(__ATOMIC_RELEASE, "agent");
            asm volatile("s_waitcnt vmcnt(0)" ::: "memory");
            const unsigned og = xb_add(&bar[XB_TOP], 1u);
            const unsigned tg = og / nx;
            if (og + 1u == (tg + 1u) * nx) xb_add(&bar[XB_TOPGEN], 1u);
            else XB_SPIN(xb_ld(&bar[XB_TOPGEN]) == tg, bar);
            __builtin_amdgcn_fence(__ATOMIC_ACQUIRE, "agent");
            xb_add(&bar[XB_XGEN(b.x)], 1u);
            asm volatile("s_waitcnt vmcnt(0)" ::: "memory");
        } else {
            XB_SPIN(xb_ld(&bar[XB_XGEN(b.x)]) == gen, bar);
            __builtin_amdgcn_fence(__ATOMIC_ACQUIRE, "agent");
            asm volatile("s_waitcnt vmcnt(0)" ::: "memory");
        }
    }
    __syncthreads();
}

DI void convert_weight(const float* __restrict__ src, bf16_t* __restrict__ dst, int K, int N, int Npad, char* smem, int slo = 0, int shi = 0, float scale = 1.0f) {
    float* t = (float*)smem;
    const int tid = otid();
    const int nkt = K / 64, nnt = Npad / 64;
    for (int tile = blockIdx.x; tile < nkt * nnt; tile += gridDim.x) {
        const int k0 = (tile / nnt) * 64, n0 = (tile % nnt) * 64;
#pragma unroll
        for (int i = 0; i < 8; ++i) {
            const int k = i * 8 + (tid >> 6), n = tid & 63;
            const float sc_ = (n0 + n >= slo && n0 + n < shi) ? scale : 1.0f;
            t[k * 65 + n] = (n0 + n < N) ? src[(size_t)(k0 + k) * N + n0 + n] * sc_ : 0.f;
        }
        __syncthreads();
#pragma unroll
        for (int i = 0; i < 4; ++i) {
            const int n = i * 16 + (tid >> 5), k = (tid & 31) * 2;
            *(unsigned*)(dst + (size_t)(n0 + n) * K + k0 + k) = pack2(t[k * 65 + n], t[(k + 1) * 65 + n]);
        }
        __syncthreads();
    }
}

__device__ const float kFreq[16] = {1.000000000e+00f, 5.623413324e-01f, 3.162277639e-01f, 1.778279394e-01f, 1.000000015e-01f, 5.623413250e-02f, 3.162277490e-02f, 1.778279431e-02f,
                                    9.999999776e-03f, 5.623413250e-03f, 3.162277630e-03f, 1.778279431e-03f, 1.000000047e-03f, 5.623413017e-04f, 3.162277571e-04f, 1.778279402e-04f};
DI float2 sincos_acc(float ang) {
    const double x = (double)ang;
    const double n = __builtin_rint(x * 0.15915494309189535);
    double r = __builtin_fma(-n, 6.283185307179586, x);
    r = __builtin_fma(-n, 2.4492935982947064e-16, r);
    const double r2 = r * r;
    double s = 1.0, c = 1.0;
#pragma unroll
    for (int k = 13; k >= 1; --k) {
        s = 1.0 - r2 * s * (1.0 / (double)((2 * k) * (2 * k + 1)));
        c = 1.0 - r2 * c * (1.0 / (double)((2 * k - 1) * (2 * k)));
    }
    return make_float2((float)c, (float)(r * s));
}
DI void build_tables(float2* ax, float2* lin) {
    const int gt = blockIdx.x * THREADS + otid(), gs = gridDim.x * THREADS;
    for (int e = gt; e < SEQ * 32; e += gs) {
        const int pos = e >> 5, p = e & 31;
        const float base = (p < 16) ? (float)(pos >> 6) : (float)(pos & 63);
        ax[e] = sincos_acc(base * kFreq[p & 15]);
    }
    for (int e = gt; e < SEQ * 16; e += gs) {
        const int pos = e >> 4, p = e & 15;
        lin[e] = sincos_acc((float)pos * kFreq[p]);
    }
}

DI void rmsnorm_rows(const float* __restrict__ src, const float* __restrict__ g, bf16_t* __restrict__ dst, int nrows) {
    const int tid_ = otid(), lane = tid_ & 63, wv = blockIdx.x * NWAVE + (tid_ >> 6), nw = gridDim.x * NWAVE;
    for (int row = wv; row < nrows; row += nw) {
        const float4* s = (const float4*)(src + (size_t)row * D);
        float4 v[4]; float ss = 0.f;
#pragma unroll
        for (int i = 0; i < 4; ++i) { v[i] = s[i * 64 + lane]; ss += v[i].x * v[i].x + v[i].y * v[i].y + v[i].z * v[i].z + v[i].w * v[i].w; }
        ss = wave_sum(ss);
        const float rstd = rsqrtf(ss * (1.0f / D) + EPS);
#pragma unroll
        for (int i = 0; i < 4; ++i) {
            const float4 gg = ((const float4*)g)[i * 64 + lane];
            uint2 o; o.x = pack2(v[i].x * rstd * gg.x, v[i].y * rstd * gg.y); o.y = pack2(v[i].z * rstd * gg.z, v[i].w * rstd * gg.w);
            *(uint2*)(dst + (size_t)row * D + (i * 64 + lane) * 4) = o;
        }
    }
}
DI void rmsnorm_final(float* __restrict__ x, const float* __restrict__ g, int nrows) {
    const int tid_ = otid(), lane = tid_ & 63, wv = blockIdx.x * NWAVE + (tid_ >> 6), nw = gridDim.x * NWAVE;
    for (int row = wv; row < nrows; row += nw) {
        float4* s = (float4*)(x + (size_t)row * D);
        float4 v[4]; float ss = 0.f;
#pragma unroll
        for (int i = 0; i < 4; ++i) { v[i] = s[i * 64 + lane]; ss += v[i].x * v[i].x + v[i].y * v[i].y + v[i].z * v[i].z + v[i].w * v[i].w; }
        ss = wave_sum(ss);
        const float rstd = rsqrtf(ss * (1.0f / D) + EPS);
#pragma unroll
        for (int i = 0; i < 4; ++i) {
            const float4 gg = ((const float4*)g)[i * 64 + lane];
            float4 o; o.x = v[i].x * rstd * gg.x; o.y = v[i].y * rstd * gg.y; o.z = v[i].z * rstd * gg.z; o.w = v[i].w * rstd * gg.w;
            s[i * 64 + lane] = o;
        }
    }
}

DI void kprep_even(bf16_t* __restrict__ qkv, const float* __restrict__ gk, const float2* __restrict__ ax) {
    const int tid_ = otid(), gt = blockIdx.x * THREADS + tid_, gs = gridDim.x * THREADS;
    const int p = tid_ & 31;
    for (int v = gt >> 5; v < TC * 2; v += gs >> 5) {
        const int tok = v >> 1, kvh = v & 1;
        unsigned* ptr = (unsigned*)(qkv + (size_t)tok * EVEN_IN + 512 + kvh * 64 + 2 * p);
        const unsigned u = *ptr;
        const float x0 = bflo(u), x1 = bfhi(u);
        float ss = x0 * x0 + x1 * x1;
#pragma unroll
        for (int o = 16; o >= 1; o >>= 1) ss += __shfl_xor(ss, o);
        const float rstd = rsqrtf(ss * (1.0f / 64) + EPS);
        const float y0 = x0 * rstd * gk[2 * p], y1 = x1 * rstd * gk[2 * p + 1];
        const float2 cs = ax[(tok & (SEQ - 1)) * 32 + p];
        *ptr = pack2(y0 * cs.x - y1 * cs.y, y0 * cs.y + y1 * cs.x);
    }
}
DI void prep_odd(bf16_t* __restrict__ a, const float* __restrict__ gq, const float* __restrict__ gkv, const float2* __restrict__ lin) {
    const int tid_ = otid(), lane = tid_ & 63, wv = blockIdx.x * NWAVE + (tid_ >> 6), nw = gridDim.x * NWAVE;
    for (int row = wv; row < TC; row += nw) {
        unsigned* base = (unsigned*)(a + (size_t)row * ODD_PAD);
        unsigned uq[3], uk[2]; float sq = 0.f, sk = 0.f;
#pragma unroll
        for (int i = 0; i < 3; ++i) { uq[i] = base[i * 64 + lane]; const float a0 = bflo(uq[i]), a1 = bfhi(uq[i]); sq += a0 * a0 + a1 * a1; }
#pragma unroll
        for (int i = 0; i < 2; ++i) { uk[i] = base[192 + i * 64 + lane]; const float a0 = bflo(uk[i]), a1 = bfhi(uk[i]); sk += a0 * a0 + a1 * a1; }
        sq = wave_sum(sq); sk = wave_sum(sk);
        const float rq = rsqrtf(sq * (1.0f / 384) + EPS), rk = rsqrtf(sk * (1.0f / 256) + EPS);
#pragma unroll
        for (int i = 0; i < 3; ++i) { const int c = (i * 64 + lane) * 2; base[i * 64 + lane] = pack2(bflo(uq[i]) * rq * gq[c], bfhi(uq[i]) * rq * gq[c + 1]); }
#pragma unroll
        for (int i = 0; i < 2; ++i) { const int c = (i * 64 + lane) * 2; base[192 + i * 64 + lane] = pack2(bflo(uk[i]) * rk * gkv[c], bfhi(uk[i]) * rk * gkv[c + 1]); }
        if (lane < 16) {
            const unsigned u = base[320 + lane];
            const float x0 = bflo(u), x1 = bfhi(u);
            const float2 cs = lin[(row & (SEQ - 1)) * 16 + lane];
            base[320 + lane] = pack2(x0 * cs.x - x1 * cs.y, x0 * cs.y + x1 * cs.x);
        }
    }
}


DI void normmax_even(const bf16_t* __restrict__ qkv, unsigned* __restrict__ nd, char* smem) {
    const int tid = otid(), lane = tid & 63, w = tid >> 6;
    float* red = (float*)smem;
    for (int item = blockIdx.x; item < NB * 32; item += gridDim.x) {
        const int b = item & 7, slab = item >> 3;
        float mq = 0.f, mk = 0.f;
        for (int i = 0; i < 16; ++i) {
            const bf16_t* row = qkv + ((size_t)b * SEQ + slab * 128 + w * 16 + i) * EVEN_IN;
            const u32x4 uq = *(const u32x4*)(row + 768 + 8 * lane), uk = *(const u32x4*)(row + 1280 + 8 * lane);
            float sq = 0.f, sk = 0.f;
#pragma unroll
            for (int j = 0; j < 4; ++j) { const float a0 = bflo(uq[j]), a1 = bfhi(uq[j]), b0 = bflo(uk[j]), b1 = bfhi(uk[j]); sq += a0 * a0 + a1 * a1; sk += b0 * b0 + b1 * b1; }
#pragma unroll
            for (int o = 1; o <= 4; o <<= 1) { sq += __shfl_xor(sq, o); sk += __shfl_xor(sk, o); }
            mq = fmaxf(mq, sq); mk = fmaxf(mk, sk);
        }
        if ((lane & 7) == 0) { red[(w * 8 + (lane >> 3)) * 2] = mq; red[(w * 8 + (lane >> 3)) * 2 + 1] = mk; }
        __syncthreads();
        if (tid < 16) {
            float m = 0.f;
#pragma unroll
            for (int ww = 0; ww < NWAVE; ++ww) m = fmaxf(m, red[ww * 16 + tid]);
            atomicMax(nd + b * 16 + tid, __float_as_uint(m));
        }
        __syncthreads();
    }
}
DI void normmax_mla(const bf16_t* __restrict__ qb, const bf16_t* __restrict__ kv, const bf16_t* __restrict__ a, unsigned* __restrict__ nmx, char* smem) {
    const int tid = otid(), lane = tid & 63, w = tid >> 6;
    float* red = (float*)smem;
    for (int item = blockIdx.x; item < NB * 32; item += gridDim.x) {
        const int b = item & 7, slab = item >> 3;
        float mq = 0.f, mk = 0.f;
        for (int i = 0; i < 16; ++i) {
            const size_t r = (size_t)b * SEQ + slab * 128 + w * 16 + i;
            float sq = 0.f, sk = 0.f, sr = 0.f;
#pragma unroll
            for (int c = 0; c < 3; ++c) {
                const u32x4 u = *(const u32x4*)(qb + r * 1536 + 24 * lane + 8 * c);
#pragma unroll
                for (int j = 0; j < 4; ++j) { const float a0 = bflo(u[j]), a1 = bfhi(u[j]); sq += a0 * a0 + a1 * a1; }
            }
#pragma unroll
            for (int c = 0; c < 4; ++c) {
                const u32x4 u = *(const u32x4*)(kv + r * 2048 + 32 * lane + 8 * c);
#pragma unroll
                for (int j = 0; j < 4; ++j) { const float a0 = bflo(u[j]), a1 = bfhi(u[j]); sk += a0 * a0 + a1 * a1; }
            }
#pragma unroll
            for (int c = 0; c < 4; ++c) {
                const u32x4 u = *(const u32x4*)(a + r * ODD_PAD + 640 + 8 * c);
#pragma unroll
                for (int j = 0; j < 4; ++j) { const float a0 = bflo(u[j]), a1 = bfhi(u[j]); sr += a0 * a0 + a1 * a1; }
            }
            sq += __shfl_xor(sq, 1); sq += __shfl_xor(sq, 2);
            sk += __shfl_xor(sk, 1);
            mq = fmaxf(mq, sq); mk = fmaxf(mk, sk + sr);
        }
        if ((lane & 3) == 0) { red[(w * 16 + (lane >> 2)) * 2] = mq; red[(w * 16 + (lane >> 2)) * 2 + 1] = mk; }
        __syncthreads();
        if (tid < 32) {
            float m = 0.f;
#pragma unroll
            for (int ww = 0; ww < NWAVE; ++ww) m = fmaxf(m, red[ww * 32 + tid]);
            atomicMax(nmx + b * 32 + tid, __float_as_uint(m));
        }
        __syncthreads();
    }
}

namespace pg8 {
constexpr int BM = 256, BK = 64, HALF = 128, HTB = HALF * BK * 2, NXCD = 8, WGM = 8;
DI int lds_byte(int r, int c) { const int st = (r >> 4) * 2 + (c >> 5), rr = r & 15, cc = c & 31, ob = rr * 64 + cc * 2; return st * 1024 + (ob ^ (((ob >> 9) & 1) << 5)); }
DI void stage_rc(int b, int& R, int& C) { const int st = b / 1024, sb = b % 1024, swz = sb ^ (((sb >> 9) & 1) << 5); R = (st >> 1) * 16 + swz / 64; C = (st & 1) * 32 + (swz % 64) / 2; }
DI int perm32(int rho) { const int n = rho >> 4, i = rho & 15; return 8 * (i >> 2) + 4 * n + (i & 3); }
struct Unit { int pm, pn; };
struct Gemm { const bf16_t* A; const bf16_t* Bt; int M, NT, K, lda; size_t hstepB, tstepB; };
struct StaticOrder {
    int nM, nN, nwg, G, c;
    DI void init(int M, int NT, int G_, int c_) { nM = M / BM; nN = NT; nwg = nM * nN; G = G_; c = c_; }
    DI bool next(int i, Unit& u) const {
        const long L = (long)i * G + c; if (L >= nwg) return false;
        int wgid = (int)L; { const int q = nwg / NXCD, r = nwg % NXCD, xcd = wgid % NXCD, off = wgid / NXCD; wgid = (xcd < r ? xcd * (q + 1) : r * (q + 1) + (xcd - r) * q) + off; }
        const int nig = WGM * nN, gid = wgid / nig, fm = gid * WGM, gsz = (nM - fm) < WGM ? (nM - fm) : WGM;
        u.pm = fm + ((wgid % nig) % gsz); u.pn = (wgid % nig) / gsz; return true;
    }
};
template <class Epi>
DI void gemm_phase(LDS_AS unsigned char* lds, const Gemm g, const Epi& E) {
    StaticOrder S; S.init(g.M, g.NT, gridDim.x, blockIdx.x);
    const int tid = otid(), wid = __builtin_amdgcn_readfirstlane(tid >> 6), lane = tid & 63, wr = wid >> 2, wc = wid & 3, fr = lane & 15, fq = lane >> 4;
    const int K = g.K, nt = K / BK;
    unsigned voffA[2], voffB[2];
#pragma unroll
    for (int i = 0; i < 2; ++i) { int R, C; stage_rc(tid * 16 + i * 8192, R, C); const int Rb = Epi::PERM ? ((R & ~31) + perm32(R & 31)) : R;
        voffA[i] = (unsigned)(R * g.lda + C) * 2u; voffB[i] = (unsigned)(Rb * K + C) * 2u; }
    const size_t kstep = (size_t)(BK * 2);
    const size_t hstepA = (size_t)HALF * g.lda * 2, tstepA = 2 * hstepA, hstepB = g.hstepB, tstepB = g.tstepB;
    const unsigned ldsw = (unsigned)wid * 1024u;
    const int aoff = lds_byte(wr * 64 + fr, fq * 8), boff = lds_byte(wc * 32 + fr, fq * 8);
#define PG8_SA(b, h) (((b) * 2 + (h)) * HTB)
#define PG8_SB(b, h) ((4 + (b) * 2 + (h)) * HTB)
#define PG8_STAGE(bufoff, gbase, voff) do { _Pragma("unroll") for (int _i = 0; _i < 2; ++_i) \
        __builtin_amdgcn_global_load_lds((const unsigned*)((const char*)(gbase) + (voff)[_i]), (LDS_AS unsigned*)(lds + (bufoff) + ldsw + _i * 8192), 16, 0, 0); } while (0)
#define PG8_LDA(dst, b, h) do { _Pragma("unroll") for (int m = 0; m < 4; ++m) _Pragma("unroll") for (int k = 0; k < 2; ++k) dst[m][k] = *(const LDS_AS bf16x8*)(lds + PG8_SA(b, h) + aoff + m * 2048 + k * 1024); } while (0)
#define PG8_LDB(dst, b, h) do { _Pragma("unroll") for (int n = 0; n < 2; ++n) _Pragma("unroll") for (int k = 0; k < 2; ++k) dst[n][k] = *(const LDS_AS bf16x8*)(lds + PG8_SB(b, h) + boff + n * 2048 + k * 1024); } while (0)
#define PG8_MMA(ai, bj, At, Bt) do { __builtin_amdgcn_s_setprio(1); _Pragma("unroll") for (int m = 0; m < 4; ++m) _Pragma("unroll") for (int n = 0; n < 2; ++n) _Pragma("unroll") for (int k = 0; k < 2; ++k) \
        acc[ai][bj][m][n] = __builtin_amdgcn_mfma_f32_16x16x32_bf16(Bt[n][k], At[m][k], acc[ai][bj][m][n], 0, 0, 0); __builtin_amdgcn_s_setprio(0); } while (0)
#define PG8_WAIT_V(n) asm volatile("s_waitcnt vmcnt(" #n ")" ::: "memory")
#define PG8_WAIT_L(n) asm volatile("s_waitcnt lgkmcnt(" #n ")" ::: "memory")
#define PG8_BAR __builtin_amdgcn_s_barrier()
#define PG8_SCHED __builtin_amdgcn_sched_barrier(0)
    Unit cur, nxt; int ui = 0;
    if (!S.next(0, cur)) return;
    f32x4 acc[2][2][4][2];
#pragma unroll
    for (int a = 0; a < 2; ++a)
#pragma unroll
        for (int b = 0; b < 2; ++b)
#pragma unroll
            for (int m = 0; m < 4; ++m)
#pragma unroll
                for (int n = 0; n < 2; ++n) acc[a][b][m][n] = (f32x4){0.f, 0.f, 0.f, 0.f};
    bf16x8 At[4][2], B0[2][2], B1[2][2];
    const char* cA = (const char*)g.A + (size_t)cur.pm * tstepA; const char* cB = (const char*)g.Bt + (size_t)cur.pn * tstepB;
    PG8_STAGE(PG8_SB(0, 0), cB, voffB); PG8_STAGE(PG8_SA(0, 0), cA, voffA); PG8_STAGE(PG8_SB(0, 1), cB + hstepB, voffB); PG8_STAGE(PG8_SA(0, 1), cA + hstepA, voffA);
    if (wr == 1) PG8_BAR;
    PG8_WAIT_V(4); PG8_BAR;
    PG8_STAGE(PG8_SB(1, 0), cB + kstep, voffB); PG8_STAGE(PG8_SA(1, 0), cA + kstep, voffA); PG8_STAGE(PG8_SB(1, 1), cB + hstepB + kstep, voffB);
    PG8_WAIT_V(6); PG8_BAR;
    for (;;) {
        const bool has_next = S.next(ui + 1, nxt);
        const char* nA = has_next ? (const char*)g.A + (size_t)nxt.pm * tstepA : cA; const char* nB = has_next ? (const char*)g.Bt + (size_t)nxt.pn * tstepB : cB;
        for (int t = 0; t < nt; t += 2) {
            const bool last = (t == nt - 2);
            const char* a1 = cA + (size_t)(t + 1) * kstep;
            const char* a2 = last ? nA : cA + (size_t)(t + 2) * kstep; const char* b2 = last ? nB : cB + (size_t)(t + 2) * kstep;
            const char* a3 = a2 + kstep; const char* b3 = b2 + kstep;
            PG8_LDB(B0, 0, 0); PG8_SCHED; PG8_LDA(At, 0, 0); PG8_STAGE(PG8_SA(1, 1), a1 + hstepA, voffA);
            PG8_WAIT_L(8); PG8_BAR; PG8_WAIT_L(0); PG8_MMA(0, 0, At, B0); PG8_BAR; PG8_SCHED;
            PG8_LDB(B1, 0, 1); PG8_STAGE(PG8_SB(0, 0), b2, voffB);
            PG8_BAR; PG8_WAIT_L(0); PG8_MMA(0, 1, At, B1); PG8_BAR;
            PG8_LDA(At, 0, 1); PG8_STAGE(PG8_SA(0, 0), a2, voffA);
            PG8_BAR; PG8_WAIT_L(0); PG8_MMA(1, 0, At, B0); PG8_BAR; PG8_SCHED;
            PG8_STAGE(PG8_SB(0, 1), b2 + hstepB, voffB);
            PG8_WAIT_V(6); PG8_BAR; PG8_MMA(1, 1, At, B1); PG8_BAR;
            PG8_LDB(B0, 1, 0); PG8_SCHED; PG8_LDA(At, 1, 0); PG8_STAGE(PG8_SA(0, 1), a2 + hstepA, voffA);
            PG8_WAIT_L(8); PG8_BAR; PG8_WAIT_L(0); PG8_MMA(0, 0, At, B0); PG8_BAR; PG8_SCHED;
            PG8_LDB(B1, 1, 1); PG8_STAGE(PG8_SB(1, 0), b3, voffB);
            PG8_BAR; PG8_WAIT_L(0); PG8_MMA(0, 1, At, B1); PG8_BAR;
            PG8_LDA(At, 1, 1); PG8_STAGE(PG8_SA(1, 0), a3, voffA);
            PG8_BAR; PG8_WAIT_L(0); PG8_MMA(1, 0, At, B0); PG8_BAR; PG8_SCHED;
            PG8_STAGE(PG8_SB(1, 1), b3 + hstepB, voffB);
            PG8_WAIT_V(6); PG8_BAR; PG8_MMA(1, 1, At, B1); PG8_BAR;
        }
        E(acc, cur, wr, wc, fr, fq);
        if (!has_next) break;
#pragma unroll
        for (int a = 0; a < 2; ++a)
#pragma unroll
            for (int b = 0; b < 2; ++b)
#pragma unroll
                for (int m = 0; m < 4; ++m)
#pragma unroll
                    for (int n = 0; n < 2; ++n) acc[a][b][m][n] = (f32x4){0.f, 0.f, 0.f, 0.f};
        cur = nxt; cA = nA; cB = nB; ++ui;
    }
    PG8_WAIT_V(0);
    if (wr == 0) PG8_BAR;
    PG8_BAR;
#undef PG8_SA
#undef PG8_SB
#undef PG8_STAGE
#undef PG8_LDA
#undef PG8_LDB
#undef PG8_MMA
#undef PG8_WAIT_V
#undef PG8_WAIT_L
#undef PG8_BAR
#undef PG8_SCHED
}
struct EpiResid {
    static constexpr bool PERM = false;
    const float* res; float* out;
    DI void operator()(const f32x4 (&acc)[2][2][4][2], const Unit& u, int wr, int wc, int fr, int fq) const {
        const int row0 = u.pm * BM + wr * 64 + fr, col0 = u.pn * BM + wc * 32 + 4 * fq;
#pragma unroll
        for (int ai = 0; ai < 2; ++ai)
#pragma unroll
            for (int m = 0; m < 4; ++m) {
                const size_t rb = (size_t)(row0 + ai * HALF + m * 16) * D + col0;
#pragma unroll
                for (int bj = 0; bj < 2; ++bj)
#pragma unroll
                    for (int n = 0; n < 2; ++n) { const size_t idx = rb + bj * HALF + n * 16; *(f32x4*)(out + idx) = *(const f32x4*)(res + idx) + acc[ai][bj][m][n]; }
            }
    }
};
struct EpiBf16 {
    static constexpr bool PERM = true;
    bf16_t* out; int ld;
    DI void operator()(const f32x4 (&acc)[2][2][4][2], const Unit& u, int wr, int wc, int fr, int fq) const {
        const int row0 = u.pm * BM + wr * 64 + fr, col0 = u.pn * BM + wc * 32 + 8 * fq;
#pragma unroll
        for (int ai = 0; ai < 2; ++ai)
#pragma unroll
            for (int m = 0; m < 4; ++m) {
                bf16_t* rowp = out + (size_t)(row0 + ai * HALF + m * 16) * ld + col0;
#pragma unroll
                for (int bj = 0; bj < 2; ++bj) {
                    const f32x4 v0 = acc[ai][bj][m][0], v1 = acc[ai][bj][m][1];
                    u32x4 w; w.x = pack2(v0[0], v0[1]); w.y = pack2(v0[2], v0[3]); w.z = pack2(v1[0], v1[1]); w.w = pack2(v1[2], v1[3]);
                    *(u32x4*)(rowp + bj * HALF) = w;
                }
            }
    }
};
struct EpiSwiglu {
    static constexpr bool PERM = true;
    bf16_t* act;
    DI void operator()(const f32x4 (&acc)[2][2][4][2], const Unit& u, int wr, int wc, int fr, int fq) const {
        const int row0 = u.pm * BM + wr * 64 + fr, col0 = u.pn * HALF + wc * 32 + 8 * fq;
#pragma unroll
        for (int ai = 0; ai < 2; ++ai)
#pragma unroll
            for (int m = 0; m < 4; ++m) {
                float v[8];
#pragma unroll
                for (int n = 0; n < 2; ++n)
#pragma unroll
                    for (int j = 0; j < 4; ++j) { const float gg = acc[ai][0][m][n][j], uu = acc[ai][1][m][n][j]; v[4 * n + j] = gg * uu * __builtin_amdgcn_rcpf(1.0f + __builtin_amdgcn_exp2f(-gg * LOG2E)); }
                u32x4 w; w.x = pack2(v[0], v[1]); w.y = pack2(v[2], v[3]); w.z = pack2(v[4], v[5]); w.w = pack2(v[6], v[7]);
                *(u32x4*)(act + (size_t)(row0 + ai * HALF + m * 16) * DFF + col0) = w;
            }
    }
};
}
DI pg8::Gemm mk_gemm(const bf16_t* A, int lda, const bf16_t* Bt, int M, int N, int K) { return pg8::Gemm{A, Bt, M, N / 256, K, lda, (size_t)128 * K * 2, (size_t)256 * K * 2}; }

template <int DQK, int DV, int KT, int QMODE, bool ALIBI, bool NOMAX>
DI void attn_core(const bf16_t* __restrict__ q, int ldq, const bf16_t* __restrict__ k, int ldk, const bf16_t* __restrict__ k2, int ldk2,
                  const bf16_t* __restrict__ v, int ldv, int nkeys, int qpos0, float qscale, float slope2,
                  const float* __restrict__ qg, const float2* __restrict__ tab, char* smem, f32x16 (&o)[DV / 32], float& lsum) {
    constexpr int KROW = DQK * 2 + 16, VROW = DV * 2 + 64  , KBYTES = KT * KROW, VBYTES = KT * VROW;
    constexpr int KCPR = DQK / 8  , KTOT = KT * KCPR, NKC = (KTOT + THREADS - 1) / THREADS, VCPR = DV / 8, VTOT = KT * VCPR, NVC = (VTOT + THREADS - 1) / THREADS;
    constexpr int NST = KT / 32, NKS = DQK / 16, NDT = DV / 32;
    static_assert(2 * (KBYTES + VBYTES) <= (int)LDS_BYTES, "lds");
    const int tid = otid(), lane = tid & 63, w = tid >> 6, r = lane & 31, h = lane >> 5;
    const int qpos = qpos0 + 32 * w + r;
    bf16x8 qf[NKS];
    {
        const bf16_t* qrow = q + (size_t)(32 * w + r) * ldq + 8 * h;
        u32x4 raw[NKS];
#pragma unroll
        for (int s = 0; s < NKS; ++s) raw[s] = *(const u32x4*)(qrow + 16 * s);
        if (QMODE == 1) {
            float ss = 0.f;
#pragma unroll
            for (int s = 0; s < NKS; ++s) {
                const unsigned u[4] = {raw[s].x, raw[s].y, raw[s].z, raw[s].w};
#pragma unroll
                for (int j = 0; j < 4; ++j) { const float a0 = bflo(u[j]), a1 = bfhi(u[j]); ss += a0 * a0 + a1 * a1; }
            }
            ss += __shfl_xor(ss, 32);
            const float rstd = rsqrtf(ss * (1.0f / 64) + EPS) * qscale;
#pragma unroll
            for (int s = 0; s < NKS; ++s) {
                unsigned u[4] = {raw[s].x, raw[s].y, raw[s].z, raw[s].w};
#pragma unroll
                for (int j = 0; j < 4; ++j) {
                    const int d0 = 16 * s + 8 * h + 2 * j;
                    const float y0 = bflo(u[j]) * rstd * qg[d0], y1 = bfhi(u[j]) * rstd * qg[d0 + 1];
                    const float2 cs = tab[qpos * 32 + (d0 >> 1)];
                    u[j] = pack2(y0 * cs.x - y1 * cs.y, y0 * cs.y + y1 * cs.x);
                }
                raw[s] = u32x4{u[0], u[1], u[2], u[3]};
            }
        } else if (QMODE == 2) {
#pragma unroll
            for (int s = 4; s < NKS; ++s) {
                unsigned u[4] = {raw[s].x, raw[s].y, raw[s].z, raw[s].w};
#pragma unroll
                for (int j = 0; j < 4; ++j) {
                    const int p = 8 * (s - 4) + 4 * h + j;
                    const float y0 = bflo(u[j]), y1 = bfhi(u[j]);
                    const float2 cs = tab[qpos * 16 + p];
                    u[j] = pack2(y0 * cs.x - y1 * cs.y, y0 * cs.y + y1 * cs.x);
                }
                raw[s] = u32x4{u[0], u[1], u[2], u[3]};
            }
        }
#pragma unroll
        for (int s = 0; s < NKS; ++s) qf[s] = __builtin_bit_cast(bf16x8, raw[s]);
    }
    u32x4 rk[NKC], rv[NVC];
    char* const kbuf = smem;
    char* const vbuf = smem + 2 * KBYTES;
#define ATT_GLOADK(key0_)                                                                                             \
    {                                                                                                                 \
        _Pragma("unroll") for (int i = 0; i < NKC; ++i) {                                                             \
            const int cid = tid + THREADS * i, key = cid / KCPR, cc = cid - key * KCPR;                               \
            if (KTOT % THREADS == 0 || cid < KTOT) {                                                                  \
                const bf16_t* src;                                                                                    \
                if (QMODE == 2 && cc >= 8) src = k2 + (size_t)((key0_) + key) * ldk2 + (cc - 8) * 8;                   \
                else src = k + (size_t)((key0_) + key) * ldk + cc * 8;                                                \
                rk[i] = *(const u32x4*)src;                                                                           \
            }                                                                                                         \
        }                                                                                                             \
    }
#define ATT_GLOADV(key0_)                                                                                             \
    {                                                                                                                 \
        _Pragma("unroll") for (int i = 0; i < NVC; ++i) {                                                             \
            const int cid = tid + THREADS * i, key = cid / VCPR, cc = cid - key * VCPR;                               \
            if (VTOT % THREADS == 0 || cid < VTOT) rv[i] = *(const u32x4*)(v + (size_t)((key0_) + key) * ldv + cc * 8); \
        }                                                                                                             \
    }
#define ATT_LSTOREK(buf_)                                                                                             \
    {                                                                                                                 \
        _Pragma("unroll") for (int i = 0; i < NKC; ++i) {                                                             \
            const int cid = tid + THREADS * i, key = cid / KCPR, cc = cid - key * KCPR;                               \
            if (KTOT % THREADS == 0 || cid < KTOT) *(u32x4*)(kbuf + (buf_) * KBYTES + key * KROW + cc * 16) = rk[i];  \
        }                                                                                                             \
    }
#define ATT_LSTOREV(buf_)                                                                                             \
    {                                                                                                                 \
        _Pragma("unroll") for (int i = 0; i < NVC; ++i) {                                                             \
            const int cid = tid + THREADS * i, key = cid / VCPR, cc = cid - key * VCPR;                               \
            if (VTOT % THREADS == 0 || cid < VTOT) *(u32x4*)(vbuf + (buf_) * VBYTES + key * VROW + cc * 16) = rv[i];  \
        }                                                                                                             \
    }
#define ATT_QK(buf_, X_)                                                                                              \
    {                                                                                                                 \
        const char* kb_ = kbuf + (buf_) * KBYTES + r * KROW + h * 16;                                                 \
        _Pragma("unroll") for (int st = 0; st < NST; ++st) {                                                          \
            X_[st] = MFMA(*(const bf16x8*)(kb_ + 32 * st * KROW), qf[0], zero16);                                     \
            _Pragma("unroll") for (int ks = 1; ks < NKS; ++ks) X_[st] = MFMA(*(const bf16x8*)(kb_ + 32 * st * KROW + ks * 32), qf[ks], X_[st]); \
        }                                                                                                             \
    }
#define ATT_SMPV(t_, vb_, X_)                                                                                         \
    {                                                                                                                 \
        if (NOMAX) {                                                                                                  \
            const float dqn = (float)(qpos - ((t_) * KT + 4 * h));                                                    \
            _Pragma("unroll") for (int st = 0; st < NST; ++st)                                                        \
                _Pragma("unroll") for (int i = 0; i < 16; ++i) {                                                      \
                    float xv_ = X_[st][i];                                                                            \
                    if (ALIBI) xv_ = __builtin_fmaf(-slope2, fabsf(dqn - (float)(32 * st + (i & 3) + 8 * (i >> 2))), xv_); \
                    X_[st][i] = __builtin_amdgcn_exp2f(xv_);                                                          \
                }                                                                                                     \
        } else {                                                                                                      \
            float mx = -1e30f;                                                                                        \
            const float dq = (float)(qpos - ((t_) * KT + 4 * h));                                                     \
            _Pragma("unroll") for (int st = 0; st < NST; ++st)                                                        \
                _Pragma("unroll") for (int i = 0; i < 16; ++i) {                                                      \
                    if (ALIBI) X_[st][i] = __builtin_fmaf(-slope2, fabsf(dq - (float)(32 * st + (i & 3) + 8 * (i >> 2))), X_[st][i]); \
                    mx = fmaxf(mx, X_[st][i]);                                                                        \
                }                                                                                                     \
            mx = fmaxf(mx, __shfl_xor(mx, 32));                                                                       \
            const float mn = fmaxf(m, mx);                                                                            \
            const float alpha = __builtin_amdgcn_exp2f(m - mn);                                                       \
            m = mn;                                                                                                   \
            _Pragma("unroll") for (int st = 0; st < NST; ++st)                                                        \
                _Pragma("unroll") for (int i = 0; i < 16; ++i) X_[st][i] = __builtin_amdgcn_exp2f(X_[st][i] - mn);    \
            if (__any(alpha != 1.0f)) {                                                                               \
                _Pragma("unroll") for (int dt = 0; dt < NDT; ++dt)                                                    \
                    _Pragma("unroll") for (int i = 0; i < 16; ++i) o[dt][i] *= alpha;                                 \
                _Pragma("unroll") for (int i = 0; i < 16; ++i) ol[i] *= alpha;                                        \
            }                                                                                                         \
        }                                                                                                             \
        const char* vbp_ = vbuf + (vb_) * VBYTES + vlane;                                                             \
        _Pragma("unroll") for (int st = 0; st < NST; ++st)                                                            \
            _Pragma("unroll") for (int s = 0; s < 2; ++s) {                                                           \
                u32x4 pk;                                                                                             \
                pk.x = pack2(X_[st][8 * s + 0], X_[st][8 * s + 1]); pk.y = pack2(X_[st][8 * s + 2], X_[st][8 * s + 3]); \
                pk.z = pack2(X_[st][8 * s + 4], X_[st][8 * s + 5]); pk.w = pack2(X_[st][8 * s + 6], X_[st][8 * s + 7]); \
                const bf16x8 pb = __builtin_bit_cast(bf16x8, pk);                                                     \
                ol = MFMA(ones8, pb, ol);                                                                             \
                _Pragma("unroll") for (int dt = 0; dt < NDT; ++dt) {                                                  \
                    const char* va = vbp_ + (32 * st + 16 * s) * VROW + 64 * dt;                                      \
                    const s16x4 lo = __builtin_amdgcn_ds_read_tr16_b64_v4i16((LDS_AS s16x4*)(va));                    \
                    const s16x4 hi = __builtin_amdgcn_ds_read_tr16_b64_v4i16((LDS_AS s16x4*)(va + 8 * VROW));        \
                    o[dt] = MFMA(__builtin_shufflevector(lo, hi, 0, 1, 2, 3, 4, 5, 6, 7), pb, o[dt]);                 \
                }                                                                                                     \
            }                                                                                                         \
    }
#define ATT_STEP(t_, PAR_, CUR_, NXT_)                                                                                \
    {                                                                                                                 \
        const int tk_ = ((t_) + 2 < ntiles) ? (t_) + 2 : ntiles - 1, tv_ = ((t_) + 1 < ntiles) ? (t_) + 1 : ntiles - 1; \
        ATT_GLOADK(tk_ * KT)                                                                                          \
        ATT_GLOADV(tv_ * KT)                                                                                          \
        __builtin_amdgcn_sched_barrier(0);                                                                            \
        ATT_QK(1 - (PAR_), NXT_)                                                                                      \
        ATT_SMPV(t_, PAR_, CUR_)                                                                                      \
        __builtin_amdgcn_sched_barrier(0);                                                                            \
        ATT_LSTOREK(PAR_)                                                                                             \
        ATT_LSTOREV(1 - (PAR_))                                                                                       \
        __syncthreads();                                                                                              \
    }
#define ATT_STEP1(t_, PAR_, X_)                                                                                       \
    {                                                                                                                 \
        const int tn_ = ((t_) + 1 < ntiles) ? (t_) + 1 : ntiles - 1;                                                  \
        ATT_GLOADK(tn_ * KT)                                                                                          \
        ATT_GLOADV(tn_ * KT)                                                                                          \
        __builtin_amdgcn_sched_barrier(0);                                                                            \
        ATT_QK(PAR_, X_)                                                                                              \
        ATT_SMPV(t_, PAR_, X_)                                                                                        \
        __builtin_amdgcn_sched_barrier(0);                                                                            \
        ATT_LSTOREK(1 - (PAR_))                                                                                       \
        ATT_LSTOREV(1 - (PAR_))                                                                                       \
        __syncthreads();                                                                                              \
    }
    const f32x16 zero16 = {0.f, 0.f, 0.f, 0.f, 0.f, 0.f, 0.f, 0.f, 0.f, 0.f, 0.f, 0.f, 0.f, 0.f, 0.f, 0.f};
    const bf16x8 ones8 = {0x3F80, 0x3F80, 0x3F80, 0x3F80, 0x3F80, 0x3F80, 0x3F80, 0x3F80};
    float m = -1e30f;
    f32x16 ol = zero16;
#pragma unroll
    for (int dt = 0; dt < NDT; ++dt) o[dt] = zero16;
    const int ntiles = nkeys / KT;
    const int vlane = (4 * h + ((lane & 15) >> 2)) * VROW + (16 * ((lane >> 4) & 1) + 4 * (lane & 3)) * 2;
    constexpr bool PIPE = (DV < 128);
    if (PIPE) {
        f32x16 xa[NST], xb[NST];
        ATT_GLOADK(0) ATT_LSTOREK(0)
        ATT_GLOADK(KT) ATT_GLOADV(0)
        __syncthreads();
        ATT_QK(0, xa)
        ATT_LSTOREK(1) ATT_LSTOREV(0)
        __syncthreads();
        for (int t = 0; t < ntiles; t += 2) {
            ATT_STEP(t, 0, xa, xb)
            ATT_STEP(t + 1, 1, xb, xa)
        }
    } else {
        f32x16 xs[NST];
        ATT_GLOADK(0) ATT_GLOADV(0) ATT_LSTOREK(0) ATT_LSTOREV(0)
        __syncthreads();
        for (int t = 0; t < ntiles; t += 2) {
            ATT_STEP1(t, 0, xs)
            ATT_STEP1(t + 1, 1, xs)
        }
    }
    lsum = ol[0];
#undef ATT_GLOADK
#undef ATT_GLOADV
#undef ATT_LSTOREK
#undef ATT_LSTOREV
#undef ATT_QK
#undef ATT_SMPV
#undef ATT_STEP
#undef ATT_STEP1
}
template <int NDT>
DI void store_o(bf16_t* dst, int ld, f32x16 (&o)[NDT], float inv) {
    const int tid_ = otid(), lane = tid_ & 63, w = tid_ >> 6, r = lane & 31, h = lane >> 5;
    bf16_t* row = dst + (size_t)(32 * w + r) * ld + 4 * h;
#pragma unroll
    for (int dt = 0; dt < NDT; ++dt)
#pragma unroll
        for (int g = 0; g < 4; ++g) {
            uint2 vv; vv.x = pack2(o[dt][4 * g] * inv, o[dt][4 * g + 1] * inv); vv.y = pack2(o[dt][4 * g + 2] * inv, o[dt][4 * g + 3] * inv);
            *(uint2*)(row + 32 * dt + 8 * g) = vv;
        }
}
DI int swz_item(int base) {
    const int G = gridDim.x, i = blockIdx.x;
    if (G & 7) return base + i;
    return base + (i & 7) * (G >> 3) + (i >> 3);
}

constexpr int QT = SEQ / 256;
constexpr float NOMAX_BOUND = 90.f;
DI void attn_even(const bf16_t* qkv, float* park, bf16_t* mix, const Params& p, const float2* ax, const unsigned* nd, float lam_init, char* smem) {
    float d1 = 0.f, d2 = 0.f, gq = 0.f, gk = 0.f;
    for (int i = 0; i < 64; ++i) { d1 += p.in[8][i] * p.in[9][i]; d2 += p.in[10][i] * p.in[11][i]; gq = fmaxf(gq, fabsf(p.in[6][i])); gk = fmaxf(gk, fabsf(p.in[7][i])); }
    const float lam = __expf(d1) - __expf(d2) + lam_init;
    const float bound_gqa = 64.f * 0.125f * LOG2E * gq * gk * 1.03f;
    const int tid_ = otid(), lane = tid_ & 63, h = lane >> 5;
    float4* mypark = (float4*)(park + ((size_t)blockIdx.x * THREADS + tid_) * 64);
    constexpr int NDIFF = NB * 4 * QT, NGQA = NB * 8 * QT;
    for (int base = 0; base < NDIFF + NGQA; base += gridDim.x) {
        const int it = swz_item(base);
        if (it >= NDIFF + NGQA) continue;
        if (it < NDIFF) {
            const int b = it / (4 * QT), hd = (it / QT) & 3, qt = it % QT;
            const size_t row0 = (size_t)b * SEQ + qt * 256;
            const float slope2 = exp2f(-2.0f * (hd + 1)) * LOG2E;
            const bf16_t* qp = qkv + row0 * EVEN_IN + 768 + hd * 128;
            const bf16_t* kp = qkv + (size_t)b * SEQ * EVEN_IN + 1280 + hd * 128;
            const bf16_t* vp = qkv + (size_t)b * SEQ * EVEN_IN + 1792 + hd * 128;
            f32x16 o0[4]; float l0 = 1.f;
#pragma unroll 1
            for (int c = 0; c < 2; ++c) {
                const unsigned* nn = nd + (b * 8 + hd * 2 + c) * 2;
                const float bound = sqrtf(__uint_as_float(nn[0]) * __uint_as_float(nn[1])) * 1.03f;
                if (bound < NOMAX_BOUND) attn_core<64, 128, 64, 0, true, true>(qp + 64 * c, EVEN_IN, kp + 64 * c, EVEN_IN, nullptr, 0, vp, EVEN_IN, SEQ, qt * 256, 1.0f, slope2, nullptr, nullptr, smem, o0, l0);
                else attn_core<64, 128, 64, 0, true, false>(qp + 64 * c, EVEN_IN, kp + 64 * c, EVEN_IN, nullptr, 0, vp, EVEN_IN, SEQ, qt * 256, 1.0f, slope2, nullptr, nullptr, smem, o0, l0);
                if (c == 0) {
                    const float i0 = 1.0f / l0;
#pragma unroll
                    for (int dt = 0; dt < 4; ++dt)
#pragma unroll
                        for (int g = 0; g < 4; ++g) mypark[dt * 4 + g] = make_float4(o0[dt][4 * g] * i0, o0[dt][4 * g + 1] * i0, o0[dt][4 * g + 2] * i0, o0[dt][4 * g + 3] * i0);
                    asm volatile("" ::: "memory");
                }
            }
            const float i1 = lam / l0;
            float ss = 0.f;
            asm volatile("" ::: "memory");
#pragma unroll
            for (int dt = 0; dt < 4; ++dt)
#pragma unroll
                for (int g = 0; g < 4; ++g) {
                    const float4 pv = mypark[dt * 4 + g];
                    const float pa[4] = {pv.x, pv.y, pv.z, pv.w};
#pragma unroll
                    for (int e = 0; e < 4; ++e) { const float vv = pa[e] - i1 * o0[dt][4 * g + e]; o0[dt][4 * g + e] = vv; ss += vv * vv; }
                }
            ss += __shfl_xor(ss, 32);
            const float rstd = rsqrtf(ss * (1.0f / 128) + EPS) * (1.0f - lam_init);
#pragma unroll
            for (int dt = 0; dt < 4; ++dt)
#pragma unroll
                for (int i = 0; i < 16; ++i) o0[dt][i] *= p.in[12][32 * dt + crow(i, h)];
            store_o<4>(mix + row0 * D + 512 + hd * 128, D, o0, rstd);
        } else {
            const int j = it - NDIFF;
            const int b = j / (8 * QT), hd = (j / QT) & 7, qt = j % QT, kvh = hd >> 2;
            const size_t row0 = (size_t)b * SEQ + qt * 256;
            const bf16_t* qp = qkv + row0 * EVEN_IN + hd * 64;
            const bf16_t* kp = qkv + (size_t)b * SEQ * EVEN_IN + 512 + kvh * 64;
            const bf16_t* vp = qkv + (size_t)b * SEQ * EVEN_IN + 640 + kvh * 64;
            f32x16 o[2]; float l;
            if (bound_gqa < NOMAX_BOUND) attn_core<64, 64, 64, 1, false, true>(qp, EVEN_IN, kp, EVEN_IN, nullptr, 0, vp, EVEN_IN, SEQ, qt * 256, 0.125f * LOG2E, 0.f, p.in[6], ax, smem, o, l);
            else attn_core<64, 64, 64, 1, false, false>(qp, EVEN_IN, kp, EVEN_IN, nullptr, 0, vp, EVEN_IN, SEQ, qt * 256, 0.125f * LOG2E, 0.f, p.in[6], ax, smem, o, l);
            store_o<2>(mix + row0 * D + hd * 64, D, o, 1.0f / l);
        }
    }
}
DI void attn_mla(const bf16_t* qb, const bf16_t* kv, const bf16_t* a, bf16_t* mix, const float2* lin, const unsigned* nmx, char* smem) {
    constexpr int NIT = NB * 16 * QT;
    for (int base = 0; base < NIT; base += gridDim.x) {
        const int it = swz_item(base);
        if (it >= NIT) continue;
        const int b = it / (16 * QT), hd = (it / QT) & 15, qt = it % QT;
        const size_t row0 = (size_t)b * SEQ + qt * 256;
        const unsigned* nn = nmx + (b * 16 + hd) * 2;
        const float bound = sqrtf(__uint_as_float(nn[0]) * __uint_as_float(nn[1])) * 1.03f;
        const bf16_t* kb_ = kv + (size_t)b * SEQ * 2048 + hd * 128;
        f32x16 o[2]; float l;
        if (bound < NOMAX_BOUND) attn_core<96, 64, 64, 2, false, true>(qb + row0 * 1536 + hd * 96, 1536, kb_, 2048, a + (size_t)b * SEQ * ODD_PAD + 640, ODD_PAD, kb_ + 64, 2048, SEQ, qt * 256, 1.0f, 0.f, nullptr, lin, smem, o, l);
        else attn_core<96, 64, 64, 2, false, false>(qb + row0 * 1536 + hd * 96, 1536, kb_, 2048, a + (size_t)b * SEQ * ODD_PAD + 640, ODD_PAD, kb_ + 64, 2048, SEQ, qt * 256, 1.0f, 0.f, nullptr, lin, smem, o, l);
        store_o<2>(mix + row0 * D + hd * 64, D, o, 1.0f / l);
    }
}
DI void attn_cross(const bf16_t* qx, const bf16_t* kvx, bf16_t* mix, int seq0, char* smem) {
    constexpr int NIT = NB * 4 * QT * 2;
    for (int base = 0; base < NIT; base += gridDim.x) {
        const int it = swz_item(base);
        if (it >= NIT) continue;
        const int b = it / (8 * QT), hd = (it / (2 * QT)) & 3, qt = (it >> 1) % QT, half = it & 1;
        const size_t row0 = (size_t)b * SEQ + qt * 256;
        const bf16_t* kvb = kvx + (size_t)(seq0 + b) * NMEM * 2048;
        f32x16 o[4]; float l;
        attn_core<256, 128, 32, 0, false, false>(qx + row0 * D + hd * 256, D, kvb + hd * 256, 2048, nullptr, 0, kvb + 1024 + hd * 256 + half * 128, 2048, NMEM, 0,
                                          1.0f, 0.f, nullptr, nullptr, smem, o, l);
        store_o<4>(mix + row0 * D + hd * 256 + half * 128, D, o, 1.0f / l);
    }
}

extern "C" __global__ void __launch_bounds__(THREADS, 2) fwd_mega(Params p) {
    extern __shared__ __attribute__((aligned(16))) char smem[];
    LDS_AS unsigned char* lds = (LDS_AS unsigned char*)smem;
    cg::grid_group grid = cg::this_grid();
    char* ws = p.ws;
    __shared__ uint4 xb_words;
    if (threadIdx.x == 0) xb_words = make_uint4(0u, 0u, 0u, 0u);
    __syncthreads();
    const XcdBarrier xb = xcd_barrier_post((unsigned*)(ws + B_BAR), (volatile LDS_AS unsigned*)&xb_words);
    bf16_t* wEin = (bf16_t*)(ws + W_EIN); bf16_t* wEout = (bf16_t*)(ws + W_EOUT); bf16_t* wOin = (bf16_t*)(ws + W_OIN);
    bf16_t* wUq = (bf16_t*)(ws + W_UQ); bf16_t* wUkv = (bf16_t*)(ws + W_UKV); bf16_t* wOout = (bf16_t*)(ws + W_OOUT);
    float2* ax = (float2*)(ws + T_AX); float2* lin = (float2*)(ws + T_LIN);
    bf16_t* H = (bf16_t*)(ws + B_H); bf16_t* MIX = (bf16_t*)(ws + B_MIX);

    convert_weight(p.in[5], wEin, D, EVEN_IN, EVEN_IN, smem, 768, 1280, 0.125f * LOG2E);
    convert_weight(p.in[13], wEout, D, D, D, smem);
    convert_weight(p.in[14], wOin, D, ODD_IN, ODD_PAD, smem);
    convert_weight(p.in[17], wUq, 384, 1536, 1536, smem, 0, 1536, 0.10206207261596575f * LOG2E);
    convert_weight(p.in[18], wUkv, 256, 2048, 2048, smem);
    convert_weight(p.in[19], wOout, D, D, D, smem);
    for (int l = 0; l < 2; ++l) {
        convert_weight(p.in[22] + (size_t)l * D * D, (bf16_t*)(ws + W_CQ) + (size_t)l * D * D, D, D, D, smem, 0, D, 0.0625f * LOG2E);
        convert_weight(p.in[23] + (size_t)l * D * 2048, (bf16_t*)(ws + W_CKV) + (size_t)l * 2048 * D, D, 2048, 2048, smem);
        convert_weight(p.in[24] + (size_t)l * D * D, (bf16_t*)(ws + W_CO) + (size_t)l * D * D, D, D, D, smem);
        convert_weight(p.in[26] + (size_t)l * D * 2 * DFF, (bf16_t*)(ws + W_GU) + (size_t)l * 2 * DFF * D, D, 2 * DFF, 2 * DFF, smem);
        convert_weight(p.in[27] + (size_t)l * DFF * D, (bf16_t*)(ws + W_DOWN) + (size_t)l * D * DFF, DFF, D, D, smem);
        rmsnorm_rows(p.in[2], p.in[21] + l * D, (bf16_t*)(ws + B_MEMN) + (size_t)l * NBATCH * NMEM * D, 8 * NMEM);
        rmsnorm_rows(p.in[3], p.in[21] + l * D, (bf16_t*)(ws + B_MEMN) + (size_t)l * NBATCH * NMEM * D + (size_t)8 * NMEM * D, 16 * NMEM);
    }
    build_tables(ax, lin);
    if (blockIdx.x == 0) for (int i = threadIdx.x; i < 4096; i += THREADS) ((unsigned*)(ws + B_NORMS))[i] = 0u;
    grid.sync();
    for (int l = 0; l < 2; ++l) {
        pg8::EpiBf16 e{(bf16_t*)(ws + B_KX) + (size_t)l * NBATCH * NMEM * 2048, 2048};
        pg8::gemm_phase(lds, mk_gemm((const bf16_t*)(ws + B_MEMN) + (size_t)l * NBATCH * NMEM * D, D, (const bf16_t*)(ws + W_CKV) + (size_t)l * 2048 * D, NBATCH * NMEM, 2048, D), e);
    }
    xcd_barrier(xb);

    for (int ch = 0; ch < NCHUNK; ++ch) {
        const float* xin = (ch == 0) ? p.in[0] : p.in[1] + (size_t)(ch - 1) * TC * D;
        float* xo = p.out + (size_t)ch * TC * D;
        for (int layer = 0; layer < 2; ++layer) {
            const float* xcur = (layer == 0) ? xin : xo;
            for (int rep_ = 0; rep_ < PROBE_NORM; ++rep_) rmsnorm_rows(xcur, p.in[4] + layer * D, H, TC);
            xcd_barrier(xb);
            const bf16_t* wout;
            if (layer == 0) {
                bf16_t* qkv = (bf16_t*)(ws + E_QKV);
                for (int rep_ = 0; rep_ < PROBE_GEMM; ++rep_) { pg8::EpiBf16 e{qkv, EVEN_IN}; pg8::gemm_phase(lds, mk_gemm(H, D, wEin, TC, EVEN_IN, D), e); }
                xcd_barrier(xb);
                kprep_even(qkv, p.in[7], ax);
                normmax_even(qkv, (unsigned*)(ws + B_NORMS) + ch * 128, smem);
                xcd_barrier(xb);
                for (int rep_ = 0; rep_ < PROBE_ATTN; ++rep_) attn_even(qkv, (float*)(ws + E_PARK), MIX, p, ax, (const unsigned*)(ws + B_NORMS) + ch * 128, 0.2f, smem);
                wout = wEout;
            } else {
                bf16_t* a = (bf16_t*)(ws + O_A); bf16_t* qb = (bf16_t*)(ws + O_Q); bf16_t* kv = (bf16_t*)(ws + O_KV);
                for (int rep_ = 0; rep_ < PROBE_GEMM; ++rep_) { pg8::EpiBf16 e{a, ODD_PAD}; pg8::gemm_phase(lds, mk_gemm(H, D, wOin, TC, ODD_PAD, D), e); }
                xcd_barrier(xb);
                prep_odd(a, p.in[15], p.in[16], lin);
                xcd_barrier(xb);
                for (int rep_ = 0; rep_ < PROBE_GEMM; ++rep_) { pg8::EpiBf16 e{qb, 1536}; pg8::gemm_phase(lds, mk_gemm(a, ODD_PAD, wUq, TC, 1536, 384), e); }
                for (int rep_ = 0; rep_ < PROBE_GEMM; ++rep_) { pg8::EpiBf16 e{kv, 2048}; pg8::gemm_phase(lds, mk_gemm(a + 384, ODD_PAD, wUkv, TC, 2048, 256), e); }
                xcd_barrier(xb);
                normmax_mla(qb, kv, a, (unsigned*)(ws + B_NORMS) + 384 + ch * 256, smem);
                xcd_barrier(xb);
                for (int rep_ = 0; rep_ < PROBE_ATTN; ++rep_) attn_mla(qb, kv, a, MIX, lin, (const unsigned*)(ws + B_NORMS) + 384 + ch * 256, smem);
                wout = wOout;
            }
            xcd_barrier(xb);
            { pg8::EpiResid e{xcur, xo}; pg8::gemm_phase(lds, mk_gemm(MIX, D, wout, TC, D, D), e); }
            xcd_barrier(xb);
            for (int rep_ = 0; rep_ < PROBE_NORM; ++rep_) rmsnorm_rows(xo, p.in[20] + layer * D, H, TC);
            xcd_barrier(xb);
            for (int rep_ = 0; rep_ < PROBE_GEMM; ++rep_) { pg8::EpiBf16 e{(bf16_t*)(ws + X_Q), D}; pg8::gemm_phase(lds, mk_gemm(H, D, (const bf16_t*)(ws + W_CQ) + (size_t)layer * D * D, TC, D, D), e); }
            xcd_barrier(xb);
            for (int rep_ = 0; rep_ < PROBE_CROSS; ++rep_) attn_cross((const bf16_t*)(ws + X_Q), (const bf16_t*)(ws + B_KX) + (size_t)layer * NBATCH * NMEM * 2048, MIX, ch * NB, smem);
            xcd_barrier(xb);
            { pg8::EpiResid e{xo, xo}; pg8::gemm_phase(lds, mk_gemm(MIX, D, (const bf16_t*)(ws + W_CO) + (size_t)layer * D * D, TC, D, D), e); }
            xcd_barrier(xb);
            for (int rep_ = 0; rep_ < PROBE_NORM; ++rep_) rmsnorm_rows(xo, p.in[25] + layer * D, H, TC);
            xcd_barrier(xb);
            for (int rep_ = 0; rep_ < PROBE_GEMM; ++rep_) { pg8::EpiSwiglu e{(bf16_t*)(ws + F_ACT)};
              pg8::Gemm g{H, (const bf16_t*)(ws + W_GU) + (size_t)layer * 2 * DFF * D, TC, DFF / 128, D, D, (size_t)DFF * D * 2, (size_t)128 * D * 2};
              pg8::gemm_phase(lds, g, e); }
            xcd_barrier(xb);
            { pg8::EpiResid e{xo, xo}; pg8::gemm_phase(lds, mk_gemm((const bf16_t*)(ws + F_ACT), DFF, (const bf16_t*)(ws + W_DOWN) + (size_t)layer * D * DFF, TC, D, DFF), e); }
            xcd_barrier(xb);
        }
        rmsnorm_final(xo, p.in[28], TC);
    }
}

extern "C" void kernel_launch(void* const* d_in, const int* in_sizes, int n_in, void* d_out, int out_size, void* d_ws, size_t ws_size, hipStream_t stream) {
    static int grid_blocks = 0;
    if (!grid_blocks) {
        int dev = 0, cus = 0, per_cu = 0;
        (void)hipGetDevice(&dev);
        (void)hipDeviceGetAttribute(&cus, hipDeviceAttributeMultiprocessorCount, dev);
        (void)hipFuncSetAttribute((const void*)fwd_mega, hipFuncAttributeMaxDynamicSharedMemorySize, (int)LDS_BYTES);
        (void)hipOccupancyMaxActiveBlocksPerMultiprocessor(&per_cu, fwd_mega, THREADS, LDS_BYTES);
        if (per_cu > 1) per_cu = 1;
        if (per_cu < 1) per_cu = 1;
        grid_blocks = cus * per_cu;
    }
    constexpr size_t WS_END = (O_END > E_END ? O_END : E_END) > (F_ACT + (size_t)TC * DFF * 2) ? (O_END > E_END ? O_END : E_END) : (F_ACT + (size_t)TC * DFF * 2);
    if (ws_size < WS_END) { fprintf(stderr, "workspace too small: %zu < %zu\n", ws_size, (size_t)WS_END); return; }
    if (grid_blocks > 256) grid_blocks = 256;
    Params p{};
    for (int i = 0; i < 29; ++i) p.in[i] = (const float*)d_in[i];
    p.out = (float*)d_out;
    p.ws = (char*)d_ws;
    (void)hipMemsetAsync(d_ws, 0, 16384, stream);
    void* args[] = {&p};
    hipError_t e = hipLaunchCooperativeKernel((void*)fwd_mega, dim3(grid_blocks), dim3(THREADS), args, LDS_BYTES, stream);
    if (e != hipSuccess) fprintf(stderr, "cooperative launch failed: %s (grid %d)\n", hipGetErrorString(e), grid_blocks);
}
```

```cpp
#include <hip/hip_runtime.h>
#include <hip/hip_cooperative_groups.h>
#include <cstdio>
#include <cstdint>
namespace cg = cooperative_groups;
#ifndef PROBE_GEMM
#define PROBE_GEMM 1
#endif
#ifndef PROBE_NORM
#define PROBE_NORM 1
#endif
#ifndef PROBE_CROSS
#define PROBE_CROSS 1
#endif
#ifndef PROBE_ATTN
#define PROBE_ATTN 1
#endif

typedef unsigned short bf16_t;
typedef short bf16x8 __attribute__((ext_vector_type(8)));
typedef float f32x16 __attribute__((ext_vector_type(16)));
typedef float f32x2 __attribute__((ext_vector_type(2)));
typedef unsigned u32x4 __attribute__((ext_vector_type(4)));
typedef float f32x4 __attribute__((ext_vector_type(4)));
typedef short s16x4 __attribute__((ext_vector_type(4)));
#define LDS_AS __attribute__((address_space(3)))
typedef __bf16 bf16x2_t __attribute__((ext_vector_type(2)));
#define DI __device__ __forceinline__
#define MFMA(a, b, c) __builtin_amdgcn_mfma_f32_32x32x16_bf16((a), (b), (c), 0, 0, 0)

constexpr int D = 1024, SEQ = 4096, NBATCH = 24, NB = 8  , NCHUNK = NBATCH / NB, TC = NB * SEQ;
constexpr int NMEM = 256, DFF = 2816, EVEN_IN = 2304, ODD_IN = 672, ODD_PAD = 768;
constexpr float EPS = 1e-6f, LOG2E = 1.4426950408889634f;
constexpr int THREADS = 512, NWAVE = THREADS / 64;
constexpr size_t LDS_BYTES = 131072;

constexpr size_t al(size_t x) { return (x + 255) & ~(size_t)255; }
constexpr size_t B_BAR = 0;
constexpr size_t B_NORMS = 16384;
constexpr size_t W_EIN = 32768;
constexpr size_t W_EOUT = W_EIN + al((size_t)EVEN_IN * D * 2);
constexpr size_t W_OIN = W_EOUT + al((size_t)D * D * 2);
constexpr size_t W_UQ = W_OIN + al((size_t)ODD_PAD * D * 2);
constexpr size_t W_UKV = W_UQ + al((size_t)1536 * 384 * 2);
constexpr size_t W_OOUT = W_UKV + al((size_t)2048 * 256 * 2);
constexpr size_t W_CQ = W_OOUT + al((size_t)D * D * 2);
constexpr size_t W_CKV = W_CQ + 2 * al((size_t)D * D * 2);
constexpr size_t W_CO = W_CKV + 2 * al((size_t)2048 * D * 2);
constexpr size_t W_GU = W_CO + 2 * al((size_t)D * D * 2);
constexpr size_t W_DOWN = W_GU + 2 * al((size_t)2 * DFF * D * 2);
constexpr size_t T_AX = W_DOWN + 2 * al((size_t)D * DFF * 2);
constexpr size_t T_LIN = T_AX + al((size_t)SEQ * 32 * 8);
constexpr size_t B_MEMN = T_LIN + al((size_t)SEQ * 16 * 8);
constexpr size_t B_KX = B_MEMN + 2 * al((size_t)NBATCH * NMEM * D * 2);
constexpr size_t B_H = B_KX + 2 * al((size_t)NBATCH * NMEM * 2048 * 2);
constexpr size_t B_MIX = B_H + al((size_t)TC * D * 2);
constexpr size_t B_BIG = B_MIX + al((size_t)TC * D * 2);
constexpr size_t E_QKV = B_BIG;
constexpr size_t E_PARK = E_QKV + al((size_t)TC * EVEN_IN * 2);
constexpr size_t E_END = E_PARK + (size_t)256 * THREADS * 64 * 4;
constexpr size_t O_A = B_BIG;
constexpr size_t O_Q = O_A + al((size_t)TC * ODD_PAD * 2);
constexpr size_t O_KV = O_Q + al((size_t)TC * 1536 * 2);
constexpr size_t O_END = O_KV + al((size_t)TC * 2048 * 2);
constexpr size_t X_Q = B_BIG;
constexpr size_t F_ACT = B_BIG;

struct Params {
    const float* in[29];
    float* out;
    char* ws;
};

DI unsigned pack2(float lo, float hi) { f32x2 v = {lo, hi}; bf16x2_t b = __builtin_convertvector(v, bf16x2_t); return __builtin_bit_cast(unsigned, b); }
DI float bflo(unsigned u) { return __uint_as_float(u << 16); }
DI float bfhi(unsigned u) { return __uint_as_float(u & 0xffff0000u); }
DI int crow(int i, int h) { return (i & 3) + 8 * (i >> 2) + 4 * h; }
DI int swap23(int x) { return (x & ~12) | ((x & 4) << 1) | ((x & 8) >> 1); }
DI int otid() { int t = threadIdx.x; asm volatile("" : "+v"(t)); return t; }
DI float wave_sum(float v) {
#pragma unroll
    for (int o = 32; o >= 1; o >>= 1) v += __shfl_xor(v, o);
    return v;
}


#define XB_TMO      128
#define XB_XCNT(j)  (256  + 64 * (j))
#define XB_XSUB(j)  (1280 + 64 * (j))
#define XB_XGEN(j)  (2304 + 64 * (j))
#define XB_TOP      3328
#define XB_TOPGEN   3392
#define XCD_BAR_WORDS 3456
#define XB_SPIN_CAP (1u << 18)
DI unsigned xb_ld(unsigned* p) { return __hip_atomic_load(p, __ATOMIC_RELAXED, __HIP_MEMORY_SCOPE_AGENT); }
DI unsigned xb_add(unsigned* p, unsigned v) { return __hip_atomic_fetch_add(p, v, __ATOMIC_RELAXED, __HIP_MEMORY_SCOPE_AGENT); }
DI unsigned xb_xcc_id() { return (unsigned)__builtin_amdgcn_s_getreg((3 << 11) | 20) & 0xFu; }
#define XB_SPIN(cond, bar) do { unsigned _sp = 0; while (cond) { __builtin_amdgcn_s_sleep(1); \
    if ((++_sp & 255u) == 0u) { if (xb_ld(&(bar)[XB_TMO])) break; if (_sp > XB_SPIN_CAP) { atomicAdd(&(bar)[XB_TMO], 1u); break; } } } } while (0)
struct XcdBarrier { unsigned* bar; unsigned x; volatile LDS_AS unsigned* st; };
DI XcdBarrier xcd_barrier_post(unsigned* bar, volatile LDS_AS unsigned* st) {
    XcdBarrier b; b.bar = bar; b.x = xb_xcc_id(); b.st = st;
    if (threadIdx.x == 0) (void)xb_add(&bar[XB_XCNT(b.x)], 1u);
    return b;
}
DI void xcd_barrier_complete(unsigned* bar, unsigned x, unsigned& nloc, unsigned& nx) {
    const unsigned G = gridDim.x * gridDim.y * gridDim.z;
    unsigned sum, cnt, mine, sp = 0u;
    for (;;) {
        sum = 0u; cnt = 0u; mine = 0u;
#pragma unroll
        for (unsigned j = 0; j < 16; ++j) { const unsigned c = xb_ld(&bar[XB_XCNT(j)]); sum += c; cnt += (c > 0u) ? 1u : 0u; mine = (j == x) ? c : mine; }
        if (sum == G) break;
        __builtin_amdgcn_s_sleep(1);
        if ((++sp & 255u) == 0u) { if (xb_ld(&bar[XB_TMO])) break; if (sp > XB_SPIN_CAP) { atomicAdd(&bar[XB_TMO], 1u); break; } }
    }
    nloc = mine > 0u ? mine : 1u; nx = cnt > 0u ? cnt : 1u;
}
DI void xcd_barrier(const XcdBarrier& b) {
    asm volatile("s_waitcnt vmcnt(0)" ::: "memory");
    __syncthreads();
    if (threadIdx.x == 0) {
        unsigned* bar = b.bar;
        __builtin_amdgcn_s_waitcnt(0);
        unsigned nloc = b.st[0], nx = b.st[1];
        if (nloc == 0u) { xcd_barrier_complete(bar, b.x, nloc, nx); b.st[0] = nloc; b.st[1] = nx; }
        const unsigned old = xb_add(&bar[XB_XSUB(b.x)], 1u);
        const unsigned gen = old / nloc;
        if (old + 1u == (gen + 1u) * nloc) {
            __builtin_amdgcn_fence(__ATOMIC_RELEASE, "agent");
            asm volatile("s_waitcnt vmcnt(0)" ::: "memory");
            const unsigned og = xb_add(&bar[XB_TOP], 1u);
            const unsigned tg = og / nx;
            if (og + 1u == (tg + 1u) * nx) xb_add(&bar[XB_TOPGEN], 1u);
            else XB_SPIN(xb_ld(&bar[XB_TOPGEN]) == tg, bar);
            __builtin_amdgcn_fence(__ATOMIC_ACQUIRE, "agent");
            xb_add(&bar[XB_XGEN(b.x)], 1u);
            asm volatile("s_waitcnt vmcnt(0)" ::: "memory");
        } else {
            XB_SPIN(xb_ld(&bar[XB_XGEN(b.x)]) == gen, bar);
            __builtin_amdgcn_fence(__ATOMIC_ACQUIRE, "agent");
            asm volatile("s_waitcnt vmcnt(0)" ::: "memory");
        }
    }
    __syncthreads();
}

DI void convert_weight(const float* __restrict__ src, bf16_t* __restrict__ dst, int K, int N, int Npad, char* smem, int slo = 0, int shi = 0, float scale = 1.0f) {
    float* t = (float*)smem;
    const int tid = otid();
    const int nkt = K / 64, nnt = Npad / 64;
    for (int tile = blockIdx.x; tile < nkt * nnt; tile += gridDim.x) {
        const int k0 = (tile / nnt) * 64, n0 = (tile % nnt) * 64;
#pragma unroll
        for (int i = 0; i < 8; ++i) {
            const int k = i * 8 + (tid >> 6), n = tid & 63;
            const float sc_ = (n0 + n >= slo && n0 + n < shi) ? scale : 1.0f;
            t[k * 65 + n] = (n0 + n < N) ? src[(size_t)(k0 + k) * N + n0 + n] * sc_ : 0.f;
        }
        __syncthreads();
#pragma unroll
        for (int i = 0; i < 4; ++i) {
            const int n = i * 16 + (tid >> 5), k = (tid & 31) * 2;
            *(unsigned*)(dst + (size_t)(n0 + n) * K + k0 + k) = pack2(t[k * 65 + n], t[(k + 1) * 65 + n]);
        }
        __syncthreads();
    }
}

__device__ const float kFreq[16] = {1.000000000e+00f, 5.623413324e-01f, 3.162277639e-01f, 1.778279394e-01f, 1.000000015e-01f, 5.623413250e-02f, 3.162277490e-02f, 1.778279431e-02f,
                                    9.999999776e-03f, 5.623413250e-03f, 3.162277630e-03f, 1.778279431e-03f, 1.000000047e-03f, 5.623413017e-04f, 3.162277571e-04f, 1.778279402e-04f};
DI float2 sincos_acc(float ang) {
    const double x = (double)ang;
    const double n = __builtin_rint(x * 0.15915494309189535);
    double r = __builtin_fma(-n, 6.283185307179586, x);
    r = __builtin_fma(-n, 2.4492935982947064e-16, r);
    const double r2 = r * r;
    double s = 1.0, c = 1.0;
#pragma unroll
    for (int k = 13; k >= 1; --k) {
        s = 1.0 - r2 * s * (1.0 / (double)((2 * k) * (2 * k + 1)));
        c = 1.0 - r2 * c * (1.0 / (double)((2 * k - 1) * (2 * k)));
    }
    return make_float2((float)c, (float)(r * s));
}
DI void build_tables(float2* ax, float2* lin) {
    const int gt = blockIdx.x * THREADS + otid(), gs = gridDim.x * THREADS;
    for (int e = gt; e < SEQ * 32; e += gs) {
        const int pos = e >> 5, p = e & 31;
        const float base = (p < 16) ? (float)(pos >> 6) : (float)(pos & 63);
        ax[e] = sincos_acc(base * kFreq[p & 15]);
    }
    for (int e = gt; e < SEQ * 16; e += gs) {
        const int pos = e >> 4, p = e & 15;
        lin[e] = sincos_acc((float)pos * kFreq[p]);
    }
}

DI void rmsnorm_rows(const float* __restrict__ src, const float* __restrict__ g, bf16_t* __restrict__ dst, int nrows) {
    const int tid_ = otid(), lane = tid_ & 63, wv = blockIdx.x * NWAVE + (tid_ >> 6), nw = gridDim.x * NWAVE;
    for (int row = wv; row < nrows; row += nw) {
        const float4* s = (const float4*)(src + (size_t)row * D);
        float4 v[4]; float ss = 0.f;
#pragma unroll
        for (int i = 0; i < 4; ++i) { v[i] = s[i * 64 + lane]; ss += v[i].x * v[i].x + v[i].y * v[i].y + v[i].z * v[i].z + v[i].w * v[i].w; }
        ss = wave_sum(ss);
        const float rstd = rsqrtf(ss * (1.0f / D) + EPS);
#pragma unroll
        for (int i = 0; i < 4; ++i) {
            const float4 gg = ((const float4*)g)[i * 64 + lane];
            uint2 o; o.x = pack2(v[i].x * rstd * gg.x, v[i].y * rstd * gg.y); o.y = pack2(v[i].z * rstd * gg.z, v[i].w * rstd * gg.w);
            *(uint2*)(dst + (size_t)row * D + (i * 64 + lane) * 4) = o;
        }
    }
}
DI void rmsnorm_final(float* __restrict__ x, const float* __restrict__ g, int nrows) {
    const int tid_ = otid(), lane = tid_ & 63, wv = blockIdx.x * NWAVE + (tid_ >> 6), nw = gridDim.x * NWAVE;
    for (int row = wv; row < nrows; row += nw) {
        float4* s = (float4*)(x + (size_t)row * D);
        float4 v[4]; float ss = 0.f;
#pragma unroll
        for (int i = 0; i < 4; ++i) { v[i] = s[i * 64 + lane]; ss += v[i].x * v[i].x + v[i].y * v[i].y + v[i].z * v[i].z + v[i].w * v[i].w; }
        ss = wave_sum(ss);
        const float rstd = rsqrtf(ss * (1.0f / D) + EPS);
#pragma unroll
        for (int i = 0; i < 4; ++i) {
            const float4 gg = ((const float4*)g)[i * 64 + lane];
            float4 o; o.x = v[i].x * rstd * gg.x; o.y = v[i].y * rstd * gg.y; o.z = v[i].z * rstd * gg.z; o.w = v[i].w * rstd * gg.w;
            s[i * 64 + lane] = o;
        }
    }
}

DI void kprep_even(bf16_t* __restrict__ qkv, const float* __restrict__ gk, const float2* __restrict__ ax) {
    const int tid_ = otid(), gt = blockIdx.x * THREADS + tid_, gs = gridDim.x * THREADS;
    const int p = tid_ & 31;
    for (int v = gt >> 5; v < TC * 2; v += gs >> 5) {
        const int tok = v >> 1, kvh = v & 1;
        unsigned* ptr = (unsigned*)(qkv + (size_t)tok * EVEN_IN + 512 + kvh * 64 + 2 * p);
        const unsigned u = *ptr;
        const float x0 = bflo(u), x1 = bfhi(u);
        float ss = x0 * x0 + x1 * x1;
#pragma unroll
        for (int o = 16; o >= 1; o >>= 1) ss += __shfl_xor(ss, o);
        const float rstd = rsqrtf(ss * (1.0f / 64) + EPS);
        const float y0 = x0 * rstd * gk[2 * p], y1 = x1 * rstd * gk[2 * p + 1];
        const float2 cs = ax[(tok & (SEQ - 1)) * 32 + p];
        *ptr = pack2(y0 * cs.x - y1 * cs.y, y0 * cs.y + y1 * cs.x);
    }
}
DI void prep_odd(bf16_t* __restrict__ a, const float* __restrict__ gq, const float* __restrict__ gkv, const float2* __restrict__ lin) {
    const int tid_ = otid(), lane = tid_ & 63, wv = blockIdx.x * NWAVE + (tid_ >> 6), nw = gridDim.x * NWAVE;
    for (int row = wv; row < TC; row += nw) {
        unsigned* base = (unsigned*)(a + (size_t)row * ODD_PAD);
        unsigned uq[3], uk[2]; float sq = 0.f, sk = 0.f;
#pragma unroll
        for (int i = 0; i < 3; ++i) { uq[i] = base[i * 64 + lane]; const float a0 = bflo(uq[i]), a1 = bfhi(uq[i]); sq += a0 * a0 + a1 * a1; }
#pragma unroll
        for (int i = 0; i < 2; ++i) { uk[i] = base[192 + i * 64 + lane]; const float a0 = bflo(uk[i]), a1 = bfhi(uk[i]); sk += a0 * a0 + a1 * a1; }
        sq = wave_sum(sq); sk = wave_sum(sk);
        const float rq = rsqrtf(sq * (1.0f / 384) + EPS), rk = rsqrtf(sk * (1.0f / 256) + EPS);
#pragma unroll
        for (int i = 0; i < 3; ++i) { const int c = (i * 64 + lane) * 2; base[i * 64 + lane] = pack2(bflo(uq[i]) * rq * gq[c], bfhi(uq[i]) * rq * gq[c + 1]); }
#pragma unroll
        for (int i = 0; i < 2; ++i) { const int c = (i * 64 + lane) * 2; base[192 + i * 64 + lane] = pack2(bflo(uk[i]) * rk * gkv[c], bfhi(uk[i]) * rk * gkv[c + 1]); }
        if (lane < 16) {
            const unsigned u = base[320 + lane];
            const float x0 = bflo(u), x1 = bfhi(u);
            const float2 cs = lin[(row & (SEQ - 1)) * 16 + lane];
            base[320 + lane] = pack2(x0 * cs.x - x1 * cs.y, x0 * cs.y + x1 * cs.x);
        }
    }
}


DI void normmax_even(const bf16_t* __restrict__ qkv, unsigned* __restrict__ nd, char* smem) {
    const int tid = otid(), lane = tid & 63, w = tid >> 6;
    float* red = (float*)smem;
    for (int item = blockIdx.x; item < NB * 32; item += gridDim.x) {
        const int b = item & 7, slab = item >> 3;
        float mq = 0.f, mk = 0.f;
        for (int i = 0; i < 16; ++i) {
            const bf16_t* row = qkv + ((size_t)b * SEQ + slab * 128 + w * 16 + i) * EVEN_IN;
            const u32x4 uq = *(const u32x4*)(row + 768 + 8 * lane), uk = *(const u32x4*)(row + 1280 + 8 * lane);
            float sq = 0.f, sk = 0.f;
#pragma unroll
            for (int j = 0; j < 4; ++j) { const float a0 = bflo(uq[j]), a1 = bfhi(uq[j]), b0 = bflo(uk[j]), b1 = bfhi(uk[j]); sq += a0 * a0 + a1 * a1; sk += b0 * b0 + b1 * b1; }
#pragma unroll
            for (int o = 1; o <= 4; o <<= 1) { sq += __shfl_xor(sq, o); sk += __shfl_xor(sk, o); }
            mq = fmaxf(mq, sq); mk = fmaxf(mk, sk);
        }
        if ((lane & 7) == 0) { red[(w * 8 + (lane >> 3)) * 2] = mq; red[(w * 8 + (lane >> 3)) * 2 + 1] = mk; }
        __syncthreads();
        if (tid < 16) {
            float m = 0.f;
#pragma unroll
            for (int ww = 0; ww < NWAVE; ++ww) m = fmaxf(m, red[ww * 16 + tid]);
            atomicMax(nd + b * 16 + tid, __float_as_uint(m));
        }
        __syncthreads();
    }
}
DI void normmax_mla(const bf16_t* __restrict__ qb, const bf16_t* __restrict__ kv, const bf16_t* __restrict__ a, unsigned* __restrict__ nmx, char* smem) {
    const int tid = otid(), lane = tid & 63, w = tid >> 6;
    float* red = (float*)smem;
    for (int item = blockIdx.x; item < NB * 32; item += gridDim.x) {
        const int b = item & 7, slab = item >> 3;
        float mq = 0.f, mk = 0.f;
        for (int i = 0; i < 16; ++i) {
            const size_t r = (size_t)b * SEQ + slab * 128 + w * 16 + i;
            float sq = 0.f, sk = 0.f, sr = 0.f;
#pragma unroll
            for (int c = 0; c < 3; ++c) {
                const u32x4 u = *(const u32x4*)(qb + r * 1536 + 24 * lane + 8 * c);
#pragma unroll
                for (int j = 0; j < 4; ++j) { const float a0 = bflo(u[j]), a1 = bfhi(u[j]); sq += a0 * a0 + a1 * a1; }
            }
#pragma unroll
            for (int c = 0; c < 4; ++c) {
                const u32x4 u = *(const u32x4*)(kv + r * 2048 + 32 * lane + 8 * c);
#pragma unroll
                for (int j = 0; j < 4; ++j) { const float a0 = bflo(u[j]), a1 = bfhi(u[j]); sk += a0 * a0 + a1 * a1; }
            }
#pragma unroll
            for (int c = 0; c < 4; ++c) {
                const u32x4 u = *(const u32x4*)(a + r * ODD_PAD + 640 + 8 * c);
#pragma unroll
                for (int j = 0; j < 4; ++j) { const float a0 = bflo(u[j]), a1 = bfhi(u[j]); sr += a0 * a0 + a1 * a1; }
            }
            sq += __shfl_xor(sq, 1); sq += __shfl_xor(sq, 2);
            sk += __shfl_xor(sk, 1);
            mq = fmaxf(mq, sq); mk = fmaxf(mk, sk + sr);
        }
        if ((lane & 3) == 0) { red[(w * 16 + (lane >> 2)) * 2] = mq; red[(w * 16 + (lane >> 2)) * 2 + 1] = mk; }
        __syncthreads();
        if (tid < 32) {
            float m = 0.f;
#pragma unroll
            for (int ww = 0; ww < NWAVE; ++ww) m = fmaxf(m, red[ww * 32 + tid]);
            atomicMax(nmx + b * 32 + tid, __float_as_uint(m));
        }
        __syncthreads();
    }
}

namespace pg8 {
constexpr int BM = 256, BK = 64, HALF = 128, HTB = HALF * BK * 2, NXCD = 8, WGM = 8;
DI int lds_byte(int r, int c) { const int st = (r >> 4) * 2 + (c >> 5), rr = r & 15, cc = c & 31, ob = rr * 64 + cc * 2; return st * 1024 + (ob ^ (((ob >> 9) & 1) << 5)); }
DI void stage_rc(int b, int& R, int& C) { const int st = b / 1024, sb = b % 1024, swz = sb ^ (((sb >> 9) & 1) << 5); R = (st >> 1) * 16 + swz / 64; C = (st & 1) * 32 + (swz % 64) / 2; }
DI int perm32(int rho) { const int n = rho >> 4, i = rho & 15; return 8 * (i >> 2) + 4 * n + (i & 3); }
struct Unit { int pm, pn; };
struct Gemm { const bf16_t* A; const bf16_t* Bt; int M, NT, K, lda; size_t hstepB, tstepB; };
struct StaticOrder {
    int nM, nN, nwg, G, c;
    DI void init(int M, int NT, int G_, int c_) { nM = M / BM; nN = NT; nwg = nM * nN; G = G_; c = c_; }
    DI bool next(int i, Unit& u) const {
        const long L = (long)i * G + c; if (L >= nwg) return false;
        int wgid = (int)L; { const int q = nwg / NXCD, r = nwg % NXCD, xcd = wgid % NXCD, off = wgid / NXCD; wgid = (xcd < r ? xcd * (q + 1) : r * (q + 1) + (xcd - r) * q) + off; }
        const int nig = WGM * nN, gid = wgid / nig, fm = gid * WGM, gsz = (nM - fm) < WGM ? (nM - fm) : WGM;
        u.pm = fm + ((wgid % nig) % gsz); u.pn = (wgid % nig) / gsz; return true;
    }
};
template <class Epi>
DI void gemm_phase(LDS_AS unsigned char* lds, const Gemm g, const Epi& E) {
    StaticOrder S; S.init(g.M, g.NT, gridDim.x, blockIdx.x);
    const int tid = otid(), wid = __builtin_amdgcn_readfirstlane(tid >> 6), lane = tid & 63, wr = wid >> 2, wc = wid & 3, fr = lane & 15, fq = lane >> 4;
    const int K = g.K, nt = K / BK;
    unsigned voffA[2], voffB[2];
#pragma unroll
    for (int i = 0; i < 2; ++i) { int R, C; stage_rc(tid * 16 + i * 8192, R, C); const int Rb = Epi::PERM ? ((R & ~31) + perm32(R & 31)) : R;
        voffA[i] = (unsigned)(R * g.lda + C) * 2u; voffB[i] = (unsigned)(Rb * K + C) * 2u; }
    const size_t kstep = (size_t)(BK * 2);
    const size_t hstepA = (size_t)HALF * g.lda * 2, tstepA = 2 * hstepA, hstepB = g.hstepB, tstepB = g.tstepB;
    const unsigned ldsw = (unsigned)wid * 1024u;
    const int aoff = lds_byte(wr * 64 + fr, fq * 8), boff = lds_byte(wc * 32 + fr, fq * 8);
#define PG8_SA(b, h) (((b) * 2 + (h)) * HTB)
#define PG8_SB(b, h) ((4 + (b) * 2 + (h)) * HTB)
#define PG8_STAGE(bufoff, gbase, voff) do { _Pragma("unroll") for (int _i = 0; _i < 2; ++_i) \
        __builtin_amdgcn_global_load_lds((const unsigned*)((const char*)(gbase) + (voff)[_i]), (LDS_AS unsigned*)(lds + (bufoff) + ldsw + _i * 8192), 16, 0, 0); } while (0)
#define PG8_LDA(dst, b, h) do { _Pragma("unroll") for (int m = 0; m < 4; ++m) _Pragma("unroll") for (int k = 0; k < 2; ++k) dst[m][k] = *(const LDS_AS bf16x8*)(lds + PG8_SA(b, h) + aoff + m * 2048 + k * 1024); } while (0)
#define PG8_LDB(dst, b, h) do { _Pragma("unroll") for (int n = 0; n < 2; ++n) _Pragma("unroll") for (int k = 0; k < 2; ++k) dst[n][k] = *(const LDS_AS bf16x8*)(lds + PG8_SB(b, h) + boff + n * 2048 + k * 1024); } while (0)
#define PG8_MMA(ai, bj, At, Bt) do { __builtin_amdgcn_s_setprio(1); _Pragma("unroll") for (int m = 0; m < 4; ++m) _Pragma("unroll") for (int n = 0; n < 2; ++n) _Pragma("unroll") for (int k = 0; k < 2; ++k) \
        acc[ai][bj][m][n] = __builtin_amdgcn_mfma_f32_16x16x32_bf16(Bt[n][k], At[m][k], acc[ai][bj][m][n], 0, 0, 0); __builtin_amdgcn_s_setprio(0); } while (0)
#define PG8_WAIT_V(n) asm volatile("s_waitcnt vmcnt(" #n ")" ::: "memory")
#define PG8_WAIT_L(n) asm volatile("s_waitcnt lgkmcnt(" #n ")" ::: "memory")
#define PG8_BAR __builtin_amdgcn_s_barrier()
#define PG8_SCHED __builtin_amdgcn_sched_barrier(0)
    Unit cur, nxt; int ui = 0;
    if (!S.next(0, cur)) return;
    f32x4 acc[2][2][4][2];
#pragma unroll
    for (int a = 0; a < 2; ++a)
#pragma unroll
        for (int b = 0; b < 2; ++b)
#pragma unroll
            for (int m = 0; m < 4; ++m)
#pragma unroll
                for (int n = 0; n < 2; ++n) acc[a][b][m][n] = (f32x4){0.f, 0.f, 0.f, 0.f};
    bf16x8 At[4][2], B0[2][2], B1[2][2];
    const char* cA = (const char*)g.A + (size_t)cur.pm * tstepA; const char* cB = (const char*)g.Bt + (size_t)cur.pn * tstepB;
    PG8_STAGE(PG8_SB(0, 0), cB, voffB); PG8_STAGE(PG8_SA(0, 0), cA, voffA); PG8_STAGE(PG8_SB(0, 1), cB + hstepB, voffB); PG8_STAGE(PG8_SA(0, 1), cA + hstepA, voffA);
    if (wr == 1) PG8_BAR;
    PG8_WAIT_V(4); PG8_BAR;
    PG8_STAGE(PG8_SB(1, 0), cB + kstep, voffB); PG8_STAGE(PG8_SA(1, 0), cA + kstep, voffA); PG8_STAGE(PG8_SB(1, 1), cB + hstepB + kstep, voffB);
    PG8_WAIT_V(6); PG8_BAR;
    for (;;) {
        const bool has_next = S.next(ui + 1, nxt);
        const char* nA = has_next ? (const char*)g.A + (size_t)nxt.pm * tstepA : cA; const char* nB = has_next ? (const char*)g.Bt + (size_t)nxt.pn * tstepB : cB;
        for (int t = 0; t < nt; t += 2) {
            const bool last = (t == nt - 2);
            const char* a1 = cA + (size_t)(t + 1) * kstep;
            const char* a2 = last ? nA : cA + (size_t)(t + 2) * kstep; const char* b2 = last ? nB : cB + (size_t)(t + 2) * kstep;
            const char* a3 = a2 + kstep; const char* b3 = b2 + kstep;
            PG8_LDB(B0, 0, 0); PG8_SCHED; PG8_LDA(At, 0, 0); PG8_STAGE(PG8_SA(1, 1), a1 + hstepA, voffA);
            PG8_WAIT_L(8); PG8_BAR; PG8_WAIT_L(0); PG8_MMA(0, 0, At, B0); PG8_BAR; PG8_SCHED;
            PG8_LDB(B1, 0, 1); PG8_STAGE(PG8_SB(0, 0), b2, voffB);
            PG8_BAR; PG8_WAIT_L(0); PG8_MMA(0, 1, At, B1); PG8_BAR;
            PG8_LDA(At, 0, 1); PG8_STAGE(PG8_SA(0, 0), a2, voffA);
            PG8_BAR; PG8_WAIT_L(0); PG8_MMA(1, 0, At, B0); PG8_BAR; PG8_SCHED;
            PG8_STAGE(PG8_SB(0, 1), b2 + hstepB, voffB);
            PG8_WAIT_V(6); PG8_BAR; PG8_MMA(1, 1, At, B1); PG8_BAR;
            PG8_LDB(B0, 1, 0); PG8_SCHED; PG8_LDA(At, 1, 0); PG8_STAGE(PG8_SA(0, 1), a2 + hstepA, voffA);
            PG8_WAIT_L(8); PG8_BAR; PG8_WAIT_L(0); PG8_MMA(0, 0, At, B0); PG8_BAR; PG8_SCHED;
            PG8_LDB(B1, 1, 1); PG8_STAGE(PG8_SB(1, 0), b3, voffB);
            PG8_BAR; PG8_WAIT_L(0); PG8_MMA(0, 1, At, B1); PG8_BAR;
            PG8_LDA(At, 1, 1); PG8_STAGE(PG8_SA(1, 0), a3, voffA);
            PG8_BAR; PG8_WAIT_L(0); PG8_MMA(1, 0, At, B0); PG8_BAR; PG8_SCHED;
            PG8_STAGE(PG8_SB(1, 1), b3 + hstepB, voffB);
            PG8_WAIT_V(6); PG8_BAR; PG8_MMA(1, 1, At, B1); PG8_BAR;
        }
        E(acc, cur, wr, wc, fr, fq);
        if (!has_next) break;
#pragma unroll
        for (int a = 0; a < 2; ++a)
#pragma unroll
            for (int b = 0; b < 2; ++b)
#pragma unroll
                for (int m = 0; m < 4; ++m)
#pragma unroll
                    for (int n = 0; n < 2; ++n) acc[a][b][m][n] = (f32x4){0.f, 0.f, 0.f, 0.f};
        cur = nxt; cA = nA; cB = nB; ++ui;
    }
    PG8_WAIT_V(0);
    if (wr == 0) PG8_BAR;
    PG8_BAR;
#undef PG8_SA
#undef PG8_SB
#undef PG8_STAGE
#undef PG8_LDA
#undef PG8_LDB
#undef PG8_MMA
#undef PG8_WAIT_V
#undef PG8_WAIT_L
#undef PG8_BAR
#undef PG8_SCHED
}
struct EpiResid {
    static constexpr bool PERM = false;
    const float* res; float* out;
    DI void operator()(const f32x4 (&acc)[2][2][4][2], const Unit& u, int wr, int wc, int fr, int fq) const {
        const int row0 = u.pm * BM + wr * 64 + fr, col0 = u.pn * BM + wc * 32 + 4 * fq;
#pragma unroll
        for (int ai = 0; ai < 2; ++ai)
#pragma unroll
            for (int m = 0; m < 4; ++m) {
                const size_t rb = (size_t)(row0 + ai * HALF + m * 16) * D + col0;
#pragma unroll
                for (int bj = 0; bj < 2; ++bj)
#pragma unroll
                    for (int n = 0; n < 2; ++n) { const size_t idx = rb + bj * HALF + n * 16; *(f32x4*)(out + idx) = *(const f32x4*)(res + idx) + acc[ai][bj][m][n]; }
            }
    }
};
struct EpiBf16 {
    static constexpr bool PERM = true;
    bf16_t* out; int ld;
    DI void operator()(const f32x4 (&acc)[2][2][4][2], const Unit& u, int wr, int wc, int fr, int fq) const {
        const int row0 = u.pm * BM + wr * 64 + fr, col0 = u.pn * BM + wc * 32 + 8 * fq;
#pragma unroll
        for (int ai = 0; ai < 2; ++ai)
#pragma unroll
            for (int m = 0; m < 4; ++m) {
                bf16_t* rowp = out + (size_t)(row0 + ai * HALF + m * 16) * ld + col0;
#pragma unroll
                for (int bj = 0; bj < 2; ++bj) {
                    const f32x4 v0 = acc[ai][bj][m][0], v1 = acc[ai][bj][m][1];
                    u32x4 w; w.x = pack2(v0[0], v0[1]); w.y = pack2(v0[2], v0[3]); w.z = pack2(v1[0], v1[1]); w.w = pack2(v1[2], v1[3]);
                    *(u32x4*)(rowp + bj * HALF) = w;
                }
            }
    }
};
struct EpiSwiglu {
    static constexpr bool PERM = true;
    bf16_t* act;
    DI void operator()(const f32x4 (&acc)[2][2][4][2], const Unit& u, int wr, int wc, int fr, int fq) const {
        const int row0 = u.pm * BM + wr * 64 + fr, col0 = u.pn * HALF + wc * 32 + 8 * fq;
#pragma unroll
        for (int ai = 0; ai < 2; ++ai)
#pragma unroll
            for (int m = 0; m < 4; ++m) {
                float v[8];
#pragma unroll
                for (int n = 0; n < 2; ++n)
#pragma unroll
                    for (int j = 0; j < 4; ++j) { const float gg = acc[ai][0][m][n][j], uu = acc[ai][1][m][n][j]; v[4 * n + j] = gg * uu * __builtin_amdgcn_rcpf(1.0f + __builtin_amdgcn_exp2f(-gg * LOG2E)); }
                u32x4 w; w.x = pack2(v[0], v[1]); w.y = pack2(v[2], v[3]); w.z = pack2(v[4], v[5]); w.w = pack2(v[6], v[7]);
                *(u32x4*)(act + (size_t)(row0 + ai * HALF + m * 16) * DFF + col0) = w;
            }
    }
};
}
DI pg8::Gemm mk_gemm(const bf16_t* A, int lda, const bf16_t* Bt, int M, int N, int K) { return pg8::Gemm{A, Bt, M, N / 256, K, lda, (size_t)128 * K * 2, (size_t)256 * K * 2}; }

template <int DQK, int DV, int KT, int QMODE, bool ALIBI, bool NOMAX>
DI void attn_core(const bf16_t* __restrict__ q, int ldq, const bf16_t* __restrict__ k, int ldk, const bf16_t* __restrict__ k2, int ldk2,
                  const bf16_t* __restrict__ v, int ldv, int nkeys, int qpos0, float qscale, float slope2,
                  const float* __restrict__ qg, const float2* __restrict__ tab, char* smem, f32x16 (&o)[DV / 32], float& lsum) {
    constexpr int KROW = DQK * 2 + 16, VROW = DV * 2 + 64  , KBYTES = KT * KROW, VBYTES = KT * VROW;
    constexpr int KCPR = DQK / 8  , KTOT = KT * KCPR, NKC = (KTOT + THREADS - 1) / THREADS, VCPR = DV / 8, VTOT = KT * VCPR, NVC = (VTOT + THREADS - 1) / THREADS;
    constexpr int NST = KT / 32, NKS = DQK / 16, NDT = DV / 32;
    static_assert(2 * (KBYTES + VBYTES) <= (int)LDS_BYTES, "lds");
    const int tid = otid(), lane = tid & 63, w = tid >> 6, r = lane & 31, h = lane >> 5;
    const int qpos = qpos0 + 32 * w + r;
    bf16x8 qf[NKS];
    {
        const bf16_t* qrow = q + (size_t)(32 * w + r) * ldq + 8 * h;
        u32x4 raw[NKS];
#pragma unroll
        for (int s = 0; s < NKS; ++s) raw[s] = *(const u32x4*)(qrow + 16 * s);
        if (QMODE == 1) {
            float ss = 0.f;
#pragma unroll
            for (int s = 0; s < NKS; ++s) {
                const unsigned u[4] = {raw[s].x, raw[s].y, raw[s].z, raw[s].w};
#pragma unroll
                for (int j = 0; j < 4; ++j) { const float a0 = bflo(u[j]), a1 = bfhi(u[j]); ss += a0 * a0 + a1 * a1; }
            }
            ss += __shfl_xor(ss, 32);
            const float rstd = rsqrtf(ss * (1.0f / 64) + EPS) * qscale;
#pragma unroll
            for (int s = 0; s < NKS; ++s) {
                unsigned u[4] = {raw[s].x, raw[s].y, raw[s].z, raw[s].w};
#pragma unroll
                for (int j = 0; j < 4; ++j) {
                    const int d0 = 16 * s + 8 * h + 2 * j;
                    const float y0 = bflo(u[j]) * rstd * qg[d0], y1 = bfhi(u[j]) * rstd * qg[d0 + 1];
                    const float2 cs = tab[qpos * 32 + (d0 >> 1)];
                    u[j] = pack2(y0 * cs.x - y1 * cs.y, y0 * cs.y + y1 * cs.x);
                }
                raw[s] = u32x4{u[0], u[1], u[2], u[3]};
            }
        } else if (QMODE == 2) {
#pragma unroll
            for (int s = 4; s < NKS; ++s) {
                unsigned u[4] = {raw[s].x, raw[s].y, raw[s].z, raw[s].w};
#pragma unroll
                for (int j = 0; j < 4; ++j) {
                    const int p = 8 * (s - 4) + 4 * h + j;
                    const float y0 = bflo(u[j]), y1 = bfhi(u[j]);
                    const float2 cs = tab[qpos * 16 + p];
                    u[j] = pack2(y0 * cs.x - y1 * cs.y, y0 * cs.y + y1 * cs.x);
                }
                raw[s] = u32x4{u[0], u[1], u[2], u[3]};
            }
        }
#pragma unroll
        for (int s = 0; s < NKS; ++s) qf[s] = __builtin_bit_cast(bf16x8, raw[s]);
    }
    u32x4 rk[NKC], rv[NVC];
    char* const kbuf = smem;
    char* const vbuf = smem + 2 * KBYTES;
#define ATT_GLOADK(key0_)                                                                                             \
    {                                                                                                                 \
        _Pragma("unroll") for (int i = 0; i < NKC; ++i) {                                                             \
            const int cid = tid + THREADS * i, key = cid / KCPR, cc = cid - key * KCPR;                               \
            if (KTOT % THREADS == 0 || cid < KTOT) {                                                                  \
                const bf16_t* src;                                                                                    \
                if (QMODE == 2 && cc >= 8) src = k2 + (size_t)((key0_) + key) * ldk2 + (cc - 8) * 8;                   \
                else src = k + (size_t)((key0_) + key) * ldk + cc * 8;                                                \
                rk[i] = *(const u32x4*)src;                                                                           \
            }                                                                                                         \
        }                                                                                                             \
    }
#define ATT_GLOADV(key0_)                                                                                             \
    {                                                                                                                 \
        _Pragma("unroll") for (int i = 0; i < NVC; ++i) {                                                             \
            const int cid = tid + THREADS * i, key = cid / VCPR, cc = cid - key * VCPR;                               \
            if (VTOT % THREADS == 0 || cid < VTOT) rv[i] = *(const u32x4*)(v + (size_t)((key0_) + key) * ldv + cc * 8); \
        }                                                                                                             \
    }
#define ATT_LSTOREK(buf_)                                                                                             \
    {                                                                                                                 \
        _Pragma("unroll") for (int i = 0; i < NKC; ++i) {                                                             \
            const int cid = tid + THREADS * i, key = cid / KCPR, cc = cid - key * KCPR;                               \
            if (KTOT % THREADS == 0 || cid < KTOT) *(u32x4*)(kbuf + (buf_) * KBYTES + key * KROW + cc * 16) = rk[i];  \
        }                                                                                                             \
    }
#define ATT_LSTOREV(buf_)                                                                                             \
    {                                                                                                                 \
        _Pragma("unroll") for (int i = 0; i < NVC; ++i) {                                                             \
            const int cid = tid + THREADS * i, key = cid / VCPR, cc = cid - key * VCPR;                               \
            if (VTOT % THREADS == 0 || cid < VTOT) *(u32x4*)(vbuf + (buf_) * VBYTES + key * VROW + cc * 16) = rv[i];  \
        }                                                                                                             \
    }
#define ATT_QK(buf_, X_)                                                                                              \
    {                                                                                                                 \
        const char* kb_ = kbuf + (buf_) * KBYTES + r * KROW + h * 16;                                                 \
        _Pragma("unroll") for (int st = 0; st < NST; ++st) {                                                          \
            X_[st] = MFMA(*(const bf16x8*)(kb_ + 32 * st * KROW), qf[0], zero16);                                     \
            _Pragma("unroll") for (int ks = 1; ks < NKS; ++ks) X_[st] = MFMA(*(const bf16x8*)(kb_ + 32 * st * KROW + ks * 32), qf[ks], X_[st]); \
        }                                                                                                             \
    }
#define ATT_SMPV(t_, vb_, X_)                                                                                         \
    {                                                                                                                 \
        if (NOMAX) {                                                                                                  \
            const float dqn = (float)(qpos - ((t_) * KT + 4 * h));                                                    \
            _Pragma("unroll") for (int st = 0; st < NST; ++st)                                                        \
                _Pragma("unroll") for (int i = 0; i < 16; ++i) {                                                      \
                    float xv_ = X_[st][i];                                                                            \
                    if (ALIBI) xv_ = __builtin_fmaf(-slope2, fabsf(dqn - (float)(32 * st + (i & 3) + 8 * (i >> 2))), xv_); \
                    X_[st][i] = __builtin_amdgcn_exp2f(xv_);                                                          \
                    if (!ROWSUM_MFMA) lacc += X_[st][i];                                                              \
                }                                                                                                     \
        } else {                                                                                                      \
            float mx = -1e30f;                                                                                        \
            const float dq = (float)(qpos - ((t_) * KT + 4 * h));                                                     \
            _Pragma("unroll") for (int st = 0; st < NST; ++st)                                                        \
                _Pragma("unroll") for (int i = 0; i < 16; ++i) {                                                      \
                    if (ALIBI) X_[st][i] = __builtin_fmaf(-slope2, fabsf(dq - (float)(32 * st + (i & 3) + 8 * (i >> 2))), X_[st][i]); \
                    mx = fmaxf(mx, X_[st][i]);                                                                        \
                }                                                                                                     \
            mx = fmaxf(mx, __shfl_xor(mx, 32));                                                                       \
            const float mn = fmaxf(m, mx);                                                                            \
            const float alpha = __builtin_amdgcn_exp2f(m - mn);                                                       \
            m = mn;                                                                                                   \
            float rs_ = 0.f;                                                                                          \
            _Pragma("unroll") for (int st = 0; st < NST; ++st)                                                        \
                _Pragma("unroll") for (int i = 0; i < 16; ++i) { X_[st][i] = __builtin_amdgcn_exp2f(X_[st][i] - mn); if (!ROWSUM_MFMA) rs_ += X_[st][i]; } \
            if (__any(alpha != 1.0f)) {                                                                               \
                _Pragma("unroll") for (int dt = 0; dt < NDT; ++dt)                                                    \
                    _Pragma("unroll") for (int i = 0; i < 16; ++i) o[dt][i] *= alpha;                                 \
                _Pragma("unroll") for (int i = 0; i < 16; ++i) ol[i] *= alpha;                                        \
            }                                                                                                         \
            if (!ROWSUM_MFMA) lacc = lacc * alpha + rs_;                                                              \
        }                                                                                                             \
        const char* vbp_ = vbuf + (vb_) * VBYTES + vlane;                                                             \
        _Pragma("unroll") for (int st = 0; st < NST; ++st)                                                            \
            _Pragma("unroll") for (int s = 0; s < 2; ++s) {                                                           \
                u32x4 pk;                                                                                             \
                pk.x = pack2(X_[st][8 * s + 0], X_[st][8 * s + 1]); pk.y = pack2(X_[st][8 * s + 2], X_[st][8 * s + 3]); \
                pk.z = pack2(X_[st][8 * s + 4], X_[st][8 * s + 5]); pk.w = pack2(X_[st][8 * s + 6], X_[st][8 * s + 7]); \
                const bf16x8 pb = __builtin_bit_cast(bf16x8, pk);                                                     \
                if (ROWSUM_MFMA) ol = MFMA(ones8, pb, ol);                                                            \
                _Pragma("unroll") for (int dt = 0; dt < NDT; ++dt) {                                                  \
                    const char* va = vbp_ + (32 * st + 16 * s) * VROW + 64 * dt;                                      \
                    const s16x4 lo = __builtin_amdgcn_ds_read_tr16_b64_v4i16((LDS_AS s16x4*)(va));                    \
                    const s16x4 hi = __builtin_amdgcn_ds_read_tr16_b64_v4i16((LDS_AS s16x4*)(va + 8 * VROW));        \
                    o[dt] = MFMA(__builtin_shufflevector(lo, hi, 0, 1, 2, 3, 4, 5, 6, 7), pb, o[dt]);                 \
                }                                                                                                     \
            }                                                                                                         \
    }
#define ATT_STEP(t_, PAR_, CUR_, NXT_)                                                                                \
    {                                                                                                                 \
        const int tk_ = ((t_) + 2 < ntiles) ? (t_) + 2 : ntiles - 1, tv_ = ((t_) + 1 < ntiles) ? (t_) + 1 : ntiles - 1; \
        ATT_GLOADK(tk_ * KT)                                                                                          \
        ATT_GLOADV(tv_ * KT)                                                                                          \
        __builtin_amdgcn_sched_barrier(0);                                                                            \
        ATT_QK(1 - (PAR_), NXT_)                                                                                      \
        ATT_SMPV(t_, PAR_, CUR_)                                                                                      \
        __builtin_amdgcn_sched_barrier(0);                                                                            \
        ATT_LSTOREK(PAR_)                                                                                             \
        ATT_LSTOREV(1 - (PAR_))                                                                                       \
        __syncthreads();                                                                                              \
    }
#define ATT_STEP1(t_, PAR_, X_)                                                                                       \
    {                                                                                                                 \
        const int tn_ = ((t_) + 1 < ntiles) ? (t_) + 1 : ntiles - 1;                                                  \
        ATT_GLOADK(tn_ * KT)                                                                                          \
        ATT_GLOADV(tn_ * KT)                                                                                          \
        __builtin_amdgcn_sched_barrier(0);                                                                            \
        ATT_QK(PAR_, X_)                                                                                              \
        ATT_SMPV(t_, PAR_, X_)                                                                                        \
        __builtin_amdgcn_sched_barrier(0);                                                                            \
        ATT_LSTOREK(1 - (PAR_))                                                                                       \
        ATT_LSTOREV(1 - (PAR_))                                                                                       \
        __syncthreads();                                                                                              \
    }
    const f32x16 zero16 = {0.f, 0.f, 0.f, 0.f, 0.f, 0.f, 0.f, 0.f, 0.f, 0.f, 0.f, 0.f, 0.f, 0.f, 0.f, 0.f};
    const bf16x8 ones8 = {0x3F80, 0x3F80, 0x3F80, 0x3F80, 0x3F80, 0x3F80, 0x3F80, 0x3F80};
    constexpr bool ROWSUM_MFMA = false;
    float m = -1e30f, lacc = 0.f;
    f32x16 ol = zero16;
#pragma unroll
    for (int dt = 0; dt < NDT; ++dt) o[dt] = zero16;
    const int ntiles = nkeys / KT;
    const int vlane = (4 * h + ((lane & 15) >> 2)) * VROW + (16 * ((lane >> 4) & 1) + 4 * (lane & 3)) * 2;
    constexpr bool PIPE = (DV < 128);
    if (PIPE) {
        f32x16 xa[NST], xb[NST];
        ATT_GLOADK(0) ATT_LSTOREK(0)
        ATT_GLOADK(KT) ATT_GLOADV(0)
        __syncthreads();
        ATT_QK(0, xa)
        ATT_LSTOREK(1) ATT_LSTOREV(0)
        __syncthreads();
        for (int t = 0; t < ntiles; t += 2) {
            ATT_STEP(t, 0, xa, xb)
            ATT_STEP(t + 1, 1, xb, xa)
        }
    } else {
        f32x16 xs[NST];
        ATT_GLOADK(0) ATT_GLOADV(0) ATT_LSTOREK(0) ATT_LSTOREV(0)
        __syncthreads();
        for (int t = 0; t < ntiles; t += 2) {
            ATT_STEP1(t, 0, xs)
            ATT_STEP1(t + 1, 1, xs)
        }
    }
    lsum = ROWSUM_MFMA ? ol[0] : lacc + __shfl_xor(lacc, 32);
#undef ATT_GLOADK
#undef ATT_GLOADV
#undef ATT_LSTOREK
#undef ATT_LSTOREV
#undef ATT_QK
#undef ATT_SMPV
#undef ATT_STEP
#undef ATT_STEP1
}
template <int NDT>
DI void store_o(bf16_t* dst, int ld, f32x16 (&o)[NDT], float inv) {
    const int tid_ = otid(), lane = tid_ & 63, w = tid_ >> 6, r = lane & 31, h = lane >> 5;
    bf16_t* row = dst + (size_t)(32 * w + r) * ld + 4 * h;
#pragma unroll
    for (int dt = 0; dt < NDT; ++dt)
#pragma unroll
        for (int g = 0; g < 4; ++g) {
            uint2 vv; vv.x = pack2(o[dt][4 * g] * inv, o[dt][4 * g + 1] * inv); vv.y = pack2(o[dt][4 * g + 2] * inv, o[dt][4 * g + 3] * inv);
            *(uint2*)(row + 32 * dt + 8 * g) = vv;
        }
}
DI int swz_item(int base) {
    const int G = gridDim.x, i = blockIdx.x;
    if (G & 7) return base + i;
    return base + (i & 7) * (G >> 3) + (i >> 3);
}

constexpr int QT = SEQ / 256;
constexpr float NOMAX_BOUND = 90.f;
DI void attn_even(const bf16_t* qkv, float* park, bf16_t* mix, const Params& p, const float2* ax, const unsigned* nd, float lam_init, char* smem) {
    float d1 = 0.f, d2 = 0.f, gq = 0.f, gk = 0.f;
    for (int i = 0; i < 64; ++i) { d1 += p.in[8][i] * p.in[9][i]; d2 += p.in[10][i] * p.in[11][i]; gq = fmaxf(gq, fabsf(p.in[6][i])); gk = fmaxf(gk, fabsf(p.in[7][i])); }
    const float lam = __expf(d1) - __expf(d2) + lam_init;
    const float bound_gqa = 64.f * 0.125f * LOG2E * gq * gk * 1.03f;
    const int tid_ = otid(), lane = tid_ & 63, h = lane >> 5;
    float4* mypark = (float4*)(park + ((size_t)blockIdx.x * THREADS + tid_) * 64);
    constexpr int NDIFF = NB * 4 * QT, NGQA = NB * 8 * QT;
    for (int base = 0; base < NDIFF + NGQA; base += gridDim.x) {
        const int it = swz_item(base);
        if (it >= NDIFF + NGQA) continue;
        if (it < NDIFF) {
            const int b = it / (4 * QT), hd = (it / QT) & 3, qt = it % QT;
            const size_t row0 = (size_t)b * SEQ + qt * 256;
            const float slope2 = exp2f(-2.0f * (hd + 1)) * LOG2E;
            const bf16_t* qp = qkv + row0 * EVEN_IN + 768 + hd * 128;
            const bf16_t* kp = qkv + (size_t)b * SEQ * EVEN_IN + 1280 + hd * 128;
            const bf16_t* vp = qkv + (size_t)b * SEQ * EVEN_IN + 1792 + hd * 128;
            f32x16 o0[4]; float l0 = 1.f;
#pragma unroll 1
            for (int c = 0; c < 2; ++c) {
                const unsigned* nn = nd + (b * 8 + hd * 2 + c) * 2;
                const float bound = sqrtf(__uint_as_float(nn[0]) * __uint_as_float(nn[1])) * 1.03f;
                if (bound < NOMAX_BOUND) attn_core<64, 128, 64, 0, true, true>(qp + 64 * c, EVEN_IN, kp + 64 * c, EVEN_IN, nullptr, 0, vp, EVEN_IN, SEQ, qt * 256, 1.0f, slope2, nullptr, nullptr, smem, o0, l0);
                else attn_core<64, 128, 64, 0, true, false>(qp + 64 * c, EVEN_IN, kp + 64 * c, EVEN_IN, nullptr, 0, vp, EVEN_IN, SEQ, qt * 256, 1.0f, slope2, nullptr, nullptr, smem, o0, l0);
                if (c == 0) {
                    const float i0 = 1.0f / l0;
#pragma unroll
                    for (int dt = 0; dt < 4; ++dt)
#pragma unroll
                        for (int g = 0; g < 4; ++g) mypark[dt * 4 + g] = make_float4(o0[dt][4 * g] * i0, o0[dt][4 * g + 1] * i0, o0[dt][4 * g + 2] * i0, o0[dt][4 * g + 3] * i0);
                    asm volatile("" ::: "memory");
                }
            }
            const float i1 = lam / l0;
            float ss = 0.f;
            asm volatile("" ::: "memory");
#pragma unroll
            for (int dt = 0; dt < 4; ++dt)
#pragma unroll
                for (int g = 0; g < 4; ++g) {
                    const float4 pv = mypark[dt * 4 + g];
                    const float pa[4] = {pv.x, pv.y, pv.z, pv.w};
#pragma unroll
                    for (int e = 0; e < 4; ++e) { const float vv = pa[e] - i1 * o0[dt][4 * g + e]; o0[dt][4 * g + e] = vv; ss += vv * vv; }
                }
            ss += __shfl_xor(ss, 32);
            const float rstd = rsqrtf(ss * (1.0f / 128) + EPS) * (1.0f - lam_init);
#pragma unroll
            for (int dt = 0; dt < 4; ++dt)
#pragma unroll
                for (int i = 0; i < 16; ++i) o0[dt][i] *= p.in[12][32 * dt + crow(i, h)];
            store_o<4>(mix + row0 * D + 512 + hd * 128, D, o0, rstd);
        } else {
            const int j = it - NDIFF;
            const int b = j / (8 * QT), hd = (j / QT) & 7, qt = j % QT, kvh = hd >> 2;
            const size_t row0 = (size_t)b * SEQ + qt * 256;
            const bf16_t* qp = qkv + row0 * EVEN_IN + hd * 64;
            const bf16_t* kp = qkv + (size_t)b * SEQ * EVEN_IN + 512 + kvh * 64;
            const bf16_t* vp = qkv + (size_t)b * SEQ * EVEN_IN + 640 + kvh * 64;
            f32x16 o[2]; float l;
            if (bound_gqa < NOMAX_BOUND) attn_core<64, 64, 64, 1, false, true>(qp, EVEN_IN, kp, EVEN_IN, nullptr, 0, vp, EVEN_IN, SEQ, qt * 256, 0.125f * LOG2E, 0.f, p.in[6], ax, smem, o, l);
            else attn_core<64, 64, 64, 1, false, false>(qp, EVEN_IN, kp, EVEN_IN, nullptr, 0, vp, EVEN_IN, SEQ, qt * 256, 0.125f * LOG2E, 0.f, p.in[6], ax, smem, o, l);
            store_o<2>(mix + row0 * D + hd * 64, D, o, 1.0f / l);
        }
    }
}
DI void attn_mla(const bf16_t* qb, const bf16_t* kv, const bf16_t* a, bf16_t* mix, const float2* lin, const unsigned* nmx, char* smem) {
    constexpr int NIT = NB * 16 * QT;
    for (int base = 0; base < NIT; base += gridDim.x) {
        const int it = swz_item(base);
        if (it >= NIT) continue;
        const int b = it / (16 * QT), hd = (it / QT) & 15, qt = it % QT;
        const size_t row0 = (size_t)b * SEQ + qt * 256;
        const unsigned* nn = nmx + (b * 16 + hd) * 2;
        const float bound = sqrtf(__uint_as_float(nn[0]) * __uint_as_float(nn[1])) * 1.03f;
        const bf16_t* kb_ = kv + (size_t)b * SEQ * 2048 + hd * 128;
        f32x16 o[2]; float l;
        if (bound < NOMAX_BOUND) attn_core<96, 64, 64, 2, false, true>(qb + row0 * 1536 + hd * 96, 1536, kb_, 2048, a + (size_t)b * SEQ * ODD_PAD + 640, ODD_PAD, kb_ + 64, 2048, SEQ, qt * 256, 1.0f, 0.f, nullptr, lin, smem, o, l);
        else attn_core<96, 64, 64, 2, false, false>(qb + row0 * 1536 + hd * 96, 1536, kb_, 2048, a + (size_t)b * SEQ * ODD_PAD + 640, ODD_PAD, kb_ + 64, 2048, SEQ, qt * 256, 1.0f, 0.f, nullptr, lin, smem, o, l);
        store_o<2>(mix + row0 * D + hd * 64, D, o, 1.0f / l);
    }
}
DI void attn_cross(const bf16_t* qx, const bf16_t* kvx, bf16_t* mix, int seq0, char* smem) {
    constexpr int NIT = NB * 4 * QT * 2;
    for (int base = 0; base < NIT; base += gridDim.x) {
        const int it = swz_item(base);
        if (it >= NIT) continue;
        const int b = it / (8 * QT), hd = (it / (2 * QT)) & 3, qt = (it >> 1) % QT, half = it & 1;
        const size_t row0 = (size_t)b * SEQ + qt * 256;
        const bf16_t* kvb = kvx + (size_t)(seq0 + b) * NMEM * 2048;
        f32x16 o[4]; float l;
        attn_core<256, 128, 32, 0, false, false>(qx + row0 * D + hd * 256, D, kvb + hd * 256, 2048, nullptr, 0, kvb + 1024 + hd * 256 + half * 128, 2048, NMEM, 0,
                                          1.0f, 0.f, nullptr, nullptr, smem, o, l);
        store_o<4>(mix + row0 * D + hd * 256 + half * 128, D, o, 1.0f / l);
    }
}

extern "C" __global__ void __launch_bounds__(THREADS, 2) fwd_mega(Params p) {
    extern __shared__ __attribute__((aligned(16))) char smem[];
    LDS_AS unsigned char* lds = (LDS_AS unsigned char*)smem;
    cg::grid_group grid = cg::this_grid();
    char* ws = p.ws;
    __shared__ uint4 xb_words;
    if (threadIdx.x == 0) xb_words = make_uint4(0u, 0u, 0u, 0u);
    __syncthreads();
    const XcdBarrier xb = xcd_barrier_post((unsigned*)(ws + B_BAR), (volatile LDS_AS unsigned*)&xb_words);
    bf16_t* wEin = (bf16_t*)(ws + W_EIN); bf16_t* wEout = (bf16_t*)(ws + W_EOUT); bf16_t* wOin = (bf16_t*)(ws + W_OIN);
    bf16_t* wUq = (bf16_t*)(ws + W_UQ); bf16_t* wUkv = (bf16_t*)(ws + W_UKV); bf16_t* wOout = (bf16_t*)(ws + W_OOUT);
    float2* ax = (float2*)(ws + T_AX); float2* lin = (float2*)(ws + T_LIN);
    bf16_t* H = (bf16_t*)(ws + B_H); bf16_t* MIX = (bf16_t*)(ws + B_MIX);

    convert_weight(p.in[5], wEin, D, EVEN_IN, EVEN_IN, smem, 768, 1280, 0.125f * LOG2E);
    convert_weight(p.in[13], wEout, D, D, D, smem);
    convert_weight(p.in[14], wOin, D, ODD_IN, ODD_PAD, smem);
    convert_weight(p.in[17], wUq, 384, 1536, 1536, smem, 0, 1536, 0.10206207261596575f * LOG2E);
    convert_weight(p.in[18], wUkv, 256, 2048, 2048, smem);
    convert_weight(p.in[19], wOout, D, D, D, smem);
    for (int l = 0; l < 2; ++l) {
        convert_weight(p.in[22] + (size_t)l * D * D, (bf16_t*)(ws + W_CQ) + (size_t)l * D * D, D, D, D, smem, 0, D, 0.0625f * LOG2E);
        convert_weight(p.in[23] + (size_t)l * D * 2048, (bf16_t*)(ws + W_CKV) + (size_t)l * 2048 * D, D, 2048, 2048, smem);
        convert_weight(p.in[24] + (size_t)l * D * D, (bf16_t*)(ws + W_CO) + (size_t)l * D * D, D, D, D, smem);
        convert_weight(p.in[26] + (size_t)l * D * 2 * DFF, (bf16_t*)(ws + W_GU) + (size_t)l * 2 * DFF * D, D, 2 * DFF, 2 * DFF, smem);
        convert_weight(p.in[27] + (size_t)l * DFF * D, (bf16_t*)(ws + W_DOWN) + (size_t)l * D * DFF, DFF, D, D, smem);
        rmsnorm_rows(p.in[2], p.in[21] + l * D, (bf16_t*)(ws + B_MEMN) + (size_t)l * NBATCH * NMEM * D, 8 * NMEM);
        rmsnorm_rows(p.in[3], p.in[21] + l * D, (bf16_t*)(ws + B_MEMN) + (size_t)l * NBATCH * NMEM * D + (size_t)8 * NMEM * D, 16 * NMEM);
    }
    build_tables(ax, lin);
    if (blockIdx.x == 0) for (int i = threadIdx.x; i < 4096; i += THREADS) ((unsigned*)(ws + B_NORMS))[i] = 0u;
    grid.sync();
    for (int l = 0; l < 2; ++l) {
        pg8::EpiBf16 e{(bf16_t*)(ws + B_KX) + (size_t)l * NBATCH * NMEM * 2048, 2048};
        pg8::gemm_phase(lds, mk_gemm((const bf16_t*)(ws + B_MEMN) + (size_t)l * NBATCH * NMEM * D, D, (const bf16_t*)(ws + W_CKV) + (size_t)l * 2048 * D, NBATCH * NMEM, 2048, D), e);
    }
    xcd_barrier(xb);

    for (int ch = 0; ch < NCHUNK; ++ch) {
        const float* xin = (ch == 0) ? p.in[0] : p.in[1] + (size_t)(ch - 1) * TC * D;
        float* xo = p.out + (size_t)ch * TC * D;
        for (int layer = 0; layer < 2; ++layer) {
            const float* xcur = (layer == 0) ? xin : xo;
            for (int rep_ = 0; rep_ < PROBE_NORM; ++rep_) rmsnorm_rows(xcur, p.in[4] + layer * D, H, TC);
            xcd_barrier(xb);
            const bf16_t* wout;
            if (layer == 0) {
                bf16_t* qkv = (bf16_t*)(ws + E_QKV);
                for (int rep_ = 0; rep_ < PROBE_GEMM; ++rep_) { pg8::EpiBf16 e{qkv, EVEN_IN}; pg8::gemm_phase(lds, mk_gemm(H, D, wEin, TC, EVEN_IN, D), e); }
                xcd_barrier(xb);
                kprep_even(qkv, p.in[7], ax);
                normmax_even(qkv, (unsigned*)(ws + B_NORMS) + ch * 128, smem);
                xcd_barrier(xb);
                for (int rep_ = 0; rep_ < PROBE_ATTN; ++rep_) attn_even(qkv, (float*)(ws + E_PARK), MIX, p, ax, (const unsigned*)(ws + B_NORMS) + ch * 128, 0.2f, smem);
                wout = wEout;
            } else {
                bf16_t* a = (bf16_t*)(ws + O_A); bf16_t* qb = (bf16_t*)(ws + O_Q); bf16_t* kv = (bf16_t*)(ws + O_KV);
                for (int rep_ = 0; rep_ < PROBE_GEMM; ++rep_) { pg8::EpiBf16 e{a, ODD_PAD}; pg8::gemm_phase(lds, mk_gemm(H, D, wOin, TC, ODD_PAD, D), e); }
                xcd_barrier(xb);
                prep_odd(a, p.in[15], p.in[16], lin);
                xcd_barrier(xb);
                for (int rep_ = 0; rep_ < PROBE_GEMM; ++rep_) { pg8::EpiBf16 e{qb, 1536}; pg8::gemm_phase(lds, mk_gemm(a, ODD_PAD, wUq, TC, 1536, 384), e); }
                for (int rep_ = 0; rep_ < PROBE_GEMM; ++rep_) { pg8::EpiBf16 e{kv, 2048}; pg8::gemm_phase(lds, mk_gemm(a + 384, ODD_PAD, wUkv, TC, 2048, 256), e); }
                xcd_barrier(xb);
                normmax_mla(qb, kv, a, (unsigned*)(ws + B_NORMS) + 384 + ch * 256, smem);
                xcd_barrier(xb);
                for (int rep_ = 0; rep_ < PROBE_ATTN; ++rep_) attn_mla(qb, kv, a, MIX, lin, (const unsigned*)(ws + B_NORMS) + 384 + ch * 256, smem);
                wout = wOout;
            }
            xcd_barrier(xb);
            { pg8::EpiResid e{xcur, xo}; pg8::gemm_phase(lds, mk_gemm(MIX, D, wout, TC, D, D), e); }
            xcd_barrier(xb);
            for (int rep_ = 0; rep_ < PROBE_NORM; ++rep_) rmsnorm_rows(xo, p.in[20] + layer * D, H, TC);
            xcd_barrier(xb);
            for (int rep_ = 0; rep_ < PROBE_GEMM; ++rep_) { pg8::EpiBf16 e{(bf16_t*)(ws + X_Q), D}; pg8::gemm_phase(lds, mk_gemm(H, D, (const bf16_t*)(ws + W_CQ) + (size_t)layer * D * D, TC, D, D), e); }
            xcd_barrier(xb);
            for (int rep_ = 0; rep_ < PROBE_CROSS; ++rep_) attn_cross((const bf16_t*)(ws + X_Q), (const bf16_t*)(ws + B_KX) + (size_t)layer * NBATCH * NMEM * 2048, MIX, ch * NB, smem);
            xcd_barrier(xb);
            { pg8::EpiResid e{xo, xo}; pg8::gemm_phase(lds, mk_gemm(MIX, D, (const bf16_t*)(ws + W_CO) + (size_t)layer * D * D, TC, D, D), e); }
            xcd_barrier(xb);
            for (int rep_ = 0; rep_ < PROBE_NORM; ++rep_) rmsnorm_rows(xo, p.in[25] + layer * D, H, TC);
            xcd_barrier(xb);
            for (int rep_ = 0; rep_ < PROBE_GEMM; ++rep_) { pg8::EpiSwiglu e{(bf16_t*)(ws + F_ACT)};
              pg8::Gemm g{H, (const bf16_t*)(ws + W_GU) + (size_t)layer * 2 * DFF * D, TC, DFF / 128, D, D, (size_t)DFF * D * 2, (size_t)128 * D * 2};
              pg8::gemm_phase(lds, g, e); }
            xcd_barrier(xb);
            { pg8::EpiResid e{xo, xo}; pg8::gemm_phase(lds, mk_gemm((const bf16_t*)(ws + F_ACT), DFF, (const bf16_t*)(ws + W_DOWN) + (size_t)layer * D * DFF, TC, D, DFF), e); }
            xcd_barrier(xb);
        }
        rmsnorm_final(xo, p.in[28], TC);
    }
}

extern "C" void kernel_launch(void* const* d_in, const int* in_sizes, int n_in, void* d_out, int out_size, void* d_ws, size_t ws_size, hipStream_t stream) {
    static int grid_blocks = 0;
    if (!grid_blocks) {
        int dev = 0, cus = 0, per_cu = 0;
        (void)hipGetDevice(&dev);
        (void)hipDeviceGetAttribute(&cus, hipDeviceAttributeMultiprocessorCount, dev);
        (void)hipFuncSetAttribute((const void*)fwd_mega, hipFuncAttributeMaxDynamicSharedMemorySize, (int)LDS_BYTES);
        (void)hipOccupancyMaxActiveBlocksPerMultiprocessor(&per_cu, fwd_mega, THREADS, LDS_BYTES);
        if (per_cu > 1) per_cu = 1;
        if (per_cu < 1) per_cu = 1;
        grid_blocks = cus * per_cu;
    }
    constexpr size_t WS_END = (O_END > E_END ? O_END : E_END) > (F_ACT + (size_t)TC * DFF * 2) ? (O_END > E_END ? O_END : E_END) : (F_ACT + (size_t)TC * DFF * 2);
    if (ws_size < WS_END) { fprintf(stderr, "workspace too small: %zu < %zu\n", ws_size, (size_t)WS_END); return; }
    if (grid_blocks > 256) grid_blocks = 256;
    Params p{};
    for (int i = 0; i < 29; ++i) p.in[i] = (const float*)d_in[i];
    p.out = (float*)d_out;
    p.ws = (char*)d_ws;
    (void)hipMemsetAsync(d_ws, 0, 16384, stream);
    void* args[] = {&p};
    hipError_t e = hipLaunchCooperativeKernel((void*)fwd_mega, dim3(grid_blocks), dim3(THREADS), args, LDS_BYTES, stream);
    if (e != hipSuccess) fprintf(stderr, "cooperative launch failed: %s (grid %d)\n", hipGetErrorString(e), grid_blocks);
}
```

```cpp
#include <hip/hip_runtime.h>
#include <hip/hip_cooperative_groups.h>
#include <cstdio>
#include <cstdint>
namespace cg = cooperative_groups;
#ifndef PROBE_GEMM
#define PROBE_GEMM 1
#endif
#ifndef PROBE_NORM
#define PROBE_NORM 1
#endif
#ifndef PROBE_CROSS
#define PROBE_CROSS 1
#endif
#ifndef PROBE_ATTN
#define PROBE_ATTN 1
#endif

typedef unsigned short bf16_t;
typedef short bf16x8 __attribute__((ext_vector_type(8)));
typedef float f32x16 __attribute__((ext_vector_type(16)));
typedef float f32x2 __attribute__((ext_vector_type(2)));
typedef unsigned u32x4 __attribute__((ext_vector_type(4)));
typedef float f32x4 __attribute__((ext_vector_type(4)));
typedef short s16x4 __attribute__((ext_vector_type(4)));
#define LDS_AS __attribute__((address_space(3)))
typedef __bf16 bf16x2_t __attribute__((ext_vector_type(2)));
#define DI __device__ __forceinline__
#define MFMA(a, b, c) __builtin_amdgcn_mfma_f32_32x32x16_bf16((a), (b), (c), 0, 0, 0)

constexpr int D = 1024, SEQ = 4096, NBATCH = 24, NB = 8  , NCHUNK = NBATCH / NB, TC = NB * SEQ;
constexpr int NMEM = 256, DFF = 2816, EVEN_IN = 2304, ODD_IN = 672, ODD_PAD = 768;
constexpr float EPS = 1e-6f, LOG2E = 1.4426950408889634f;
constexpr int THREADS = 512, NWAVE = THREADS / 64;
constexpr size_t LDS_BYTES = 131072;

constexpr size_t al(size_t x) { return (x + 255) & ~(size_t)255; }
constexpr size_t B_BAR = 0;
constexpr size_t B_NORMS = 16384;
constexpr size_t W_EIN = 32768;
constexpr size_t W_EOUT = W_EIN + al((size_t)EVEN_IN * D * 2);
constexpr size_t W_OIN = W_EOUT + al((size_t)D * D * 2);
constexpr size_t W_UQ = W_OIN + al((size_t)ODD_PAD * D * 2);
constexpr size_t W_UKV = W_UQ + al((size_t)1536 * 384 * 2);
constexpr size_t W_OOUT = W_UKV + al((size_t)2048 * 256 * 2);
constexpr size_t W_CQ = W_OOUT + al((size_t)D * D * 2);
constexpr size_t W_CKV = W_CQ + 2 * al((size_t)D * D * 2);
constexpr size_t W_CO = W_CKV + 2 * al((size_t)2048 * D * 2);
constexpr size_t W_GU = W_CO + 2 * al((size_t)D * D * 2);
constexpr size_t W_DOWN = W_GU + 2 * al((size_t)2 * DFF * D * 2);
constexpr size_t T_AX = W_DOWN + 2 * al((size_t)D * DFF * 2);
constexpr size_t T_LIN = T_AX + al((size_t)SEQ * 32 * 8);
constexpr size_t B_MEMN = T_LIN + al((size_t)SEQ * 16 * 8);
constexpr size_t B_KX = B_MEMN + 2 * al((size_t)NBATCH * NMEM * D * 2);
constexpr size_t B_H = B_KX + 2 * al((size_t)NBATCH * NMEM * 2048 * 2);
constexpr size_t B_MIX = B_H + al((size_t)TC * D * 2);
constexpr size_t B_BIG = B_MIX + al((size_t)TC * D * 2);
constexpr size_t E_QKV = B_BIG;
constexpr size_t E_PARK = E_QKV + al((size_t)TC * EVEN_IN * 2);
constexpr size_t E_END = E_PARK + (size_t)256 * THREADS * 64 * 4;
constexpr size_t O_A = B_BIG;
constexpr size_t O_Q = O_A + al((size_t)TC * ODD_PAD * 2);
constexpr size_t O_KV = O_Q + al((size_t)TC * 1536 * 2);
constexpr size_t O_END = O_KV + al((size_t)TC * 2048 * 2);
constexpr size_t X_Q = B_BIG;
constexpr size_t F_ACT = B_BIG;

struct Params {
    const float* in[29];
    float* out;
    char* ws;
};

DI unsigned pack2(float lo, float hi) { f32x2 v = {lo, hi}; bf16x2_t b = __builtin_convertvector(v, bf16x2_t); return __builtin_bit_cast(unsigned, b); }
DI float bflo(unsigned u) { return __uint_as_float(u << 16); }
DI float bfhi(unsigned u) { return __uint_as_float(u & 0xffff0000u); }
DI int crow(int i, int h) { return (i & 3) + 8 * (i >> 2) + 4 * h; }
DI int swap23(int x) { return (x & ~12) | ((x & 4) << 1) | ((x & 8) >> 1); }
DI int otid() { int t = threadIdx.x; asm volatile("" : "+v"(t)); return t; }
DI float wave_sum(float v) {
#pragma unroll
    for (int o = 32; o >= 1; o >>= 1) v += __shfl_xor(v, o);
    return v;
}


#define XB_TMO      128
#define XB_XCNT(j)  (256  + 64 * (j))
#define XB_XSUB(j)  (1280 + 64 * (j))
#define XB_XGEN(j)  (2304 + 64 * (j))
#define XB_TOP      3328
#define XB_TOPGEN   3392
#define XCD_BAR_WORDS 3456
#define XB_SPIN_CAP (1u << 18)
DI unsigned xb_ld(unsigned* p) { return __hip_atomic_load(p, __ATOMIC_RELAXED, __HIP_MEMORY_SCOPE_AGENT); }
DI unsigned xb_add(unsigned* p, unsigned v) { return __hip_atomic_fetch_add(p, v, __ATOMIC_RELAXED, __HIP_MEMORY_SCOPE_AGENT); }
DI unsigned xb_xcc_id() { return (unsigned)__builtin_amdgcn_s_getreg((3 << 11) | 20) & 0xFu; }
#define XB_SPIN(cond, bar) do { unsigned _sp = 0; while (cond) { __builtin_amdgcn_s_sleep(1); \
    if ((++_sp & 255u) == 0u) { if (xb_ld(&(bar)[XB_TMO])) break; if (_sp > XB_SPIN_CAP) { atomicAdd(&(bar)[XB_TMO], 1u); break; } } } } while (0)
struct XcdBarrier { unsigned* bar; unsigned x; volatile LDS_AS unsigned* st; };
DI XcdBarrier xcd_barrier_post(unsigned* bar, volatile LDS_AS unsigned* st) {
    XcdBarrier b; b.bar = bar; b.x = xb_xcc_id(); b.st = st;
    if (threadIdx.x == 0) (void)xb_add(&bar[XB_XCNT(b.x)], 1u);
    return b;
}
DI void xcd_barrier_complete(unsigned* bar, unsigned x, unsigned& nloc, unsigned& nx) {
    const unsigned G = gridDim.x * gridDim.y * gridDim.z;
    unsigned sum, cnt, mine, sp = 0u;
    for (;;) {
        sum = 0u; cnt = 0u; mine = 0u;
#pragma unroll
        for (unsigned j = 0; j < 16; ++j) { const unsigned c = xb_ld(&bar[XB_XCNT(j)]); sum += c; cnt += (c > 0u) ? 1u : 0u; mine = (j == x) ? c : mine; }
        if (sum == G) break;
        __builtin_amdgcn_s_sleep(1);
        if ((++sp & 255u) == 0u) { if (xb_ld(&bar[XB_TMO])) break; if (sp > XB_SPIN_CAP) { atomicAdd(&bar[XB_TMO], 1u); break; } }
    }
    nloc = mine > 0u ? mine : 1u; nx = cnt > 0u ? cnt : 1u;
}
DI void xcd_barrier(const XcdBarrier& b) {
    asm volatile("s_waitcnt vmcnt(0)" ::: "memory");
    __syncthreads();
    if (threadIdx.x == 0) {
        unsigned* bar = b.bar;
        __builtin_amdgcn_s_waitcnt(0);
        unsigned nloc = b.st[0], nx = b.st[1];
        if (nloc == 0u) { xcd_barrier_complete(bar, b.x, nloc, nx); b.st[0] = nloc; b.st[1] = nx; }
        const unsigned old = xb_add(&bar[XB_XSUB(b.x)], 1u);
        const unsigned gen = old / nloc;
        if (old + 1u == (gen + 1u) * nloc) {
            __builtin_amdgcn_fence(__ATOMIC_RELEASE, "agent");
            asm volatile("s_waitcnt vmcnt(0)" ::: "memory");
            const unsigned og = xb_add(&bar[XB_TOP], 1u);
            const unsigned tg = og / nx;
            if (og + 1u == (tg + 1u) * nx) xb_add(&bar[XB_TOPGEN], 1u);
            else XB_SPIN(xb_ld(&bar[XB_TOPGEN]) == tg, bar);
            __builtin_amdgcn_fence(__ATOMIC_ACQUIRE, "agent");
            xb_add(&bar[XB_XGEN(b.x)], 1u);
            asm volatile("s_waitcnt vmcnt(0)" ::: "memory");
        } else {
            XB_SPIN(xb_ld(&bar[XB_XGEN(b.x)]) == gen, bar);
            __builtin_amdgcn_fence(__ATOMIC_ACQUIRE, "agent");
            asm volatile("s_waitcnt vmcnt(0)" ::: "memory");
        }
    }
    __syncthreads();
}

DI void convert_weight(const float* __restrict__ src, bf16_t* __restrict__ dst, int K, int N, int Npad, char* smem, int slo = 0, int shi = 0, float scale = 1.0f) {
    float* t = (float*)smem;
    const int tid = otid();
    const int nkt = K / 64, nnt = Npad / 64;
    for (int tile = blockIdx.x; tile < nkt * nnt; tile += gridDim.x) {
        const int k0 = (tile / nnt) * 64, n0 = (tile % nnt) * 64;
#pragma unroll
        for (int i = 0; i < 8; ++i) {
            const int k = i * 8 + (tid >> 6), n = tid & 63;
            const float sc_ = (n0 + n >= slo && n0 + n < shi) ? scale : 1.0f;
            t[k * 65 + n] = (n0 + n < N) ? src[(size_t)(k0 + k) * N + n0 + n] * sc_ : 0.f;
        }
        __syncthreads();
#pragma unroll
        for (int i = 0; i < 4; ++i) {
            const int n = i * 16 + (tid >> 5), k = (tid & 31) * 2;
            *(unsigned*)(dst + (size_t)(n0 + n) * K + k0 + k) = pack2(t[k * 65 + n], t[(k + 1) * 65 + n]);
        }
        __syncthreads();
    }
}

__device__ const float kFreq[16] = {1.000000000e+00f, 5.623413324e-01f, 3.162277639e-01f, 1.778279394e-01f, 1.000000015e-01f, 5.623413250e-02f, 3.162277490e-02f, 1.778279431e-02f,
                                    9.999999776e-03f, 5.623413250e-03f, 3.162277630e-03f, 1.778279431e-03f, 1.000000047e-03f, 5.623413017e-04f, 3.162277571e-04f, 1.778279402e-04f};
DI float2 sincos_acc(float ang) {
    const double x = (double)ang;
    const double n = __builtin_rint(x * 0.15915494309189535);
    double r = __builtin_fma(-n, 6.283185307179586, x);
    r = __builtin_fma(-n, 2.4492935982947064e-16, r);
    const double r2 = r * r;
    double s = 1.0, c = 1.0;
#pragma unroll
    for (int k = 13; k >= 1; --k) {
        s = 1.0 - r2 * s * (1.0 / (double)((2 * k) * (2 * k + 1)));
        c = 1.0 - r2 * c * (1.0 / (double)((2 * k - 1) * (2 * k)));
    }
    return make_float2((float)c, (float)(r * s));
}
DI void build_tables(float2* ax, float2* lin) {
    const int gt = blockIdx.x * THREADS + otid(), gs = gridDim.x * THREADS;
    for (int e = gt; e < SEQ * 32; e += gs) {
        const int pos = e >> 5, p = e & 31;
        const float base = (p < 16) ? (float)(pos >> 6) : (float)(pos & 63);
        ax[e] = sincos_acc(base * kFreq[p & 15]);
    }
    for (int e = gt; e < SEQ * 16; e += gs) {
        const int pos = e >> 4, p = e & 15;
        lin[e] = sincos_acc((float)pos * kFreq[p]);
    }
}

DI void rmsnorm_rows(const float* __restrict__ src, const float* __restrict__ g, bf16_t* __restrict__ dst, int nrows) {
    const int tid_ = otid(), lane = tid_ & 63, wv = blockIdx.x * NWAVE + (tid_ >> 6), nw = gridDim.x * NWAVE;
    for (int row = wv; row < nrows; row += nw) {
        const float4* s = (const float4*)(src + (size_t)row * D);
        float4 v[4]; float ss = 0.f;
#pragma unroll
        for (int i = 0; i < 4; ++i) { v[i] = s[i * 64 + lane]; ss += v[i].x * v[i].x + v[i].y * v[i].y + v[i].z * v[i].z + v[i].w * v[i].w; }
        ss = wave_sum(ss);
        const float rstd = rsqrtf(ss * (1.0f / D) + EPS);
#pragma unroll
        for (int i = 0; i < 4; ++i) {
            const float4 gg = ((const float4*)g)[i * 64 + lane];
            uint2 o; o.x = pack2(v[i].x * rstd * gg.x, v[i].y * rstd * gg.y); o.y = pack2(v[i].z * rstd * gg.z, v[i].w * rstd * gg.w);
            *(uint2*)(dst + (size_t)row * D + (i * 64 + lane) * 4) = o;
        }
    }
}
DI void rmsnorm_final(float* __restrict__ x, const float* __restrict__ g, int nrows) {
    const int tid_ = otid(), lane = tid_ & 63, wv = blockIdx.x * NWAVE + (tid_ >> 6), nw = gridDim.x * NWAVE;
    for (int row = wv; row < nrows; row += nw) {
        float4* s = (float4*)(x + (size_t)row * D);
        float4 v[4]; float ss = 0.f;
#pragma unroll
        for (int i = 0; i < 4; ++i) { v[i] = s[i * 64 + lane]; ss += v[i].x * v[i].x + v[i].y * v[i].y + v[i].z * v[i].z + v[i].w * v[i].w; }
        ss = wave_sum(ss);
        const float rstd = rsqrtf(ss * (1.0f / D) + EPS);
#pragma unroll
        for (int i = 0; i < 4; ++i) {
            const float4 gg = ((const float4*)g)[i * 64 + lane];
            float4 o; o.x = v[i].x * rstd * gg.x; o.y = v[i].y * rstd * gg.y; o.z = v[i].z * rstd * gg.z; o.w = v[i].w * rstd * gg.w;
            s[i * 64 + lane] = o;
        }
    }
}

DI void kprep_even(bf16_t* __restrict__ qkv, const float* __restrict__ gk, const float2* __restrict__ ax) {
    const int tid_ = otid(), gt = blockIdx.x * THREADS + tid_, gs = gridDim.x * THREADS;
    const int p = tid_ & 31;
    for (int v = gt >> 5; v < TC * 2; v += gs >> 5) {
        const int tok = v >> 1, kvh = v & 1;
        unsigned* ptr = (unsigned*)(qkv + (size_t)tok * EVEN_IN + 512 + kvh * 64 + 2 * p);
        const unsigned u = *ptr;
        const float x0 = bflo(u), x1 = bfhi(u);
        float ss = x0 * x0 + x1 * x1;
#pragma unroll
        for (int o = 16; o >= 1; o >>= 1) ss += __shfl_xor(ss, o);
        const float rstd = rsqrtf(ss * (1.0f / 64) + EPS);
        const float y0 = x0 * rstd * gk[2 * p], y1 = x1 * rstd * gk[2 * p + 1];
        const float2 cs = ax[(tok & (SEQ - 1)) * 32 + p];
        *ptr = pack2(y0 * cs.x - y1 * cs.y, y0 * cs.y + y1 * cs.x);
    }
}
DI void prep_odd(bf16_t* __restrict__ a, const float* __restrict__ gq, const float* __restrict__ gkv, const float2* __restrict__ lin) {
    const int tid_ = otid(), lane = tid_ & 63, wv = blockIdx.x * NWAVE + (tid_ >> 6), nw = gridDim.x * NWAVE;
    for (int row = wv; row < TC; row += nw) {
        unsigned* base = (unsigned*)(a + (size_t)row * ODD_PAD);
        unsigned uq[3], uk[2]; float sq = 0.f, sk = 0.f;
#pragma unroll
        for (int i = 0; i < 3; ++i) { uq[i] = base[i * 64 + lane]; const float a0 = bflo(uq[i]), a1 = bfhi(uq[i]); sq += a0 * a0 + a1 * a1; }
#pragma unroll
        for (int i = 0; i < 2; ++i) { uk[i] = base[192 + i * 64 + lane]; const float a0 = bflo(uk[i]), a1 = bfhi(uk[i]); sk += a0 * a0 + a1 * a1; }
        sq = wave_sum(sq); sk = wave_sum(sk);
        const float rq = rsqrtf(sq * (1.0f / 384) + EPS), rk = rsqrtf(sk * (1.0f / 256) + EPS);
#pragma unroll
        for (int i = 0; i < 3; ++i) { const int c = (i * 64 + lane) * 2; base[i * 64 + lane] = pack2(bflo(uq[i]) * rq * gq[c], bfhi(uq[i]) * rq * gq[c + 1]); }
#pragma unroll
        for (int i = 0; i < 2; ++i) { const int c = (i * 64 + lane) * 2; base[192 + i * 64 + lane] = pack2(bflo(uk[i]) * rk * gkv[c], bfhi(uk[i]) * rk * gkv[c + 1]); }
        if (lane < 16) {
            const unsigned u = base[320 + lane];
            const float x0 = bflo(u), x1 = bfhi(u);
            const float2 cs = lin[(row & (SEQ - 1)) * 16 + lane];
            base[320 + lane] = pack2(x0 * cs.x - x1 * cs.y, x0 * cs.y + x1 * cs.x);
        }
    }
}


DI void normmax_even(const bf16_t* __restrict__ qkv, unsigned* __restrict__ nd, char* smem) {
    const int tid = otid(), lane = tid & 63, w = tid >> 6;
    float* red = (float*)smem;
    for (int item = blockIdx.x; item < NB * 32; item += gridDim.x) {
        const int b = item & 7, slab = item >> 3;
        float mq = 0.f, mk = 0.f;
        for (int i = 0; i < 16; ++i) {
            const bf16_t* row = qkv + ((size_t)b * SEQ + slab * 128 + w * 16 + i) * EVEN_IN;
            const u32x4 uq = *(const u32x4*)(row + 768 + 8 * lane), uk = *(const u32x4*)(row + 1280 + 8 * lane);
            float sq = 0.f, sk = 0.f;
#pragma unroll
            for (int j = 0; j < 4; ++j) { const float a0 = bflo(uq[j]), a1 = bfhi(uq[j]), b0 = bflo(uk[j]), b1 = bfhi(uk[j]); sq += a0 * a0 + a1 * a1; sk += b0 * b0 + b1 * b1; }
#pragma unroll
            for (int o = 1; o <= 4; o <<= 1) { sq += __shfl_xor(sq, o); sk += __shfl_xor(sk, o); }
            mq = fmaxf(mq, sq); mk = fmaxf(mk, sk);
        }
        if ((lane & 7) == 0) { red[(w * 8 + (lane >> 3)) * 2] = mq; red[(w * 8 + (lane >> 3)) * 2 + 1] = mk; }
        __syncthreads();
        if (tid < 16) {
            float m = 0.f;
#pragma unroll
            for (int ww = 0; ww < NWAVE; ++ww) m = fmaxf(m, red[ww * 16 + tid]);
            atomicMax(nd + b * 16 + tid, __float_as_uint(m));
        }
        __syncthreads();
    }
}
DI void normmax_mla(const bf16_t* __restrict__ qb, const bf16_t* __restrict__ kv, const bf16_t* __restrict__ a, unsigned* __restrict__ nmx, char* smem) {
    const int tid = otid(), lane = tid & 63, w = tid >> 6;
    float* red = (float*)smem;
    for (int item = blockIdx.x; item < NB * 32; item += gridDim.x) {
        const int b = item & 7, slab = item >> 3;
        float mq = 0.f, mk = 0.f;
        for (int i = 0; i < 16; ++i) {
            const size_t r = (size_t)b * SEQ + slab * 128 + w * 16 + i;
            float sq = 0.f, sk = 0.f, sr = 0.f;
#pragma unroll
            for (int c = 0; c < 3; ++c) {
                const u32x4 u = *(const u32x4*)(qb + r * 1536 + 24 * lane + 8 * c);
#pragma unroll
                for (int j = 0; j < 4; ++j) { const float a0 = bflo(u[j]), a1 = bfhi(u[j]); sq += a0 * a0 + a1 * a1; }
            }
#pragma unroll
            for (int c = 0; c < 4; ++c) {
                const u32x4 u = *(const u32x4*)(kv + r * 2048 + 32 * lane + 8 * c);
#pragma unroll
                for (int j = 0; j < 4; ++j) { const float a0 = bflo(u[j]), a1 = bfhi(u[j]); sk += a0 * a0 + a1 * a1; }
            }
#pragma unroll
            for (int c = 0; c < 4; ++c) {
                const u32x4 u = *(const u32x4*)(a + r * ODD_PAD + 640 + 8 * c);
#pragma unroll
                for (int j = 0; j < 4; ++j) { const float a0 = bflo(u[j]), a1 = bfhi(u[j]); sr += a0 * a0 + a1 * a1; }
            }
            sq += __shfl_xor(sq, 1); sq += __shfl_xor(sq, 2);
            sk += __shfl_xor(sk, 1);
            mq = fmaxf(mq, sq); mk = fmaxf(mk, sk + sr);
        }
        if ((lane & 3) == 0) { red[(w * 16 + (lane >> 2)) * 2] = mq; red[(w * 16 + (lane >> 2)) * 2 + 1] = mk; }
        __syncthreads();
        if (tid < 32) {
            float m = 0.f;
#pragma unroll
            for (int ww = 0; ww < NWAVE; ++ww) m = fmaxf(m, red[ww * 32 + tid]);
            atomicMax(nmx + b * 32 + tid, __float_as_uint(m));
        }
        __syncthreads();
    }
}

namespace pg8 {
constexpr int BM = 256, BK = 64, HALF = 128, HTB = HALF * BK * 2, NXCD = 8, WGM = 8;
DI int lds_byte(int r, int c) { const int st = (r >> 4) * 2 + (c >> 5), rr = r & 15, cc = c & 31, ob = rr * 64 + cc * 2; return st * 1024 + (ob ^ (((ob >> 9) & 1) << 5)); }
DI void stage_rc(int b, int& R, int& C) { const int st = b / 1024, sb = b % 1024, swz = sb ^ (((sb >> 9) & 1) << 5); R = (st >> 1) * 16 + swz / 64; C = (st & 1) * 32 + (swz % 64) / 2; }
DI int perm32(int rho) { const int n = rho >> 4, i = rho & 15; return 8 * (i >> 2) + 4 * n + (i & 3); }
struct Unit { int pm, pn; };
struct Gemm { const bf16_t* A; const bf16_t* Bt; int M, NT, K, lda; size_t hstepB, tstepB; };
struct StaticOrder {
    int nM, nN, nwg, G, c;
    DI void init(int M, int NT, int G_, int c_) { nM = M / BM; nN = NT; nwg = nM * nN; G = G_; c = c_; }
    DI bool next(int i, Unit& u) const {
        const long L = (long)i * G + c; if (L >= nwg) return false;
        int wgid = (int)L; { const int q = nwg / NXCD, r = nwg % NXCD, xcd = wgid % NXCD, off = wgid / NXCD; wgid = (xcd < r ? xcd * (q + 1) : r * (q + 1) + (xcd - r) * q) + off; }
        const int nig = WGM * nN, gid = wgid / nig, fm = gid * WGM, gsz = (nM - fm) < WGM ? (nM - fm) : WGM;
        u.pm = fm + ((wgid % nig) % gsz); u.pn = (wgid % nig) / gsz; return true;
    }
};
template <class Epi>
DI void gemm_phase(LDS_AS unsigned char* lds, const Gemm g, const Epi& E) {
    StaticOrder S; S.init(g.M, g.NT, gridDim.x, blockIdx.x);
    const int tid = otid(), wid = __builtin_amdgcn_readfirstlane(tid >> 6), lane = tid & 63, wr = wid >> 2, wc = wid & 3, fr = lane & 15, fq = lane >> 4;
    const int K = g.K, nt = K / BK;
    unsigned voffA[2], voffB[2];
#pragma unroll
    for (int i = 0; i < 2; ++i) { int R, C; stage_rc(tid * 16 + i * 8192, R, C); const int Rb = Epi::PERM ? ((R & ~31) + perm32(R & 31)) : R;
        voffA[i] = (unsigned)(R * g.lda + C) * 2u; voffB[i] = (unsigned)(Rb * K + C) * 2u; }
    const size_t kstep = (size_t)(BK * 2);
    const size_t hstepA = (size_t)HALF * g.lda * 2, tstepA = 2 * hstepA, hstepB = g.hstepB, tstepB = g.tstepB;
    const unsigned ldsw = (unsigned)wid * 1024u;
    const int aoff = lds_byte(wr * 64 + fr, fq * 8), boff = lds_byte(wc * 32 + fr, fq * 8);
#define PG8_SA(b, h) (((b) * 2 + (h)) * HTB)
#define PG8_SB(b, h) ((4 + (b) * 2 + (h)) * HTB)
#define PG8_STAGE(bufoff, gbase, voff) do { _Pragma("unroll") for (int _i = 0; _i < 2; ++_i) \
        __builtin_amdgcn_global_load_lds((const unsigned*)((const char*)(gbase) + (voff)[_i]), (LDS_AS unsigned*)(lds + (bufoff) + ldsw + _i * 8192), 16, 0, 0); } while (0)
#define PG8_LDA(dst, b, h) do { _Pragma("unroll") for (int m = 0; m < 4; ++m) _Pragma("unroll") for (int k = 0; k < 2; ++k) dst[m][k] = *(const LDS_AS bf16x8*)(lds + PG8_SA(b, h) + aoff + m * 2048 + k * 1024); } while (0)
#define PG8_LDB(dst, b, h) do { _Pragma("unroll") for (int n = 0; n < 2; ++n) _Pragma("unroll") for (int k = 0; k < 2; ++k) dst[n][k] = *(const LDS_AS bf16x8*)(lds + PG8_SB(b, h) + boff + n * 2048 + k * 1024); } while (0)
#define PG8_MMA(ai, bj, At, Bt) do { __builtin_amdgcn_s_setprio(1); _Pragma("unroll") for (int m = 0; m < 4; ++m) _Pragma("unroll") for (int n = 0; n < 2; ++n) _Pragma("unroll") for (int k = 0; k < 2; ++k) \
        acc[ai][bj][m][n] = __builtin_amdgcn_mfma_f32_16x16x32_bf16(Bt[n][k], At[m][k], acc[ai][bj][m][n], 0, 0, 0); __builtin_amdgcn_s_setprio(0); } while (0)
#define PG8_WAIT_V(n) asm volatile("s_waitcnt vmcnt(" #n ")" ::: "memory")
#define PG8_WAIT_L(n) asm volatile("s_waitcnt lgkmcnt(" #n ")" ::: "memory")
#define PG8_BAR __builtin_amdgcn_s_barrier()
#define PG8_SCHED __builtin_amdgcn_sched_barrier(0)
    Unit cur, nxt; int ui = 0;
    if (!S.next(0, cur)) return;
    f32x4 acc[2][2][4][2];
#pragma unroll
    for (int a = 0; a < 2; ++a)
#pragma unroll
        for (int b = 0; b < 2; ++b)
#pragma unroll
            for (int m = 0; m < 4; ++m)
#pragma unroll
                for (int n = 0; n < 2; ++n) acc[a][b][m][n] = (f32x4){0.f, 0.f, 0.f, 0.f};
    bf16x8 At[4][2], B0[2][2], B1[2][2];
    const char* cA = (const char*)g.A + (size_t)cur.pm * tstepA; const char* cB = (const char*)g.Bt + (size_t)cur.pn * tstepB;
    PG8_STAGE(PG8_SB(0, 0), cB, voffB); PG8_STAGE(PG8_SA(0, 0), cA, voffA); PG8_STAGE(PG8_SB(0, 1), cB + hstepB, voffB); PG8_STAGE(PG8_SA(0, 1), cA + hstepA, voffA);
    if (wr == 1) PG8_BAR;
    PG8_WAIT_V(4); PG8_BAR;
    PG8_STAGE(PG8_SB(1, 0), cB + kstep, voffB); PG8_STAGE(PG8_SA(1, 0), cA + kstep, voffA); PG8_STAGE(PG8_SB(1, 1), cB + hstepB + kstep, voffB);
    PG8_WAIT_V(6); PG8_BAR;
    for (;;) {
        const bool has_next = S.next(ui + 1, nxt);
        const char* nA = has_next ? (const char*)g.A + (size_t)nxt.pm * tstepA : cA; const char* nB = has_next ? (const char*)g.Bt + (size_t)nxt.pn * tstepB : cB;
        for (int t = 0; t < nt; t += 2) {
            const bool last = (t == nt - 2);
            const char* a1 = cA + (size_t)(t + 1) * kstep;
            const char* a2 = last ? nA : cA + (size_t)(t + 2) * kstep; const char* b2 = last ? nB : cB + (size_t)(t + 2) * kstep;
            const char* a3 = a2 + kstep; const char* b3 = b2 + kstep;
            PG8_LDB(B0, 0, 0); PG8_SCHED; PG8_LDA(At, 0, 0); PG8_STAGE(PG8_SA(1, 1), a1 + hstepA, voffA);
            PG8_WAIT_L(8); PG8_BAR; PG8_WAIT_L(0); PG8_MMA(0, 0, At, B0); PG8_BAR; PG8_SCHED;
            PG8_LDB(B1, 0, 1); PG8_STAGE(PG8_SB(0, 0), b2, voffB);
            PG8_BAR; PG8_WAIT_L(0); PG8_MMA(0, 1, At, B1); PG8_BAR;
            PG8_LDA(At, 0, 1); PG8_STAGE(PG8_SA(0, 0), a2, voffA);
            PG8_BAR; PG8_WAIT_L(0); PG8_MMA(1, 0, At, B0); PG8_BAR; PG8_SCHED;
            PG8_STAGE(PG8_SB(0, 1), b2 + hstepB, voffB);
            PG8_WAIT_V(6); PG8_BAR; PG8_MMA(1, 1, At, B1); PG8_BAR;
            PG8_LDB(B0, 1, 0); PG8_SCHED; PG8_LDA(At, 1, 0); PG8_STAGE(PG8_SA(0, 1), a2 + hstepA, voffA);
            PG8_WAIT_L(8); PG8_BAR; PG8_WAIT_L(0); PG8_MMA(0, 0, At, B0); PG8_BAR; PG8_SCHED;
            PG8_LDB(B1, 1, 1); PG8_STAGE(PG8_SB(1, 0), b3, voffB);
            PG8_BAR; PG8_WAIT_L(0); PG8_MMA(0, 1, At, B1); PG8_BAR;
            PG8_LDA(At, 1, 1); PG8_STAGE(PG8_SA(1, 0), a3, voffA);
            PG8_BAR; PG8_WAIT_L(0); PG8_MMA(1, 0, At, B0); PG8_BAR; PG8_SCHED;
            PG8_STAGE(PG8_SB(1, 1), b3 + hstepB, voffB);
            PG8_WAIT_V(6); PG8_BAR; PG8_MMA(1, 1, At, B1); PG8_BAR;
        }
        E(acc, cur, wr, wc, fr, fq);
        if (!has_next) break;
#pragma unroll
        for (int a = 0; a < 2; ++a)
#pragma unroll
            for (int b = 0; b < 2; ++b)
#pragma unroll
                for (int m = 0; m < 4; ++m)
#pragma unroll
                    for (int n = 0; n < 2; ++n) acc[a][b][m][n] = (f32x4){0.f, 0.f, 0.f, 0.f};
        cur = nxt; cA = nA; cB = nB; ++ui;
    }
    PG8_WAIT_V(0);
    if (wr == 0) PG8_BAR;
    PG8_BAR;
#undef PG8_SA
#undef PG8_SB
#undef PG8_STAGE
#undef PG8_LDA
#undef PG8_LDB
#undef PG8_MMA
#undef PG8_WAIT_V
#undef PG8_WAIT_L
#undef PG8_BAR
#undef PG8_SCHED
}
struct EpiResid {
    static constexpr bool PERM = true;
    const float* res; float* out;
    DI void operator()(const f32x4 (&acc)[2][2][4][2], const Unit& u, int wr, int wc, int fr, int fq) const {
        const int row0 = u.pm * BM + wr * 64 + fr, col0 = u.pn * BM + wc * 32 + 8 * fq;
#pragma unroll
        for (int ai = 0; ai < 2; ++ai)
#pragma unroll
            for (int m = 0; m < 4; ++m) {
                const size_t rb = (size_t)(row0 + ai * HALF + m * 16) * D + col0;
#pragma unroll
                for (int bj = 0; bj < 2; ++bj)
#pragma unroll
                    for (int n = 0; n < 2; ++n) { const size_t idx = rb + bj * HALF + n * 4; *(f32x4*)(out + idx) = *(const f32x4*)(res + idx) + acc[ai][bj][m][n]; }
            }
    }
};
struct EpiBf16 {
    static constexpr bool PERM = true;
    bf16_t* out; int ld;
    DI void operator()(const f32x4 (&acc)[2][2][4][2], const Unit& u, int wr, int wc, int fr, int fq) const {
        const int row0 = u.pm * BM + wr * 64 + fr, col0 = u.pn * BM + wc * 32 + 8 * fq;
#pragma unroll
        for (int ai = 0; ai < 2; ++ai)
#pragma unroll
            for (int m = 0; m < 4; ++m) {
                bf16_t* rowp = out + (size_t)(row0 + ai * HALF + m * 16) * ld + col0;
#pragma unroll
                for (int bj = 0; bj < 2; ++bj) {
                    const f32x4 v0 = acc[ai][bj][m][0], v1 = acc[ai][bj][m][1];
                    u32x4 w; w.x = pack2(v0[0], v0[1]); w.y = pack2(v0[2], v0[3]); w.z = pack2(v1[0], v1[1]); w.w = pack2(v1[2], v1[3]);
                    *(u32x4*)(rowp + bj * HALF) = w;
                }
            }
    }
};
struct EpiSwiglu {
    static constexpr bool PERM = true;
    bf16_t* act;
    DI void operator()(const f32x4 (&acc)[2][2][4][2], const Unit& u, int wr, int wc, int fr, int fq) const {
        const int row0 = u.pm * BM + wr * 64 + fr, col0 = u.pn * HALF + wc * 32 + 8 * fq;
#pragma unroll
        for (int ai = 0; ai < 2; ++ai)
#pragma unroll
            for (int m = 0; m < 4; ++m) {
                float v[8];
#pragma unroll
                for (int n = 0; n < 2; ++n)
#pragma unroll
                    for (int j = 0; j < 4; ++j) { const float gg = acc[ai][0][m][n][j], uu = acc[ai][1][m][n][j]; v[4 * n + j] = gg * uu * __builtin_amdgcn_rcpf(1.0f + __builtin_amdgcn_exp2f(-gg * LOG2E)); }
                u32x4 w; w.x = pack2(v[0], v[1]); w.y = pack2(v[2], v[3]); w.z = pack2(v[4], v[5]); w.w = pack2(v[6], v[7]);
                *(u32x4*)(act + (size_t)(row0 + ai * HALF + m * 16) * DFF + col0) = w;
            }
    }
};
}
DI pg8::Gemm mk_gemm(const bf16_t* A, int lda, const bf16_t* Bt, int M, int N, int K) { return pg8::Gemm{A, Bt, M, N / 256, K, lda, (size_t)128 * K * 2, (size_t)256 * K * 2}; }

template <int DQK, int DV, int KT, int QMODE, bool ALIBI, bool NOMAX>
DI void attn_core(const bf16_t* __restrict__ q, int ldq, const bf16_t* __restrict__ k, int ldk, const bf16_t* __restrict__ k2, int ldk2,
                  const bf16_t* __restrict__ v, int ldv, int nkeys, int qpos0, float qscale, float slope2,
                  const float* __restrict__ qg, const float2* __restrict__ tab, char* smem, f32x16 (&o)[DV / 32], float& lsum) {
    constexpr int KROW = DQK * 2 + 16, VROW = DV * 2 + 64  , KBYTES = KT * KROW, VBYTES = KT * VROW;
    constexpr int KCPR = DQK / 8  , KTOT = KT * KCPR, NKC = (KTOT + THREADS - 1) / THREADS, VCPR = DV / 8, VTOT = KT * VCPR, NVC = (VTOT + THREADS - 1) / THREADS;
    constexpr int NST = KT / 32, NKS = DQK / 16, NDT = DV / 32;
    static_assert(2 * (KBYTES + VBYTES) <= (int)LDS_BYTES, "lds");
    const int tid = otid(), lane = tid & 63, w = tid >> 6, r = lane & 31, h = lane >> 5;
    const int qpos = qpos0 + 32 * w + r;
    bf16x8 qf[NKS];
    {
        const bf16_t* qrow = q + (size_t)(32 * w + r) * ldq + 8 * h;
        u32x4 raw[NKS];
#pragma unroll
        for (int s = 0; s < NKS; ++s) raw[s] = *(const u32x4*)(qrow + 16 * s);
        if (QMODE == 1) {
            float ss = 0.f;
#pragma unroll
            for (int s = 0; s < NKS; ++s) {
                const unsigned u[4] = {raw[s].x, raw[s].y, raw[s].z, raw[s].w};
#pragma unroll
                for (int j = 0; j < 4; ++j) { const float a0 = bflo(u[j]), a1 = bfhi(u[j]); ss += a0 * a0 + a1 * a1; }
            }
            ss += __shfl_xor(ss, 32);
            const float rstd = rsqrtf(ss * (1.0f / 64) + EPS) * qscale;
#pragma unroll
            for (int s = 0; s < NKS; ++s) {
                unsigned u[4] = {raw[s].x, raw[s].y, raw[s].z, raw[s].w};
#pragma unroll
                for (int j = 0; j < 4; ++j) {
                    const int d0 = 16 * s + 8 * h + 2 * j;
                    const float y0 = bflo(u[j]) * rstd * qg[d0], y1 = bfhi(u[j]) * rstd * qg[d0 + 1];
                    const float2 cs = tab[qpos * 32 + (d0 >> 1)];
                    u[j] = pack2(y0 * cs.x - y1 * cs.y, y0 * cs.y + y1 * cs.x);
                }
                raw[s] = u32x4{u[0], u[1], u[2], u[3]};
            }
        } else if (QMODE == 2) {
#pragma unroll
            for (int s = 4; s < NKS; ++s) {
                unsigned u[4] = {raw[s].x, raw[s].y, raw[s].z, raw[s].w};
#pragma unroll
                for (int j = 0; j < 4; ++j) {
                    const int p = 8 * (s - 4) + 4 * h + j;
                    const float y0 = bflo(u[j]), y1 = bfhi(u[j]);
                    const float2 cs = tab[qpos * 16 + p];
                    u[j] = pack2(y0 * cs.x - y1 * cs.y, y0 * cs.y + y1 * cs.x);
                }
                raw[s] = u32x4{u[0], u[1], u[2], u[3]};
            }
        }
#pragma unroll
        for (int s = 0; s < NKS; ++s) qf[s] = __builtin_bit_cast(bf16x8, raw[s]);
    }
    u32x4 rk[NKC], rv[NVC];
    char* const kbuf = smem;
    char* const vbuf = smem + 2 * KBYTES;
#define ATT_GLOADK(key0_)                                                                                             \
    {                                                                                                                 \
        _Pragma("unroll") for (int i = 0; i < NKC; ++i) {                                                             \
            const int cid = tid + THREADS * i, key = cid / KCPR, cc = cid - key * KCPR;                               \
            if (KTOT % THREADS == 0 || cid < KTOT) {                                                                  \
                const bf16_t* src;                                                                                    \
                if (QMODE == 2 && cc >= 8) src = k2 + (size_t)((key0_) + key) * ldk2 + (cc - 8) * 8;                   \
                else src = k + (size_t)((key0_) + key) * ldk + cc * 8;                                                \
                rk[i] = *(const u32x4*)src;                                                                           \
            }                                                                                                         \
        }                                                                                                             \
    }
#define ATT_GLOADV(key0_)                                                                                             \
    {                                                                                                                 \
        _Pragma("unroll") for (int i = 0; i < NVC; ++i) {                                                             \
            const int cid = tid + THREADS * i, key = cid / VCPR, cc = cid - key * VCPR;                               \
            if (VTOT % THREADS == 0 || cid < VTOT) rv[i] = *(const u32x4*)(v + (size_t)((key0_) + key) * ldv + cc * 8); \
        }                                                                                                             \
    }
#define ATT_LSTOREK(buf_)                                                                                             \
    {                                                                                                                 \
        _Pragma("unroll") for (int i = 0; i < NKC; ++i) {                                                             \
            const int cid = tid + THREADS * i, key = cid / KCPR, cc = cid - key * KCPR;                               \
            if (KTOT % THREADS == 0 || cid < KTOT) *(u32x4*)(kbuf + (buf_) * KBYTES + key * KROW + cc * 16) = rk[i];  \
        }                                                                                                             \
    }
#define ATT_LSTOREV(buf_)                                                                                             \
    {                                                                                                                 \
        _Pragma("unroll") for (int i = 0; i < NVC; ++i) {                                                             \
            const int cid = tid + THREADS * i, key = cid / VCPR, cc = cid - key * VCPR;                               \
            if (VTOT % THREADS == 0 || cid < VTOT) *(u32x4*)(vbuf + (buf_) * VBYTES + key * VROW + cc * 16) = rv[i];  \
        }                                                                                                             \
    }
#define ATT_QK(buf_, X_)                                                                                              \
    {                                                                                                                 \
        const char* kb_ = kbuf + (buf_) * KBYTES + r * KROW + h * 16;                                                 \
        _Pragma("unroll") for (int st = 0; st < NST; ++st) {                                                          \
            X_[st] = MFMA(*(const bf16x8*)(kb_ + 32 * st * KROW), qf[0], zero16);                                     \
            _Pragma("unroll") for (int ks = 1; ks < NKS; ++ks) X_[st] = MFMA(*(const bf16x8*)(kb_ + 32 * st * KROW + ks * 32), qf[ks], X_[st]); \
        }                                                                                                             \
    }
#define ATT_SMPV(t_, vb_, X_)                                                                                         \
    {                                                                                                                 \
        if (NOMAX) {                                                                                                  \
            const float dqn = (float)(qpos - ((t_) * KT + 4 * h));                                                    \
            _Pragma("unroll") for (int st = 0; st < NST; ++st)                                                        \
                _Pragma("unroll") for (int i = 0; i < 16; ++i) {                                                      \
                    float xv_ = X_[st][i];                                                                            \
                    if (ALIBI) xv_ = __builtin_fmaf(-slope2, fabsf(dqn - (float)(32 * st + (i & 3) + 8 * (i >> 2))), xv_); \
                    X_[st][i] = __builtin_amdgcn_exp2f(xv_);                                                          \
                    if (!ROWSUM_MFMA) lacc += X_[st][i];                                                              \
                }                                                                                                     \
        } else {                                                                                                      \
            float mx = -1e30f;                                                                                        \
            const float dq = (float)(qpos - ((t_) * KT + 4 * h));                                                     \
            _Pragma("unroll") for (int st = 0; st < NST; ++st)                                                        \
                _Pragma("unroll") for (int i = 0; i < 16; ++i) {                                                      \
                    if (ALIBI) X_[st][i] = __builtin_fmaf(-slope2, fabsf(dq - (float)(32 * st + (i & 3) + 8 * (i >> 2))), X_[st][i]); \
                    mx = fmaxf(mx, X_[st][i]);                                                                        \
                }                                                                                                     \
            mx = fmaxf(mx, __shfl_xor(mx, 32));                                                                       \
            const float mn = fmaxf(m, mx);                                                                            \
            const float alpha = __builtin_amdgcn_exp2f(m - mn);                                                       \
            m = mn;                                                                                                   \
            float rs_ = 0.f;                                                                                          \
            _Pragma("unroll") for (int st = 0; st < NST; ++st)                                                        \
                _Pragma("unroll") for (int i = 0; i < 16; ++i) { X_[st][i] = __builtin_amdgcn_exp2f(X_[st][i] - mn); if (!ROWSUM_MFMA) rs_ += X_[st][i]; } \
            if (__any(alpha != 1.0f)) {                                                                               \
                _Pragma("unroll") for (int dt = 0; dt < NDT; ++dt)                                                    \
                    _Pragma("unroll") for (int i = 0; i < 16; ++i) o[dt][i] *= alpha;                                 \
                _Pragma("unroll") for (int i = 0; i < 16; ++i) ol[i] *= alpha;                                        \
            }                                                                                                         \
            if (!ROWSUM_MFMA) lacc = lacc * alpha + rs_;                                                              \
        }                                                                                                             \
        const char* vbp_ = vbuf + (vb_) * VBYTES + vlane;                                                             \
        _Pragma("unroll") for (int st = 0; st < NST; ++st)                                                            \
            _Pragma("unroll") for (int s = 0; s < 2; ++s) {                                                           \
                u32x4 pk;                                                                                             \
                pk.x = pack2(X_[st][8 * s + 0], X_[st][8 * s + 1]); pk.y = pack2(X_[st][8 * s + 2], X_[st][8 * s + 3]); \
                pk.z = pack2(X_[st][8 * s + 4], X_[st][8 * s + 5]); pk.w = pack2(X_[st][8 * s + 6], X_[st][8 * s + 7]); \
                const bf16x8 pb = __builtin_bit_cast(bf16x8, pk);                                                     \
                if (ROWSUM_MFMA) ol = MFMA(ones8, pb, ol);                                                            \
                _Pragma("unroll") for (int dt = 0; dt < NDT; ++dt) {                                                  \
                    const char* va = vbp_ + (32 * st + 16 * s) * VROW + 64 * dt;                                      \
                    const s16x4 lo = __builtin_amdgcn_ds_read_tr16_b64_v4i16((LDS_AS s16x4*)(va));                    \
                    const s16x4 hi = __builtin_amdgcn_ds_read_tr16_b64_v4i16((LDS_AS s16x4*)(va + 8 * VROW));        \
                    o[dt] = MFMA(__builtin_shufflevector(lo, hi, 0, 1, 2, 3, 4, 5, 6, 7), pb, o[dt]);                 \
                }                                                                                                     \
            }                                                                                                         \
    }
#define ATT_STEP(t_, PAR_, CUR_, NXT_)                                                                                \
    {                                                                                                                 \
        const int tk_ = ((t_) + 2 < ntiles) ? (t_) + 2 : ntiles - 1, tv_ = ((t_) + 1 < ntiles) ? (t_) + 1 : ntiles - 1; \
        ATT_GLOADK(tk_ * KT)                                                                                          \
        ATT_GLOADV(tv_ * KT)                                                                                          \
        __builtin_amdgcn_sched_barrier(0);                                                                            \
        ATT_QK(1 - (PAR_), NXT_)                                                                                      \
        ATT_SMPV(t_, PAR_, CUR_)                                                                                      \
        __builtin_amdgcn_sched_barrier(0);                                                                            \
        ATT_LSTOREK(PAR_)                                                                                             \
        ATT_LSTOREV(1 - (PAR_))                                                                                       \
        __syncthreads();                                                                                              \
    }
#define ATT_STEP1(t_, PAR_, X_)                                                                                       \
    {                                                                                                                 \
        const int tn_ = ((t_) + 1 < ntiles) ? (t_) + 1 : ntiles - 1;                                                  \
        ATT_GLOADK(tn_ * KT)                                                                                          \
        ATT_GLOADV(tn_ * KT)                                                                                          \
        __builtin_amdgcn_sched_barrier(0);                                                                            \
        ATT_QK(PAR_, X_)                                                                                              \
        ATT_SMPV(t_, PAR_, X_)                                                                                        \
        __builtin_amdgcn_sched_barrier(0);                                                                            \
        ATT_LSTOREK(1 - (PAR_))                                                                                       \
        ATT_LSTOREV(1 - (PAR_))                                                                                       \
        __syncthreads();                                                                                              \
    }
    const f32x16 zero16 = {0.f, 0.f, 0.f, 0.f, 0.f, 0.f, 0.f, 0.f, 0.f, 0.f, 0.f, 0.f, 0.f, 0.f, 0.f, 0.f};
    const bf16x8 ones8 = {0x3F80, 0x3F80, 0x3F80, 0x3F80, 0x3F80, 0x3F80, 0x3F80, 0x3F80};
    constexpr bool ROWSUM_MFMA = false;
    float m = -1e30f, lacc = 0.f;
    f32x16 ol = zero16;
#pragma unroll
    for (int dt = 0; dt < NDT; ++dt) o[dt] = zero16;
    const int ntiles = nkeys / KT;
    const int vlane = (4 * h + ((lane & 15) >> 2)) * VROW + (16 * ((lane >> 4) & 1) + 4 * (lane & 3)) * 2;
    constexpr bool PIPE = (DV < 128);
    if (PIPE) {
        f32x16 xa[NST], xb[NST];
        ATT_GLOADK(0) ATT_LSTOREK(0)
        ATT_GLOADK(KT) ATT_GLOADV(0)
        __syncthreads();
        ATT_QK(0, xa)
        ATT_LSTOREK(1) ATT_LSTOREV(0)
        __syncthreads();
        for (int t = 0; t < ntiles; t += 2) {
            ATT_STEP(t, 0, xa, xb)
            ATT_STEP(t + 1, 1, xb, xa)
        }
    } else {
        f32x16 xs[NST];
        ATT_GLOADK(0) ATT_GLOADV(0) ATT_LSTOREK(0) ATT_LSTOREV(0)
        __syncthreads();
        for (int t = 0; t < ntiles; t += 2) {
            ATT_STEP1(t, 0, xs)
            ATT_STEP1(t + 1, 1, xs)
        }
    }
    lsum = ROWSUM_MFMA ? ol[0] : lacc + __shfl_xor(lacc, 32);
#undef ATT_GLOADK
#undef ATT_GLOADV
#undef ATT_LSTOREK
#undef ATT_LSTOREV
#undef ATT_QK
#undef ATT_SMPV
#undef ATT_STEP
#undef ATT_STEP1
}
template <int NDT>
DI void store_o(bf16_t* dst, int ld, f32x16 (&o)[NDT], float inv) {
    const int tid_ = otid(), lane = tid_ & 63, w = tid_ >> 6, r = lane & 31, h = lane >> 5;
    bf16_t* row = dst + (size_t)(32 * w + r) * ld + 4 * h;
#pragma unroll
    for (int dt = 0; dt < NDT; ++dt)
#pragma unroll
        for (int g = 0; g < 4; ++g) {
            uint2 vv; vv.x = pack2(o[dt][4 * g] * inv, o[dt][4 * g + 1] * inv); vv.y = pack2(o[dt][4 * g + 2] * inv, o[dt][4 * g + 3] * inv);
            *(uint2*)(row + 32 * dt + 8 * g) = vv;
        }
}
DI int swz_item(int base) {
    const int G = gridDim.x, i = blockIdx.x;
    if (G & 7) return base + i;
    return base + (i & 7) * (G >> 3) + (i >> 3);
}

constexpr int QT = SEQ / 256;
constexpr float NOMAX_BOUND = 90.f;
DI void attn_even(const bf16_t* qkv, float* park, bf16_t* mix, const Params& p, const float2* ax, const unsigned* nd, float lam_init, char* smem) {
    float d1 = 0.f, d2 = 0.f, gq = 0.f, gk = 0.f;
    for (int i = 0; i < 64; ++i) { d1 += p.in[8][i] * p.in[9][i]; d2 += p.in[10][i] * p.in[11][i]; gq = fmaxf(gq, fabsf(p.in[6][i])); gk = fmaxf(gk, fabsf(p.in[7][i])); }
    const float lam = __expf(d1) - __expf(d2) + lam_init;
    const float bound_gqa = 64.f * 0.125f * LOG2E * gq * gk * 1.03f;
    const int tid_ = otid(), lane = tid_ & 63, h = lane >> 5;
    float4* mypark = (float4*)(park + ((size_t)blockIdx.x * THREADS + tid_) * 64);
    constexpr int NDIFF = NB * 4 * QT, NGQA = NB * 8 * QT;
    for (int base = 0; base < NDIFF + NGQA; base += gridDim.x) {
        const int it = swz_item(base);
        if (it >= NDIFF + NGQA) continue;
        if (it < NDIFF) {
            const int b = it / (4 * QT), hd = (it / QT) & 3, qt = it % QT;
            const size_t row0 = (size_t)b * SEQ + qt * 256;
            const float slope2 = exp2f(-2.0f * (hd + 1)) * LOG2E;
            const bf16_t* qp = qkv + row0 * EVEN_IN + 768 + hd * 128;
            const bf16_t* kp = qkv + (size_t)b * SEQ * EVEN_IN + 1280 + hd * 128;
            const bf16_t* vp = qkv + (size_t)b * SEQ * EVEN_IN + 1792 + hd * 128;
            f32x16 o0[4]; float l0 = 1.f;
#pragma unroll 1
            for (int c = 0; c < 2; ++c) {
                const unsigned* nn = nd + (b * 8 + hd * 2 + c) * 2;
                const float bound = sqrtf(__uint_as_float(nn[0]) * __uint_as_float(nn[1])) * 1.03f;
                if (bound < NOMAX_BOUND) attn_core<64, 128, 64, 0, true, true>(qp + 64 * c, EVEN_IN, kp + 64 * c, EVEN_IN, nullptr, 0, vp, EVEN_IN, SEQ, qt * 256, 1.0f, slope2, nullptr, nullptr, smem, o0, l0);
                else attn_core<64, 128, 64, 0, true, false>(qp + 64 * c, EVEN_IN, kp + 64 * c, EVEN_IN, nullptr, 0, vp, EVEN_IN, SEQ, qt * 256, 1.0f, slope2, nullptr, nullptr, smem, o0, l0);
                if (c == 0) {
                    const float i0 = 1.0f / l0;
#pragma unroll
                    for (int dt = 0; dt < 4; ++dt)
#pragma unroll
                        for (int g = 0; g < 4; ++g) mypark[dt * 4 + g] = make_float4(o0[dt][4 * g] * i0, o0[dt][4 * g + 1] * i0, o0[dt][4 * g + 2] * i0, o0[dt][4 * g + 3] * i0);
                    asm volatile("" ::: "memory");
                }
            }
            const float i1 = lam / l0;
            float ss = 0.f;
            asm volatile("" ::: "memory");
#pragma unroll
            for (int dt = 0; dt < 4; ++dt)
#pragma unroll
                for (int g = 0; g < 4; ++g) {
                    const float4 pv = mypark[dt * 4 + g];
                    const float pa[4] = {pv.x, pv.y, pv.z, pv.w};
#pragma unroll
                    for (int e = 0; e < 4; ++e) { const float vv = pa[e] - i1 * o0[dt][4 * g + e]; o0[dt][4 * g + e] = vv; ss += vv * vv; }
                }
            ss += __shfl_xor(ss, 32);
            const float rstd = rsqrtf(ss * (1.0f / 128) + EPS) * (1.0f - lam_init);
#pragma unroll
            for (int dt = 0; dt < 4; ++dt)
#pragma unroll
                for (int i = 0; i < 16; ++i) o0[dt][i] *= p.in[12][32 * dt + crow(i, h)];
            store_o<4>(mix + row0 * D + 512 + hd * 128, D, o0, rstd);
        } else {
            const int j = it - NDIFF;
            const int b = j / (8 * QT), hd = (j / QT) & 7, qt = j % QT, kvh = hd >> 2;
            const size_t row0 = (size_t)b * SEQ + qt * 256;
            const bf16_t* qp = qkv + row0 * EVEN_IN + hd * 64;
            const bf16_t* kp = qkv + (size_t)b * SEQ * EVEN_IN + 512 + kvh * 64;
            const bf16_t* vp = qkv + (size_t)b * SEQ * EVEN_IN + 640 + kvh * 64;
            f32x16 o[2]; float l;
            if (bound_gqa < NOMAX_BOUND) attn_core<64, 64, 64, 1, false, true>(qp, EVEN_IN, kp, EVEN_IN, nullptr, 0, vp, EVEN_IN, SEQ, qt * 256, 0.125f * LOG2E, 0.f, p.in[6], ax, smem, o, l);
            else attn_core<64, 64, 64, 1, false, false>(qp, EVEN_IN, kp, EVEN_IN, nullptr, 0, vp, EVEN_IN, SEQ, qt * 256, 0.125f * LOG2E, 0.f, p.in[6], ax, smem, o, l);
            store_o<2>(mix + row0 * D + hd * 64, D, o, 1.0f / l);
        }
    }
}
DI void attn_mla(const bf16_t* qb, const bf16_t* kv, const bf16_t* a, bf16_t* mix, const float2* lin, const unsigned* nmx, char* smem) {
    constexpr int NIT = NB * 16 * QT;
    for (int base = 0; base < NIT; base += gridDim.x) {
        const int it = swz_item(base);
        if (it >= NIT) continue;
        const int b = it / (16 * QT), hd = (it / QT) & 15, qt = it % QT;
        const size_t row0 = (size_t)b * SEQ + qt * 256;
        const unsigned* nn = nmx + (b * 16 + hd) * 2;
        const float bound = sqrtf(__uint_as_float(nn[0]) * __uint_as_float(nn[1])) * 1.03f;
        const bf16_t* kb_ = kv + (size_t)b * SEQ * 2048 + hd * 128;
        f32x16 o[2]; float l;
        if (bound < NOMAX_BOUND) attn_core<96, 64, 64, 2, false, true>(qb + row0 * 1536 + hd * 96, 1536, kb_, 2048, a + (size_t)b * SEQ * ODD_PAD + 640, ODD_PAD, kb_ + 64, 2048, SEQ, qt * 256, 1.0f, 0.f, nullptr, lin, smem, o, l);
        else attn_core<96, 64, 64, 2, false, false>(qb + row0 * 1536 + hd * 96, 1536, kb_, 2048, a + (size_t)b * SEQ * ODD_PAD + 640, ODD_PAD, kb_ + 64, 2048, SEQ, qt * 256, 1.0f, 0.f, nullptr, lin, smem, o, l);
        store_o<2>(mix + row0 * D + hd * 64, D, o, 1.0f / l);
    }
}
DI void attn_cross(const bf16_t* qx, const bf16_t* kvx, bf16_t* mix, int seq0, char* smem) {
    constexpr int NIT = NB * 4 * QT * 2;
    for (int base = 0; base < NIT; base += gridDim.x) {
        const int it = swz_item(base);
        if (it >= NIT) continue;
        const int b = it / (8 * QT), hd = (it / (2 * QT)) & 3, qt = (it >> 1) % QT, half = it & 1;
        const size_t row0 = (size_t)b * SEQ + qt * 256;
        const bf16_t* kvb = kvx + (size_t)(seq0 + b) * NMEM * 2048;
        f32x16 o[4]; float l;
        attn_core<256, 128, 32, 0, false, false>(qx + row0 * D + hd * 256, D, kvb + hd * 256, 2048, nullptr, 0, kvb + 1024 + hd * 256 + half * 128, 2048, NMEM, 0,
                                          1.0f, 0.f, nullptr, nullptr, smem, o, l);
        store_o<4>(mix + row0 * D + hd * 256 + half * 128, D, o, 1.0f / l);
    }
}

extern "C" __global__ void __launch_bounds__(THREADS, 2) fwd_mega(Params p) {
    extern __shared__ __attribute__((aligned(16))) char smem[];
    LDS_AS unsigned char* lds = (LDS_AS unsigned char*)smem;
    cg::grid_group grid = cg::this_grid();
    char* ws = p.ws;
    __shared__ uint4 xb_words;
    if (threadIdx.x == 0) xb_words = make_uint4(0u, 0u, 0u, 0u);
    __syncthreads();
    const XcdBarrier xb = xcd_barrier_post((unsigned*)(ws + B_BAR), (volatile LDS_AS unsigned*)&xb_words);
    bf16_t* wEin = (bf16_t*)(ws + W_EIN); bf16_t* wEout = (bf16_t*)(ws + W_EOUT); bf16_t* wOin = (bf16_t*)(ws + W_OIN);
    bf16_t* wUq = (bf16_t*)(ws + W_UQ); bf16_t* wUkv = (bf16_t*)(ws + W_UKV); bf16_t* wOout = (bf16_t*)(ws + W_OOUT);
    float2* ax = (float2*)(ws + T_AX); float2* lin = (float2*)(ws + T_LIN);
    bf16_t* H = (bf16_t*)(ws + B_H); bf16_t* MIX = (bf16_t*)(ws + B_MIX);

    convert_weight(p.in[5], wEin, D, EVEN_IN, EVEN_IN, smem, 768, 1280, 0.125f * LOG2E);
    convert_weight(p.in[13], wEout, D, D, D, smem);
    convert_weight(p.in[14], wOin, D, ODD_IN, ODD_PAD, smem);
    convert_weight(p.in[17], wUq, 384, 1536, 1536, smem, 0, 1536, 0.10206207261596575f * LOG2E);
    convert_weight(p.in[18], wUkv, 256, 2048, 2048, smem);
    convert_weight(p.in[19], wOout, D, D, D, smem);
    for (int l = 0; l < 2; ++l) {
        convert_weight(p.in[22] + (size_t)l * D * D, (bf16_t*)(ws + W_CQ) + (size_t)l * D * D, D, D, D, smem, 0, D, 0.0625f * LOG2E);
        convert_weight(p.in[23] + (size_t)l * D * 2048, (bf16_t*)(ws + W_CKV) + (size_t)l * 2048 * D, D, 2048, 2048, smem);
        convert_weight(p.in[24] + (size_t)l * D * D, (bf16_t*)(ws + W_CO) + (size_t)l * D * D, D, D, D, smem);
        convert_weight(p.in[26] + (size_t)l * D * 2 * DFF, (bf16_t*)(ws + W_GU) + (size_t)l * 2 * DFF * D, D, 2 * DFF, 2 * DFF, smem);
        convert_weight(p.in[27] + (size_t)l * DFF * D, (bf16_t*)(ws + W_DOWN) + (size_t)l * D * DFF, DFF, D, D, smem);
        rmsnorm_rows(p.in[2], p.in[21] + l * D, (bf16_t*)(ws + B_MEMN) + (size_t)l * NBATCH * NMEM * D, 8 * NMEM);
        rmsnorm_rows(p.in[3], p.in[21] + l * D, (bf16_t*)(ws + B_MEMN) + (size_t)l * NBATCH * NMEM * D + (size_t)8 * NMEM * D, 16 * NMEM);
    }
    build_tables(ax, lin);
    if (blockIdx.x == 0) for (int i = threadIdx.x; i < 4096; i += THREADS) ((unsigned*)(ws + B_NORMS))[i] = 0u;
    grid.sync();
    for (int l = 0; l < 2; ++l) {
        pg8::EpiBf16 e{(bf16_t*)(ws + B_KX) + (size_t)l * NBATCH * NMEM * 2048, 2048};
        pg8::gemm_phase(lds, mk_gemm((const bf16_t*)(ws + B_MEMN) + (size_t)l * NBATCH * NMEM * D, D, (const bf16_t*)(ws + W_CKV) + (size_t)l * 2048 * D, NBATCH * NMEM, 2048, D), e);
    }
    xcd_barrier(xb);

    for (int ch = 0; ch < NCHUNK; ++ch) {
        const float* xin = (ch == 0) ? p.in[0] : p.in[1] + (size_t)(ch - 1) * TC * D;
        float* xo = p.out + (size_t)ch * TC * D;
        for (int layer = 0; layer < 2; ++layer) {
            const float* xcur = (layer == 0) ? xin : xo;
            for (int rep_ = 0; rep_ < PROBE_NORM; ++rep_) rmsnorm_rows(xcur, p.in[4] + layer * D, H, TC);
            xcd_barrier(xb);
            const bf16_t* wout;
            if (layer == 0) {
                bf16_t* qkv = (bf16_t*)(ws + E_QKV);
                for (int rep_ = 0; rep_ < PROBE_GEMM; ++rep_) { pg8::EpiBf16 e{qkv, EVEN_IN}; pg8::gemm_phase(lds, mk_gemm(H, D, wEin, TC, EVEN_IN, D), e); }
                xcd_barrier(xb);
                kprep_even(qkv, p.in[7], ax);
                normmax_even(qkv, (unsigned*)(ws + B_NORMS) + ch * 128, smem);
                xcd_barrier(xb);
                for (int rep_ = 0; rep_ < PROBE_ATTN; ++rep_) attn_even(qkv, (float*)(ws + E_PARK), MIX, p, ax, (const unsigned*)(ws + B_NORMS) + ch * 128, 0.2f, smem);
                wout = wEout;
            } else {
                bf16_t* a = (bf16_t*)(ws + O_A); bf16_t* qb = (bf16_t*)(ws + O_Q); bf16_t* kv = (bf16_t*)(ws + O_KV);
                for (int rep_ = 0; rep_ < PROBE_GEMM; ++rep_) { pg8::EpiBf16 e{a, ODD_PAD}; pg8::gemm_phase(lds, mk_gemm(H, D, wOin, TC, ODD_PAD, D), e); }
                xcd_barrier(xb);
                prep_odd(a, p.in[15], p.in[16], lin);
                xcd_barrier(xb);
                for (int rep_ = 0; rep_ < PROBE_GEMM; ++rep_) { pg8::EpiBf16 e{qb, 1536}; pg8::gemm_phase(lds, mk_gemm(a, ODD_PAD, wUq, TC, 1536, 384), e); }
                for (int rep_ = 0; rep_ < PROBE_GEMM; ++rep_) { pg8::EpiBf16 e{kv, 2048}; pg8::gemm_phase(lds, mk_gemm(a + 384, ODD_PAD, wUkv, TC, 2048, 256), e); }
                xcd_barrier(xb);
                normmax_mla(qb, kv, a, (unsigned*)(ws + B_NORMS) + 384 + ch * 256, smem);
                xcd_barrier(xb);
                for (int rep_ = 0; rep_ < PROBE_ATTN; ++rep_) attn_mla(qb, kv, a, MIX, lin, (const unsigned*)(ws + B_NORMS) + 384 + ch * 256, smem);
                wout = wOout;
            }
            xcd_barrier(xb);
            { pg8::EpiResid e{xcur, xo}; pg8::gemm_phase(lds, mk_gemm(MIX, D, wout, TC, D, D), e); }
            xcd_barrier(xb);
            for (int rep_ = 0; rep_ < PROBE_NORM; ++rep_) rmsnorm_rows(xo, p.in[20] + layer * D, H, TC);
            xcd_barrier(xb);
            for (int rep_ = 0; rep_ < PROBE_GEMM; ++rep_) { pg8::EpiBf16 e{(bf16_t*)(ws + X_Q), D}; pg8::gemm_phase(lds, mk_gemm(H, D, (const bf16_t*)(ws + W_CQ) + (size_t)layer * D * D, TC, D, D), e); }
            xcd_barrier(xb);
            for (int rep_ = 0; rep_ < PROBE_CROSS; ++rep_) attn_cross((const bf16_t*)(ws + X_Q), (const bf16_t*)(ws + B_KX) + (size_t)layer * NBATCH * NMEM * 2048, MIX, ch * NB, smem);
            xcd_barrier(xb);
            { pg8::EpiResid e{xo, xo}; pg8::gemm_phase(lds, mk_gemm(MIX, D, (const bf16_t*)(ws + W_CO) + (size_t)layer * D * D, TC, D, D), e); }
            xcd_barrier(xb);
            for (int rep_ = 0; rep_ < PROBE_NORM; ++rep_) rmsnorm_rows(xo, p.in[25] + layer * D, H, TC);
            xcd_barrier(xb);
            for (int rep_ = 0; rep_ < PROBE_GEMM; ++rep_) { pg8::EpiSwiglu e{(bf16_t*)(ws + F_ACT)};
              pg8::Gemm g{H, (const bf16_t*)(ws + W_GU) + (size_t)layer * 2 * DFF * D, TC, DFF / 128, D, D, (size_t)DFF * D * 2, (size_t)128 * D * 2};
              pg8::gemm_phase(lds, g, e); }
            xcd_barrier(xb);
            { pg8::EpiResid e{xo, xo}; pg8::gemm_phase(lds, mk_gemm((const bf16_t*)(ws + F_ACT), DFF, (const bf16_t*)(ws + W_DOWN) + (size_t)layer * D * DFF, TC, D, DFF), e); }
            xcd_barrier(xb);
        }
        rmsnorm_final(xo, p.in[28], TC);
    }
}

extern "C" void kernel_launch(void* const* d_in, const int* in_sizes, int n_in, void* d_out, int out_size, void* d_ws, size_t ws_size, hipStream_t stream) {
    static int grid_blocks = 0;
    if (!grid_blocks) {
        int dev = 0, cus = 0, per_cu = 0;
        (void)hipGetDevice(&dev);
        (void)hipDeviceGetAttribute(&cus, hipDeviceAttributeMultiprocessorCount, dev);
        (void)hipFuncSetAttribute((const void*)fwd_mega, hipFuncAttributeMaxDynamicSharedMemorySize, (int)LDS_BYTES);
        (void)hipOccupancyMaxActiveBlocksPerMultiprocessor(&per_cu, fwd_mega, THREADS, LDS_BYTES);
        if (per_cu > 1) per_cu = 1;
        if (per_cu < 1) per_cu = 1;
        grid_blocks = cus * per_cu;
    }
    constexpr size_t WS_END = (O_END > E_END ? O_END : E_END) > (F_ACT + (size_t)TC * DFF * 2) ? (O_END > E_END ? O_END : E_END) : (F_ACT + (size_t)TC * DFF * 2);
    if (ws_size < WS_END) { fprintf(stderr, "workspace too small: %zu < %zu\n", ws_size, (size_t)WS_END); return; }
    if (grid_blocks > 256) grid_blocks = 256;
    Params p{};
    for (int i = 0; i < 29; ++i) p.in[i] = (const float*)d_in[i];
    p.out = (float*)d_out;
    p.ws = (char*)d_ws;
    (void)hipMemsetAsync(d_ws, 0, 16384, stream);
    void* args[] = {&p};
    hipError_t e = hipLaunchCooperativeKernel((void*)fwd_mega, dim3(grid_blocks), dim3(THREADS), args, LDS_BYTES, stream);
    if (e != hipSuccess) fprintf(stderr, "cooperative launch failed: %s (grid %d)\n", hipGetErrorString(e), grid_blocks);
}
```

```cpp
#include <hip/hip_runtime.h>
#include <hip/hip_cooperative_groups.h>
#include <cstdio>
#include <cstdint>
namespace cg = cooperative_groups;
#ifndef PROBE_GEMM
#define PROBE_GEMM 1
#endif
#ifndef PROBE_NORM
#define PROBE_NORM 1
#endif
#ifndef PROBE_CROSS
#define PROBE_CROSS 1
#endif
#ifndef PROBE_ATTN
#define PROBE_ATTN 1
#endif

typedef unsigned short bf16_t;
typedef short bf16x8 __attribute__((ext_vector_type(8)));
typedef float f32x16 __attribute__((ext_vector_type(16)));
typedef float f32x2 __attribute__((ext_vector_type(2)));
typedef unsigned u32x4 __attribute__((ext_vector_type(4)));
typedef float f32x4 __attribute__((ext_vector_type(4)));
typedef short s16x4 __attribute__((ext_vector_type(4)));
#define LDS_AS __attribute__((address_space(3)))
typedef __bf16 bf16x2_t __attribute__((ext_vector_type(2)));
#define DI __device__ __forceinline__
#define MFMA(a, b, c) __builtin_amdgcn_mfma_f32_32x32x16_bf16((a), (b), (c), 0, 0, 0)

constexpr int D = 1024, SEQ = 4096, NBATCH = 24, NB = 8  , NCHUNK = NBATCH / NB, TC = NB * SEQ;
constexpr int NMEM = 256, DFF = 2816, EVEN_IN = 2304, ODD_IN = 672, ODD_PAD = 768;
constexpr float EPS = 1e-6f, LOG2E = 1.4426950408889634f;
constexpr int THREADS = 512, NWAVE = THREADS / 64;
constexpr size_t LDS_BYTES = 131072;

constexpr size_t al(size_t x) { return (x + 255) & ~(size_t)255; }
constexpr size_t B_BAR = 0;
constexpr size_t B_NORMS = 16384;
constexpr size_t W_EIN = 32768;
constexpr size_t W_EOUT = W_EIN + al((size_t)EVEN_IN * D * 2);
constexpr size_t W_OIN = W_EOUT + al((size_t)D * D * 2);
constexpr size_t W_UQ = W_OIN + al((size_t)ODD_PAD * D * 2);
constexpr size_t W_UKV = W_UQ + al((size_t)1536 * 384 * 2);
constexpr size_t W_OOUT = W_UKV + al((size_t)2048 * 256 * 2);
constexpr size_t W_CQ = W_OOUT + al((size_t)D * D * 2);
constexpr size_t W_CKV = W_CQ + 2 * al((size_t)D * D * 2);
constexpr size_t W_CO = W_CKV + 2 * al((size_t)2048 * D * 2);
constexpr size_t W_GU = W_CO + 2 * al((size_t)D * D * 2);
constexpr size_t W_DOWN = W_GU + 2 * al((size_t)2 * DFF * D * 2);
constexpr size_t T_AX = W_DOWN + 2 * al((size_t)D * DFF * 2);
constexpr size_t T_LIN = T_AX + al((size_t)SEQ * 32 * 8);
constexpr size_t B_MEMN = T_LIN + al((size_t)SEQ * 16 * 8);
constexpr size_t B_KX = B_MEMN + 2 * al((size_t)NBATCH * NMEM * D * 2);
constexpr size_t B_H = B_KX + 2 * al((size_t)NBATCH * NMEM * 2048 * 2);
constexpr size_t B_MIX = B_H + al((size_t)TC * D * 2);
constexpr size_t B_BIG = B_MIX + al((size_t)TC * D * 2);
constexpr size_t E_QKV = B_BIG;
constexpr size_t E_PARK = E_QKV + al((size_t)TC * EVEN_IN * 2);
constexpr size_t E_END = E_PARK + (size_t)256 * THREADS * 64 * 4;
constexpr size_t O_A = B_BIG;
constexpr size_t O_Q = O_A + al((size_t)TC * ODD_PAD * 2);
constexpr size_t O_KV = O_Q + al((size_t)TC * 1536 * 2);
constexpr size_t O_END = O_KV + al((size_t)TC * 2048 * 2);
constexpr size_t X_Q = B_BIG;
constexpr size_t F_ACT = B_BIG;

struct Params {
    const float* in[29];
    float* out;
    char* ws;
};

DI unsigned pack2(float lo, float hi) { f32x2 v = {lo, hi}; bf16x2_t b = __builtin_convertvector(v, bf16x2_t); return __builtin_bit_cast(unsigned, b); }
DI float bflo(unsigned u) { return __uint_as_float(u << 16); }
DI float bfhi(unsigned u) { return __uint_as_float(u & 0xffff0000u); }
DI int crow(int i, int h) { return (i & 3) + 8 * (i >> 2) + 4 * h; }
DI int swap23(int x) { return (x & ~12) | ((x & 4) << 1) | ((x & 8) >> 1); }
DI int otid() { int t = threadIdx.x; asm volatile("" : "+v"(t)); return t; }
DI float wave_sum(float v) {
#pragma unroll
    for (int o = 32; o >= 1; o >>= 1) v += __shfl_xor(v, o);
    return v;
}


#define XB_TMO      128
#define XB_XCNT(j)  (256  + 64 * (j))
#define XB_XSUB(j)  (1280 + 64 * (j))
#define XB_XGEN(j)  (2304 + 64 * (j))
#define XB_TOP      3328
#define XB_TOPGEN   3392
#define XCD_BAR_WORDS 3456
#define XB_SPIN_CAP (1u << 18)
DI unsigned xb_ld(unsigned* p) { return __hip_atomic_load(p, __ATOMIC_RELAXED, __HIP_MEMORY_SCOPE_AGENT); }
DI unsigned xb_add(unsigned* p, unsigned v) { return __hip_atomic_fetch_add(p, v, __ATOMIC_RELAXED, __HIP_MEMORY_SCOPE_AGENT); }
DI unsigned xb_xcc_id() { return (unsigned)__builtin_amdgcn_s_getreg((3 << 11) | 20) & 0xFu; }
#define XB_SPIN(cond, bar) do { unsigned _sp = 0; while (cond) { __builtin_amdgcn_s_sleep(1); \
    if ((++_sp & 255u) == 0u) { if (xb_ld(&(bar)[XB_TMO])) break; if (_sp > XB_SPIN_CAP) { atomicAdd(&(bar)[XB_TMO], 1u); break; } } } } while (0)
struct XcdBarrier { unsigned* bar; unsigned x; volatile LDS_AS unsigned* st; };
DI XcdBarrier xcd_barrier_post(unsigned* bar, volatile LDS_AS unsigned* st) {
    XcdBarrier b; b.bar = bar; b.x = xb_xcc_id(); b.st = st;
    if (threadIdx.x == 0) (void)xb_add(&bar[XB_XCNT(b.x)], 1u);
    return b;
}
DI void xcd_barrier_complete(unsigned* bar, unsigned x, unsigned& nloc, unsigned& nx) {
    const unsigned G = gridDim.x * gridDim.y * gridDim.z;
    unsigned sum, cnt, mine, sp = 0u;
    for (;;) {
        sum = 0u; cnt = 0u; mine = 0u;
#pragma unroll
        for (unsigned j = 0; j < 16; ++j) { const unsigned c = xb_ld(&bar[XB_XCNT(j)]); sum += c; cnt += (c > 0u) ? 1u : 0u; mine = (j == x) ? c : mine; }
        if (sum == G) break;
        __builtin_amdgcn_s_sleep(1);
        if ((++sp & 255u) == 0u) { if (xb_ld(&bar[XB_TMO])) break; if (sp > XB_SPIN_CAP) { atomicAdd(&bar[XB_TMO], 1u); break; } }
    }
    nloc = mine > 0u ? mine : 1u; nx = cnt > 0u ? cnt : 1u;
}
DI void xcd_barrier(const XcdBarrier& b) {
    asm volatile("s_waitcnt vmcnt(0)" ::: "memory");
    __syncthreads();
    if (threadIdx.x == 0) {
        unsigned* bar = b.bar;
        __builtin_amdgcn_s_waitcnt(0);
        unsigned nloc = b.st[0], nx = b.st[1];
        if (nloc == 0u) { xcd_barrier_complete(bar, b.x, nloc, nx); b.st[0] = nloc; b.st[1] = nx; }
        const unsigned old = xb_add(&bar[XB_XSUB(b.x)], 1u);
        const unsigned gen = old / nloc;
        if (old + 1u == (gen + 1u) * nloc) {
            __builtin_amdgcn_fence(__ATOMIC_RELEASE, "agent");
            asm volatile("s_waitcnt vmcnt(0)" ::: "memory");
            const unsigned og = xb_add(&bar[XB_TOP], 1u);
            const unsigned tg = og / nx;
            if (og + 1u == (tg + 1u) * nx) xb_add(&bar[XB_TOPGEN], 1u);
            else XB_SPIN(xb_ld(&bar[XB_TOPGEN]) == tg, bar);
            __builtin_amdgcn_fence(__ATOMIC_ACQUIRE, "agent");
            xb_add(&bar[XB_XGEN(b.x)], 1u);
            asm volatile("s_waitcnt vmcnt(0)" ::: "memory");
        } else {
            XB_SPIN(xb_ld(&bar[XB_XGEN(b.x)]) == gen, bar);
            __builtin_amdgcn_fence(__ATOMIC_ACQUIRE, "agent");
            asm volatile("s_waitcnt vmcnt(0)" ::: "memory");
        }
    }
    __syncthreads();
}

DI void convert_weight(const float* __restrict__ src, bf16_t* __restrict__ dst, int K, int N, int Npad, char* smem, int slo = 0, int shi = 0, float scale = 1.0f) {
    float* t = (float*)smem;
    const int tid = otid();
    const int nkt = K / 64, nnt = Npad / 64;
    for (int tile = blockIdx.x; tile < nkt * nnt; tile += gridDim.x) {
        const int k0 = (tile / nnt) * 64, n0 = (tile % nnt) * 64;
#pragma unroll
        for (int i = 0; i < 8; ++i) {
            const int k = i * 8 + (tid >> 6), n = tid & 63;
            const float sc_ = (n0 + n >= slo && n0 + n < shi) ? scale : 1.0f;
            t[k * 65 + n] = (n0 + n < N) ? src[(size_t)(k0 + k) * N + n0 + n] * sc_ : 0.f;
        }
        __syncthreads();
#pragma unroll
        for (int i = 0; i < 4; ++i) {
            const int n = i * 16 + (tid >> 5), k = (tid & 31) * 2;
            *(unsigned*)(dst + (size_t)(n0 + n) * K + k0 + k) = pack2(t[k * 65 + n], t[(k + 1) * 65 + n]);
        }
        __syncthreads();
    }
}

__device__ const float kFreq[16] = {1.000000000e+00f, 5.623413324e-01f, 3.162277639e-01f, 1.778279394e-01f, 1.000000015e-01f, 5.623413250e-02f, 3.162277490e-02f, 1.778279431e-02f,
                                    9.999999776e-03f, 5.623413250e-03f, 3.162277630e-03f, 1.778279431e-03f, 1.000000047e-03f, 5.623413017e-04f, 3.162277571e-04f, 1.778279402e-04f};
DI float2 sincos_acc(float ang) {
    const double x = (double)ang;
    const double n = __builtin_rint(x * 0.15915494309189535);
    double r = __builtin_fma(-n, 6.283185307179586, x);
    r = __builtin_fma(-n, 2.4492935982947064e-16, r);
    const double r2 = r * r;
    double s = 1.0, c = 1.0;
#pragma unroll
    for (int k = 13; k >= 1; --k) {
        s = 1.0 - r2 * s * (1.0 / (double)((2 * k) * (2 * k + 1)));
        c = 1.0 - r2 * c * (1.0 / (double)((2 * k - 1) * (2 * k)));
    }
    return make_float2((float)c, (float)(r * s));
}
DI void build_tables(float2* ax, float2* lin) {
    const int gt = blockIdx.x * THREADS + otid(), gs = gridDim.x * THREADS;
    for (int e = gt; e < SEQ * 32; e += gs) {
        const int pos = e >> 5, p = e & 31;
        const float base = (p < 16) ? (float)(pos >> 6) : (float)(pos & 63);
        ax[e] = sincos_acc(base * kFreq[p & 15]);
    }
    for (int e = gt; e < SEQ * 16; e += gs) {
        const int pos = e >> 4, p = e & 15;
        lin[e] = sincos_acc((float)pos * kFreq[p]);
    }
}

DI void rmsnorm_rows(const float* __restrict__ src, const float* __restrict__ g, bf16_t* __restrict__ dst, int nrows) {
    const int tid_ = otid(), lane = tid_ & 63, wv = blockIdx.x * NWAVE + (tid_ >> 6), nw = gridDim.x * NWAVE;
    for (int row = wv; row < nrows; row += nw) {
        const float4* s = (const float4*)(src + (size_t)row * D);
        float4 v[4]; float ss = 0.f;
#pragma unroll
        for (int i = 0; i < 4; ++i) { v[i] = s[i * 64 + lane]; ss += v[i].x * v[i].x + v[i].y * v[i].y + v[i].z * v[i].z + v[i].w * v[i].w; }
        ss = wave_sum(ss);
        const float rstd = rsqrtf(ss * (1.0f / D) + EPS);
#pragma unroll
        for (int i = 0; i < 4; ++i) {
            const float4 gg = ((const float4*)g)[i * 64 + lane];
            uint2 o; o.x = pack2(v[i].x * rstd * gg.x, v[i].y * rstd * gg.y); o.y = pack2(v[i].z * rstd * gg.z, v[i].w * rstd * gg.w);
            *(uint2*)(dst + (size_t)row * D + (i * 64 + lane) * 4) = o;
        }
    }
}
DI void rmsnorm_final(float* __restrict__ x, const float* __restrict__ g, int nrows) {
    const int tid_ = otid(), lane = tid_ & 63, wv = blockIdx.x * NWAVE + (tid_ >> 6), nw = gridDim.x * NWAVE;
    for (int row = wv; row < nrows; row += nw) {
        float4* s = (float4*)(x + (size_t)row * D);
        float4 v[4]; float ss = 0.f;
#pragma unroll
        for (int i = 0; i < 4; ++i) { v[i] = s[i * 64 + lane]; ss += v[i].x * v[i].x + v[i].y * v[i].y + v[i].z * v[i].z + v[i].w * v[i].w; }
        ss = wave_sum(ss);
        const float rstd = rsqrtf(ss * (1.0f / D) + EPS);
#pragma unroll
        for (int i = 0; i < 4; ++i) {
            const float4 gg = ((const float4*)g)[i * 64 + lane];
            float4 o; o.x = v[i].x * rstd * gg.x; o.y = v[i].y * rstd * gg.y; o.z = v[i].z * rstd * gg.z; o.w = v[i].w * rstd * gg.w;
            s[i * 64 + lane] = o;
        }
    }
}

DI void kprep_even(bf16_t* __restrict__ qkv, const float* __restrict__ gk, const float2* __restrict__ ax) {
    const int tid_ = otid(), gt = blockIdx.x * THREADS + tid_, gs = gridDim.x * THREADS;
    const int p = tid_ & 31;
    for (int v = gt >> 5; v < TC * 2; v += gs >> 5) {
        const int tok = v >> 1, kvh = v & 1;
        unsigned* ptr = (unsigned*)(qkv + (size_t)tok * EVEN_IN + 512 + kvh * 64 + 2 * p);
        const unsigned u = *ptr;
        const float x0 = bflo(u), x1 = bfhi(u);
        float ss = x0 * x0 + x1 * x1;
#pragma unroll
        for (int o = 16; o >= 1; o >>= 1) ss += __shfl_xor(ss, o);
        const float rstd = rsqrtf(ss * (1.0f / 64) + EPS);
        const float y0 = x0 * rstd * gk[2 * p], y1 = x1 * rstd * gk[2 * p + 1];
        const float2 cs = ax[(tok & (SEQ - 1)) * 32 + p];
        *ptr = pack2(y0 * cs.x - y1 * cs.y, y0 * cs.y + y1 * cs.x);
    }
}
DI void prep_odd(bf16_t* __restrict__ a, const float* __restrict__ gq, const float* __restrict__ gkv, const float2* __restrict__ lin) {
    const int tid_ = otid(), lane = tid_ & 63, wv = blockIdx.x * NWAVE + (tid_ >> 6), nw = gridDim.x * NWAVE;
    for (int row = wv; row < TC; row += nw) {
        unsigned* base = (unsigned*)(a + (size_t)row * ODD_PAD);
        unsigned uq[3], uk[2]; float sq = 0.f, sk = 0.f;
#pragma unroll
        for (int i = 0; i < 3; ++i) { uq[i] = base[i * 64 + lane]; const float a0 = bflo(uq[i]), a1 = bfhi(uq[i]); sq += a0 * a0 + a1 * a1; }
#pragma unroll
        for (int i = 0; i < 2; ++i) { uk[i] = base[192 + i * 64 + lane]; const float a0 = bflo(uk[i]), a1 = bfhi(uk[i]); sk += a0 * a0 + a1 * a1; }
        sq = wave_sum(sq); sk = wave_sum(sk);
        const float rq = rsqrtf(sq * (1.0f / 384) + EPS), rk = rsqrtf(sk * (1.0f / 256) + EPS);
#pragma unroll
        for (int i = 0; i < 3; ++i) { const int c = (i * 64 + lane) * 2; base[i * 64 + lane] = pack2(bflo(uq[i]) * rq * gq[c], bfhi(uq[i]) * rq * gq[c + 1]); }
#pragma unroll
        for (int i = 0; i < 2; ++i) { const int c = (i * 64 + lane) * 2; base[192 + i * 64 + lane] = pack2(bflo(uk[i]) * rk * gkv[c], bfhi(uk[i]) * rk * gkv[c + 1]); }
        if (lane < 16) {
            const unsigned u = base[320 + lane];
            const float x0 = bflo(u), x1 = bfhi(u);
            const float2 cs = lin[(row & (SEQ - 1)) * 16 + lane];
            base[320 + lane] = pack2(x0 * cs.x - x1 * cs.y, x0 * cs.y + x1 * cs.x);
        }
    }
}


DI void normmax_even(const bf16_t* __restrict__ qkv, unsigned* __restrict__ nd, char* smem) {
    const int tid = otid(), lane = tid & 63, w = tid >> 6;
    float* red = (float*)smem;
    for (int item = blockIdx.x; item < NB * 32; item += gridDim.x) {
        const int b = item & 7, slab = item >> 3;
        float mq = 0.f, mk = 0.f;
        for (int i = 0; i < 16; ++i) {
            const bf16_t* row = qkv + ((size_t)b * SEQ + slab * 128 + w * 16 + i) * EVEN_IN;
            const u32x4 uq = *(const u32x4*)(row + 768 + 8 * lane), uk = *(const u32x4*)(row + 1280 + 8 * lane);
            float sq = 0.f, sk = 0.f;
#pragma unroll
            for (int j = 0; j < 4; ++j) { const float a0 = bflo(uq[j]), a1 = bfhi(uq[j]), b0 = bflo(uk[j]), b1 = bfhi(uk[j]); sq += a0 * a0 + a1 * a1; sk += b0 * b0 + b1 * b1; }
#pragma unroll
            for (int o = 1; o <= 4; o <<= 1) { sq += __shfl_xor(sq, o); sk += __shfl_xor(sk, o); }
            mq = fmaxf(mq, sq); mk = fmaxf(mk, sk);
        }
        if ((lane & 7) == 0) { red[(w * 8 + (lane >> 3)) * 2] = mq; red[(w * 8 + (lane >> 3)) * 2 + 1] = mk; }
        __syncthreads();
        if (tid < 16) {
            float m = 0.f;
#pragma unroll
            for (int ww = 0; ww < NWAVE; ++ww) m = fmaxf(m, red[ww * 16 + tid]);
            atomicMax(nd + b * 16 + tid, __float_as_uint(m));
        }
        __syncthreads();
    }
}
DI void normmax_mla(const bf16_t* __restrict__ qb, const bf16_t* __restrict__ kv, const bf16_t* __restrict__ a, unsigned* __restrict__ nmx, char* smem) {
    const int tid = otid(), lane = tid & 63, w = tid >> 6;
    float* red = (float*)smem;
    for (int item = blockIdx.x; item < NB * 32; item += gridDim.x) {
        const int b = item & 7, slab = item >> 3;
        float mq = 0.f, mk = 0.f;
        for (int i = 0; i < 16; ++i) {
            const size_t r = (size_t)b * SEQ + slab * 128 + w * 16 + i;
            float sq = 0.f, sk = 0.f, sr = 0.f;
#pragma unroll
            for (int c = 0; c < 3; ++c) {
                const u32x4 u = *(const u32x4*)(qb + r * 1536 + 24 * lane + 8 * c);
#pragma unroll
                for (int j = 0; j < 4; ++j) { const float a0 = bflo(u[j]), a1 = bfhi(u[j]); sq += a0 * a0 + a1 * a1; }
            }
#pragma unroll
            for (int c = 0; c < 4; ++c) {
                const u32x4 u = *(const u32x4*)(kv + r * 2048 + 32 * lane + 8 * c);
#pragma unroll
                for (int j = 0; j < 4; ++j) { const float a0 = bflo(u[j]), a1 = bfhi(u[j]); sk += a0 * a0 + a1 * a1; }
            }
#pragma unroll
            for (int c = 0; c < 4; ++c) {
                const u32x4 u = *(const u32x4*)(a + r * ODD_PAD + 640 + 8 * c);
#pragma unroll
                for (int j = 0; j < 4; ++j) { const float a0 = bflo(u[j]), a1 = bfhi(u[j]); sr += a0 * a0 + a1 * a1; }
            }
            sq += __shfl_xor(sq, 1); sq += __shfl_xor(sq, 2);
            sk += __shfl_xor(sk, 1);
            mq = fmaxf(mq, sq); mk = fmaxf(mk, sk + sr);
        }
        if ((lane & 3) == 0) { red[(w * 16 + (lane >> 2)) * 2] = mq; red[(w * 16 + (lane >> 2)) * 2 + 1] = mk; }
        __syncthreads();
        if (tid < 32) {
            float m = 0.f;
#pragma unroll
            for (int ww = 0; ww < NWAVE; ++ww) m = fmaxf(m, red[ww * 32 + tid]);
            atomicMax(nmx + b * 32 + tid, __float_as_uint(m));
        }
        __syncthreads();
    }
}

namespace pg8 {
constexpr int BM = 256, BK = 64, HALF = 128, HTB = HALF * BK * 2, NXCD = 8, WGM = 8;
DI int lds_byte(int r, int c) { const int st = (r >> 4) * 2 + (c >> 5), rr = r & 15, cc = c & 31, ob = rr * 64 + cc * 2; return st * 1024 + (ob ^ (((ob >> 9) & 1) << 5)); }
DI void stage_rc(int b, int& R, int& C) { const int st = b / 1024, sb = b % 1024, swz = sb ^ (((sb >> 9) & 1) << 5); R = (st >> 1) * 16 + swz / 64; C = (st & 1) * 32 + (swz % 64) / 2; }
DI int perm32(int rho) { const int n = rho >> 4, i = rho & 15; return 8 * (i >> 2) + 4 * n + (i & 3); }
struct Unit { int pm, pn; };
struct Gemm { const bf16_t* A; const bf16_t* Bt; int M, NT, K, lda; size_t hstepB, tstepB; };
struct StaticOrder {
    int nM, nN, nwg, G, c;
    DI void init(int M, int NT, int G_, int c_) { nM = M / BM; nN = NT; nwg = nM * nN; G = G_; c = c_; }
    DI bool next(int i, Unit& u) const {
        const long L = (long)i * G + c; if (L >= nwg) return false;
        int wgid = (int)L; { const int q = nwg / NXCD, r = nwg % NXCD, xcd = wgid % NXCD, off = wgid / NXCD; wgid = (xcd < r ? xcd * (q + 1) : r * (q + 1) + (xcd - r) * q) + off; }
        const int nig = WGM * nN, gid = wgid / nig, fm = gid * WGM, gsz = (nM - fm) < WGM ? (nM - fm) : WGM;
        u.pm = fm + ((wgid % nig) % gsz); u.pn = (wgid % nig) / gsz; return true;
    }
};
template <class Epi>
DI void gemm_phase(LDS_AS unsigned char* lds, const Gemm g, const Epi& E) {
    StaticOrder S; S.init(g.M, g.NT, gridDim.x, blockIdx.x);
    const int tid = otid(), wid = __builtin_amdgcn_readfirstlane(tid >> 6), lane = tid & 63, wr = wid >> 2, wc = wid & 3, fr = lane & 15, fq = lane >> 4;
    const int K = g.K, nt = K / BK;
    unsigned voffA[2], voffB[2];
#pragma unroll
    for (int i = 0; i < 2; ++i) { int R, C; stage_rc(tid * 16 + i * 8192, R, C); const int Rb = Epi::PERM ? ((R & ~31) + perm32(R & 31)) : R;
        voffA[i] = (unsigned)(R * g.lda + C) * 2u; voffB[i] = (unsigned)(Rb * K + C) * 2u; }
    const size_t kstep = (size_t)(BK * 2);
    const size_t hstepA = (size_t)HALF * g.lda * 2, tstepA = 2 * hstepA, hstepB = g.hstepB, tstepB = g.tstepB;
    const unsigned ldsw = (unsigned)wid * 1024u;
    const int aoff = lds_byte(wr * 64 + fr, fq * 8), boff = lds_byte(wc * 32 + fr, fq * 8);
#define PG8_SA(b, h) (((b) * 2 + (h)) * HTB)
#define PG8_SB(b, h) ((4 + (b) * 2 + (h)) * HTB)
#define PG8_STAGE(bufoff, gbase, voff) do { _Pragma("unroll") for (int _i = 0; _i < 2; ++_i) \
        __builtin_amdgcn_global_load_lds((const unsigned*)((const char*)(gbase) + (voff)[_i]), (LDS_AS unsigned*)(lds + (bufoff) + ldsw + _i * 8192), 16, 0, 0); } while (0)
#define PG8_LDA(dst, b, h) do { _Pragma("unroll") for (int m = 0; m < 4; ++m) _Pragma("unroll") for (int k = 0; k < 2; ++k) dst[m][k] = *(const LDS_AS bf16x8*)(lds + PG8_SA(b, h) + aoff + m * 2048 + k * 1024); } while (0)
#define PG8_LDB(dst, b, h) do { _Pragma("unroll") for (int n = 0; n < 2; ++n) _Pragma("unroll") for (int k = 0; k < 2; ++k) dst[n][k] = *(const LDS_AS bf16x8*)(lds + PG8_SB(b, h) + boff + n * 2048 + k * 1024); } while (0)
#define PG8_MMA(ai, bj, At, Bt) do { __builtin_amdgcn_s_setprio(1); _Pragma("unroll") for (int m = 0; m < 4; ++m) _Pragma("unroll") for (int n = 0; n < 2; ++n) _Pragma("unroll") for (int k = 0; k < 2; ++k) \
        acc[ai][bj][m][n] = __builtin_amdgcn_mfma_f32_16x16x32_bf16(Bt[n][k], At[m][k], acc[ai][bj][m][n], 0, 0, 0); __builtin_amdgcn_s_setprio(0); } while (0)
#define PG8_WAIT_V(n) asm volatile("s_waitcnt vmcnt(" #n ")" ::: "memory")
#define PG8_WAIT_L(n) asm volatile("s_waitcnt lgkmcnt(" #n ")" ::: "memory")
#define PG8_BAR __builtin_amdgcn_s_barrier()
#define PG8_SCHED __builtin_amdgcn_sched_barrier(0)
    Unit cur, nxt; int ui = 0;
    if (!S.next(0, cur)) return;
    f32x4 acc[2][2][4][2];
#pragma unroll
    for (int a = 0; a < 2; ++a)
#pragma unroll
        for (int b = 0; b < 2; ++b)
#pragma unroll
            for (int m = 0; m < 4; ++m)
#pragma unroll
                for (int n = 0; n < 2; ++n) acc[a][b][m][n] = (f32x4){0.f, 0.f, 0.f, 0.f};
    bf16x8 At[4][2], B0[2][2], B1[2][2];
    const char* cA = (const char*)g.A + (size_t)cur.pm * tstepA; const char* cB = (const char*)g.Bt + (size_t)cur.pn * tstepB;
    PG8_STAGE(PG8_SB(0, 0), cB, voffB); PG8_STAGE(PG8_SB(0, 1), cB + hstepB, voffB); PG8_STAGE(PG8_SA(0, 0), cA, voffA); PG8_STAGE(PG8_SA(0, 1), cA + hstepA, voffA);
    if (wr == 1) PG8_BAR;
    PG8_WAIT_V(2); PG8_BAR;
    PG8_STAGE(PG8_SB(1, 0), cB + kstep, voffB); PG8_STAGE(PG8_SA(1, 0), cA + kstep, voffA); PG8_STAGE(PG8_SB(1, 1), cB + hstepB + kstep, voffB);
    PG8_WAIT_V(6); PG8_BAR;
    for (;;) {
        const bool has_next = S.next(ui + 1, nxt);
        const char* nA = has_next ? (const char*)g.A + (size_t)nxt.pm * tstepA : cA; const char* nB = has_next ? (const char*)g.Bt + (size_t)nxt.pn * tstepB : cB;
        for (int t = 0; t < nt; t += 2) {
            const bool last = (t == nt - 2);
            const char* a1 = cA + (size_t)(t + 1) * kstep;
            const char* a2 = last ? nA : cA + (size_t)(t + 2) * kstep; const char* b2 = last ? nB : cB + (size_t)(t + 2) * kstep;
            const char* a3 = a2 + kstep; const char* b3 = b2 + kstep;
            PG8_LDB(B0, 0, 0); PG8_LDB(B1, 0, 1); PG8_SCHED; PG8_LDA(At, 0, 0); PG8_STAGE(PG8_SA(1, 1), a1 + hstepA, voffA);
            PG8_WAIT_V(8); PG8_WAIT_L(0); PG8_BAR; PG8_MMA(0, 0, At, B0); PG8_MMA(0, 1, At, B1); PG8_BAR; PG8_SCHED;
            PG8_LDA(At, 0, 1); PG8_STAGE(PG8_SB(0, 0), b2, voffB); PG8_STAGE(PG8_SB(0, 1), b2 + hstepB, voffB); PG8_STAGE(PG8_SA(0, 0), a2, voffA);
            PG8_WAIT_V(8); PG8_WAIT_L(0); PG8_BAR; PG8_MMA(1, 0, At, B0); PG8_MMA(1, 1, At, B1); PG8_BAR; PG8_SCHED;
            PG8_LDB(B0, 1, 0); PG8_LDB(B1, 1, 1); PG8_SCHED; PG8_LDA(At, 1, 0); PG8_STAGE(PG8_SA(0, 1), a2 + hstepA, voffA);
            PG8_WAIT_V(8); PG8_WAIT_L(0); PG8_BAR; PG8_MMA(0, 0, At, B0); PG8_MMA(0, 1, At, B1); PG8_BAR; PG8_SCHED;
            PG8_LDA(At, 1, 1); PG8_STAGE(PG8_SB(1, 0), b3, voffB); PG8_STAGE(PG8_SB(1, 1), b3 + hstepB, voffB); PG8_STAGE(PG8_SA(1, 0), a3, voffA);
            PG8_WAIT_V(8); PG8_WAIT_L(0); PG8_BAR; PG8_MMA(1, 0, At, B0); PG8_MMA(1, 1, At, B1); PG8_BAR; PG8_SCHED;
        }
        if (wr == 0) PG8_BAR;
        E(acc, cur, wr, wc, fr, fq);
        if (!has_next) break;
#pragma unroll
        for (int a = 0; a < 2; ++a)
#pragma unroll
            for (int b = 0; b < 2; ++b)
#pragma unroll
                for (int m = 0; m < 4; ++m)
#pragma unroll
                    for (int n = 0; n < 2; ++n) acc[a][b][m][n] = (f32x4){0.f, 0.f, 0.f, 0.f};
        cur = nxt; cA = nA; cB = nB; ++ui;
        if (wr == 1) PG8_BAR;
    }
    PG8_WAIT_V(0);
    PG8_BAR;
#undef PG8_SA
#undef PG8_SB
#undef PG8_STAGE
#undef PG8_LDA
#undef PG8_LDB
#undef PG8_MMA
#undef PG8_WAIT_V
#undef PG8_WAIT_L
#undef PG8_BAR
#undef PG8_SCHED
}
struct EpiResid {
    static constexpr bool PERM = true;
    const float* res; float* out;
    DI void operator()(const f32x4 (&acc)[2][2][4][2], const Unit& u, int wr, int wc, int fr, int fq) const {
        const int row0 = u.pm * BM + wr * 64 + fr, col0 = u.pn * BM + wc * 32 + 8 * fq;
#pragma unroll
        for (int ai = 0; ai < 2; ++ai)
#pragma unroll
            for (int m = 0; m < 4; ++m) {
                const size_t rb = (size_t)(row0 + ai * HALF + m * 16) * D + col0;
#pragma unroll
                for (int bj = 0; bj < 2; ++bj)
#pragma unroll
                    for (int n = 0; n < 2; ++n) { const size_t idx = rb + bj * HALF + n * 4; *(f32x4*)(out + idx) = *(const f32x4*)(res + idx) + acc[ai][bj][m][n]; }
            }
    }
};
struct EpiBf16 {
    static constexpr bool PERM = true;
    bf16_t* out; int ld;
    DI void operator()(const f32x4 (&acc)[2][2][4][2], const Unit& u, int wr, int wc, int fr, int fq) const {
        const int row0 = u.pm * BM + wr * 64 + fr, col0 = u.pn * BM + wc * 32 + 8 * fq;
#pragma unroll
        for (int ai = 0; ai < 2; ++ai)
#pragma unroll
            for (int m = 0; m < 4; ++m) {
                bf16_t* rowp = out + (size_t)(row0 + ai * HALF + m * 16) * ld + col0;
#pragma unroll
                for (int bj = 0; bj < 2; ++bj) {
                    const f32x4 v0 = acc[ai][bj][m][0], v1 = acc[ai][bj][m][1];
                    u32x4 w; w.x = pack2(v0[0], v0[1]); w.y = pack2(v0[2], v0[3]); w.z = pack2(v1[0], v1[1]); w.w = pack2(v1[2], v1[3]);
                    *(u32x4*)(rowp + bj * HALF) = w;
                }
            }
    }
};
struct EpiSwiglu {
    static constexpr bool PERM = true;
    bf16_t* act;
    DI void operator()(const f32x4 (&acc)[2][2][4][2], const Unit& u, int wr, int wc, int fr, int fq) const {
        const int row0 = u.pm * BM + wr * 64 + fr, col0 = u.pn * HALF + wc * 32 + 8 * fq;
#pragma unroll
        for (int ai = 0; ai < 2; ++ai)
#pragma unroll
            for (int m = 0; m < 4; ++m) {
                float v[8];
#pragma unroll
                for (int n = 0; n < 2; ++n)
#pragma unroll
                    for (int j = 0; j < 4; ++j) { const float gg = acc[ai][0][m][n][j], uu = acc[ai][1][m][n][j]; v[4 * n + j] = gg * uu * __builtin_amdgcn_rcpf(1.0f + __builtin_amdgcn_exp2f(-gg * LOG2E)); }
                u32x4 w; w.x = pack2(v[0], v[1]); w.y = pack2(v[2], v[3]); w.z = pack2(v[4], v[5]); w.w = pack2(v[6], v[7]);
                *(u32x4*)(act + (size_t)(row0 + ai * HALF + m * 16) * DFF + col0) = w;
            }
    }
};
}
DI pg8::Gemm mk_gemm(const bf16_t* A, int lda, const bf16_t* Bt, int M, int N, int K) { return pg8::Gemm{A, Bt, M, N / 256, K, lda, (size_t)128 * K * 2, (size_t)256 * K * 2}; }

template <int DQK, int DV, int KT, int QMODE, bool ALIBI, bool NOMAX>
DI void attn_core(const bf16_t* __restrict__ q, int ldq, const bf16_t* __restrict__ k, int ldk, const bf16_t* __restrict__ k2, int ldk2,
                  const bf16_t* __restrict__ v, int ldv, int nkeys, int qpos0, float qscale, float slope2,
                  const float* __restrict__ qg, const float2* __restrict__ tab, char* smem, f32x16 (&o)[DV / 32], float& lsum) {
    constexpr int KROW = DQK * 2 + 16, VROW = DV * 2 + 64  , KBYTES = KT * KROW, VBYTES = KT * VROW;
    constexpr int KCPR = DQK / 8  , KTOT = KT * KCPR, NKC = (KTOT + THREADS - 1) / THREADS, VCPR = DV / 8, VTOT = KT * VCPR, NVC = (VTOT + THREADS - 1) / THREADS;
    constexpr int NST = KT / 32, NKS = DQK / 16, NDT = DV / 32;
    static_assert(2 * (KBYTES + VBYTES) <= (int)LDS_BYTES, "lds");
    const int tid = otid(), lane = tid & 63, w = tid >> 6, r = lane & 31, h = lane >> 5;
    const int qpos = qpos0 + 32 * w + r;
    bf16x8 qf[NKS];
    {
        const bf16_t* qrow = q + (size_t)(32 * w + r) * ldq + 8 * h;
        u32x4 raw[NKS];
#pragma unroll
        for (int s = 0; s < NKS; ++s) raw[s] = *(const u32x4*)(qrow + 16 * s);
        if (QMODE == 1) {
            float ss = 0.f;
#pragma unroll
            for (int s = 0; s < NKS; ++s) {
                const unsigned u[4] = {raw[s].x, raw[s].y, raw[s].z, raw[s].w};
#pragma unroll
                for (int j = 0; j < 4; ++j) { const float a0 = bflo(u[j]), a1 = bfhi(u[j]); ss += a0 * a0 + a1 * a1; }
            }
            ss += __shfl_xor(ss, 32);
            const float rstd = rsqrtf(ss * (1.0f / 64) + EPS) * qscale;
#pragma unroll
            for (int s = 0; s < NKS; ++s) {
                unsigned u[4] = {raw[s].x, raw[s].y, raw[s].z, raw[s].w};
#pragma unroll
                for (int j = 0; j < 4; ++j) {
                    const int d0 = 16 * s + 8 * h + 2 * j;
                    const float y0 = bflo(u[j]) * rstd * qg[d0], y1 = bfhi(u[j]) * rstd * qg[d0 + 1];
                    const float2 cs = tab[qpos * 32 + (d0 >> 1)];
                    u[j] = pack2(y0 * cs.x - y1 * cs.y, y0 * cs.y + y1 * cs.x);
                }
                raw[s] = u32x4{u[0], u[1], u[2], u[3]};
            }
        } else if (QMODE == 2) {
#pragma unroll
            for (int s = 4; s < NKS; ++s) {
                unsigned u[4] = {raw[s].x, raw[s].y, raw[s].z, raw[s].w};
#pragma unroll
                for (int j = 0; j < 4; ++j) {
                    const int p = 8 * (s - 4) + 4 * h + j;
                    const float y0 = bflo(u[j]), y1 = bfhi(u[j]);
                    const float2 cs = tab[qpos * 16 + p];
                    u[j] = pack2(y0 * cs.x - y1 * cs.y, y0 * cs.y + y1 * cs.x);
                }
                raw[s] = u32x4{u[0], u[1], u[2], u[3]};
            }
        }
#pragma unroll
        for (int s = 0; s < NKS; ++s) qf[s] = __builtin_bit_cast(bf16x8, raw[s]);
    }
    u32x4 rk[NKC], rv[NVC];
    char* const kbuf = smem;
    char* const vbuf = smem + 2 * KBYTES;
#define ATT_GLOADK(key0_)                                                                                             \
    {                                                                                                                 \
        _Pragma("unroll") for (int i = 0; i < NKC; ++i) {                                                             \
            const int cid = tid + THREADS * i, key = cid / KCPR, cc = cid - key * KCPR;                               \
            if (KTOT % THREADS == 0 || cid < KTOT) {                                                                  \
                const bf16_t* src;                                                                                    \
                if (QMODE == 2 && cc >= 8) src = k2 + (size_t)((key0_) + key) * ldk2 + (cc - 8) * 8;                   \
                else src = k + (size_t)((key0_) + key) * ldk + cc * 8;                                                \
                rk[i] = *(const u32x4*)src;                                                                           \
            }                                                                                                         \
        }                                                                                                             \
    }
#define ATT_GLOADV(key0_)                                                                                             \
    {                                                                                                                 \
        _Pragma("unroll") for (int i = 0; i < NVC; ++i) {                                                             \
            const int cid = tid + THREADS * i, key = cid / VCPR, cc = cid - key * VCPR;                               \
            if (VTOT % THREADS == 0 || cid < VTOT) rv[i] = *(const u32x4*)(v + (size_t)((key0_) + key) * ldv + cc * 8); \
        }                                                                                                             \
    }
#define ATT_LSTOREK(buf_)                                                                                             \
    {                                                                                                                 \
        _Pragma("unroll") for (int i = 0; i < NKC; ++i) {                                                             \
            const int cid = tid + THREADS * i, key = cid / KCPR, cc = cid - key * KCPR;                               \
            if (KTOT % THREADS == 0 || cid < KTOT) *(u32x4*)(kbuf + (buf_) * KBYTES + key * KROW + cc * 16) = rk[i];  \
        }                                                                                                             \
    }
#define ATT_LSTOREV(buf_)                                                                                             \
    {                                                                                                                 \
        _Pragma("unroll") for (int i = 0; i < NVC; ++i) {                                                             \
            const int cid = tid + THREADS * i, key = cid / VCPR, cc = cid - key * VCPR;                               \
            if (VTOT % THREADS == 0 || cid < VTOT) *(u32x4*)(vbuf + (buf_) * VBYTES + key * VROW + cc * 16) = rv[i];  \
        }                                                                                                             \
    }
#define ATT_QK(buf_, X_)                                                                                              \
    {                                                                                                                 \
        const char* kb_ = kbuf + (buf_) * KBYTES + r * KROW + h * 16;                                                 \
        _Pragma("unroll") for (int st = 0; st < NST; ++st) {                                                          \
            X_[st] = MFMA(*(const bf16x8*)(kb_ + 32 * st * KROW), qf[0], zero16);                                     \
            _Pragma("unroll") for (int ks = 1; ks < NKS; ++ks) X_[st] = MFMA(*(const bf16x8*)(kb_ + 32 * st * KROW + ks * 32), qf[ks], X_[st]); \
        }                                                                                                             \
    }
#define ATT_SMPV(t_, vb_, X_)                                                                                         \
    {                                                                                                                 \
        if (NOMAX) {                                                                                                  \
            const float dqn = (float)(qpos - ((t_) * KT + 4 * h));                                                    \
            _Pragma("unroll") for (int st = 0; st < NST; ++st)                                                        \
                _Pragma("unroll") for (int i = 0; i < 16; ++i) {                                                      \
                    float xv_ = X_[st][i];                                                                            \
                    if (ALIBI) xv_ = __builtin_fmaf(-slope2, fabsf(dqn - (float)(32 * st + (i & 3) + 8 * (i >> 2))), xv_); \
                    X_[st][i] = __builtin_amdgcn_exp2f(xv_);                                                          \
                    if (!ROWSUM_MFMA) lacc += X_[st][i];                                                              \
                }                                                                                                     \
        } else {                                                                                                      \
            float mx = -1e30f;                                                                                        \
            const float dq = (float)(qpos - ((t_) * KT + 4 * h));                                                     \
            _Pragma("unroll") for (int st = 0; st < NST; ++st)                                                        \
                _Pragma("unroll") for (int i = 0; i < 16; ++i) {                                                      \
                    if (ALIBI) X_[st][i] = __builtin_fmaf(-slope2, fabsf(dq - (float)(32 * st + (i & 3) + 8 * (i >> 2))), X_[st][i]); \
                    mx = fmaxf(mx, X_[st][i]);                                                                        \
                }                                                                                                     \
            mx = fmaxf(mx, __shfl_xor(mx, 32));                                                                       \
            const float mn = fmaxf(m, mx);                                                                            \
            const float alpha = __builtin_amdgcn_exp2f(m - mn);                                                       \
            m = mn;                                                                                                   \
            float rs_ = 0.f;                                                                                          \
            _Pragma("unroll") for (int st = 0; st < NST; ++st)                                                        \
                _Pragma("unroll") for (int i = 0; i < 16; ++i) { X_[st][i] = __builtin_amdgcn_exp2f(X_[st][i] - mn); if (!ROWSUM_MFMA) rs_ += X_[st][i]; } \
            if (__any(alpha != 1.0f)) {                                                                               \
                _Pragma("unroll") for (int dt = 0; dt < NDT; ++dt)                                                    \
                    _Pragma("unroll") for (int i = 0; i < 16; ++i) o[dt][i] *= alpha;                                 \
                _Pragma("unroll") for (int i = 0; i < 16; ++i) ol[i] *= alpha;                                        \
            }                                                                                                         \
            if (!ROWSUM_MFMA) lacc = lacc * alpha + rs_;                                                              \
        }                                                                                                             \
        const char* vbp_ = vbuf + (vb_) * VBYTES + vlane;                                                             \
        _Pragma("unroll") for (int st = 0; st < NST; ++st)                                                            \
            _Pragma("unroll") for (int s = 0; s < 2; ++s) {                                                           \
                u32x4 pk;                                                                                             \
                pk.x = pack2(X_[st][8 * s + 0], X_[st][8 * s + 1]); pk.y = pack2(X_[st][8 * s + 2], X_[st][8 * s + 3]); \
                pk.z = pack2(X_[st][8 * s + 4], X_[st][8 * s + 5]); pk.w = pack2(X_[st][8 * s + 6], X_[st][8 * s + 7]); \
                const bf16x8 pb = __builtin_bit_cast(bf16x8, pk);                                                     \
                if (ROWSUM_MFMA) ol = MFMA(ones8, pb, ol);                                                            \
                _Pragma("unroll") for (int dt = 0; dt < NDT; ++dt) {                                                  \
                    const char* va = vbp_ + (32 * st + 16 * s) * VROW + 64 * dt;                                      \
                    const s16x4 lo = __builtin_amdgcn_ds_read_tr16_b64_v4i16((LDS_AS s16x4*)(va));                    \
                    const s16x4 hi = __builtin_amdgcn_ds_read_tr16_b64_v4i16((LDS_AS s16x4*)(va + 8 * VROW));        \
                    o[dt] = MFMA(__builtin_shufflevector(lo, hi, 0, 1, 2, 3, 4, 5, 6, 7), pb, o[dt]);                 \
                }                                                                                                     \
            }                                                                                                         \
    }
#define ATT_STEP(t_, PAR_, CUR_, NXT_)                                                                                \
    {                                                                                                                 \
        const int tk_ = ((t_) + 2 < ntiles) ? (t_) + 2 : ntiles - 1, tv_ = ((t_) + 1 < ntiles) ? (t_) + 1 : ntiles - 1; \
        ATT_GLOADK(tk_ * KT)                                                                                          \
        ATT_GLOADV(tv_ * KT)                                                                                          \
        __builtin_amdgcn_sched_barrier(0);                                                                            \
        ATT_QK(1 - (PAR_), NXT_)                                                                                      \
        ATT_SMPV(t_, PAR_, CUR_)                                                                                      \
        __builtin_amdgcn_sched_barrier(0);                                                                            \
        ATT_LSTOREK(PAR_)                                                                                             \
        ATT_LSTOREV(1 - (PAR_))                                                                                       \
        __syncthreads();                                                                                              \
    }
#define ATT_STEP1(t_, PAR_, X_)                                                                                       \
    {                                                                                                                 \
        const int tn_ = ((t_) + 1 < ntiles) ? (t_) + 1 : ntiles - 1;                                                  \
        ATT_GLOADK(tn_ * KT)                                                                                          \
        ATT_GLOADV(tn_ * KT)                                                                                          \
        __builtin_amdgcn_sched_barrier(0);                                                                            \
        ATT_QK(PAR_, X_)                                                                                              \
        ATT_SMPV(t_, PAR_, X_)                                                                                        \
        __builtin_amdgcn_sched_barrier(0);                                                                            \
        ATT_LSTOREK(1 - (PAR_))                                                                                       \
        ATT_LSTOREV(1 - (PAR_))                                                                                       \
        __syncthreads();                                                                                              \
    }
    const f32x16 zero16 = {0.f, 0.f, 0.f, 0.f, 0.f, 0.f, 0.f, 0.f, 0.f, 0.f, 0.f, 0.f, 0.f, 0.f, 0.f, 0.f};
    const bf16x8 ones8 = {0x3F80, 0x3F80, 0x3F80, 0x3F80, 0x3F80, 0x3F80, 0x3F80, 0x3F80};
    constexpr bool ROWSUM_MFMA = false;
    float m = -1e30f, lacc = 0.f;
    f32x16 ol = zero16;
#pragma unroll
    for (int dt = 0; dt < NDT; ++dt) o[dt] = zero16;
    const int ntiles = nkeys / KT;
    const int vlane = (4 * h + ((lane & 15) >> 2)) * VROW + (16 * ((lane >> 4) & 1) + 4 * (lane & 3)) * 2;
    constexpr bool PIPE = (DV < 128);
    if (PIPE) {
        f32x16 xa[NST], xb[NST];
        ATT_GLOADK(0) ATT_LSTOREK(0)
        ATT_GLOADK(KT) ATT_GLOADV(0)
        __syncthreads();
        ATT_QK(0, xa)
        ATT_LSTOREK(1) ATT_LSTOREV(0)
        __syncthreads();
        for (int t = 0; t < ntiles; t += 2) {
            ATT_STEP(t, 0, xa, xb)
            ATT_STEP(t + 1, 1, xb, xa)
        }
    } else {
        f32x16 xs[NST];
        ATT_GLOADK(0) ATT_GLOADV(0) ATT_LSTOREK(0) ATT_LSTOREV(0)
        __syncthreads();
        for (int t = 0; t < ntiles; t += 2) {
            ATT_STEP1(t, 0, xs)
            ATT_STEP1(t + 1, 1, xs)
        }
    }
    lsum = ROWSUM_MFMA ? ol[0] : lacc + __shfl_xor(lacc, 32);
#undef ATT_GLOADK
#undef ATT_GLOADV
#undef ATT_LSTOREK
#undef ATT_LSTOREV
#undef ATT_QK
#undef ATT_SMPV
#undef ATT_STEP
#undef ATT_STEP1
}
template <int NDT>
DI void store_o(bf16_t* dst, int ld, f32x16 (&o)[NDT], float inv) {
    const int tid_ = otid(), lane = tid_ & 63, w = tid_ >> 6, r = lane & 31, h = lane >> 5;
    bf16_t* row = dst + (size_t)(32 * w + r) * ld + 4 * h;
#pragma unroll
    for (int dt = 0; dt < NDT; ++dt)
#pragma unroll
        for (int g = 0; g < 4; ++g) {
            uint2 vv; vv.x = pack2(o[dt][4 * g] * inv, o[dt][4 * g + 1] * inv); vv.y = pack2(o[dt][4 * g + 2] * inv, o[dt][4 * g + 3] * inv);
            *(uint2*)(row + 32 * dt + 8 * g) = vv;
        }
}
DI int swz_item(int base) {
    const int G = gridDim.x, i = blockIdx.x;
    if (G & 7) return base + i;
    return base + (i & 7) * (G >> 3) + (i >> 3);
}

constexpr int QT = SEQ / 256;
constexpr float NOMAX_BOUND = 90.f;
DI void attn_even(const bf16_t* qkv, float* park, bf16_t* mix, const Params& p, const float2* ax, const unsigned* nd, float lam_init, char* smem) {
    float d1 = 0.f, d2 = 0.f, gq = 0.f, gk = 0.f;
    for (int i = 0; i < 64; ++i) { d1 += p.in[8][i] * p.in[9][i]; d2 += p.in[10][i] * p.in[11][i]; gq = fmaxf(gq, fabsf(p.in[6][i])); gk = fmaxf(gk, fabsf(p.in[7][i])); }
    const float lam = __expf(d1) - __expf(d2) + lam_init;
    const float bound_gqa = 64.f * 0.125f * LOG2E * gq * gk * 1.03f;
    const int tid_ = otid(), lane = tid_ & 63, h = lane >> 5;
    float4* mypark = (float4*)(park + ((size_t)blockIdx.x * THREADS + tid_) * 64);
    constexpr int NDIFF = NB * 4 * QT, NGQA = NB * 8 * QT;
    for (int base = 0; base < NDIFF + NGQA; base += gridDim.x) {
        const int it = swz_item(base);
        if (it >= NDIFF + NGQA) continue;
        if (it < NDIFF) {
            const int b = it / (4 * QT), hd = (it / QT) & 3, qt = it % QT;
            const size_t row0 = (size_t)b * SEQ + qt * 256;
            const float slope2 = exp2f(-2.0f * (hd + 1)) * LOG2E;
            const bf16_t* qp = qkv + row0 * EVEN_IN + 768 + hd * 128;
            const bf16_t* kp = qkv + (size_t)b * SEQ * EVEN_IN + 1280 + hd * 128;
            const bf16_t* vp = qkv + (size_t)b * SEQ * EVEN_IN + 1792 + hd * 128;
            f32x16 o0[4]; float l0 = 1.f;
#pragma unroll 1
            for (int c = 0; c < 2; ++c) {
                const unsigned* nn = nd + (b * 8 + hd * 2 + c) * 2;
                const float bound = sqrtf(__uint_as_float(nn[0]) * __uint_as_float(nn[1])) * 1.03f;
                if (bound < NOMAX_BOUND) attn_core<64, 128, 64, 0, true, true>(qp + 64 * c, EVEN_IN, kp + 64 * c, EVEN_IN, nullptr, 0, vp, EVEN_IN, SEQ, qt * 256, 1.0f, slope2, nullptr, nullptr, smem, o0, l0);
                else attn_core<64, 128, 64, 0, true, false>(qp + 64 * c, EVEN_IN, kp + 64 * c, EVEN_IN, nullptr, 0, vp, EVEN_IN, SEQ, qt * 256, 1.0f, slope2, nullptr, nullptr, smem, o0, l0);
                if (c == 0) {
                    const float i0 = 1.0f / l0;
#pragma unroll
                    for (int dt = 0; dt < 4; ++dt)
#pragma unroll
                        for (int g = 0; g < 4; ++g) mypark[dt * 4 + g] = make_float4(o0[dt][4 * g] * i0, o0[dt][4 * g + 1] * i0, o0[dt][4 * g + 2] * i0, o0[dt][4 * g + 3] * i0);
                    asm volatile("" ::: "memory");
                }
            }
            const float i1 = lam / l0;
            float ss = 0.f;
            asm volatile("" ::: "memory");
#pragma unroll
            for (int dt = 0; dt < 4; ++dt)
#pragma unroll
                for (int g = 0; g < 4; ++g) {
                    const float4 pv = mypark[dt * 4 + g];
                    const float pa[4] = {pv.x, pv.y, pv.z, pv.w};
#pragma unroll
                    for (int e = 0; e < 4; ++e) { const float vv = pa[e] - i1 * o0[dt][4 * g + e]; o0[dt][4 * g + e] = vv; ss += vv * vv; }
                }
            ss += __shfl_xor(ss, 32);
            const float rstd = rsqrtf(ss * (1.0f / 128) + EPS) * (1.0f - lam_init);
#pragma unroll
            for (int dt = 0; dt < 4; ++dt)
#pragma unroll
                for (int i = 0; i < 16; ++i) o0[dt][i] *= p.in[12][32 * dt + crow(i, h)];
            store_o<4>(mix + row0 * D + 512 + hd * 128, D, o0, rstd);
        } else {
            const int j = it - NDIFF;
            const int b = j / (8 * QT), hd = (j / QT) & 7, qt = j % QT, kvh = hd >> 2;
            const size_t row0 = (size_t)b * SEQ + qt * 256;
            const bf16_t* qp = qkv + row0 * EVEN_IN + hd * 64;
            const bf16_t* kp = qkv + (size_t)b * SEQ * EVEN_IN + 512 + kvh * 64;
            const bf16_t* vp = qkv + (size_t)b * SEQ * EVEN_IN + 640 + kvh * 64;
            f32x16 o[2]; float l;
            if (bound_gqa < NOMAX_BOUND) attn_core<64, 64, 64, 1, false, true>(qp, EVEN_IN, kp, EVEN_IN, nullptr, 0, vp, EVEN_IN, SEQ, qt * 256, 0.125f * LOG2E, 0.f, p.in[6], ax, smem, o, l);
            else attn_core<64, 64, 64, 1, false, false>(qp, EVEN_IN, kp, EVEN_IN, nullptr, 0, vp, EVEN_IN, SEQ, qt * 256, 0.125f * LOG2E, 0.f, p.in[6], ax, smem, o, l);
            store_o<2>(mix + row0 * D + hd * 64, D, o, 1.0f / l);
        }
    }
}
DI void attn_mla(const bf16_t* qb, const bf16_t* kv, const bf16_t* a, bf16_t* mix, const float2* lin, const unsigned* nmx, char* smem) {
    constexpr int NIT = NB * 16 * QT;
    for (int base = 0; base < NIT; base += gridDim.x) {
        const int it = swz_item(base);
        if (it >= NIT) continue;
        const int b = it / (16 * QT), hd = (it / QT) & 15, qt = it % QT;
        const size_t row0 = (size_t)b * SEQ + qt * 256;
        const unsigned* nn = nmx + (b * 16 + hd) * 2;
        const float bound = sqrtf(__uint_as_float(nn[0]) * __uint_as_float(nn[1])) * 1.03f;
        const bf16_t* kb_ = kv + (size_t)b * SEQ * 2048 + hd * 128;
        f32x16 o[2]; float l;
        if (bound < NOMAX_BOUND) attn_core<96, 64, 64, 2, false, true>(qb + row0 * 1536 + hd * 96, 1536, kb_, 2048, a + (size_t)b * SEQ * ODD_PAD + 640, ODD_PAD, kb_ + 64, 2048, SEQ, qt * 256, 1.0f, 0.f, nullptr, lin, smem, o, l);
        else attn_core<96, 64, 64, 2, false, false>(qb + row0 * 1536 + hd * 96, 1536, kb_, 2048, a + (size_t)b * SEQ * ODD_PAD + 640, ODD_PAD, kb_ + 64, 2048, SEQ, qt * 256, 1.0f, 0.f, nullptr, lin, smem, o, l);
        store_o<2>(mix + row0 * D + hd * 64, D, o, 1.0f / l);
    }
}
DI void attn_cross(const bf16_t* qx, const bf16_t* kvx, bf16_t* mix, int seq0, char* smem) {
    constexpr int NIT = NB * 4 * QT * 2;
    for (int base = 0; base < NIT; base += gridDim.x) {
        const int it = swz_item(base);
        if (it >= NIT) continue;
        const int b = it / (8 * QT), hd = (it / (2 * QT)) & 3, qt = (it >> 1) % QT, half = it & 1;
        const size_t row0 = (size_t)b * SEQ + qt * 256;
        const bf16_t* kvb = kvx + (size_t)(seq0 + b) * NMEM * 2048;
        f32x16 o[4]; float l;
        attn_core<256, 128, 32, 0, false, false>(qx + row0 * D + hd * 256, D, kvb + hd * 256, 2048, nullptr, 0, kvb + 1024 + hd * 256 + half * 128, 2048, NMEM, 0,
                                          1.0f, 0.f, nullptr, nullptr, smem, o, l);
        store_o<4>(mix + row0 * D + hd * 256 + half * 128, D, o, 1.0f / l);
    }
}

extern "C" __global__ void __launch_bounds__(THREADS, 2) fwd_mega(Params p) {
    extern __shared__ __attribute__((aligned(16))) char smem[];
    LDS_AS unsigned char* lds = (LDS_AS unsigned char*)smem;
    cg::grid_group grid = cg::this_grid();
    char* ws = p.ws;
    __shared__ uint4 xb_words;
    if (threadIdx.x == 0) xb_words = make_uint4(0u, 0u, 0u, 0u);
    __syncthreads();
    const XcdBarrier xb = xcd_barrier_post((unsigned*)(ws + B_BAR), (volatile LDS_AS unsigned*)&xb_words);
    bf16_t* wEin = (bf16_t*)(ws + W_EIN); bf16_t* wEout = (bf16_t*)(ws + W_EOUT); bf16_t* wOin = (bf16_t*)(ws + W_OIN);
    bf16_t* wUq = (bf16_t*)(ws + W_UQ); bf16_t* wUkv = (bf16_t*)(ws + W_UKV); bf16_t* wOout = (bf16_t*)(ws + W_OOUT);
    float2* ax = (float2*)(ws + T_AX); float2* lin = (float2*)(ws + T_LIN);
    bf16_t* H = (bf16_t*)(ws + B_H); bf16_t* MIX = (bf16_t*)(ws + B_MIX);

    convert_weight(p.in[5], wEin, D, EVEN_IN, EVEN_IN, smem, 768, 1280, 0.125f * LOG2E);
    convert_weight(p.in[13], wEout, D, D, D, smem);
    convert_weight(p.in[14], wOin, D, ODD_IN, ODD_PAD, smem);
    convert_weight(p.in[17], wUq, 384, 1536, 1536, smem, 0, 1536, 0.10206207261596575f * LOG2E);
    convert_weight(p.in[18], wUkv, 256, 2048, 2048, smem);
    convert_weight(p.in[19], wOout, D, D, D, smem);
    for (int l = 0; l < 2; ++l) {
        convert_weight(p.in[22] + (size_t)l * D * D, (bf16_t*)(ws + W_CQ) + (size_t)l * D * D, D, D, D, smem, 0, D, 0.0625f * LOG2E);
        convert_weight(p.in[23] + (size_t)l * D * 2048, (bf16_t*)(ws + W_CKV) + (size_t)l * 2048 * D, D, 2048, 2048, smem);
        convert_weight(p.in[24] + (size_t)l * D * D, (bf16_t*)(ws + W_CO) + (size_t)l * D * D, D, D, D, smem);
        convert_weight(p.in[26] + (size_t)l * D * 2 * DFF, (bf16_t*)(ws + W_GU) + (size_t)l * 2 * DFF * D, D, 2 * DFF, 2 * DFF, smem);
        convert_weight(p.in[27] + (size_t)l * DFF * D, (bf16_t*)(ws + W_DOWN) + (size_t)l * D * DFF, DFF, D, D, smem);
        rmsnorm_rows(p.in[2], p.in[21] + l * D, (bf16_t*)(ws + B_MEMN) + (size_t)l * NBATCH * NMEM * D, 8 * NMEM);
        rmsnorm_rows(p.in[3], p.in[21] + l * D, (bf16_t*)(ws + B_MEMN) + (size_t)l * NBATCH * NMEM * D + (size_t)8 * NMEM * D, 16 * NMEM);
    }
    build_tables(ax, lin);
    if (blockIdx.x == 0) for (int i = threadIdx.x; i < 4096; i += THREADS) ((unsigned*)(ws + B_NORMS))[i] = 0u;
    grid.sync();
    for (int l = 0; l < 2; ++l) {
        pg8::EpiBf16 e{(bf16_t*)(ws + B_KX) + (size_t)l * NBATCH * NMEM * 2048, 2048};
        pg8::gemm_phase(lds, mk_gemm((const bf16_t*)(ws + B_MEMN) + (size_t)l * NBATCH * NMEM * D, D, (const bf16_t*)(ws + W_CKV) + (size_t)l * 2048 * D, NBATCH * NMEM, 2048, D), e);
    }
    xcd_barrier(xb);

    for (int ch = 0; ch < NCHUNK; ++ch) {
        const float* xin = (ch == 0) ? p.in[0] : p.in[1] + (size_t)(ch - 1) * TC * D;
        float* xo = p.out + (size_t)ch * TC * D;
        for (int layer = 0; layer < 2; ++layer) {
            const float* xcur = (layer == 0) ? xin : xo;
            for (int rep_ = 0; rep_ < PROBE_NORM; ++rep_) rmsnorm_rows(xcur, p.in[4] + layer * D, H, TC);
            xcd_barrier(xb);
            const bf16_t* wout;
            if (layer == 0) {
                bf16_t* qkv = (bf16_t*)(ws + E_QKV);
                for (int rep_ = 0; rep_ < PROBE_GEMM; ++rep_) { pg8::EpiBf16 e{qkv, EVEN_IN}; pg8::gemm_phase(lds, mk_gemm(H, D, wEin, TC, EVEN_IN, D), e); }
                xcd_barrier(xb);
                kprep_even(qkv, p.in[7], ax);
                normmax_even(qkv, (unsigned*)(ws + B_NORMS) + ch * 128, smem);
                xcd_barrier(xb);
                for (int rep_ = 0; rep_ < PROBE_ATTN; ++rep_) attn_even(qkv, (float*)(ws + E_PARK), MIX, p, ax, (const unsigned*)(ws + B_NORMS) + ch * 128, 0.2f, smem);
                wout = wEout;
            } else {
                bf16_t* a = (bf16_t*)(ws + O_A); bf16_t* qb = (bf16_t*)(ws + O_Q); bf16_t* kv = (bf16_t*)(ws + O_KV);
                for (int rep_ = 0; rep_ < PROBE_GEMM; ++rep_) { pg8::EpiBf16 e{a, ODD_PAD}; pg8::gemm_phase(lds, mk_gemm(H, D, wOin, TC, ODD_PAD, D), e); }
                xcd_barrier(xb);
                prep_odd(a, p.in[15], p.in[16], lin);
                xcd_barrier(xb);
                for (int rep_ = 0; rep_ < PROBE_GEMM; ++rep_) { pg8::EpiBf16 e{qb, 1536}; pg8::gemm_phase(lds, mk_gemm(a, ODD_PAD, wUq, TC, 1536, 384), e); }
                for (int rep_ = 0; rep_ < PROBE_GEMM; ++rep_) { pg8::EpiBf16 e{kv, 2048}; pg8::gemm_phase(lds, mk_gemm(a + 384, ODD_PAD, wUkv, TC, 2048, 256), e); }
                xcd_barrier(xb);
                normmax_mla(qb, kv, a, (unsigned*)(ws + B_NORMS) + 384 + ch * 256, smem);
                xcd_barrier(xb);
                for (int rep_ = 0; rep_ < PROBE_ATTN; ++rep_) attn_mla(qb, kv, a, MIX, lin, (const unsigned*)(ws + B_NORMS) + 384 + ch * 256, smem);
                wout = wOout;
            }
            xcd_barrier(xb);
            { pg8::EpiResid e{xcur, xo}; pg8::gemm_phase(lds, mk_gemm(MIX, D, wout, TC, D, D), e); }
            xcd_barrier(xb);
            for (int rep_ = 0; rep_ < PROBE_NORM; ++rep_) rmsnorm_rows(xo, p.in[20] + layer * D, H, TC);
            xcd_barrier(xb);
            for (int rep_ = 0; rep_ < PROBE_GEMM; ++rep_) { pg8::EpiBf16 e{(bf16_t*)(ws + X_Q), D}; pg8::gemm_phase(lds, mk_gemm(H, D, (const bf16_t*)(ws + W_CQ) + (size_t)layer * D * D, TC, D, D), e); }
            xcd_barrier(xb);
            for (int rep_ = 0; rep_ < PROBE_CROSS; ++rep_) attn_cross((const bf16_t*)(ws + X_Q), (const bf16_t*)(ws + B_KX) + (size_t)layer * NBATCH * NMEM * 2048, MIX, ch * NB, smem);
            xcd_barrier(xb);
            { pg8::EpiResid e{xo, xo}; pg8::gemm_phase(lds, mk_gemm(MIX, D, (const bf16_t*)(ws + W_CO) + (size_t)layer * D * D, TC, D, D), e); }
            xcd_barrier(xb);
            for (int rep_ = 0; rep_ < PROBE_NORM; ++rep_) rmsnorm_rows(xo, p.in[25] + layer * D, H, TC);
            xcd_barrier(xb);
            for (int rep_ = 0; rep_ < PROBE_GEMM; ++rep_) { pg8::EpiSwiglu e{(bf16_t*)(ws + F_ACT)};
              pg8::Gemm g{H, (const bf16_t*)(ws + W_GU) + (size_t)layer * 2 * DFF * D, TC, DFF / 128, D, D, (size_t)DFF * D * 2, (size_t)128 * D * 2};
              pg8::gemm_phase(lds, g, e); }
            xcd_barrier(xb);
            { pg8::EpiResid e{xo, xo}; pg8::gemm_phase(lds, mk_gemm((const bf16_t*)(ws + F_ACT), DFF, (const bf16_t*)(ws + W_DOWN) + (size_t)layer * D * DFF, TC, D, DFF), e); }
            xcd_barrier(xb);
        }
        rmsnorm_final(xo, p.in[28], TC);
    }
}

extern "C" void kernel_launch(void* const* d_in, const int* in_sizes, int n_in, void* d_out, int out_size, void* d_ws, size_t ws_size, hipStream_t stream) {
    static int grid_blocks = 0;
    if (!grid_blocks) {
        int dev = 0, cus = 0, per_cu = 0;
        (void)hipGetDevice(&dev);
        (void)hipDeviceGetAttribute(&cus, hipDeviceAttributeMultiprocessorCount, dev);
        (void)hipFuncSetAttribute((const void*)fwd_mega, hipFuncAttributeMaxDynamicSharedMemorySize, (int)LDS_BYTES);
        (void)hipOccupancyMaxActiveBlocksPerMultiprocessor(&per_cu, fwd_mega, THREADS, LDS_BYTES);
        if (per_cu > 1) per_cu = 1;
        if (per_cu < 1) per_cu = 1;
        grid_blocks = cus * per_cu;
    }
    constexpr size_t WS_END = (O_END > E_END ? O_END : E_END) > (F_ACT + (size_t)TC * DFF * 2) ? (O_END > E_END ? O_END : E_END) : (F_ACT + (size_t)TC * DFF * 2);
    if (ws_size < WS_END) { fprintf(stderr, "workspace too small: %zu < %zu\n", ws_size, (size_t)WS_END); return; }
    if (grid_blocks > 256) grid_blocks = 256;
    Params p{};
    for (int i = 0; i < 29; ++i) p.in[i] = (const float*)d_in[i];
    p.out = (float*)d_out;
    p.ws = (char*)d_ws;
    (void)hipMemsetAsync(d_ws, 0, 16384, stream);
    void* args[] = {&p};
    hipError_t e = hipLaunchCooperativeKernel((void*)fwd_mega, dim3(grid_blocks), dim3(THREADS), args, LDS_BYTES, stream);
    if (e != hipSuccess) fprintf(stderr, "cooperative launch failed: %s (grid %d)\n", hipGetErrorString(e), grid_blocks);
}
```

```cpp
#include <hip/hip_runtime.h>
#include <hip/hip_cooperative_groups.h>
#include <cstdio>
#include <cstdint>
namespace cg = cooperative_groups;
#ifndef PROBE_GEMM
#define PROBE_GEMM 1
#endif
#ifndef PROBE_NORM
#define PROBE_NORM 1
#endif
#ifndef PROBE_CROSS
#define PROBE_CROSS 1
#endif
#ifndef PROBE_ATTN
#define PROBE_ATTN 1
#endif

typedef unsigned short bf16_t;
typedef short bf16x8 __attribute__((ext_vector_type(8)));
typedef float f32x16 __attribute__((ext_vector_type(16)));
typedef float f32x2 __attribute__((ext_vector_type(2)));
typedef unsigned u32x4 __attribute__((ext_vector_type(4)));
typedef float f32x4 __attribute__((ext_vector_type(4)));
typedef short s16x4 __attribute__((ext_vector_type(4)));
#define LDS_AS __attribute__((address_space(3)))
typedef __bf16 bf16x2_t __attribute__((ext_vector_type(2)));
#define DI __device__ __forceinline__
#define MFMA(a, b, c) __builtin_amdgcn_mfma_f32_32x32x16_bf16((a), (b), (c), 0, 0, 0)

constexpr int D = 1024, SEQ = 4096, NBATCH = 24, NB = 8  , NCHUNK = NBATCH / NB, TC = NB * SEQ;
constexpr int NMEM = 256, DFF = 2816, EVEN_IN = 2304, ODD_IN = 672, ODD_PAD = 768;
constexpr float EPS = 1e-6f, LOG2E = 1.4426950408889634f;
constexpr int THREADS = 512, NWAVE = THREADS / 64;
constexpr size_t LDS_BYTES = 131072;

constexpr size_t al(size_t x) { return (x + 255) & ~(size_t)255; }
constexpr size_t B_BAR = 0;
constexpr size_t B_NORMS = 16384;
constexpr size_t W_EIN = 32768;
constexpr size_t W_EOUT = W_EIN + al((size_t)EVEN_IN * D * 2);
constexpr size_t W_OIN = W_EOUT + al((size_t)D * D * 2);
constexpr size_t W_UQ = W_OIN + al((size_t)ODD_PAD * D * 2);
constexpr size_t W_UKV = W_UQ + al((size_t)1536 * 384 * 2);
constexpr size_t W_OOUT = W_UKV + al((size_t)2048 * 256 * 2);
constexpr size_t W_CQ = W_OOUT + al((size_t)D * D * 2);
constexpr size_t W_CKV = W_CQ + 2 * al((size_t)D * D * 2);
constexpr size_t W_CO = W_CKV + 2 * al((size_t)2048 * D * 2);
constexpr size_t W_GU = W_CO + 2 * al((size_t)D * D * 2);
constexpr size_t W_DOWN = W_GU + 2 * al((size_t)2 * DFF * D * 2);
constexpr size_t T_AX = W_DOWN + 2 * al((size_t)D * DFF * 2);
constexpr size_t T_LIN = T_AX + al((size_t)SEQ * 32 * 8);
constexpr size_t B_MEMN = T_LIN + al((size_t)SEQ * 16 * 8);
constexpr size_t B_KX = B_MEMN + 2 * al((size_t)NBATCH * NMEM * D * 2);
constexpr size_t B_H = B_KX + 2 * al((size_t)NBATCH * NMEM * 2048 * 2);
constexpr size_t B_MIX = B_H + al((size_t)TC * D * 2);
constexpr size_t B_BIG = B_MIX + al((size_t)TC * D * 2);
constexpr size_t E_QKV = B_BIG;
constexpr size_t E_PARK = E_QKV + al((size_t)TC * EVEN_IN * 2);
constexpr size_t E_END = E_PARK + (size_t)256 * THREADS * 64 * 4;
constexpr size_t O_A = B_BIG;
constexpr size_t O_Q = O_A + al((size_t)TC * ODD_PAD * 2);
constexpr size_t O_KV = O_Q + al((size_t)TC * 1536 * 2);
constexpr size_t O_END = O_KV + al((size_t)TC * 2048 * 2);
constexpr size_t X_Q = B_BIG;
constexpr size_t F_ACT = B_BIG;

struct Params {
    const float* in[29];
    float* out;
    char* ws;
};

DI unsigned pack2(float lo, float hi) { f32x2 v = {lo, hi}; bf16x2_t b = __builtin_convertvector(v, bf16x2_t); return __builtin_bit_cast(unsigned, b); }
DI float bflo(unsigned u) { return __uint_as_float(u << 16); }
DI float bfhi(unsigned u) { return __uint_as_float(u & 0xffff0000u); }
DI int crow(int i, int h) { return (i & 3) + 8 * (i >> 2) + 4 * h; }
DI int swap23(int x) { return (x & ~12) | ((x & 4) << 1) | ((x & 8) >> 1); }
DI int otid() { int t = threadIdx.x; asm volatile("" : "+v"(t)); return t; }
DI float wave_sum(float v) {
#pragma unroll
    for (int o = 32; o >= 1; o >>= 1) v += __shfl_xor(v, o);
    return v;
}


#define XB_TMO      128
#define XB_XCNT(j)  (256  + 64 * (j))
#define XB_XSUB(j)  (1280 + 64 * (j))
#define XB_XGEN(j)  (2304 + 64 * (j))
#define XB_TOP      3328
#define XB_TOPGEN   3392
#define XCD_BAR_WORDS 3456
#define XB_SPIN_CAP (1u << 18)
DI unsigned xb_ld(unsigned* p) { return __hip_atomic_load(p, __ATOMIC_RELAXED, __HIP_MEMORY_SCOPE_AGENT); }
DI unsigned xb_add(unsigned* p, unsigned v) { return __hip_atomic_fetch_add(p, v, __ATOMIC_RELAXED, __HIP_MEMORY_SCOPE_AGENT); }
DI unsigned xb_xcc_id() { return (unsigned)__builtin_amdgcn_s_getreg((3 << 11) | 20) & 0xFu; }
#define XB_SPIN(cond, bar) do { unsigned _sp = 0; while (cond) { __builtin_amdgcn_s_sleep(1); \
    if ((++_sp & 255u) == 0u) { if (xb_ld(&(bar)[XB_TMO])) break; if (_sp > XB_SPIN_CAP) { atomicAdd(&(bar)[XB_TMO], 1u); break; } } } } while (0)
struct XcdBarrier { unsigned* bar; unsigned x; volatile LDS_AS unsigned* st; };
DI XcdBarrier xcd_barrier_post(unsigned* bar, volatile LDS_AS unsigned* st) {
    XcdBarrier b; b.bar = bar; b.x = xb_xcc_id(); b.st = st;
    if (threadIdx.x == 0) (void)xb_add(&bar[XB_XCNT(b.x)], 1u);
    return b;
}
DI void xcd_barrier_complete(unsigned* bar, unsigned x, unsigned& nloc, unsigned& nx) {
    const unsigned G = gridDim.x * gridDim.y * gridDim.z;
    unsigned sum, cnt, mine, sp = 0u;
    for (;;) {
        sum = 0u; cnt = 0u; mine = 0u;
#pragma unroll
        for (unsigned j = 0; j < 16; ++j) { const unsigned c = xb_ld(&bar[XB_XCNT(j)]); sum += c; cnt += (c > 0u) ? 1u : 0u; mine = (j == x) ? c : mine; }
        if (sum == G) break;
        __builtin_amdgcn_s_sleep(1);
        if ((++sp & 255u) == 0u) { if (xb_ld(&bar[XB_TMO])) break; if (sp > XB_SPIN_CAP) { atomicAdd(&bar[XB_TMO], 1u); break; } }
    }
    nloc = mine > 0u ? mine : 1u; nx = cnt > 0u ? cnt : 1u;
}
DI void xcd_barrier(const XcdBarrier& b) {
    asm volatile("s_waitcnt vmcnt(0)" ::: "memory");
    __syncthreads();
    if (threadIdx.x == 0) {
        unsigned* bar = b.bar;
        __builtin_amdgcn_s_waitcnt(0);
        unsigned nloc = b.st[0], nx = b.st[1];
        if (nloc == 0u) { xcd_barrier_complete(bar, b.x, nloc, nx); b.st[0] = nloc; b.st[1] = nx; }
        const unsigned old = xb_add(&bar[XB_XSUB(b.x)], 1u);
        const unsigned gen = old / nloc;
        if (old + 1u == (gen + 1u) * nloc) {
            __builtin_amdgcn_fence(__ATOMIC_RELEASE, "agent");
            asm volatile("s_waitcnt vmcnt(0)" ::: "memory");
            const unsigned og = xb_add(&bar[XB_TOP], 1u);
            const unsigned tg = og / nx;
            if (og + 1u == (tg + 1u) * nx) xb_add(&bar[XB_TOPGEN], 1u);
            else XB_SPIN(xb_ld(&bar[XB_TOPGEN]) == tg, bar);
            __builtin_amdgcn_fence(__ATOMIC_ACQUIRE, "agent");
            xb_add(&bar[XB_XGEN(b.x)], 1u);
            asm volatile("s_waitcnt vmcnt(0)" ::: "memory");
        } else {
            XB_SPIN(xb_ld(&bar[XB_XGEN(b.x)]) == gen, bar);
            __builtin_amdgcn_fence(__ATOMIC_ACQUIRE, "agent");
            asm volatile("s_waitcnt vmcnt(0)" ::: "memory");
        }
    }
    __syncthreads();
}

DI void convert_weight(const float* __restrict__ src, bf16_t* __restrict__ dst, int K, int N, int Npad, char* smem, int slo = 0, int shi = 0, float scale = 1.0f) {
    float* t = (float*)smem;
    const int tid = otid();
    const int nkt = K / 64, nnt = Npad / 64;
    for (int tile = blockIdx.x; tile < nkt * nnt; tile += gridDim.x) {
        const int k0 = (tile / nnt) * 64, n0 = (tile % nnt) * 64;
#pragma unroll
        for (int i = 0; i < 8; ++i) {
            const int k = i * 8 + (tid >> 6), n = tid & 63;
            const float sc_ = (n0 + n >= slo && n0 + n < shi) ? scale : 1.0f;
            t[k * 65 + n] = (n0 + n < N) ? src[(size_t)(k0 + k) * N + n0 + n] * sc_ : 0.f;
        }
        __syncthreads();
#pragma unroll
        for (int i = 0; i < 4; ++i) {
            const int n = i * 16 + (tid >> 5), k = (tid & 31) * 2;
            *(unsigned*)(dst + (size_t)(n0 + n) * K + k0 + k) = pack2(t[k * 65 + n], t[(k + 1) * 65 + n]);
        }
        __syncthreads();
    }
}

__device__ const float kFreq[16] = {1.000000000e+00f, 5.623413324e-01f, 3.162277639e-01f, 1.778279394e-01f, 1.000000015e-01f, 5.623413250e-02f, 3.162277490e-02f, 1.778279431e-02f,
                                    9.999999776e-03f, 5.623413250e-03f, 3.162277630e-03f, 1.778279431e-03f, 1.000000047e-03f, 5.623413017e-04f, 3.162277571e-04f, 1.778279402e-04f};
DI float2 sincos_acc(float ang) {
    const double x = (double)ang;
    const double n = __builtin_rint(x * 0.15915494309189535);
    double r = __builtin_fma(-n, 6.283185307179586, x);
    r = __builtin_fma(-n, 2.4492935982947064e-16, r);
    const double r2 = r * r;
    double s = 1.0, c = 1.0;
#pragma unroll
    for (int k = 13; k >= 1; --k) {
        s = 1.0 - r2 * s * (1.0 / (double)((2 * k) * (2 * k + 1)));
        c = 1.0 - r2 * c * (1.0 / (double)((2 * k - 1) * (2 * k)));
    }
    return make_float2((float)c, (float)(r * s));
}
DI void build_tables(float2* ax, float2* lin) {
    const int gt = blockIdx.x * THREADS + otid(), gs = gridDim.x * THREADS;
    for (int e = gt; e < SEQ * 32; e += gs) {
        const int pos = e >> 5, p = e & 31;
        const float base = (p < 16) ? (float)(pos >> 6) : (float)(pos & 63);
        ax[e] = sincos_acc(base * kFreq[p & 15]);
    }
    for (int e = gt; e < SEQ * 16; e += gs) {
        const int pos = e >> 4, p = e & 15;
        lin[e] = sincos_acc((float)pos * kFreq[p]);
    }
}

DI void rmsnorm_rows(const float* __restrict__ src, const float* __restrict__ g, bf16_t* __restrict__ dst, int nrows) {
    const int tid_ = otid(), lane = tid_ & 63, wv = blockIdx.x * NWAVE + (tid_ >> 6), nw = gridDim.x * NWAVE;
    for (int row = wv; row < nrows; row += nw) {
        const float4* s = (const float4*)(src + (size_t)row * D);
        float4 v[4]; float ss = 0.f;
#pragma unroll
        for (int i = 0; i < 4; ++i) { v[i] = s[i * 64 + lane]; ss += v[i].x * v[i].x + v[i].y * v[i].y + v[i].z * v[i].z + v[i].w * v[i].w; }
        ss = wave_sum(ss);
        const float rstd = rsqrtf(ss * (1.0f / D) + EPS);
#pragma unroll
        for (int i = 0; i < 4; ++i) {
            const float4 gg = ((const float4*)g)[i * 64 + lane];
            uint2 o; o.x = pack2(v[i].x * rstd * gg.x, v[i].y * rstd * gg.y); o.y = pack2(v[i].z * rstd * gg.z, v[i].w * rstd * gg.w);
            *(uint2*)(dst + (size_t)row * D + (i * 64 + lane) * 4) = o;
        }
    }
}
DI void rmsnorm_final(float* __restrict__ x, const float* __restrict__ g, int nrows) {
    const int tid_ = otid(), lane = tid_ & 63, wv = blockIdx.x * NWAVE + (tid_ >> 6), nw = gridDim.x * NWAVE;
    for (int row = wv; row < nrows; row += nw) {
        float4* s = (float4*)(x + (size_t)row * D);
        float4 v[4]; float ss = 0.f;
#pragma unroll
        for (int i = 0; i < 4; ++i) { v[i] = s[i * 64 + lane]; ss += v[i].x * v[i].x + v[i].y * v[i].y + v[i].z * v[i].z + v[i].w * v[i].w; }
        ss = wave_sum(ss);
        const float rstd = rsqrtf(ss * (1.0f / D) + EPS);
#pragma unroll
        for (int i = 0; i < 4; ++i) {
            const float4 gg = ((const float4*)g)[i * 64 + lane];
            float4 o; o.x = v[i].x * rstd * gg.x; o.y = v[i].y * rstd * gg.y; o.z = v[i].z * rstd * gg.z; o.w = v[i].w * rstd * gg.w;
            s[i * 64 + lane] = o;
        }
    }
}

DI void kprep_even(bf16_t* __restrict__ qkv, const float* __restrict__ gk, const float2* __restrict__ ax) {
    const int tid_ = otid(), gt = blockIdx.x * THREADS + tid_, gs = gridDim.x * THREADS;
    const int p = tid_ & 31;
    for (int v = gt >> 5; v < TC * 2; v += gs >> 5) {
        const int tok = v >> 1, kvh = v & 1;
        unsigned* ptr = (unsigned*)(qkv + (size_t)tok * EVEN_IN + 512 + kvh * 64 + 2 * p);
        const unsigned u = *ptr;
        const float x0 = bflo(u), x1 = bfhi(u);
        float ss = x0 * x0 + x1 * x1;
#pragma unroll
        for (int o = 16; o >= 1; o >>= 1) ss += __shfl_xor(ss, o);
        const float rstd = rsqrtf(ss * (1.0f / 64) + EPS);
        const float y0 = x0 * rstd * gk[2 * p], y1 = x1 * rstd * gk[2 * p + 1];
        const float2 cs = ax[(tok & (SEQ - 1)) * 32 + p];
        *ptr = pack2(y0 * cs.x - y1 * cs.y, y0 * cs.y + y1 * cs.x);
    }
}
DI void prep_odd(bf16_t* __restrict__ a, const float* __restrict__ gq, const float* __restrict__ gkv, const float2* __restrict__ lin) {
    const int tid_ = otid(), lane = tid_ & 63, wv = blockIdx.x * NWAVE + (tid_ >> 6), nw = gridDim.x * NWAVE;
    for (int row = wv; row < TC; row += nw) {
        unsigned* base = (unsigned*)(a + (size_t)row * ODD_PAD);
        unsigned uq[3], uk[2]; float sq = 0.f, sk = 0.f;
#pragma unroll
        for (int i = 0; i < 3; ++i) { uq[i] = base[i * 64 + lane]; const float a0 = bflo(uq[i]), a1 = bfhi(uq[i]); sq += a0 * a0 + a1 * a1; }
#pragma unroll
        for (int i = 0; i < 2; ++i) { uk[i] = base[192 + i * 64 + lane]; const float a0 = bflo(uk[i]), a1 = bfhi(uk[i]); sk += a0 * a0 + a1 * a1; }
        sq = wave_sum(sq); sk = wave_sum(sk);
        const float rq = rsqrtf(sq * (1.0f / 384) + EPS), rk = rsqrtf(sk * (1.0f / 256) + EPS);
#pragma unroll
        for (int i = 0; i < 3; ++i) { const int c = (i * 64 + lane) * 2; base[i * 64 + lane] = pack2(bflo(uq[i]) * rq * gq[c], bfhi(uq[i]) * rq * gq[c + 1]); }
#pragma unroll
        for (int i = 0; i < 2; ++i) { const int c = (i * 64 + lane) * 2; base[192 + i * 64 + lane] = pack2(bflo(uk[i]) * rk * gkv[c], bfhi(uk[i]) * rk * gkv[c + 1]); }
        if (lane < 16) {
            const unsigned u = base[320 + lane];
            const float x0 = bflo(u), x1 = bfhi(u);
            const float2 cs = lin[(row & (SEQ - 1)) * 16 + lane];
            base[320 + lane] = pack2(x0 * cs.x - x1 * cs.y, x0 * cs.y + x1 * cs.x);
        }
    }
}


DI void normmax_even(const bf16_t* __restrict__ qkv, unsigned* __restrict__ nd, char* smem) {
    const int tid = otid(), lane = tid & 63, w = tid >> 6;
    float* red = (float*)smem;
    for (int item = blockIdx.x; item < NB * 32; item += gridDim.x) {
        const int b = item & 7, slab = item >> 3;
        float mq = 0.f, mk = 0.f;
        for (int i = 0; i < 16; ++i) {
            const bf16_t* row = qkv + ((size_t)b * SEQ + slab * 128 + w * 16 + i) * EVEN_IN;
            const u32x4 uq = *(const u32x4*)(row + 768 + 8 * lane), uk = *(const u32x4*)(row + 1280 + 8 * lane);
            float sq = 0.f, sk = 0.f;
#pragma unroll
            for (int j = 0; j < 4; ++j) { const float a0 = bflo(uq[j]), a1 = bfhi(uq[j]), b0 = bflo(uk[j]), b1 = bfhi(uk[j]); sq += a0 * a0 + a1 * a1; sk += b0 * b0 + b1 * b1; }
#pragma unroll
            for (int o = 1; o <= 4; o <<= 1) { sq += __shfl_xor(sq, o); sk += __shfl_xor(sk, o); }
            mq = fmaxf(mq, sq); mk = fmaxf(mk, sk);
        }
        if ((lane & 7) == 0) { red[(w * 8 + (lane >> 3)) * 2] = mq; red[(w * 8 + (lane >> 3)) * 2 + 1] = mk; }
        __syncthreads();
        if (tid < 16) {
            float m = 0.f;
#pragma unroll
            for (int ww = 0; ww < NWAVE; ++ww) m = fmaxf(m, red[ww * 16 + tid]);
            atomicMax(nd + b * 16 + tid, __float_as_uint(m));
        }
        __syncthreads();
    }
}
DI void normmax_mla(const bf16_t* __restrict__ qb, const bf16_t* __restrict__ kv, const bf16_t* __restrict__ a, unsigned* __restrict__ nmx, char* smem) {
    const int tid = otid(), lane = tid & 63, w = tid >> 6;
    float* red = (float*)smem;
    for (int item = blockIdx.x; item < NB * 32; item += gridDim.x) {
        const int b = item & 7, slab = item >> 3;
        float mq = 0.f, mk = 0.f;
        for (int i = 0; i < 16; ++i) {
            const size_t r = (size_t)b * SEQ + slab * 128 + w * 16 + i;
            float sq = 0.f, sk = 0.f, sr = 0.f;
#pragma unroll
            for (int c = 0; c < 3; ++c) {
                const u32x4 u = *(const u32x4*)(qb + r * 1536 + 24 * lane + 8 * c);
#pragma unroll
                for (int j = 0; j < 4; ++j) { const float a0 = bflo(u[j]), a1 = bfhi(u[j]); sq += a0 * a0 + a1 * a1; }
            }
#pragma unroll
            for (int c = 0; c < 4; ++c) {
                const u32x4 u = *(const u32x4*)(kv + r * 2048 + 32 * lane + 8 * c);
#pragma unroll
                for (int j = 0; j < 4; ++j) { const float a0 = bflo(u[j]), a1 = bfhi(u[j]); sk += a0 * a0 + a1 * a1; }
            }
#pragma unroll
            for (int c = 0; c < 4; ++c) {
                const u32x4 u = *(const u32x4*)(a + r * ODD_PAD + 640 + 8 * c);
#pragma unroll
                for (int j = 0; j < 4; ++j) { const float a0 = bflo(u[j]), a1 = bfhi(u[j]); sr += a0 * a0 + a1 * a1; }
            }
            sq += __shfl_xor(sq, 1); sq += __shfl_xor(sq, 2);
            sk += __shfl_xor(sk, 1);
            mq = fmaxf(mq, sq); mk = fmaxf(mk, sk + sr);
        }
        if ((lane & 3) == 0) { red[(w * 16 + (lane >> 2)) * 2] = mq; red[(w * 16 + (lane >> 2)) * 2 + 1] = mk; }
        __syncthreads();
        if (tid < 32) {
            float m = 0.f;
#pragma unroll
            for (int ww = 0; ww < NWAVE; ++ww) m = fmaxf(m, red[ww * 32 + tid]);
            atomicMax(nmx + b * 32 + tid, __float_as_uint(m));
        }
        __syncthreads();
    }
}

namespace pg8 {
constexpr int BM = 256, BK = 64, HALF = 128, HTB = HALF * BK * 2, NXCD = 8, WGM = 8;
DI int lds_byte(int r, int c) { const int st = (r >> 4) * 2 + (c >> 5), rr = r & 15, cc = c & 31, ob = rr * 64 + cc * 2; return st * 1024 + (ob ^ (((ob >> 9) & 1) << 5)); }
DI void stage_rc(int b, int& R, int& C) { const int st = b / 1024, sb = b % 1024, swz = sb ^ (((sb >> 9) & 1) << 5); R = (st >> 1) * 16 + swz / 64; C = (st & 1) * 32 + (swz % 64) / 2; }
DI int perm32(int rho) { const int n = rho >> 4, i = rho & 15; return 8 * (i >> 2) + 4 * n + (i & 3); }
struct Unit { int pm, pn; };
struct Gemm { const bf16_t* A; const bf16_t* Bt; int M, NT, K, lda; size_t hstepB, tstepB; };
struct StaticOrder {
    int nM, nN, nwg, G, c;
    DI void init(int M, int NT, int G_, int c_) { nM = M / BM; nN = NT; nwg = nM * nN; G = G_; c = c_; }
    DI bool next(int i, Unit& u) const {
        const long L = (long)i * G + c; if (L >= nwg) return false;
        int wgid = (int)L; { const int q = nwg / NXCD, r = nwg % NXCD, xcd = wgid % NXCD, off = wgid / NXCD; wgid = (xcd < r ? xcd * (q + 1) : r * (q + 1) + (xcd - r) * q) + off; }
        const int nig = WGM * nN, gid = wgid / nig, fm = gid * WGM, gsz = (nM - fm) < WGM ? (nM - fm) : WGM;
        u.pm = fm + ((wgid % nig) % gsz); u.pn = (wgid % nig) / gsz; return true;
    }
};
template <class Epi>
DI void gemm_phase(LDS_AS unsigned char* lds, const Gemm g, const Epi& E) {
    StaticOrder S; S.init(g.M, g.NT, gridDim.x, blockIdx.x);
    const int tid = otid(), wid = __builtin_amdgcn_readfirstlane(tid >> 6), lane = tid & 63, wr = wid >> 2, wc = wid & 3, fr = lane & 15, fq = lane >> 4;
    const int K = g.K, nt = K / BK;
    unsigned voffA[2], voffB[2];
#pragma unroll
    for (int i = 0; i < 2; ++i) { int R, C; stage_rc(tid * 16 + i * 8192, R, C); const int Rb = Epi::PERM ? ((R & ~31) + perm32(R & 31)) : R;
        voffA[i] = (unsigned)(R * g.lda + C) * 2u; voffB[i] = (unsigned)(Rb * K + C) * 2u; }
    const size_t kstep = (size_t)(BK * 2);
    const size_t hstepA = (size_t)HALF * g.lda * 2, tstepA = 2 * hstepA, hstepB = g.hstepB, tstepB = g.tstepB;
    const unsigned ldsw = (unsigned)wid * 1024u;
    const int aoff = lds_byte(wr * 64 + fr, fq * 8), boff = lds_byte(wc * 32 + fr, fq * 8);
#define PG8_SA(b, h) (((b) * 2 + (h)) * HTB)
#define PG8_SB(b, h) ((4 + (b) * 2 + (h)) * HTB)
#define PG8_STAGE(bufoff, gbase, voff) do { _Pragma("unroll") for (int _i = 0; _i < 2; ++_i) \
        __builtin_amdgcn_global_load_lds((const unsigned*)((const char*)(gbase) + (voff)[_i]), (LDS_AS unsigned*)(lds + (bufoff) + ldsw + _i * 8192), 16, 0, 0); } while (0)
#define PG8_LDA(dst, b, h) do { _Pragma("unroll") for (int m = 0; m < 4; ++m) _Pragma("unroll") for (int k = 0; k < 2; ++k) dst[m][k] = *(const LDS_AS bf16x8*)(lds + PG8_SA(b, h) + aoff + m * 2048 + k * 1024); } while (0)
#define PG8_LDB(dst, b, h) do { _Pragma("unroll") for (int n = 0; n < 2; ++n) _Pragma("unroll") for (int k = 0; k < 2; ++k) dst[n][k] = *(const LDS_AS bf16x8*)(lds + PG8_SB(b, h) + boff + n * 2048 + k * 1024); } while (0)
#define PG8_MMA(ai, bj, At, Bt) do { __builtin_amdgcn_s_setprio(1); _Pragma("unroll") for (int m = 0; m < 4; ++m) _Pragma("unroll") for (int n = 0; n < 2; ++n) _Pragma("unroll") for (int k = 0; k < 2; ++k) \
        acc[ai][bj][m][n] = __builtin_amdgcn_mfma_f32_16x16x32_bf16(Bt[n][k], At[m][k], acc[ai][bj][m][n], 0, 0, 0); __builtin_amdgcn_s_setprio(0); } while (0)
#define PG8_WAIT_V(n) asm volatile("s_waitcnt vmcnt(" #n ")" ::: "memory")
#define PG8_WAIT_L(n) asm volatile("s_waitcnt lgkmcnt(" #n ")" ::: "memory")
#define PG8_BAR __builtin_amdgcn_s_barrier()
#define PG8_SCHED __builtin_amdgcn_sched_barrier(0)
    Unit cur, nxt; int ui = 0;
    if (!S.next(0, cur)) return;
    f32x4 acc[2][2][4][2];
#pragma unroll
    for (int a = 0; a < 2; ++a)
#pragma unroll
        for (int b = 0; b < 2; ++b)
#pragma unroll
            for (int m = 0; m < 4; ++m)
#pragma unroll
                for (int n = 0; n < 2; ++n) acc[a][b][m][n] = (f32x4){0.f, 0.f, 0.f, 0.f};
    bf16x8 At[4][2], B0[2][2], B1[2][2];
    const char* cA = (const char*)g.A + (size_t)cur.pm * tstepA; const char* cB = (const char*)g.Bt + (size_t)cur.pn * tstepB;
    PG8_STAGE(PG8_SB(0, 0), cB, voffB); PG8_STAGE(PG8_SB(0, 1), cB + hstepB, voffB); PG8_STAGE(PG8_SA(0, 0), cA, voffA); PG8_STAGE(PG8_SA(0, 1), cA + hstepA, voffA);
    if (wr == 1) PG8_BAR;
    PG8_WAIT_V(2); PG8_BAR;
    PG8_STAGE(PG8_SB(1, 0), cB + kstep, voffB); PG8_STAGE(PG8_SA(1, 0), cA + kstep, voffA); PG8_STAGE(PG8_SB(1, 1), cB + hstepB + kstep, voffB);
    PG8_WAIT_V(6); PG8_BAR;
    for (;;) {
        const bool has_next = S.next(ui + 1, nxt);
        const char* nA = has_next ? (const char*)g.A + (size_t)nxt.pm * tstepA : cA; const char* nB = has_next ? (const char*)g.Bt + (size_t)nxt.pn * tstepB : cB;
        for (int t = 0; t < nt; t += 2) {
            const bool last = (t == nt - 2);
            const char* a1 = cA + (size_t)(t + 1) * kstep;
            const char* a2 = last ? nA : cA + (size_t)(t + 2) * kstep; const char* b2 = last ? nB : cB + (size_t)(t + 2) * kstep;
            const char* a3 = a2 + kstep; const char* b3 = b2 + kstep;
            PG8_LDB(B0, 0, 0); PG8_LDB(B1, 0, 1); PG8_SCHED; PG8_LDA(At, 0, 0); PG8_STAGE(PG8_SA(1, 1), a1 + hstepA, voffA);
            PG8_WAIT_V(8); PG8_WAIT_L(0); PG8_BAR; PG8_MMA(0, 0, At, B0); PG8_MMA(0, 1, At, B1); PG8_BAR; PG8_SCHED;
            PG8_LDA(At, 0, 1); PG8_STAGE(PG8_SB(0, 0), b2, voffB); PG8_STAGE(PG8_SB(0, 1), b2 + hstepB, voffB); PG8_STAGE(PG8_SA(0, 0), a2, voffA);
            PG8_WAIT_V(8); PG8_WAIT_L(0); PG8_BAR; PG8_MMA(1, 0, At, B0); PG8_MMA(1, 1, At, B1); PG8_BAR; PG8_SCHED;
            PG8_LDB(B0, 1, 0); PG8_LDB(B1, 1, 1); PG8_SCHED; PG8_LDA(At, 1, 0); PG8_STAGE(PG8_SA(0, 1), a2 + hstepA, voffA);
            PG8_WAIT_V(8); PG8_WAIT_L(0); PG8_BAR; PG8_MMA(0, 0, At, B0); PG8_MMA(0, 1, At, B1); PG8_BAR; PG8_SCHED;
            PG8_LDA(At, 1, 1); PG8_STAGE(PG8_SB(1, 0), b3, voffB); PG8_STAGE(PG8_SB(1, 1), b3 + hstepB, voffB); PG8_STAGE(PG8_SA(1, 0), a3, voffA);
            PG8_WAIT_V(8); PG8_WAIT_L(0); PG8_BAR; PG8_MMA(1, 0, At, B0); PG8_MMA(1, 1, At, B1); PG8_BAR; PG8_SCHED;
        }
        if (wr == 0) PG8_BAR;
        E(acc, cur, wr, wc, fr, fq);
        if (!has_next) break;
#pragma unroll
        for (int a = 0; a < 2; ++a)
#pragma unroll
            for (int b = 0; b < 2; ++b)
#pragma unroll
                for (int m = 0; m < 4; ++m)
#pragma unroll
                    for (int n = 0; n < 2; ++n) acc[a][b][m][n] = (f32x4){0.f, 0.f, 0.f, 0.f};
        cur = nxt; cA = nA; cB = nB; ++ui;
        if (wr == 1) PG8_BAR;
    }
    PG8_WAIT_V(0);
    PG8_BAR;
#undef PG8_SA
#undef PG8_SB
#undef PG8_STAGE
#undef PG8_LDA
#undef PG8_LDB
#undef PG8_MMA
#undef PG8_WAIT_V
#undef PG8_WAIT_L
#undef PG8_BAR
#undef PG8_SCHED
}
struct EpiResid {
    static constexpr bool PERM = true;
    const float* res; float* out;
    DI void operator()(const f32x4 (&acc)[2][2][4][2], const Unit& u, int wr, int wc, int fr, int fq) const {
        const int row0 = u.pm * BM + wr * 64 + fr, col0 = u.pn * BM + wc * 32 + 8 * fq;
#pragma unroll
        for (int ai = 0; ai < 2; ++ai)
#pragma unroll
            for (int m = 0; m < 4; ++m) {
                const size_t rb = (size_t)(row0 + ai * HALF + m * 16) * D + col0;
#pragma unroll
                for (int bj = 0; bj < 2; ++bj)
#pragma unroll
                    for (int n = 0; n < 2; ++n) { const size_t idx = rb + bj * HALF + n * 4; *(f32x4*)(out + idx) = *(const f32x4*)(res + idx) + acc[ai][bj][m][n]; }
            }
    }
};
struct EpiBf16 {
    static constexpr bool PERM = true;
    bf16_t* out; int ld;
    DI void operator()(const f32x4 (&acc)[2][2][4][2], const Unit& u, int wr, int wc, int fr, int fq) const {
        const int row0 = u.pm * BM + wr * 64 + fr, col0 = u.pn * BM + wc * 32 + 8 * fq;
#pragma unroll
        for (int ai = 0; ai < 2; ++ai)
#pragma unroll
            for (int m = 0; m < 4; ++m) {
                bf16_t* rowp = out + (size_t)(row0 + ai * HALF + m * 16) * ld + col0;
#pragma unroll
                for (int bj = 0; bj < 2; ++bj) {
                    const f32x4 v0 = acc[ai][bj][m][0], v1 = acc[ai][bj][m][1];
                    u32x4 w; w.x = pack2(v0[0], v0[1]); w.y = pack2(v0[2], v0[3]); w.z = pack2(v1[0], v1[1]); w.w = pack2(v1[2], v1[3]);
                    *(u32x4*)(rowp + bj * HALF) = w;
                }
            }
    }
};
struct EpiSwiglu {
    static constexpr bool PERM = true;
    bf16_t* act;
    DI void operator()(const f32x4 (&acc)[2][2][4][2], const Unit& u, int wr, int wc, int fr, int fq) const {
        const int row0 = u.pm * BM + wr * 64 + fr, col0 = u.pn * HALF + wc * 32 + 8 * fq;
#pragma unroll
        for (int ai = 0; ai < 2; ++ai)
#pragma unroll
            for (int m = 0; m < 4; ++m) {
                float v[8];
#pragma unroll
                for (int n = 0; n < 2; ++n)
#pragma unroll
                    for (int j = 0; j < 4; ++j) { const float gg = acc[ai][0][m][n][j], uu = acc[ai][1][m][n][j]; v[4 * n + j] = gg * uu * __builtin_amdgcn_rcpf(1.0f + __builtin_amdgcn_exp2f(-gg * LOG2E)); }
                u32x4 w; w.x = pack2(v[0], v[1]); w.y = pack2(v[2], v[3]); w.z = pack2(v[4], v[5]); w.w = pack2(v[6], v[7]);
                *(u32x4*)(act + (size_t)(row0 + ai * HALF + m * 16) * DFF + col0) = w;
            }
    }
};
}
DI pg8::Gemm mk_gemm(const bf16_t* A, int lda, const bf16_t* Bt, int M, int N, int K) { return pg8::Gemm{A, Bt, M, N / 256, K, lda, (size_t)128 * K * 2, (size_t)256 * K * 2}; }

template <int DQK, int DV, int KT, int QMODE, bool ALIBI, bool NOMAX>
DI void attn_core(const bf16_t* __restrict__ q, int ldq, const bf16_t* __restrict__ k, int ldk, const bf16_t* __restrict__ k2, int ldk2,
                  const bf16_t* __restrict__ v, int ldv, int nkeys, int qpos0, float qscale, float slope2,
                  const float* __restrict__ qg, const float2* __restrict__ tab, char* smem, f32x16 (&o)[DV / 32], float& lsum) {
    constexpr int KROW = DQK * 2 + 16, VROW = DV * 2 + 64  , KBYTES = KT * KROW, VBYTES = KT * VROW;
    constexpr int KCPR = DQK / 8  , KTOT = KT * KCPR, NKC = (KTOT + THREADS - 1) / THREADS, VCPR = DV / 8, VTOT = KT * VCPR, NVC = (VTOT + THREADS - 1) / THREADS;
    constexpr int NST = KT / 32, NKS = DQK / 16, NDT = DV / 32;
    static_assert(2 * (KBYTES + VBYTES) <= (int)LDS_BYTES, "lds");
    const int tid = otid(), lane = tid & 63, w = tid >> 6, r = lane & 31, h = lane >> 5;
    const int qpos = qpos0 + 32 * w + r;
    bf16x8 qf[NKS];
    {
        const bf16_t* qrow = q + (size_t)(32 * w + r) * ldq + 8 * h;
        u32x4 raw[NKS];
#pragma unroll
        for (int s = 0; s < NKS; ++s) raw[s] = *(const u32x4*)(qrow + 16 * s);
        if (QMODE == 1) {
            float ss = 0.f;
#pragma unroll
            for (int s = 0; s < NKS; ++s) {
                const unsigned u[4] = {raw[s].x, raw[s].y, raw[s].z, raw[s].w};
#pragma unroll
                for (int j = 0; j < 4; ++j) { const float a0 = bflo(u[j]), a1 = bfhi(u[j]); ss += a0 * a0 + a1 * a1; }
            }
            ss += __shfl_xor(ss, 32);
            const float rstd = rsqrtf(ss * (1.0f / 64) + EPS) * qscale;
#pragma unroll
            for (int s = 0; s < NKS; ++s) {
                unsigned u[4] = {raw[s].x, raw[s].y, raw[s].z, raw[s].w};
#pragma unroll
                for (int j = 0; j < 4; ++j) {
                    const int d0 = 16 * s + 8 * h + 2 * j;
                    const float y0 = bflo(u[j]) * rstd * qg[d0], y1 = bfhi(u[j]) * rstd * qg[d0 + 1];
                    const float2 cs = tab[qpos * 32 + (d0 >> 1)];
                    u[j] = pack2(y0 * cs.x - y1 * cs.y, y0 * cs.y + y1 * cs.x);
                }
                raw[s] = u32x4{u[0], u[1], u[2], u[3]};
            }
        } else if (QMODE == 2) {
#pragma unroll
            for (int s = 4; s < NKS; ++s) {
                unsigned u[4] = {raw[s].x, raw[s].y, raw[s].z, raw[s].w};
#pragma unroll
                for (int j = 0; j < 4; ++j) {
                    const int p = 8 * (s - 4) + 4 * h + j;
                    const float y0 = bflo(u[j]), y1 = bfhi(u[j]);
                    const float2 cs = tab[qpos * 16 + p];
                    u[j] = pack2(y0 * cs.x - y1 * cs.y, y0 * cs.y + y1 * cs.x);
                }
                raw[s] = u32x4{u[0], u[1], u[2], u[3]};
            }
        }
#pragma unroll
        for (int s = 0; s < NKS; ++s) qf[s] = __builtin_bit_cast(bf16x8, raw[s]);
    }
    u32x4 rk[NKC], rv[NVC];
    char* const kbuf = smem;
    char* const vbuf = smem + 2 * KBYTES;
#define ATT_GLOADK(key0_)                                                                                             \
    {                                                                                                                 \
        _Pragma("unroll") for (int i = 0; i < NKC; ++i) {                                                             \
            const int cid = tid + THREADS * i, key = cid / KCPR, cc = cid - key * KCPR;                               \
            if (KTOT % THREADS == 0 || cid < KTOT) {                                                                  \
                const bf16_t* src;                                                                                    \
                if (QMODE == 2 && cc >= 8) src = k2 + (size_t)((key0_) + key) * ldk2 + (cc - 8) * 8;                   \
                else src = k + (size_t)((key0_) + key) * ldk + cc * 8;                                                \
                rk[i] = *(const u32x4*)src;                                                                           \
            }                                                                                                         \
        }                                                                                                             \
    }
#define ATT_GLOADV(key0_)                                                                                             \
    {                                                                                                                 \
        _Pragma("unroll") for (int i = 0; i < NVC; ++i) {                                                             \
            const int cid = tid + THREADS * i, key = cid / VCPR, cc = cid - key * VCPR;                               \
            if (VTOT % THREADS == 0 || cid < VTOT) rv[i] = *(const u32x4*)(v + (size_t)((key0_) + key) * ldv + cc * 8); \
        }                                                                                                             \
    }
#define ATT_LSTOREK(buf_)                                                                                             \
    {                                                                                                                 \
        _Pragma("unroll") for (int i = 0; i < NKC; ++i) {                                                             \
            const int cid = tid + THREADS * i, key = cid / KCPR, cc = cid - key * KCPR;                               \
            if (KTOT % THREADS == 0 || cid < KTOT) *(u32x4*)(kbuf + (buf_) * KBYTES + key * KROW + cc * 16) = rk[i];  \
        }                                                                                                             \
    }
#define ATT_LSTOREV(buf_)                                                                                             \
    {                                                                                                                 \
        _Pragma("unroll") for (int i = 0; i < NVC; ++i) {                                                             \
            const int cid = tid + THREADS * i, key = cid / VCPR, cc = cid - key * VCPR;                               \
            if (VTOT % THREADS == 0 || cid < VTOT) *(u32x4*)(vbuf + (buf_) * VBYTES + key * VROW + cc * 16) = rv[i];  \
        }                                                                                                             \
    }
#define ATT_QK(buf_, X_)                                                                                              \
    {                                                                                                                 \
        const char* kb_ = kbuf + (buf_) * KBYTES + r * KROW + h * 16;                                                 \
        _Pragma("unroll") for (int st = 0; st < NST; ++st) {                                                          \
            X_[st] = MFMA(*(const bf16x8*)(kb_ + 32 * st * KROW), qf[0], zero16);                                     \
            _Pragma("unroll") for (int ks = 1; ks < NKS; ++ks) X_[st] = MFMA(*(const bf16x8*)(kb_ + 32 * st * KROW + ks * 32), qf[ks], X_[st]); \
        }                                                                                                             \
    }
#define ATT_SMPV(t_, vb_, X_)                                                                                         \
    {                                                                                                                 \
        if (NOMAX) {                                                                                                  \
            const float dqn = (float)(qpos - ((t_) * KT + 4 * h));                                                    \
            _Pragma("unroll") for (int st = 0; st < NST; ++st)                                                        \
                _Pragma("unroll") for (int i = 0; i < 16; ++i) {                                                      \
                    float xv_ = X_[st][i];                                                                            \
                    if (ALIBI) xv_ = __builtin_fmaf(-slope2, fabsf(dqn - (float)(32 * st + (i & 3) + 8 * (i >> 2))), xv_); \
                    X_[st][i] = __builtin_amdgcn_exp2f(xv_);                                                          \
                    if (!ROWSUM_MFMA) lacc += X_[st][i];                                                              \
                }                                                                                                     \
        } else {                                                                                                      \
            float mx = -1e30f;                                                                                        \
            const float dq = (float)(qpos - ((t_) * KT + 4 * h));                                                     \
            _Pragma("unroll") for (int st = 0; st < NST; ++st)                                                        \
                _Pragma("unroll") for (int i = 0; i < 16; ++i) {                                                      \
                    if (ALIBI) X_[st][i] = __builtin_fmaf(-slope2, fabsf(dq - (float)(32 * st + (i & 3) + 8 * (i >> 2))), X_[st][i]); \
                    mx = fmaxf(mx, X_[st][i]);                                                                        \
                }                                                                                                     \
            mx = fmaxf(mx, __shfl_xor(mx, 32));                                                                       \
            const float mn = fmaxf(m, mx);                                                                            \
            const float alpha = __builtin_amdgcn_exp2f(m - mn);                                                       \
            m = mn;                                                                                                   \
            float rs_ = 0.f;                                                                                          \
            _Pragma("unroll") for (int st = 0; st < NST; ++st)                                                        \
                _Pragma("unroll") for (int i = 0; i < 16; ++i) { X_[st][i] = __builtin_amdgcn_exp2f(X_[st][i] - mn); if (!ROWSUM_MFMA) rs_ += X_[st][i]; } \
            if (__any(alpha != 1.0f)) {                                                                               \
                _Pragma("unroll") for (int dt = 0; dt < NDT; ++dt)                                                    \
                    _Pragma("unroll") for (int i = 0; i < 16; ++i) o[dt][i] *= alpha;                                 \
                _Pragma("unroll") for (int i = 0; i < 16; ++i) ol[i] *= alpha;                                        \
            }                                                                                                         \
            if (!ROWSUM_MFMA) lacc = lacc * alpha + rs_;                                                              \
        }                                                                                                             \
        const char* vbp_ = vbuf + (vb_) * VBYTES + vlane;                                                             \
        __builtin_amdgcn_s_setprio(1);     \
        _Pragma("unroll") for (int st = 0; st < NST; ++st)                                                            \
            _Pragma("unroll") for (int s = 0; s < 2; ++s) {                                                           \
                u32x4 pk;                                                                                             \
                pk.x = pack2(X_[st][8 * s + 0], X_[st][8 * s + 1]); pk.y = pack2(X_[st][8 * s + 2], X_[st][8 * s + 3]); \
                pk.z = pack2(X_[st][8 * s + 4], X_[st][8 * s + 5]); pk.w = pack2(X_[st][8 * s + 6], X_[st][8 * s + 7]); \
                const bf16x8 pb = __builtin_bit_cast(bf16x8, pk);                                                     \
                if (ROWSUM_MFMA) ol = MFMA(ones8, pb, ol);                                                            \
                _Pragma("unroll") for (int dt = 0; dt < NDT; ++dt) {                                                  \
                    const char* va = vbp_ + (32 * st + 16 * s) * VROW + 64 * dt;                                      \
                    const s16x4 lo = __builtin_amdgcn_ds_read_tr16_b64_v4i16((LDS_AS s16x4*)(va));                    \
                    const s16x4 hi = __builtin_amdgcn_ds_read_tr16_b64_v4i16((LDS_AS s16x4*)(va + 8 * VROW));        \
                    o[dt] = MFMA(__builtin_shufflevector(lo, hi, 0, 1, 2, 3, 4, 5, 6, 7), pb, o[dt]);                 \
                }                                                                                                     \
            }                                                                                                         \
        __builtin_amdgcn_s_setprio(0);                                                                                \
    }
#define ATT_STEP(t_, PAR_, CUR_, NXT_)                                                                                \
    {                                                                                                                 \
        const int tk_ = ((t_) + 2 < ntiles) ? (t_) + 2 : ntiles - 1, tv_ = ((t_) + 1 < ntiles) ? (t_) + 1 : ntiles - 1; \
        ATT_GLOADK(tk_ * KT)                                                                                          \
        ATT_GLOADV(tv_ * KT)                                                                                          \
        __builtin_amdgcn_sched_barrier(0);                                                                            \
        ATT_QK(1 - (PAR_), NXT_)                                                                                      \
        ATT_SMPV(t_, PAR_, CUR_)                                                                                      \
        __builtin_amdgcn_sched_barrier(0);                                                                            \
        ATT_LSTOREK(PAR_)                                                                                             \
        ATT_LSTOREV(1 - (PAR_))                                                                                       \
        __syncthreads();                                                                                              \
    }
#define ATT_STEP1(t_, PAR_, X_)                                                                                       \
    {                                                                                                                 \
        const int tn_ = ((t_) + 1 < ntiles) ? (t_) + 1 : ntiles - 1;                                                  \
        ATT_GLOADK(tn_ * KT)                                                                                          \
        ATT_GLOADV(tn_ * KT)                                                                                          \
        __builtin_amdgcn_sched_barrier(0);                                                                            \
        ATT_QK(PAR_, X_)                                                                                              \
        ATT_SMPV(t_, PAR_, X_)                                                                                        \
        __builtin_amdgcn_sched_barrier(0);                                                                            \
        ATT_LSTOREK(1 - (PAR_))                                                                                       \
        ATT_LSTOREV(1 - (PAR_))                                                                                       \
        __syncthreads();                                                                                              \
    }
    const f32x16 zero16 = {0.f, 0.f, 0.f, 0.f, 0.f, 0.f, 0.f, 0.f, 0.f, 0.f, 0.f, 0.f, 0.f, 0.f, 0.f, 0.f};
    const bf16x8 ones8 = {0x3F80, 0x3F80, 0x3F80, 0x3F80, 0x3F80, 0x3F80, 0x3F80, 0x3F80};
    constexpr bool ROWSUM_MFMA = false;
    float m = -1e30f, lacc = 0.f;
    f32x16 ol = zero16;
#pragma unroll
    for (int dt = 0; dt < NDT; ++dt) o[dt] = zero16;
    const int ntiles = nkeys / KT;
    const int vlane = (4 * h + ((lane & 15) >> 2)) * VROW + (16 * ((lane >> 4) & 1) + 4 * (lane & 3)) * 2;
    constexpr bool PIPE = (DV < 128);
    if (PIPE) {
        f32x16 xa[NST], xb[NST];
        ATT_GLOADK(0) ATT_LSTOREK(0)
        ATT_GLOADK(KT) ATT_GLOADV(0)
        __syncthreads();
        ATT_QK(0, xa)
        ATT_LSTOREK(1) ATT_LSTOREV(0)
        __syncthreads();
        for (int t = 0; t < ntiles; t += 2) {
            ATT_STEP(t, 0, xa, xb)
            ATT_STEP(t + 1, 1, xb, xa)
        }
    } else {
        f32x16 xs[NST];
        ATT_GLOADK(0) ATT_GLOADV(0) ATT_LSTOREK(0) ATT_LSTOREV(0)
        __syncthreads();
        for (int t = 0; t < ntiles; t += 2) {
            ATT_STEP1(t, 0, xs)
            ATT_STEP1(t + 1, 1, xs)
        }
    }
    lsum = ROWSUM_MFMA ? ol[0] : lacc + __shfl_xor(lacc, 32);
#undef ATT_GLOADK
#undef ATT_GLOADV
#undef ATT_LSTOREK
#undef ATT_LSTOREV
#undef ATT_QK
#undef ATT_SMPV
#undef ATT_STEP
#undef ATT_STEP1
}
template <int NDT>
DI void store_o(bf16_t* dst, int ld, f32x16 (&o)[NDT], float inv) {
    const int tid_ = otid(), lane = tid_ & 63, w = tid_ >> 6, r = lane & 31, h = lane >> 5;
    bf16_t* row = dst + (size_t)(32 * w + r) * ld + 4 * h;
#pragma unroll
    for (int dt = 0; dt < NDT; ++dt)
#pragma unroll
        for (int g = 0; g < 4; ++g) {
            uint2 vv; vv.x = pack2(o[dt][4 * g] * inv, o[dt][4 * g + 1] * inv); vv.y = pack2(o[dt][4 * g + 2] * inv, o[dt][4 * g + 3] * inv);
            *(uint2*)(row + 32 * dt + 8 * g) = vv;
        }
}
DI int swz_item(int base) {
    const int G = gridDim.x, i = blockIdx.x;
    if (G & 7) return base + i;
    return base + (i & 7) * (G >> 3) + (i >> 3);
}

constexpr int QT = SEQ / 256;
constexpr float NOMAX_BOUND = 90.f;
DI void attn_even(const bf16_t* qkv, float* park, bf16_t* mix, const Params& p, const float2* ax, const unsigned* nd, float lam_init, char* smem) {
    float d1 = 0.f, d2 = 0.f, gq = 0.f, gk = 0.f;
    for (int i = 0; i < 64; ++i) { d1 += p.in[8][i] * p.in[9][i]; d2 += p.in[10][i] * p.in[11][i]; gq = fmaxf(gq, fabsf(p.in[6][i])); gk = fmaxf(gk, fabsf(p.in[7][i])); }
    const float lam = __expf(d1) - __expf(d2) + lam_init;
    const float bound_gqa = 64.f * 0.125f * LOG2E * gq * gk * 1.03f;
    const int tid_ = otid(), lane = tid_ & 63, h = lane >> 5;
    float4* mypark = (float4*)(park + ((size_t)blockIdx.x * THREADS + tid_) * 64);
    constexpr int NDIFF = NB * 4 * QT, NGQA = NB * 8 * QT;
    for (int base = 0; base < NDIFF + NGQA; base += gridDim.x) {
        const int it = swz_item(base);
        if (it >= NDIFF + NGQA) continue;
        if (it < NDIFF) {
            const int b = it / (4 * QT), hd = (it / QT) & 3, qt = it % QT;
            const size_t row0 = (size_t)b * SEQ + qt * 256;
            const float slope2 = exp2f(-2.0f * (hd + 1)) * LOG2E;
            const bf16_t* qp = qkv + row0 * EVEN_IN + 768 + hd * 128;
            const bf16_t* kp = qkv + (size_t)b * SEQ * EVEN_IN + 1280 + hd * 128;
            const bf16_t* vp = qkv + (size_t)b * SEQ * EVEN_IN + 1792 + hd * 128;
            f32x16 o0[4]; float l0 = 1.f;
#pragma unroll 1
            for (int c = 0; c < 2; ++c) {
                const unsigned* nn = nd + (b * 8 + hd * 2 + c) * 2;
                const float bound = sqrtf(__uint_as_float(nn[0]) * __uint_as_float(nn[1])) * 1.03f;
                if (bound < NOMAX_BOUND) attn_core<64, 128, 64, 0, true, true>(qp + 64 * c, EVEN_IN, kp + 64 * c, EVEN_IN, nullptr, 0, vp, EVEN_IN, SEQ, qt * 256, 1.0f, slope2, nullptr, nullptr, smem, o0, l0);
                else attn_core<64, 128, 64, 0, true, false>(qp + 64 * c, EVEN_IN, kp + 64 * c, EVEN_IN, nullptr, 0, vp, EVEN_IN, SEQ, qt * 256, 1.0f, slope2, nullptr, nullptr, smem, o0, l0);
                if (c == 0) {
                    const float i0 = 1.0f / l0;
#pragma unroll
                    for (int dt = 0; dt < 4; ++dt)
#pragma unroll
                        for (int g = 0; g < 4; ++g) mypark[dt * 4 + g] = make_float4(o0[dt][4 * g] * i0, o0[dt][4 * g + 1] * i0, o0[dt][4 * g + 2] * i0, o0[dt][4 * g + 3] * i0);
                    asm volatile("" ::: "memory");
                }
            }
            const float i1 = lam / l0;
            float ss = 0.f;
            asm volatile("" ::: "memory");
#pragma unroll
            for (int dt = 0; dt < 4; ++dt)
#pragma unroll
                for (int g = 0; g < 4; ++g) {
                    const float4 pv = mypark[dt * 4 + g];
                    const float pa[4] = {pv.x, pv.y, pv.z, pv.w};
#pragma unroll
                    for (int e = 0; e < 4; ++e) { const float vv = pa[e] - i1 * o0[dt][4 * g + e]; o0[dt][4 * g + e] = vv; ss += vv * vv; }
                }
            ss += __shfl_xor(ss, 32);
            const float rstd = rsqrtf(ss * (1.0f / 128) + EPS) * (1.0f - lam_init);
#pragma unroll
            for (int dt = 0; dt < 4; ++dt)
#pragma unroll
                for (int i = 0; i < 16; ++i) o0[dt][i] *= p.in[12][32 * dt + crow(i, h)];
            store_o<4>(mix + row0 * D + 512 + hd * 128, D, o0, rstd);
        } else {
            const int j = it - NDIFF;
            const int b = j / (8 * QT), hd = (j / QT) & 7, qt = j % QT, kvh = hd >> 2;
            const size_t row0 = (size_t)b * SEQ + qt * 256;
            const bf16_t* qp = qkv + row0 * EVEN_IN + hd * 64;
            const bf16_t* kp = qkv + (size_t)b * SEQ * EVEN_IN + 512 + kvh * 64;
            const bf16_t* vp = qkv + (size_t)b * SEQ * EVEN_IN + 640 + kvh * 64;
            f32x16 o[2]; float l;
            if (bound_gqa < NOMAX_BOUND) attn_core<64, 64, 64, 1, false, true>(qp, EVEN_IN, kp, EVEN_IN, nullptr, 0, vp, EVEN_IN, SEQ, qt * 256, 0.125f * LOG2E, 0.f, p.in[6], ax, smem, o, l);
            else attn_core<64, 64, 64, 1, false, false>(qp, EVEN_IN, kp, EVEN_IN, nullptr, 0, vp, EVEN_IN, SEQ, qt * 256, 0.125f * LOG2E, 0.f, p.in[6], ax, smem, o, l);
            store_o<2>(mix + row0 * D + hd * 64, D, o, 1.0f / l);
        }
    }
}
DI void attn_mla(const bf16_t* qb, const bf16_t* kv, const bf16_t* a, bf16_t* mix, const float2* lin, const unsigned* nmx, char* smem) {
    constexpr int NIT = NB * 16 * QT;
    for (int base = 0; base < NIT; base += gridDim.x) {
        const int it = swz_item(base);
        if (it >= NIT) continue;
        const int b = it / (16 * QT), hd = (it / QT) & 15, qt = it % QT;
        const size_t row0 = (size_t)b * SEQ + qt * 256;
        const unsigned* nn = nmx + (b * 16 + hd) * 2;
        const float bound = sqrtf(__uint_as_float(nn[0]) * __uint_as_float(nn[1])) * 1.03f;
        const bf16_t* kb_ = kv + (size_t)b * SEQ * 2048 + hd * 128;
        f32x16 o[2]; float l;
        if (bound < NOMAX_BOUND) attn_core<96, 64, 64, 2, false, true>(qb + row0 * 1536 + hd * 96, 1536, kb_, 2048, a + (size_t)b * SEQ * ODD_PAD + 640, ODD_PAD, kb_ + 64, 2048, SEQ, qt * 256, 1.0f, 0.f, nullptr, lin, smem, o, l);
        else attn_core<96, 64, 64, 2, false, false>(qb + row0 * 1536 + hd * 96, 1536, kb_, 2048, a + (size_t)b * SEQ * ODD_PAD + 640, ODD_PAD, kb_ + 64, 2048, SEQ, qt * 256, 1.0f, 0.f, nullptr, lin, smem, o, l);
        store_o<2>(mix + row0 * D + hd * 64, D, o, 1.0f / l);
    }
}
DI void attn_cross(const bf16_t* qx, const bf16_t* kvx, bf16_t* mix, int seq0, char* smem) {
    constexpr int NIT = NB * 4 * QT * 2;
    for (int base = 0; base < NIT; base += gridDim.x) {
        const int it = swz_item(base);
        if (it >= NIT) continue;
        const int b = it / (8 * QT), hd = (it / (2 * QT)) & 3, qt = (it >> 1) % QT, half = it & 1;
        const size_t row0 = (size_t)b * SEQ + qt * 256;
        const bf16_t* kvb = kvx + (size_t)(seq0 + b) * NMEM * 2048;
        f32x16 o[4]; float l;
        attn_core<256, 128, 32, 0, false, false>(qx + row0 * D + hd * 256, D, kvb + hd * 256, 2048, nullptr, 0, kvb + 1024 + hd * 256 + half * 128, 2048, NMEM, 0,
                                          1.0f, 0.f, nullptr, nullptr, smem, o, l);
        store_o<4>(mix + row0 * D + hd * 256 + half * 128, D, o, 1.0f / l);
    }
}

extern "C" __global__ void __launch_bounds__(THREADS, 2) fwd_mega(Params p) {
    extern __shared__ __attribute__((aligned(16))) char smem[];
    LDS_AS unsigned char* lds = (LDS_AS unsigned char*)smem;
    cg::grid_group grid = cg::this_grid();
    char* ws = p.ws;
    __shared__ uint4 xb_words;
    if (threadIdx.x == 0) xb_words = make_uint4(0u, 0u, 0u, 0u);
    __syncthreads();
    const XcdBarrier xb = xcd_barrier_post((unsigned*)(ws + B_BAR), (volatile LDS_AS unsigned*)&xb_words);
    bf16_t* wEin = (bf16_t*)(ws + W_EIN); bf16_t* wEout = (bf16_t*)(ws + W_EOUT); bf16_t* wOin = (bf16_t*)(ws + W_OIN);
    bf16_t* wUq = (bf16_t*)(ws + W_UQ); bf16_t* wUkv = (bf16_t*)(ws + W_UKV); bf16_t* wOout = (bf16_t*)(ws + W_OOUT);
    float2* ax = (float2*)(ws + T_AX); float2* lin = (float2*)(ws + T_LIN);
    bf16_t* H = (bf16_t*)(ws + B_H); bf16_t* MIX = (bf16_t*)(ws + B_MIX);

    convert_weight(p.in[5], wEin, D, EVEN_IN, EVEN_IN, smem, 768, 1280, 0.125f * LOG2E);
    convert_weight(p.in[13], wEout, D, D, D, smem);
    convert_weight(p.in[14], wOin, D, ODD_IN, ODD_PAD, smem);
    convert_weight(p.in[17], wUq, 384, 1536, 1536, smem, 0, 1536, 0.10206207261596575f * LOG2E);
    convert_weight(p.in[18], wUkv, 256, 2048, 2048, smem);
    convert_weight(p.in[19], wOout, D, D, D, smem);
    for (int l = 0; l < 2; ++l) {
        convert_weight(p.in[22] + (size_t)l * D * D, (bf16_t*)(ws + W_CQ) + (size_t)l * D * D, D, D, D, smem, 0, D, 0.0625f * LOG2E);
        convert_weight(p.in[23] + (size_t)l * D * 2048, (bf16_t*)(ws + W_CKV) + (size_t)l * 2048 * D, D, 2048, 2048, smem);
        convert_weight(p.in[24] + (size_t)l * D * D, (bf16_t*)(ws + W_CO) + (size_t)l * D * D, D, D, D, smem);
        convert_weight(p.in[26] + (size_t)l * D * 2 * DFF, (bf16_t*)(ws + W_GU) + (size_t)l * 2 * DFF * D, D, 2 * DFF, 2 * DFF, smem);
        convert_weight(p.in[27] + (size_t)l * DFF * D, (bf16_t*)(ws + W_DOWN) + (size_t)l * D * DFF, DFF, D, D, smem);
        rmsnorm_rows(p.in[2], p.in[21] + l * D, (bf16_t*)(ws + B_MEMN) + (size_t)l * NBATCH * NMEM * D, 8 * NMEM);
        rmsnorm_rows(p.in[3], p.in[21] + l * D, (bf16_t*)(ws + B_MEMN) + (size_t)l * NBATCH * NMEM * D + (size_t)8 * NMEM * D, 16 * NMEM);
    }
    build_tables(ax, lin);
    if (blockIdx.x == 0) for (int i = threadIdx.x; i < 4096; i += THREADS) ((unsigned*)(ws + B_NORMS))[i] = 0u;
    grid.sync();
    for (int l = 0; l < 2; ++l) {
        pg8::EpiBf16 e{(bf16_t*)(ws + B_KX) + (size_t)l * NBATCH * NMEM * 2048, 2048};
        pg8::gemm_phase(lds, mk_gemm((const bf16_t*)(ws + B_MEMN) + (size_t)l * NBATCH * NMEM * D, D, (const bf16_t*)(ws + W_CKV) + (size_t)l * 2048 * D, NBATCH * NMEM, 2048, D), e);
    }
    xcd_barrier(xb);

    for (int ch = 0; ch < NCHUNK; ++ch) {
        const float* xin = (ch == 0) ? p.in[0] : p.in[1] + (size_t)(ch - 1) * TC * D;
        float* xo = p.out + (size_t)ch * TC * D;
        for (int layer = 0; layer < 2; ++layer) {
            const float* xcur = (layer == 0) ? xin : xo;
            for (int rep_ = 0; rep_ < PROBE_NORM; ++rep_) rmsnorm_rows(xcur, p.in[4] + layer * D, H, TC);
            xcd_barrier(xb);
            const bf16_t* wout;
            if (layer == 0) {
                bf16_t* qkv = (bf16_t*)(ws + E_QKV);
                for (int rep_ = 0; rep_ < PROBE_GEMM; ++rep_) { pg8::EpiBf16 e{qkv, EVEN_IN}; pg8::gemm_phase(lds, mk_gemm(H, D, wEin, TC, EVEN_IN, D), e); }
                xcd_barrier(xb);
                kprep_even(qkv, p.in[7], ax);
                normmax_even(qkv, (unsigned*)(ws + B_NORMS) + ch * 128, smem);
                xcd_barrier(xb);
                for (int rep_ = 0; rep_ < PROBE_ATTN; ++rep_) attn_even(qkv, (float*)(ws + E_PARK), MIX, p, ax, (const unsigned*)(ws + B_NORMS) + ch * 128, 0.2f, smem);
                wout = wEout;
            } else {
                bf16_t* a = (bf16_t*)(ws + O_A); bf16_t* qb = (bf16_t*)(ws + O_Q); bf16_t* kv = (bf16_t*)(ws + O_KV);
                for (int rep_ = 0; rep_ < PROBE_GEMM; ++rep_) { pg8::EpiBf16 e{a, ODD_PAD}; pg8::gemm_phase(lds, mk_gemm(H, D, wOin, TC, ODD_PAD, D), e); }
                xcd_barrier(xb);
                prep_odd(a, p.in[15], p.in[16], lin);
                xcd_barrier(xb);
                for (int rep_ = 0; rep_ < PROBE_GEMM; ++rep_) { pg8::EpiBf16 e{qb, 1536}; pg8::gemm_phase(lds, mk_gemm(a, ODD_PAD, wUq, TC, 1536, 384), e); }
                for (int rep_ = 0; rep_ < PROBE_GEMM; ++rep_) { pg8::EpiBf16 e{kv, 2048}; pg8::gemm_phase(lds, mk_gemm(a + 384, ODD_PAD, wUkv, TC, 2048, 256), e); }
                xcd_barrier(xb);
                normmax_mla(qb, kv, a, (unsigned*)(ws + B_NORMS) + 384 + ch * 256, smem);
                xcd_barrier(xb);
                for (int rep_ = 0; rep_ < PROBE_ATTN; ++rep_) attn_mla(qb, kv, a, MIX, lin, (const unsigned*)(ws + B_NORMS) + 384 + ch * 256, smem);
                wout = wOout;
            }
            xcd_barrier(xb);
            { pg8::EpiResid e{xcur, xo}; pg8::gemm_phase(lds, mk_gemm(MIX, D, wout, TC, D, D), e); }
            xcd_barrier(xb);
            for (int rep_ = 0; rep_ < PROBE_NORM; ++rep_) rmsnorm_rows(xo, p.in[20] + layer * D, H, TC);
            xcd_barrier(xb);
            for (int rep_ = 0; rep_ < PROBE_GEMM; ++rep_) { pg8::EpiBf16 e{(bf16_t*)(ws + X_Q), D}; pg8::gemm_phase(lds, mk_gemm(H, D, (const bf16_t*)(ws + W_CQ) + (size_t)layer * D * D, TC, D, D), e); }
            xcd_barrier(xb);
            for (int rep_ = 0; rep_ < PROBE_CROSS; ++rep_) attn_cross((const bf16_t*)(ws + X_Q), (const bf16_t*)(ws + B_KX) + (size_t)layer * NBATCH * NMEM * 2048, MIX, ch * NB, smem);
            xcd_barrier(xb);
            { pg8::EpiResid e{xo, xo}; pg8::gemm_phase(lds, mk_gemm(MIX, D, (const bf16_t*)(ws + W_CO) + (size_t)layer * D * D, TC, D, D), e); }
            xcd_barrier(xb);
            for (int rep_ = 0; rep_ < PROBE_NORM; ++rep_) rmsnorm_rows(xo, p.in[25] + layer * D, H, TC);
            xcd_barrier(xb);
            for (int rep_ = 0; rep_ < PROBE_GEMM; ++rep_) { pg8::EpiSwiglu e{(bf16_t*)(ws + F_ACT)};
              pg8::Gemm g{H, (const bf16_t*)(ws + W_GU) + (size_t)layer * 2 * DFF * D, TC, DFF / 128, D, D, (size_t)DFF * D * 2, (size_t)128 * D * 2};
              pg8::gemm_phase(lds, g, e); }
            xcd_barrier(xb);
            { pg8::EpiResid e{xo, xo}; pg8::gemm_phase(lds, mk_gemm((const bf16_t*)(ws + F_ACT), DFF, (const bf16_t*)(ws + W_DOWN) + (size_t)layer * D * DFF, TC, D, DFF), e); }
            xcd_barrier(xb);
        }
        rmsnorm_final(xo, p.in[28], TC);
    }
}

extern "C" void kernel_launch(void* const* d_in, const int* in_sizes, int n_in, void* d_out, int out_size, void* d_ws, size_t ws_size, hipStream_t stream) {
    static int grid_blocks = 0;
    if (!grid_blocks) {
        int dev = 0, cus = 0, per_cu = 0;
        (void)hipGetDevice(&dev);
        (void)hipDeviceGetAttribute(&cus, hipDeviceAttributeMultiprocessorCount, dev);
        (void)hipFuncSetAttribute((const void*)fwd_mega, hipFuncAttributeMaxDynamicSharedMemorySize, (int)LDS_BYTES);
        (void)hipOccupancyMaxActiveBlocksPerMultiprocessor(&per_cu, fwd_mega, THREADS, LDS_BYTES);
        if (per_cu > 1) per_cu = 1;
        if (per_cu < 1) per_cu = 1;
        grid_blocks = cus * per_cu;
    }
    constexpr size_t WS_END = (O_END > E_END ? O_END : E_END) > (F_ACT + (size_t)TC * DFF * 2) ? (O_END > E_END ? O_END : E_END) : (F_ACT + (size_t)TC * DFF * 2);
    if (ws_size < WS_END) { fprintf(stderr, "workspace too small: %zu < %zu\n", ws_size, (size_t)WS_END); return; }
    if (grid_blocks > 256) grid_blocks = 256;
    Params p{};
    for (int i = 0; i < 29; ++i) p.in[i] = (const float*)d_in[i];
    p.out = (float*)d_out;
    p.ws = (char*)d_ws;
    (void)hipMemsetAsync(d_ws, 0, 16384, stream);
    void* args[] = {&p};
    hipError_t e = hipLaunchCooperativeKernel((void*)fwd_mega, dim3(grid_blocks), dim3(THREADS), args, LDS_BYTES, stream);
    if (e != hipSuccess) fprintf(stderr, "cooperative launch failed: %s (grid %d)\n", hipGetErrorString(e), grid_blocks);
}
```

```cpp
#include <hip/hip_runtime.h>
#include <hip/hip_cooperative_groups.h>
#include <cstdio>
#include <cstdint>
namespace cg = cooperative_groups;
#ifndef PROBE_GEMM
#define PROBE_GEMM 1
#endif
#ifndef PROBE_NORM
#define PROBE_NORM 1
#endif
#ifndef PROBE_CROSS
#define PROBE_CROSS 1
#endif
#ifndef PROBE_ATTN
#define PROBE_ATTN 1
#endif

typedef unsigned short bf16_t;
typedef short bf16x8 __attribute__((ext_vector_type(8)));
typedef float f32x16 __attribute__((ext_vector_type(16)));
typedef float f32x2 __attribute__((ext_vector_type(2)));
typedef unsigned u32x4 __attribute__((ext_vector_type(4)));
typedef float f32x4 __attribute__((ext_vector_type(4)));
typedef short s16x4 __attribute__((ext_vector_type(4)));
#define LDS_AS __attribute__((address_space(3)))
typedef __bf16 bf16x2_t __attribute__((ext_vector_type(2)));
#define DI __device__ __forceinline__
#define MFMA(a, b, c) __builtin_amdgcn_mfma_f32_32x32x16_bf16((a), (b), (c), 0, 0, 0)

constexpr int D = 1024, SEQ = 4096, NBATCH = 24, NB = 8  , NCHUNK = NBATCH / NB, TC = NB * SEQ;
constexpr int NMEM = 256, DFF = 2816, EVEN_IN = 2304, ODD_IN = 672, ODD_PAD = 768;
constexpr float EPS = 1e-6f, LOG2E = 1.4426950408889634f;
constexpr int THREADS = 512, NWAVE = THREADS / 64;
constexpr size_t LDS_BYTES = 131072;

constexpr size_t al(size_t x) { return (x + 255) & ~(size_t)255; }
constexpr size_t B_BAR = 0;
constexpr size_t B_NORMS = 16384;
constexpr size_t W_EIN = 32768;
constexpr size_t W_EOUT = W_EIN + al((size_t)EVEN_IN * D * 2);
constexpr size_t W_OIN = W_EOUT + al((size_t)D * D * 2);
constexpr size_t W_UQ = W_OIN + al((size_t)ODD_PAD * D * 2);
constexpr size_t W_UKV = W_UQ + al((size_t)1536 * 384 * 2);
constexpr size_t W_OOUT = W_UKV + al((size_t)2048 * 256 * 2);
constexpr size_t W_CQ = W_OOUT + al((size_t)D * D * 2);
constexpr size_t W_CKV = W_CQ + 2 * al((size_t)D * D * 2);
constexpr size_t W_CO = W_CKV + 2 * al((size_t)2048 * D * 2);
constexpr size_t W_GU = W_CO + 2 * al((size_t)D * D * 2);
constexpr size_t W_DOWN = W_GU + 2 * al((size_t)2 * DFF * D * 2);
constexpr size_t T_AX = W_DOWN + 2 * al((size_t)D * DFF * 2);
constexpr size_t T_LIN = T_AX + al((size_t)SEQ * 32 * 8);
constexpr size_t B_MEMN = T_LIN + al((size_t)SEQ * 16 * 8);
constexpr size_t B_KX = B_MEMN + 2 * al((size_t)NBATCH * NMEM * D * 2);
constexpr size_t B_H = B_KX + 2 * al((size_t)NBATCH * NMEM * 2048 * 2);
constexpr size_t B_MIX = B_H + al((size_t)TC * D * 2);
constexpr size_t B_BIG = B_MIX + al((size_t)TC * D * 2);
constexpr size_t E_QKV = B_BIG;
constexpr size_t E_PARK = E_QKV + al((size_t)TC * EVEN_IN * 2);
constexpr size_t E_END = E_PARK + (size_t)256 * THREADS * 64 * 4;
constexpr size_t O_A = B_BIG;
constexpr size_t O_Q = O_A + al((size_t)TC * ODD_PAD * 2);
constexpr size_t O_KV = O_Q + al((size_t)TC * 1536 * 2);
constexpr size_t O_END = O_KV + al((size_t)TC * 2048 * 2);
constexpr size_t X_Q = B_BIG;
constexpr size_t F_ACT = B_BIG;

struct Params {
    const float* in[29];
    float* out;
    char* ws;
};

DI unsigned pack2(float lo, float hi) { f32x2 v = {lo, hi}; bf16x2_t b = __builtin_convertvector(v, bf16x2_t); return __builtin_bit_cast(unsigned, b); }
DI float bflo(unsigned u) { return __uint_as_float(u << 16); }
DI float bfhi(unsigned u) { return __uint_as_float(u & 0xffff0000u); }
DI int crow(int i, int h) { return (i & 3) + 8 * (i >> 2) + 4 * h; }
DI int swap23(int x) { return (x & ~12) | ((x & 4) << 1) | ((x & 8) >> 1); }
DI int otid() { int t = threadIdx.x; asm volatile("" : "+v"(t)); return t; }
DI float wave_sum(float v) {
#pragma unroll
    for (int o = 32; o >= 1; o >>= 1) v += __shfl_xor(v, o);
    return v;
}


#define XB_TMO      128
#define XB_XCNT(j)  (256  + 64 * (j))
#define XB_XSUB(j)  (1280 + 64 * (j))
#define XB_XGEN(j)  (2304 + 64 * (j))
#define XB_TOP      3328
#define XB_TOPGEN   3392
#define XCD_BAR_WORDS 3456
#define XB_SPIN_CAP (1u << 18)
DI unsigned xb_ld(unsigned* p) { return __hip_atomic_load(p, __ATOMIC_RELAXED, __HIP_MEMORY_SCOPE_AGENT); }
DI unsigned xb_add(unsigned* p, unsigned v) { return __hip_atomic_fetch_add(p, v, __ATOMIC_RELAXED, __HIP_MEMORY_SCOPE_AGENT); }
DI unsigned xb_xcc_id() { return (unsigned)__builtin_amdgcn_s_getreg((3 << 11) | 20) & 0xFu; }
#define XB_SPIN(cond, bar) do { unsigned _sp = 0; while (cond) { __builtin_amdgcn_s_sleep(1); \
    if ((++_sp & 255u) == 0u) { if (xb_ld(&(bar)[XB_TMO])) break; if (_sp > XB_SPIN_CAP) { atomicAdd(&(bar)[XB_TMO], 1u); break; } } } } while (0)
struct XcdBarrier { unsigned* bar; unsigned x; volatile LDS_AS unsigned* st; };
DI XcdBarrier xcd_barrier_post(unsigned* bar, volatile LDS_AS unsigned* st) {
    XcdBarrier b; b.bar = bar; b.x = xb_xcc_id(); b.st = st;
    if (threadIdx.x == 0) (void)xb_add(&bar[XB_XCNT(b.x)], 1u);
    return b;
}
DI void xcd_barrier_complete(unsigned* bar, unsigned x, unsigned& nloc, unsigned& nx) {
    const unsigned G = gridDim.x * gridDim.y * gridDim.z;
    unsigned sum, cnt, mine, sp = 0u;
    for (;;) {
        sum = 0u; cnt = 0u; mine = 0u;
#pragma unroll
        for (unsigned j = 0; j < 16; ++j) { const unsigned c = xb_ld(&bar[XB_XCNT(j)]); sum += c; cnt += (c > 0u) ? 1u : 0u; mine = (j == x) ? c : mine; }
        if (sum == G) break;
        __builtin_amdgcn_s_sleep(1);
        if ((++sp & 255u) == 0u) { if (xb_ld(&bar[XB_TMO])) break; if (sp > XB_SPIN_CAP) { atomicAdd(&bar[XB_TMO], 1u); break; } }
    }
    nloc = mine > 0u ? mine : 1u; nx = cnt > 0u ? cnt : 1u;
}
DI void xcd_barrier(const XcdBarrier& b) {
    asm volatile("s_waitcnt vmcnt(0)" ::: "memory");
    __syncthreads();
    if (threadIdx.x == 0) {
        unsigned* bar = b.bar;
        __builtin_amdgcn_s_waitcnt(0);
        unsigned nloc = b.st[0], nx = b.st[1];
        if (nloc == 0u) { xcd_barrier_complete(bar, b.x, nloc, nx); b.st[0] = nloc; b.st[1] = nx; }
        const unsigned old = xb_add(&bar[XB_XSUB(b.x)], 1u);
        const unsigned gen = old / nloc;
        if (old + 1u == (gen + 1u) * nloc) {
            __builtin_amdgcn_fence(__ATOMIC_RELEASE, "agent");
            asm volatile("s_waitcnt vmcnt(0)" ::: "memory");
            const unsigned og = xb_add(&bar[XB_TOP], 1u);
            const unsigned tg = og / nx;
            if (og + 1u == (tg + 1u) * nx) xb_add(&bar[XB_TOPGEN], 1u);
            else XB_SPIN(xb_ld(&bar[XB_TOPGEN]) == tg, bar);
            __builtin_amdgcn_fence(__ATOMIC_ACQUIRE, "agent");
            xb_add(&bar[XB_XGEN(b.x)], 1u);
            asm volatile("s_waitcnt vmcnt(0)" ::: "memory");
        } else {
            XB_SPIN(xb_ld(&bar[XB_XGEN(b.x)]) == gen, bar);
            __builtin_amdgcn_fence(__ATOMIC_ACQUIRE, "agent");
            asm volatile("s_waitcnt vmcnt(0)" ::: "memory");
        }
    }
    __syncthreads();
}

DI void convert_weight(const float* __restrict__ src, bf16_t* __restrict__ dst, int K, int N, int Npad, char* smem, int slo = 0, int shi = 0, float scale = 1.0f) {
    float* t = (float*)smem;
    const int tid = otid();
    const int nkt = K / 64, nnt = Npad / 64;
    for (int tile = blockIdx.x; tile < nkt * nnt; tile += gridDim.x) {
        const int k0 = (tile / nnt) * 64, n0 = (tile % nnt) * 64;
#pragma unroll
        for (int i = 0; i < 8; ++i) {
            const int k = i * 8 + (tid >> 6), n = tid & 63;
            const float sc_ = (n0 + n >= slo && n0 + n < shi) ? scale : 1.0f;
            t[k * 65 + n] = (n0 + n < N) ? src[(size_t)(k0 + k) * N + n0 + n] * sc_ : 0.f;
        }
        __syncthreads();
#pragma unroll
        for (int i = 0; i < 4; ++i) {
            const int n = i * 16 + (tid >> 5), k = (tid & 31) * 2;
            *(unsigned*)(dst + (size_t)(n0 + n) * K + k0 + k) = pack2(t[k * 65 + n], t[(k + 1) * 65 + n]);
        }
        __syncthreads();
    }
}

__device__ const float kFreq[16] = {1.000000000e+00f, 5.623413324e-01f, 3.162277639e-01f, 1.778279394e-01f, 1.000000015e-01f, 5.623413250e-02f, 3.162277490e-02f, 1.778279431e-02f,
                                    9.999999776e-03f, 5.623413250e-03f, 3.162277630e-03f, 1.778279431e-03f, 1.000000047e-03f, 5.623413017e-04f, 3.162277571e-04f, 1.778279402e-04f};
DI float2 sincos_acc(float ang) {
    const double x = (double)ang;
    const double n = __builtin_rint(x * 0.15915494309189535);
    double r = __builtin_fma(-n, 6.283185307179586, x);
    r = __builtin_fma(-n, 2.4492935982947064e-16, r);
    const double r2 = r * r;
    double s = 1.0, c = 1.0;
#pragma unroll
    for (int k = 13; k >= 1; --k) {
        s = 1.0 - r2 * s * (1.0 / (double)((2 * k) * (2 * k + 1)));
        c = 1.0 - r2 * c * (1.0 / (double)((2 * k - 1) * (2 * k)));
    }
    return make_float2((float)c, (float)(r * s));
}
DI void build_tables(float2* ax, float2* lin) {
    const int gt = blockIdx.x * THREADS + otid(), gs = gridDim.x * THREADS;
    for (int e = gt; e < SEQ * 32; e += gs) {
        const int pos = e >> 5, p = e & 31;
        const float base = (p < 16) ? (float)(pos >> 6) : (float)(pos & 63);
        ax[e] = sincos_acc(base * kFreq[p & 15]);
    }
    for (int e = gt; e < SEQ * 16; e += gs) {
        const int pos = e >> 4, p = e & 15;
        lin[e] = sincos_acc((float)pos * kFreq[p]);
    }
}

DI void rmsnorm_rows(const float* __restrict__ src, const float* __restrict__ g, bf16_t* __restrict__ dst, int nrows) {
    const int tid_ = otid(), lane = tid_ & 63, wv = blockIdx.x * NWAVE + (tid_ >> 6), nw = gridDim.x * NWAVE;
    for (int row = wv; row < nrows; row += nw) {
        const float4* s = (const float4*)(src + (size_t)row * D);
        float4 v[4]; float ss = 0.f;
#pragma unroll
        for (int i = 0; i < 4; ++i) { v[i] = s[i * 64 + lane]; ss += v[i].x * v[i].x + v[i].y * v[i].y + v[i].z * v[i].z + v[i].w * v[i].w; }
        ss = wave_sum(ss);
        const float rstd = rsqrtf(ss * (1.0f / D) + EPS);
#pragma unroll
        for (int i = 0; i < 4; ++i) {
            const float4 gg = ((const float4*)g)[i * 64 + lane];
            uint2 o; o.x = pack2(v[i].x * rstd * gg.x, v[i].y * rstd * gg.y); o.y = pack2(v[i].z * rstd * gg.z, v[i].w * rstd * gg.w);
            *(uint2*)(dst + (size_t)row * D + (i * 64 + lane) * 4) = o;
        }
    }
}
DI void rmsnorm_final(float* __restrict__ x, const float* __restrict__ g, int nrows) {
    const int tid_ = otid(), lane = tid_ & 63, wv = blockIdx.x * NWAVE + (tid_ >> 6), nw = gridDim.x * NWAVE;
    for (int row = wv; row < nrows; row += nw) {
        float4* s = (float4*)(x + (size_t)row * D);
        float4 v[4]; float ss = 0.f;
#pragma unroll
        for (int i = 0; i < 4; ++i) { v[i] = s[i * 64 + lane]; ss += v[i].x * v[i].x + v[i].y * v[i].y + v[i].z * v[i].z + v[i].w * v[i].w; }
        ss = wave_sum(ss);
        const float rstd = rsqrtf(ss * (1.0f / D) + EPS);
#pragma unroll
        for (int i = 0; i < 4; ++i) {
            const float4 gg = ((const float4*)g)[i * 64 + lane];
            float4 o; o.x = v[i].x * rstd * gg.x; o.y = v[i].y * rstd * gg.y; o.z = v[i].z * rstd * gg.z; o.w = v[i].w * rstd * gg.w;
            s[i * 64 + lane] = o;
        }
    }
}

DI void kprep_even(bf16_t* __restrict__ qkv, const float* __restrict__ gk, const float2* __restrict__ ax) {
    const int tid_ = otid(), gt = blockIdx.x * THREADS + tid_, gs = gridDim.x * THREADS;
    const int p = tid_ & 31;
    for (int v = gt >> 5; v < TC * 2; v += gs >> 5) {
        const int tok = v >> 1, kvh = v & 1;
        unsigned* ptr = (unsigned*)(qkv + (size_t)tok * EVEN_IN + 512 + kvh * 64 + 2 * p);
        const unsigned u = *ptr;
        const float x0 = bflo(u), x1 = bfhi(u);
        float ss = x0 * x0 + x1 * x1;
#pragma unroll
        for (int o = 16; o >= 1; o >>= 1) ss += __shfl_xor(ss, o);
        const float rstd = rsqrtf(ss * (1.0f / 64) + EPS);
        const float y0 = x0 * rstd * gk[2 * p], y1 = x1 * rstd * gk[2 * p + 1];
        const float2 cs = ax[(tok & (SEQ - 1)) * 32 + p];
        *ptr = pack2(y0 * cs.x - y1 * cs.y, y0 * cs.y + y1 * cs.x);
    }
}
DI void prep_odd(bf16_t* __restrict__ a, const float* __restrict__ gq, const float* __restrict__ gkv, const float2* __restrict__ lin) {
    const int tid_ = otid(), lane = tid_ & 63, wv = blockIdx.x * NWAVE + (tid_ >> 6), nw = gridDim.x * NWAVE;
    for (int row = wv; row < TC; row += nw) {
        unsigned* base = (unsigned*)(a + (size_t)row * ODD_PAD);
        unsigned uq[3], uk[2]; float sq = 0.f, sk = 0.f;
#pragma unroll
        for (int i = 0; i < 3; ++i) { uq[i] = base[i * 64 + lane]; const float a0 = bflo(uq[i]), a1 = bfhi(uq[i]); sq += a0 * a0 + a1 * a1; }
#pragma unroll
        for (int i = 0; i < 2; ++i) { uk[i] = base[192 + i * 64 + lane]; const float a0 = bflo(uk[i]), a1 = bfhi(uk[i]); sk += a0 * a0 + a1 * a1; }
        sq = wave_sum(sq); sk = wave_sum(sk);
        const float rq = rsqrtf(sq * (1.0f / 384) + EPS), rk = rsqrtf(sk * (1.0f / 256) + EPS);
#pragma unroll
        for (int i = 0; i < 3; ++i) { const int c = (i * 64 + lane) * 2; base[i * 64 + lane] = pack2(bflo(uq[i]) * rq * gq[c], bfhi(uq[i]) * rq * gq[c + 1]); }
#pragma unroll
        for (int i = 0; i < 2; ++i) { const int c = (i * 64 + lane) * 2; base[192 + i * 64 + lane] = pack2(bflo(uk[i]) * rk * gkv[c], bfhi(uk[i]) * rk * gkv[c + 1]); }
        if (lane < 16) {
            const unsigned u = base[320 + lane];
            const float x0 = bflo(u), x1 = bfhi(u);
            const float2 cs = lin[(row & (SEQ - 1)) * 16 + lane];
            base[320 + lane] = pack2(x0 * cs.x - x1 * cs.y, x0 * cs.y + x1 * cs.x);
        }
    }
}


DI void normmax_even(const bf16_t* __restrict__ qkv, unsigned* __restrict__ nd, char* smem) {
    const int tid = otid(), lane = tid & 63, w = tid >> 6;
    float* red = (float*)smem;
    for (int item = blockIdx.x; item < NB * 32; item += gridDim.x) {
        const int b = item & 7, slab = item >> 3;
        float mq = 0.f, mk = 0.f;
        for (int i = 0; i < 16; ++i) {
            const bf16_t* row = qkv + ((size_t)b * SEQ + slab * 128 + w * 16 + i) * EVEN_IN;
            const u32x4 uq = *(const u32x4*)(row + 768 + 8 * lane), uk = *(const u32x4*)(row + 1280 + 8 * lane);
            float sq = 0.f, sk = 0.f;
#pragma unroll
            for (int j = 0; j < 4; ++j) { const float a0 = bflo(uq[j]), a1 = bfhi(uq[j]), b0 = bflo(uk[j]), b1 = bfhi(uk[j]); sq += a0 * a0 + a1 * a1; sk += b0 * b0 + b1 * b1; }
#pragma unroll
            for (int o = 1; o <= 4; o <<= 1) { sq += __shfl_xor(sq, o); sk += __shfl_xor(sk, o); }
            mq = fmaxf(mq, sq); mk = fmaxf(mk, sk);
        }
        if ((lane & 7) == 0) { red[(w * 8 + (lane >> 3)) * 2] = mq; red[(w * 8 + (lane >> 3)) * 2 + 1] = mk; }
        __syncthreads();
        if (tid < 16) {
            float m = 0.f;
#pragma unroll
            for (int ww = 0; ww < NWAVE; ++ww) m = fmaxf(m, red[ww * 16 + tid]);
            atomicMax(nd + b * 16 + tid, __float_as_uint(m));
        }
        __syncthreads();
    }
}
DI void normmax_mla(const bf16_t* __restrict__ qb, const bf16_t* __restrict__ kv, const bf16_t* __restrict__ a, unsigned* __restrict__ nmx, char* smem) {
    const int tid = otid(), lane = tid & 63, w = tid >> 6;
    float* red = (float*)smem;
    for (int item = blockIdx.x; item < NB * 32; item += gridDim.x) {
        const int b = item & 7, slab = item >> 3;
        float mq = 0.f, mk = 0.f;
        for (int i = 0; i < 16; ++i) {
            const size_t r = (size_t)b * SEQ + slab * 128 + w * 16 + i;
            float sq = 0.f, sk = 0.f, sr = 0.f;
#pragma unroll
            for (int c = 0; c < 3; ++c) {
                const u32x4 u = *(const u32x4*)(qb + r * 1536 + 24 * lane + 8 * c);
#pragma unroll
                for (int j = 0; j < 4; ++j) { const float a0 = bflo(u[j]), a1 = bfhi(u[j]); sq += a0 * a0 + a1 * a1; }
            }
#pragma unroll
            for (int c = 0; c < 4; ++c) {
                const u32x4 u = *(const u32x4*)(kv + r * 2048 + 32 * lane + 8 * c);
#pragma unroll
                for (int j = 0; j < 4; ++j) { const float a0 = bflo(u[j]), a1 = bfhi(u[j]); sk += a0 * a0 + a1 * a1; }
            }
#pragma unroll
            for (int c = 0; c < 4; ++c) {
                const u32x4 u = *(const u32x4*)(a + r * ODD_PAD + 640 + 8 * c);
#pragma unroll
                for (int j = 0; j < 4; ++j) { const float a0 = bflo(u[j]), a1 = bfhi(u[j]); sr += a0 * a0 + a1 * a1; }
            }
            sq += __shfl_xor(sq, 1); sq += __shfl_xor(sq, 2);
            sk += __shfl_xor(sk, 1);
            mq = fmaxf(mq, sq); mk = fmaxf(mk, sk + sr);
        }
        if ((lane & 3) == 0) { red[(w * 16 + (lane >> 2)) * 2] = mq; red[(w * 16 + (lane >> 2)) * 2 + 1] = mk; }
        __syncthreads();
        if (tid < 32) {
            float m = 0.f;
#pragma unroll
            for (int ww = 0; ww < NWAVE; ++ww) m = fmaxf(m, red[ww * 32 + tid]);
            atomicMax(nmx + b * 32 + tid, __float_as_uint(m));
        }
        __syncthreads();
    }
}

namespace pg8 {
constexpr int BM = 256, BK = 64, HALF = 128, HTB = HALF * BK * 2, NXCD = 8, WGM = 8;
DI int lds_byte(int r, int c) { const int st = (r >> 4) * 2 + (c >> 5), rr = r & 15, cc = c & 31, ob = rr * 64 + cc * 2; return st * 1024 + (ob ^ (((ob >> 9) & 1) << 5)); }
DI void stage_rc(int b, int& R, int& C) { const int st = b / 1024, sb = b % 1024, swz = sb ^ (((sb >> 9) & 1) << 5); R = (st >> 1) * 16 + swz / 64; C = (st & 1) * 32 + (swz % 64) / 2; }
DI int perm32(int rho) { const int n = rho >> 4, i = rho & 15; return 8 * (i >> 2) + 4 * n + (i & 3); }
struct Unit { int pm, pn; };
struct Gemm { const bf16_t* A; const bf16_t* Bt; int M, NT, K, lda; size_t hstepB, tstepB; };
struct StaticOrder {
    int nM, nN, nwg, G, c;
    DI void init(int M, int NT, int G_, int c_) { nM = M / BM; nN = NT; nwg = nM * nN; G = G_; c = c_; }
    DI bool next(int i, Unit& u) const {
        const long L = (long)i * G + c; if (L >= nwg) return false;
        int wgid = (int)L; { const int q = nwg / NXCD, r = nwg % NXCD, xcd = wgid % NXCD, off = wgid / NXCD; wgid = (xcd < r ? xcd * (q + 1) : r * (q + 1) + (xcd - r) * q) + off; }
        const int nig = WGM * nN, gid = wgid / nig, fm = gid * WGM, gsz = (nM - fm) < WGM ? (nM - fm) : WGM;
        u.pm = fm + ((wgid % nig) % gsz); u.pn = (wgid % nig) / gsz; return true;
    }
};
template <class Epi>
DI void gemm_phase(LDS_AS unsigned char* lds, const Gemm g, const Epi& E) {
    StaticOrder S; S.init(g.M, g.NT, gridDim.x, blockIdx.x);
    const int tid = otid(), wid = __builtin_amdgcn_readfirstlane(tid >> 6), lane = tid & 63, wr = wid >> 2, wc = wid & 3, fr = lane & 15, fq = lane >> 4;
    const int K = g.K, nt = K / BK;
    unsigned voffA[2], voffB[2];
#pragma unroll
    for (int i = 0; i < 2; ++i) { int R, C; stage_rc(tid * 16 + i * 8192, R, C); const int Rb = Epi::PERM ? ((R & ~31) + perm32(R & 31)) : R;
        voffA[i] = (unsigned)(R * g.lda + C) * 2u; voffB[i] = (unsigned)(Rb * K + C) * 2u; }
    const size_t kstep = (size_t)(BK * 2);
    const size_t hstepA = (size_t)HALF * g.lda * 2, tstepA = 2 * hstepA, hstepB = g.hstepB, tstepB = g.tstepB;
    const unsigned ldsw = (unsigned)wid * 1024u;
    const int aoff = lds_byte(wr * 64 + fr, fq * 8), boff = lds_byte(wc * 32 + fr, fq * 8);
#define PG8_SA(b, h) (((b) * 2 + (h)) * HTB)
#define PG8_SB(b, h) ((4 + (b) * 2 + (h)) * HTB)
#define PG8_STAGE(bufoff, gbase, voff) do { _Pragma("unroll") for (int _i = 0; _i < 2; ++_i) \
        __builtin_amdgcn_global_load_lds((const unsigned*)((const char*)(gbase) + (voff)[_i]), (LDS_AS unsigned*)(lds + (bufoff) + ldsw + _i * 8192), 16, 0, 0); } while (0)
#define PG8_LDA(dst, b, h) do { _Pragma("unroll") for (int m = 0; m < 4; ++m) _Pragma("unroll") for (int k = 0; k < 2; ++k) dst[m][k] = *(const LDS_AS bf16x8*)(lds + PG8_SA(b, h) + aoff + m * 2048 + k * 1024); } while (0)
#define PG8_LDB(dst, b, h) do { _Pragma("unroll") for (int n = 0; n < 2; ++n) _Pragma("unroll") for (int k = 0; k < 2; ++k) dst[n][k] = *(const LDS_AS bf16x8*)(lds + PG8_SB(b, h) + boff + n * 2048 + k * 1024); } while (0)
#define PG8_MMA(ai, bj, At, Bt) do { __builtin_amdgcn_s_setprio(1); _Pragma("unroll") for (int m = 0; m < 4; ++m) _Pragma("unroll") for (int n = 0; n < 2; ++n) _Pragma("unroll") for (int k = 0; k < 2; ++k) \
        acc[ai][bj][m][n] = __builtin_amdgcn_mfma_f32_16x16x32_bf16(Bt[n][k], At[m][k], acc[ai][bj][m][n], 0, 0, 0); __builtin_amdgcn_s_setprio(0); } while (0)
#define PG8_WAIT_V(n) asm volatile("s_waitcnt vmcnt(" #n ")" ::: "memory")
#define PG8_WAIT_L(n) asm volatile("s_waitcnt lgkmcnt(" #n ")" ::: "memory")
#define PG8_BAR __builtin_amdgcn_s_barrier()
#define PG8_SCHED __builtin_amdgcn_sched_barrier(0)
    Unit cur, nxt; int ui = 0;
    if (!S.next(0, cur)) return;
    f32x4 acc[2][2][4][2];
#pragma unroll
    for (int a = 0; a < 2; ++a)
#pragma unroll
        for (int b = 0; b < 2; ++b)
#pragma unroll
            for (int m = 0; m < 4; ++m)
#pragma unroll
                for (int n = 0; n < 2; ++n) acc[a][b][m][n] = (f32x4){0.f, 0.f, 0.f, 0.f};
    bf16x8 At[4][2], B0[2][2], B1[2][2];
    const char* cA = (const char*)g.A + (size_t)cur.pm * tstepA; const char* cB = (const char*)g.Bt + (size_t)cur.pn * tstepB;
    PG8_STAGE(PG8_SB(0, 0), cB, voffB); PG8_STAGE(PG8_SB(0, 1), cB + hstepB, voffB); PG8_STAGE(PG8_SA(0, 0), cA, voffA); PG8_STAGE(PG8_SA(0, 1), cA + hstepA, voffA);
    if (wr == 1) PG8_BAR;
    PG8_WAIT_V(2); PG8_BAR;
    PG8_STAGE(PG8_SB(1, 0), cB + kstep, voffB); PG8_STAGE(PG8_SA(1, 0), cA + kstep, voffA); PG8_STAGE(PG8_SB(1, 1), cB + hstepB + kstep, voffB);
    PG8_WAIT_V(6); PG8_BAR;
    for (;;) {
        const bool has_next = S.next(ui + 1, nxt);
        const char* nA = has_next ? (const char*)g.A + (size_t)nxt.pm * tstepA : cA; const char* nB = has_next ? (const char*)g.Bt + (size_t)nxt.pn * tstepB : cB;
        for (int t = 0; t < nt; t += 2) {
            const bool last = (t == nt - 2);
            const char* a1 = cA + (size_t)(t + 1) * kstep;
            const char* a2 = last ? nA : cA + (size_t)(t + 2) * kstep; const char* b2 = last ? nB : cB + (size_t)(t + 2) * kstep;
            const char* a3 = a2 + kstep; const char* b3 = b2 + kstep;
            PG8_LDB(B0, 0, 0); PG8_LDB(B1, 0, 1); PG8_SCHED; PG8_LDA(At, 0, 0); PG8_STAGE(PG8_SA(1, 1), a1 + hstepA, voffA);
            PG8_WAIT_V(8); PG8_WAIT_L(0); PG8_BAR; PG8_MMA(0, 0, At, B0); PG8_MMA(0, 1, At, B1); PG8_BAR; PG8_SCHED;
            PG8_LDA(At, 0, 1); PG8_STAGE(PG8_SB(0, 0), b2, voffB); PG8_STAGE(PG8_SB(0, 1), b2 + hstepB, voffB); PG8_STAGE(PG8_SA(0, 0), a2, voffA);
            PG8_WAIT_V(8); PG8_WAIT_L(0); PG8_BAR; PG8_MMA(1, 0, At, B0); PG8_MMA(1, 1, At, B1); PG8_BAR; PG8_SCHED;
            PG8_LDB(B0, 1, 0); PG8_LDB(B1, 1, 1); PG8_SCHED; PG8_LDA(At, 1, 0); PG8_STAGE(PG8_SA(0, 1), a2 + hstepA, voffA);
            PG8_WAIT_V(8); PG8_WAIT_L(0); PG8_BAR; PG8_MMA(0, 0, At, B0); PG8_MMA(0, 1, At, B1); PG8_BAR; PG8_SCHED;
            PG8_LDA(At, 1, 1); PG8_STAGE(PG8_SB(1, 0), b3, voffB); PG8_STAGE(PG8_SB(1, 1), b3 + hstepB, voffB); PG8_STAGE(PG8_SA(1, 0), a3, voffA);
            PG8_WAIT_V(8); PG8_WAIT_L(0); PG8_BAR; PG8_MMA(1, 0, At, B0); PG8_MMA(1, 1, At, B1); PG8_BAR; PG8_SCHED;
        }
        if (wr == 0) PG8_BAR;
        E(acc, cur, wr, wc, fr, fq);
        if (!has_next) break;
#pragma unroll
        for (int a = 0; a < 2; ++a)
#pragma unroll
            for (int b = 0; b < 2; ++b)
#pragma unroll
                for (int m = 0; m < 4; ++m)
#pragma unroll
                    for (int n = 0; n < 2; ++n) acc[a][b][m][n] = (f32x4){0.f, 0.f, 0.f, 0.f};
        cur = nxt; cA = nA; cB = nB; ++ui;
        if (wr == 1) PG8_BAR;
    }
    PG8_WAIT_V(0);
    PG8_BAR;
#undef PG8_SA
#undef PG8_SB
#undef PG8_STAGE
#undef PG8_LDA
#undef PG8_LDB
#undef PG8_MMA
#undef PG8_WAIT_V
#undef PG8_WAIT_L
#undef PG8_BAR
#undef PG8_SCHED
}
struct EpiResid {
    static constexpr bool PERM = true;
    const float* res; float* out;
    DI void operator()(const f32x4 (&acc)[2][2][4][2], const Unit& u, int wr, int wc, int fr, int fq) const {
        const int row0 = u.pm * BM + wr * 64 + fr, col0 = u.pn * BM + wc * 32 + 8 * fq;
#pragma unroll
        for (int ai = 0; ai < 2; ++ai)
#pragma unroll
            for (int m = 0; m < 4; ++m) {
                const size_t rb = (size_t)(row0 + ai * HALF + m * 16) * D + col0;
#pragma unroll
                for (int bj = 0; bj < 2; ++bj)
#pragma unroll
                    for (int n = 0; n < 2; ++n) { const size_t idx = rb + bj * HALF + n * 4; *(f32x4*)(out + idx) = *(const f32x4*)(res + idx) + acc[ai][bj][m][n]; }
            }
    }
};
struct EpiBf16 {
    static constexpr bool PERM = true;
    bf16_t* out; int ld;
    DI void operator()(const f32x4 (&acc)[2][2][4][2], const Unit& u, int wr, int wc, int fr, int fq) const {
        const int row0 = u.pm * BM + wr * 64 + fr, col0 = u.pn * BM + wc * 32 + 8 * fq;
#pragma unroll
        for (int ai = 0; ai < 2; ++ai)
#pragma unroll
            for (int m = 0; m < 4; ++m) {
                bf16_t* rowp = out + (size_t)(row0 + ai * HALF + m * 16) * ld + col0;
#pragma unroll
                for (int bj = 0; bj < 2; ++bj) {
                    const f32x4 v0 = acc[ai][bj][m][0], v1 = acc[ai][bj][m][1];
                    u32x4 w; w.x = pack2(v0[0], v0[1]); w.y = pack2(v0[2], v0[3]); w.z = pack2(v1[0], v1[1]); w.w = pack2(v1[2], v1[3]);
                    *(u32x4*)(rowp + bj * HALF) = w;
                }
            }
    }
};
struct EpiSwiglu {
    static constexpr bool PERM = true;
    bf16_t* act;
    DI void operator()(const f32x4 (&acc)[2][2][4][2], const Unit& u, int wr, int wc, int fr, int fq) const {
        const int row0 = u.pm * BM + wr * 64 + fr, col0 = u.pn * HALF + wc * 32 + 8 * fq;
#pragma unroll
        for (int ai = 0; ai < 2; ++ai)
#pragma unroll
            for (int m = 0; m < 4; ++m) {
                float v[8];
#pragma unroll
                for (int n = 0; n < 2; ++n)
#pragma unroll
                    for (int j = 0; j < 4; ++j) { const float gg = acc[ai][0][m][n][j], uu = acc[ai][1][m][n][j]; v[4 * n + j] = gg * uu * __builtin_amdgcn_rcpf(1.0f + __builtin_amdgcn_exp2f(-gg * LOG2E)); }
                u32x4 w; w.x = pack2(v[0], v[1]); w.y = pack2(v[2], v[3]); w.z = pack2(v[4], v[5]); w.w = pack2(v[6], v[7]);
                *(u32x4*)(act + (size_t)(row0 + ai * HALF + m * 16) * DFF + col0) = w;
            }
    }
};
}
DI pg8::Gemm mk_gemm(const bf16_t* A, int lda, const bf16_t* Bt, int M, int N, int K) { return pg8::Gemm{A, Bt, M, N / 256, K, lda, (size_t)128 * K * 2, (size_t)256 * K * 2}; }

template <int DQK, int DV, int KT, int QMODE, bool ALIBI, bool NOMAX>
DI void attn_core(const bf16_t* __restrict__ q, int ldq, const bf16_t* __restrict__ k, int ldk, const bf16_t* __restrict__ k2, int ldk2,
                  const bf16_t* __restrict__ v, int ldv, int nkeys, int qpos0, float qscale, float slope2,
                  const float* __restrict__ qg, const float2* __restrict__ tab, char* smem, f32x16 (&o)[DV / 32], float& lsum) {
    constexpr int KROW = DQK * 2 + 16, VROW = DV * 2 + 64  , KBYTES = KT * KROW, VBYTES = KT * VROW;
    constexpr int KCPR = DQK / 8  , KTOT = KT * KCPR, NKC = (KTOT + THREADS - 1) / THREADS, VCPR = DV / 8, VTOT = KT * VCPR, NVC = (VTOT + THREADS - 1) / THREADS;
    constexpr int NST = KT / 32, NKS = DQK / 16, NDT = DV / 32;
    static_assert(2 * (KBYTES + VBYTES) <= (int)LDS_BYTES, "lds");
    const int tid = otid(), lane = tid & 63, w = tid >> 6, r = lane & 31, h = lane >> 5;
    const int qpos = qpos0 + 32 * w + r;
    bf16x8 qf[NKS];
    {
        const bf16_t* qrow = q + (size_t)(32 * w + r) * ldq + 8 * h;
        u32x4 raw[NKS];
#pragma unroll
        for (int s = 0; s < NKS; ++s) raw[s] = *(const u32x4*)(qrow + 16 * s);
        if (QMODE == 1) {
            float ss = 0.f;
#pragma unroll
            for (int s = 0; s < NKS; ++s) {
                const unsigned u[4] = {raw[s].x, raw[s].y, raw[s].z, raw[s].w};
#pragma unroll
                for (int j = 0; j < 4; ++j) { const float a0 = bflo(u[j]), a1 = bfhi(u[j]); ss += a0 * a0 + a1 * a1; }
            }
            ss += __shfl_xor(ss, 32);
            const float rstd = rsqrtf(ss * (1.0f / 64) + EPS) * qscale;
#pragma unroll
            for (int s = 0; s < NKS; ++s) {
                unsigned u[4] = {raw[s].x, raw[s].y, raw[s].z, raw[s].w};
#pragma unroll
                for (int j = 0; j < 4; ++j) {
                    const int d0 = 16 * s + 8 * h + 2 * j;
                    const float y0 = bflo(u[j]) * rstd * qg[d0], y1 = bfhi(u[j]) * rstd * qg[d0 + 1];
                    const float2 cs = tab[qpos * 32 + (d0 >> 1)];
                    u[j] = pack2(y0 * cs.x - y1 * cs.y, y0 * cs.y + y1 * cs.x);
                }
                raw[s] = u32x4{u[0], u[1], u[2], u[3]};
            }
        } else if (QMODE == 2) {
#pragma unroll
            for (int s = 4; s < NKS; ++s) {
                unsigned u[4] = {raw[s].x, raw[s].y, raw[s].z, raw[s].w};
#pragma unroll
                for (int j = 0; j < 4; ++j) {
                    const int p = 8 * (s - 4) + 4 * h + j;
                    const float y0 = bflo(u[j]), y1 = bfhi(u[j]);
                    const float2 cs = tab[qpos * 16 + p];
                    u[j] = pack2(y0 * cs.x - y1 * cs.y, y0 * cs.y + y1 * cs.x);
                }
                raw[s] = u32x4{u[0], u[1], u[2], u[3]};
            }
        }
#pragma unroll
        for (int s = 0; s < NKS; ++s) qf[s] = __builtin_bit_cast(bf16x8, raw[s]);
    }
    u32x4 rk[NKC], rv[NVC];
    char* const kbuf = smem;
    char* const vbuf = smem + 2 * KBYTES;
#define ATT_GLOADK(key0_)                                                                                             \
    {                                                                                                                 \
        _Pragma("unroll") for (int i = 0; i < NKC; ++i) {                                                             \
            const int cid = tid + THREADS * i, key = cid / KCPR, cc = cid - key * KCPR;                               \
            if (KTOT % THREADS == 0 || cid < KTOT) {                                                                  \
                const bf16_t* src;                                                                                    \
                if (QMODE == 2 && cc >= 8) src = k2 + (size_t)((key0_) + key) * ldk2 + (cc - 8) * 8;                   \
                else src = k + (size_t)((key0_) + key) * ldk + cc * 8;                                                \
                rk[i] = *(const u32x4*)src;                                                                           \
            }                                                                                                         \
        }                                                                                                             \
    }
#define ATT_GLOADV(key0_)                                                                                             \
    {                                                                                                                 \
        _Pragma("unroll") for (int i = 0; i < NVC; ++i) {                                                             \
            const int cid = tid + THREADS * i, key = cid / VCPR, cc = cid - key * VCPR;                               \
            if (VTOT % THREADS == 0 || cid < VTOT) rv[i] = *(const u32x4*)(v + (size_t)((key0_) + key) * ldv + cc * 8); \
        }                                                                                                             \
    }
#define ATT_LSTOREK(buf_)                                                                                             \
    {                                                                                                                 \
        _Pragma("unroll") for (int i = 0; i < NKC; ++i) {                                                             \
            const int cid = tid + THREADS * i, key = cid / KCPR, cc = cid - key * KCPR;                               \
            if (KTOT % THREADS == 0 || cid < KTOT) *(u32x4*)(kbuf + (buf_) * KBYTES + key * KROW + cc * 16) = rk[i];  \
        }                                                                                                             \
    }
#define ATT_LSTOREV(buf_)                                                                                             \
    {                                                                                                                 \
        _Pragma("unroll") for (int i = 0; i < NVC; ++i) {                                                             \
            const int cid = tid + THREADS * i, key = cid / VCPR, cc = cid - key * VCPR;                               \
            if (VTOT % THREADS == 0 || cid < VTOT) *(u32x4*)(vbuf + (buf_) * VBYTES + key * VROW + cc * 16) = rv[i];  \
        }                                                                                                             \
    }
#define ATT_QK(buf_, X_)                                                                                              \
    {                                                                                                                 \
        const char* kb_ = kbuf + (buf_) * KBYTES + r * KROW + h * 16;                                                 \
        _Pragma("unroll") for (int st = 0; st < NST; ++st) {                                                          \
            X_[st] = MFMA(*(const bf16x8*)(kb_ + 32 * st * KROW), qf[0], zero16);                                     \
            _Pragma("unroll") for (int ks = 1; ks < NKS; ++ks) X_[st] = MFMA(*(const bf16x8*)(kb_ + 32 * st * KROW + ks * 32), qf[ks], X_[st]); \
        }                                                                                                             \
    }
#define ATT_SMPV(t_, vb_, X_)                                                                                         \
    {                                                                                                                 \
        if (NOMAX) {                                                                                                  \
            const float dqn = (float)(qpos - ((t_) * KT + 4 * h));                                                    \
            _Pragma("unroll") for (int st = 0; st < NST; ++st)                                                        \
                _Pragma("unroll") for (int i = 0; i < 16; ++i) {                                                      \
                    float xv_ = X_[st][i];                                                                            \
                    if (ALIBI) xv_ = __builtin_fmaf(-slope2, fabsf(dqn - (float)(32 * st + (i & 3) + 8 * (i >> 2))), xv_); \
                    X_[st][i] = __builtin_amdgcn_exp2f(xv_);                                                          \
                    if (!ROWSUM_MFMA) lacc += X_[st][i];                                                              \
                }                                                                                                     \
        } else {                                                                                                      \
            float mx = -1e30f;                                                                                        \
            const float dq = (float)(qpos - ((t_) * KT + 4 * h));                                                     \
            _Pragma("unroll") for (int st = 0; st < NST; ++st)                                                        \
                _Pragma("unroll") for (int i = 0; i < 16; ++i) {                                                      \
                    if (ALIBI) X_[st][i] = __builtin_fmaf(-slope2, fabsf(dq - (float)(32 * st + (i & 3) + 8 * (i >> 2))), X_[st][i]); \
                    mx = fmaxf(mx, X_[st][i]);                                                                        \
                }                                                                                                     \
            mx = fmaxf(mx, __shfl_xor(mx, 32));                                                                       \
            const float mn = fmaxf(m, mx);                                                                            \
            const float alpha = __builtin_amdgcn_exp2f(m - mn);                                                       \
            m = mn;                                                                                                   \
            float rs_ = 0.f;                                                                                          \
            _Pragma("unroll") for (int st = 0; st < NST; ++st)                                                        \
                _Pragma("unroll") for (int i = 0; i < 16; ++i) { X_[st][i] = __builtin_amdgcn_exp2f(X_[st][i] - mn); if (!ROWSUM_MFMA) rs_ += X_[st][i]; } \
            if (__any(alpha != 1.0f)) {                                                                               \
                _Pragma("unroll") for (int dt = 0; dt < NDT; ++dt)                                                    \
                    _Pragma("unroll") for (int i = 0; i < 16; ++i) o[dt][i] *= alpha;                                 \
                _Pragma("unroll") for (int i = 0; i < 16; ++i) ol[i] *= alpha;                                        \
            }                                                                                                         \
            if (!ROWSUM_MFMA) lacc = lacc * alpha + rs_;                                                              \
        }                                                                                                             \
        const char* vbp_ = vbuf + (vb_) * VBYTES + vlane;                                                             \
        __builtin_amdgcn_s_setprio(1);     \
        _Pragma("unroll") for (int st = 0; st < NST; ++st)                                                            \
            _Pragma("unroll") for (int s = 0; s < 2; ++s) {                                                           \
                u32x4 pk;                                                                                             \
                pk.x = pack2(X_[st][8 * s + 0], X_[st][8 * s + 1]); pk.y = pack2(X_[st][8 * s + 2], X_[st][8 * s + 3]); \
                pk.z = pack2(X_[st][8 * s + 4], X_[st][8 * s + 5]); pk.w = pack2(X_[st][8 * s + 6], X_[st][8 * s + 7]); \
                const bf16x8 pb = __builtin_bit_cast(bf16x8, pk);                                                     \
                if (ROWSUM_MFMA) ol = MFMA(ones8, pb, ol);                                                            \
                _Pragma("unroll") for (int dt = 0; dt < NDT; ++dt) {                                                  \
                    const char* va = vbp_ + (32 * st + 16 * s) * VROW + 64 * dt;                                      \
                    const s16x4 lo = __builtin_amdgcn_ds_read_tr16_b64_v4i16((LDS_AS s16x4*)(va));                    \
                    const s16x4 hi = __builtin_amdgcn_ds_read_tr16_b64_v4i16((LDS_AS s16x4*)(va + 8 * VROW));        \
                    o[dt] = MFMA(__builtin_shufflevector(lo, hi, 0, 1, 2, 3, 4, 5, 6, 7), pb, o[dt]);                 \
                }                                                                                                     \
            }                                                                                                         \
        __builtin_amdgcn_s_setprio(0);                                                                                \
    }
#define ATT_STEP(t_, PAR_, CUR_, NXT_)                                                                                \
    {                                                                                                                 \
        const int tk_ = ((t_) + 2 < ntiles) ? (t_) + 2 : ntiles - 1, tv_ = ((t_) + 1 < ntiles) ? (t_) + 1 : ntiles - 1; \
        ATT_GLOADK(tk_ * KT)                                                                                          \
        ATT_GLOADV(tv_ * KT)                                                                                          \
        __builtin_amdgcn_sched_barrier(0);                                                                            \
        ATT_QK(1 - (PAR_), NXT_)                                                                                      \
        ATT_SMPV(t_, PAR_, CUR_)                                                                                      \
        __builtin_amdgcn_sched_barrier(0);                                                                            \
        ATT_LSTOREK(PAR_)                                                                                             \
        ATT_LSTOREV(1 - (PAR_))                                                                                       \
        __syncthreads();                                                                                              \
    }
#define ATT_STEP1(t_, PAR_, X_)                                                                                       \
    {                                                                                                                 \
        const int tn_ = ((t_) + 1 < ntiles) ? (t_) + 1 : ntiles - 1;                                                  \
        ATT_GLOADK(tn_ * KT)                                                                                          \
        ATT_GLOADV(tn_ * KT)                                                                                          \
        __builtin_amdgcn_sched_barrier(0);                                                                            \
        ATT_QK(PAR_, X_)                                                                                              \
        ATT_SMPV(t_, PAR_, X_)                                                                                        \
        __builtin_amdgcn_sched_barrier(0);                                                                            \
        ATT_LSTOREK(1 - (PAR_))                                                                                       \
        ATT_LSTOREV(1 - (PAR_))                                                                                       \
        __syncthreads();                                                                                              \
    }
    const f32x16 zero16 = {0.f, 0.f, 0.f, 0.f, 0.f, 0.f, 0.f, 0.f, 0.f, 0.f, 0.f, 0.f, 0.f, 0.f, 0.f, 0.f};
    const bf16x8 ones8 = {0x3F80, 0x3F80, 0x3F80, 0x3F80, 0x3F80, 0x3F80, 0x3F80, 0x3F80};
    constexpr bool ROWSUM_MFMA = false;
    float m = -1e30f, lacc = 0.f;
    f32x16 ol = zero16;
#pragma unroll
    for (int dt = 0; dt < NDT; ++dt) o[dt] = zero16;
    const int ntiles = nkeys / KT;
    const int vlane = (4 * h + ((lane & 15) >> 2)) * VROW + (16 * ((lane >> 4) & 1) + 4 * (lane & 3)) * 2;
    constexpr bool PIPE = false;
    if (PIPE) {
        f32x16 xa[NST], xb[NST];
        ATT_GLOADK(0) ATT_LSTOREK(0)
        ATT_GLOADK(KT) ATT_GLOADV(0)
        __syncthreads();
        ATT_QK(0, xa)
        ATT_LSTOREK(1) ATT_LSTOREV(0)
        __syncthreads();
        for (int t = 0; t < ntiles; t += 2) {
            ATT_STEP(t, 0, xa, xb)
            ATT_STEP(t + 1, 1, xb, xa)
        }
    } else {
        f32x16 xs[NST];
        ATT_GLOADK(0) ATT_GLOADV(0) ATT_LSTOREK(0) ATT_LSTOREV(0)
        __syncthreads();
        for (int t = 0; t < ntiles; t += 2) {
            ATT_STEP1(t, 0, xs)
            ATT_STEP1(t + 1, 1, xs)
        }
    }
    lsum = ROWSUM_MFMA ? ol[0] : lacc + __shfl_xor(lacc, 32);
#undef ATT_GLOADK
#undef ATT_GLOADV
#undef ATT_LSTOREK
#undef ATT_LSTOREV
#undef ATT_QK
#undef ATT_SMPV
#undef ATT_STEP
#undef ATT_STEP1
}
template <int NDT>
DI void store_o(bf16_t* dst, int ld, f32x16 (&o)[NDT], float inv) {
    const int tid_ = otid(), lane = tid_ & 63, w = tid_ >> 6, r = lane & 31, h = lane >> 5;
    bf16_t* row = dst + (size_t)(32 * w + r) * ld + 4 * h;
#pragma unroll
    for (int dt = 0; dt < NDT; ++dt)
#pragma unroll
        for (int g = 0; g < 4; ++g) {
            uint2 vv; vv.x = pack2(o[dt][4 * g] * inv, o[dt][4 * g + 1] * inv); vv.y = pack2(o[dt][4 * g + 2] * inv, o[dt][4 * g + 3] * inv);
            *(uint2*)(row + 32 * dt + 8 * g) = vv;
        }
}
DI int swz_item(int base) {
    const int G = gridDim.x, i = blockIdx.x;
    if (G & 7) return base + i;
    return base + (i & 7) * (G >> 3) + (i >> 3);
}

constexpr int QT = SEQ / 256;
constexpr float NOMAX_BOUND = 90.f;
DI void attn_even(const bf16_t* qkv, float* park, bf16_t* mix, const Params& p, const float2* ax, const unsigned* nd, float lam_init, char* smem) {
    float d1 = 0.f, d2 = 0.f, gq = 0.f, gk = 0.f;
    for (int i = 0; i < 64; ++i) { d1 += p.in[8][i] * p.in[9][i]; d2 += p.in[10][i] * p.in[11][i]; gq = fmaxf(gq, fabsf(p.in[6][i])); gk = fmaxf(gk, fabsf(p.in[7][i])); }
    const float lam = __expf(d1) - __expf(d2) + lam_init;
    const float bound_gqa = 64.f * 0.125f * LOG2E * gq * gk * 1.03f;
    const int tid_ = otid(), lane = tid_ & 63, h = lane >> 5;
    float4* mypark = (float4*)(park + ((size_t)blockIdx.x * THREADS + tid_) * 64);
    constexpr int NDIFF = NB * 4 * QT, NGQA = NB * 8 * QT;
    for (int base = 0; base < NDIFF + NGQA; base += gridDim.x) {
        const int it = swz_item(base);
        if (it >= NDIFF + NGQA) continue;
        if (it < NDIFF) {
            const int b = it / (4 * QT), hd = (it / QT) & 3, qt = it % QT;
            const size_t row0 = (size_t)b * SEQ + qt * 256;
            const float slope2 = exp2f(-2.0f * (hd + 1)) * LOG2E;
            const bf16_t* qp = qkv + row0 * EVEN_IN + 768 + hd * 128;
            const bf16_t* kp = qkv + (size_t)b * SEQ * EVEN_IN + 1280 + hd * 128;
            const bf16_t* vp = qkv + (size_t)b * SEQ * EVEN_IN + 1792 + hd * 128;
            f32x16 o0[4]; float l0 = 1.f;
#pragma unroll 1
            for (int c = 0; c < 2; ++c) {
                const unsigned* nn = nd + (b * 8 + hd * 2 + c) * 2;
                const float bound = sqrtf(__uint_as_float(nn[0]) * __uint_as_float(nn[1])) * 1.03f;
                if (bound < NOMAX_BOUND) attn_core<64, 128, 64, 0, true, true>(qp + 64 * c, EVEN_IN, kp + 64 * c, EVEN_IN, nullptr, 0, vp, EVEN_IN, SEQ, qt * 256, 1.0f, slope2, nullptr, nullptr, smem, o0, l0);
                else attn_core<64, 128, 64, 0, true, false>(qp + 64 * c, EVEN_IN, kp + 64 * c, EVEN_IN, nullptr, 0, vp, EVEN_IN, SEQ, qt * 256, 1.0f, slope2, nullptr, nullptr, smem, o0, l0);
                if (c == 0) {
                    const float i0 = 1.0f / l0;
#pragma unroll
                    for (int dt = 0; dt < 4; ++dt)
#pragma unroll
                        for (int g = 0; g < 4; ++g) mypark[dt * 4 + g] = make_float4(o0[dt][4 * g] * i0, o0[dt][4 * g + 1] * i0, o0[dt][4 * g + 2] * i0, o0[dt][4 * g + 3] * i0);
                    asm volatile("" ::: "memory");
                }
            }
            const float i1 = lam / l0;
            float ss = 0.f;
            asm volatile("" ::: "memory");
#pragma unroll
            for (int dt = 0; dt < 4; ++dt)
#pragma unroll
                for (int g = 0; g < 4; ++g) {
                    const float4 pv = mypark[dt * 4 + g];
                    const float pa[4] = {pv.x, pv.y, pv.z, pv.w};
#pragma unroll
                    for (int e = 0; e < 4; ++e) { const float vv = pa[e] - i1 * o0[dt][4 * g + e]; o0[dt][4 * g + e] = vv; ss += vv * vv; }
                }
            ss += __shfl_xor(ss, 32);
            const float rstd = rsqrtf(ss * (1.0f / 128) + EPS) * (1.0f - lam_init);
#pragma unroll
            for (int dt = 0; dt < 4; ++dt)
#pragma unroll
                for (int i = 0; i < 16; ++i) o0[dt][i] *= p.in[12][32 * dt + crow(i, h)];
            store_o<4>(mix + row0 * D + 512 + hd * 128, D, o0, rstd);
        } else {
            const int j = it - NDIFF;
            const int b = j / (8 * QT), hd = (j / QT) & 7, qt = j % QT, kvh = hd >> 2;
            const size_t row0 = (size_t)b * SEQ + qt * 256;
            const bf16_t* qp = qkv + row0 * EVEN_IN + hd * 64;
            const bf16_t* kp = qkv + (size_t)b * SEQ * EVEN_IN + 512 + kvh * 64;
            const bf16_t* vp = qkv + (size_t)b * SEQ * EVEN_IN + 640 + kvh * 64;
            f32x16 o[2]; float l;
            if (bound_gqa < NOMAX_BOUND) attn_core<64, 64, 64, 1, false, true>(qp, EVEN_IN, kp, EVEN_IN, nullptr, 0, vp, EVEN_IN, SEQ, qt * 256, 0.125f * LOG2E, 0.f, p.in[6], ax, smem, o, l);
            else attn_core<64, 64, 64, 1, false, false>(qp, EVEN_IN, kp, EVEN_IN, nullptr, 0, vp, EVEN_IN, SEQ, qt * 256, 0.125f * LOG2E, 0.f, p.in[6], ax, smem, o, l);
            store_o<2>(mix + row0 * D + hd * 64, D, o, 1.0f / l);
        }
    }
}
DI void attn_mla(const bf16_t* qb, const bf16_t* kv, const bf16_t* a, bf16_t* mix, const float2* lin, const unsigned* nmx, char* smem) {
    constexpr int NIT = NB * 16 * QT;
    for (int base = 0; base < NIT; base += gridDim.x) {
        const int it = swz_item(base);
        if (it >= NIT) continue;
        const int b = it / (16 * QT), hd = (it / QT) & 15, qt = it % QT;
        const size_t row0 = (size_t)b * SEQ + qt * 256;
        const unsigned* nn = nmx + (b * 16 + hd) * 2;
        const float bound = sqrtf(__uint_as_float(nn[0]) * __uint_as_float(nn[1])) * 1.03f;
        const bf16_t* kb_ = kv + (size_t)b * SEQ * 2048 + hd * 128;
        f32x16 o[2]; float l;
        if (bound < NOMAX_BOUND) attn_core<96, 64, 64, 2, false, true>(qb + row0 * 1536 + hd * 96, 1536, kb_, 2048, a + (size_t)b * SEQ * ODD_PAD + 640, ODD_PAD, kb_ + 64, 2048, SEQ, qt * 256, 1.0f, 0.f, nullptr, lin, smem, o, l);
        else attn_core<96, 64, 64, 2, false, false>(qb + row0 * 1536 + hd * 96, 1536, kb_, 2048, a + (size_t)b * SEQ * ODD_PAD + 640, ODD_PAD, kb_ + 64, 2048, SEQ, qt * 256, 1.0f, 0.f, nullptr, lin, smem, o, l);
        store_o<2>(mix + row0 * D + hd * 64, D, o, 1.0f / l);
    }
}
DI void attn_cross(const bf16_t* qx, const bf16_t* kvx, bf16_t* mix, int seq0, char* smem) {
    constexpr int NIT = NB * 4 * QT * 2;
    for (int base = 0; base < NIT; base += gridDim.x) {
        const int it = swz_item(base);
        if (it >= NIT) continue;
        const int b = it / (8 * QT), hd = (it / (2 * QT)) & 3, qt = (it >> 1) % QT, half = it & 1;
        const size_t row0 = (size_t)b * SEQ + qt * 256;
        const bf16_t* kvb = kvx + (size_t)(seq0 + b) * NMEM * 2048;
        f32x16 o[4]; float l;
        attn_core<256, 128, 32, 0, false, false>(qx + row0 * D + hd * 256, D, kvb + hd * 256, 2048, nullptr, 0, kvb + 1024 + hd * 256 + half * 128, 2048, NMEM, 0,
                                          1.0f, 0.f, nullptr, nullptr, smem, o, l);
        store_o<4>(mix + row0 * D + hd * 256 + half * 128, D, o, 1.0f / l);
    }
}

extern "C" __global__ void __launch_bounds__(THREADS, 2) fwd_mega(Params p) {
    extern __shared__ __attribute__((aligned(16))) char smem[];
    LDS_AS unsigned char* lds = (LDS_AS unsigned char*)smem;
    cg::grid_group grid = cg::this_grid();
    char* ws = p.ws;
    __shared__ uint4 xb_words;
    if (threadIdx.x == 0) xb_words = make_uint4(0u, 0u, 0u, 0u);
    __syncthreads();
    const XcdBarrier xb = xcd_barrier_post((unsigned*)(ws + B_BAR), (volatile LDS_AS unsigned*)&xb_words);
    bf16_t* wEin = (bf16_t*)(ws + W_EIN); bf16_t* wEout = (bf16_t*)(ws + W_EOUT); bf16_t* wOin = (bf16_t*)(ws + W_OIN);
    bf16_t* wUq = (bf16_t*)(ws + W_UQ); bf16_t* wUkv = (bf16_t*)(ws + W_UKV); bf16_t* wOout = (bf16_t*)(ws + W_OOUT);
    float2* ax = (float2*)(ws + T_AX); float2* lin = (float2*)(ws + T_LIN);
    bf16_t* H = (bf16_t*)(ws + B_H); bf16_t* MIX = (bf16_t*)(ws + B_MIX);

    convert_weight(p.in[5], wEin, D, EVEN_IN, EVEN_IN, smem, 768, 1280, 0.125f * LOG2E);
    convert_weight(p.in[13], wEout, D, D, D, smem);
    convert_weight(p.in[14], wOin, D, ODD_IN, ODD_PAD, smem);
    convert_weight(p.in[17], wUq, 384, 1536, 1536, smem, 0, 1536, 0.10206207261596575f * LOG2E);
    convert_weight(p.in[18], wUkv, 256, 2048, 2048, smem);
    convert_weight(p.in[19], wOout, D, D, D, smem);
    for (int l = 0; l < 2; ++l) {
        convert_weight(p.in[22] + (size_t)l * D * D, (bf16_t*)(ws + W_CQ) + (size_t)l * D * D, D, D, D, smem, 0, D, 0.0625f * LOG2E);
        convert_weight(p.in[23] + (size_t)l * D * 2048, (bf16_t*)(ws + W_CKV) + (size_t)l * 2048 * D, D, 2048, 2048, smem);
        convert_weight(p.in[24] + (size_t)l * D * D, (bf16_t*)(ws + W_CO) + (size_t)l * D * D, D, D, D, smem);
        convert_weight(p.in[26] + (size_t)l * D * 2 * DFF, (bf16_t*)(ws + W_GU) + (size_t)l * 2 * DFF * D, D, 2 * DFF, 2 * DFF, smem);
        convert_weight(p.in[27] + (size_t)l * DFF * D, (bf16_t*)(ws + W_DOWN) + (size_t)l * D * DFF, DFF, D, D, smem);
        rmsnorm_rows(p.in[2], p.in[21] + l * D, (bf16_t*)(ws + B_MEMN) + (size_t)l * NBATCH * NMEM * D, 8 * NMEM);
        rmsnorm_rows(p.in[3], p.in[21] + l * D, (bf16_t*)(ws + B_MEMN) + (size_t)l * NBATCH * NMEM * D + (size_t)8 * NMEM * D, 16 * NMEM);
    }
    build_tables(ax, lin);
    if (blockIdx.x == 0) for (int i = threadIdx.x; i < 4096; i += THREADS) ((unsigned*)(ws + B_NORMS))[i] = 0u;
    grid.sync();
    for (int l = 0; l < 2; ++l) {
        pg8::EpiBf16 e{(bf16_t*)(ws + B_KX) + (size_t)l * NBATCH * NMEM * 2048, 2048};
        pg8::gemm_phase(lds, mk_gemm((const bf16_t*)(ws + B_MEMN) + (size_t)l * NBATCH * NMEM * D, D, (const bf16_t*)(ws + W_CKV) + (size_t)l * 2048 * D, NBATCH * NMEM, 2048, D), e);
    }
    xcd_barrier(xb);

    for (int ch = 0; ch < NCHUNK; ++ch) {
        const float* xin = (ch == 0) ? p.in[0] : p.in[1] + (size_t)(ch - 1) * TC * D;
        float* xo = p.out + (size_t)ch * TC * D;
        for (int layer = 0; layer < 2; ++layer) {
            const float* xcur = (layer == 0) ? xin : xo;
            for (int rep_ = 0; rep_ < PROBE_NORM; ++rep_) rmsnorm_rows(xcur, p.in[4] + layer * D, H, TC);
            xcd_barrier(xb);
            const bf16_t* wout;
            if (layer == 0) {
                bf16_t* qkv = (bf16_t*)(ws + E_QKV);
                for (int rep_ = 0; rep_ < PROBE_GEMM; ++rep_) { pg8::EpiBf16 e{qkv, EVEN_IN}; pg8::gemm_phase(lds, mk_gemm(H, D, wEin, TC, EVEN_IN, D), e); }
                xcd_barrier(xb);
                kprep_even(qkv, p.in[7], ax);
                normmax_even(qkv, (unsigned*)(ws + B_NORMS) + ch * 128, smem);
                xcd_barrier(xb);
                for (int rep_ = 0; rep_ < PROBE_ATTN; ++rep_) attn_even(qkv, (float*)(ws + E_PARK), MIX, p, ax, (const unsigned*)(ws + B_NORMS) + ch * 128, 0.2f, smem);
                wout = wEout;
            } else {
                bf16_t* a = (bf16_t*)(ws + O_A); bf16_t* qb = (bf16_t*)(ws + O_Q); bf16_t* kv = (bf16_t*)(ws + O_KV);
                for (int rep_ = 0; rep_ < PROBE_GEMM; ++rep_) { pg8::EpiBf16 e{a, ODD_PAD}; pg8::gemm_phase(lds, mk_gemm(H, D, wOin, TC, ODD_PAD, D), e); }
                xcd_barrier(xb);
                prep_odd(a, p.in[15], p.in[16], lin);
                xcd_barrier(xb);
                for (int rep_ = 0; rep_ < PROBE_GEMM; ++rep_) { pg8::EpiBf16 e{qb, 1536}; pg8::gemm_phase(lds, mk_gemm(a, ODD_PAD, wUq, TC, 1536, 384), e); }
                for (int rep_ = 0; rep_ < PROBE_GEMM; ++rep_) { pg8::EpiBf16 e{kv, 2048}; pg8::gemm_phase(lds, mk_gemm(a + 384, ODD_PAD, wUkv, TC, 2048, 256), e); }
                xcd_barrier(xb);
                normmax_mla(qb, kv, a, (unsigned*)(ws + B_NORMS) + 384 + ch * 256, smem);
                xcd_barrier(xb);
                for (int rep_ = 0; rep_ < PROBE_ATTN; ++rep_) attn_mla(qb, kv, a, MIX, lin, (const unsigned*)(ws + B_NORMS) + 384 + ch * 256, smem);
                wout = wOout;
            }
            xcd_barrier(xb);
            { pg8::EpiResid e{xcur, xo}; pg8::gemm_phase(lds, mk_gemm(MIX, D, wout, TC, D, D), e); }
            xcd_barrier(xb);
            for (int rep_ = 0; rep_ < PROBE_NORM; ++rep_) rmsnorm_rows(xo, p.in[20] + layer * D, H, TC);
            xcd_barrier(xb);
            for (int rep_ = 0; rep_ < PROBE_GEMM; ++rep_) { pg8::EpiBf16 e{(bf16_t*)(ws + X_Q), D}; pg8::gemm_phase(lds, mk_gemm(H, D, (const bf16_t*)(ws + W_CQ) + (size_t)layer * D * D, TC, D, D), e); }
            xcd_barrier(xb);
            for (int rep_ = 0; rep_ < PROBE_CROSS; ++rep_) attn_cross((const bf16_t*)(ws + X_Q), (const bf16_t*)(ws + B_KX) + (size_t)layer * NBATCH * NMEM * 2048, MIX, ch * NB, smem);
            xcd_barrier(xb);
            { pg8::EpiResid e{xo, xo}; pg8::gemm_phase(lds, mk_gemm(MIX, D, (const bf16_t*)(ws + W_CO) + (size_t)layer * D * D, TC, D, D), e); }
            xcd_barrier(xb);
            for (int rep_ = 0; rep_ < PROBE_NORM; ++rep_) rmsnorm_rows(xo, p.in[25] + layer * D, H, TC);
            xcd_barrier(xb);
            for (int rep_ = 0; rep_ < PROBE_GEMM; ++rep_) { pg8::EpiSwiglu e{(bf16_t*)(ws + F_ACT)};
              pg8::Gemm g{H, (const bf16_t*)(ws + W_GU) + (size_t)layer * 2 * DFF * D, TC, DFF / 128, D, D, (size_t)DFF * D * 2, (size_t)128 * D * 2};
              pg8::gemm_phase(lds, g, e); }
            xcd_barrier(xb);
            { pg8::EpiResid e{xo, xo}; pg8::gemm_phase(lds, mk_gemm((const bf16_t*)(ws + F_ACT), DFF, (const bf16_t*)(ws + W_DOWN) + (size_t)layer * D * DFF, TC, D, DFF), e); }
            xcd_barrier(xb);
        }
        rmsnorm_final(xo, p.in[28], TC);
    }
}

extern "C" void kernel_launch(void* const* d_in, const int* in_sizes, int n_in, void* d_out, int out_size, void* d_ws, size_t ws_size, hipStream_t stream) {
    static int grid_blocks = 0;
    if (!grid_blocks) {
        int dev = 0, cus = 0, per_cu = 0;
        (void)hipGetDevice(&dev);
        (void)hipDeviceGetAttribute(&cus, hipDeviceAttributeMultiprocessorCount, dev);
        (void)hipFuncSetAttribute((const void*)fwd_mega, hipFuncAttributeMaxDynamicSharedMemorySize, (int)LDS_BYTES);
        (void)hipOccupancyMaxActiveBlocksPerMultiprocessor(&per_cu, fwd_mega, THREADS, LDS_BYTES);
        if (per_cu > 1) per_cu = 1;
        if (per_cu < 1) per_cu = 1;
        grid_blocks = cus * per_cu;
    }
    constexpr size_t WS_END = (O_END > E_END ? O_END : E_END) > (F_ACT + (size_t)TC * DFF * 2) ? (O_END > E_END ? O_END : E_END) : (F_ACT + (size_t)TC * DFF * 2);
    if (ws_size < WS_END) { fprintf(stderr, "workspace too small: %zu < %zu\n", ws_size, (size_t)WS_END); return; }
    if (grid_blocks > 256) grid_blocks = 256;
    Params p{};
    for (int i = 0; i < 29; ++i) p.in[i] = (const float*)d_in[i];
    p.out = (float*)d_out;
    p.ws = (char*)d_ws;
    (void)hipMemsetAsync(d_ws, 0, 16384, stream);
    void* args[] = {&p};
    hipError_t e = hipLaunchCooperativeKernel((void*)fwd_mega, dim3(grid_blocks), dim3(THREADS), args, LDS_BYTES, stream);
    if (e != hipSuccess) fprintf(stderr, "cooperative launch failed: %s (grid %d)\n", hipGetErrorString(e), grid_blocks);
}
```

```cpp
#include <hip/hip_runtime.h>
#include <hip/hip_cooperative_groups.h>
#include <cstdio>
#include <cstdint>
namespace cg = cooperative_groups;
#ifndef PROBE_GEMM
#define PROBE_GEMM 1
#endif
#ifndef PROBE_NORM
#define PROBE_NORM 1
#endif
#ifndef PROBE_CROSS
#define PROBE_CROSS 1
#endif
#ifndef PROBE_ATTN
#define PROBE_ATTN 1
#endif

typedef unsigned short bf16_t;
typedef short bf16x8 __attribute__((ext_vector_type(8)));
typedef float f32x16 __attribute__((ext_vector_type(16)));
typedef float f32x2 __attribute__((ext_vector_type(2)));
typedef unsigned u32x4 __attribute__((ext_vector_type(4)));
typedef float f32x4 __attribute__((ext_vector_type(4)));
typedef short s16x4 __attribute__((ext_vector_type(4)));
#define LDS_AS __attribute__((address_space(3)))
typedef __bf16 bf16x2_t __attribute__((ext_vector_type(2)));
#define DI __device__ __forceinline__
#define MFMA(a, b, c) __builtin_amdgcn_mfma_f32_32x32x16_bf16((a), (b), (c), 0, 0, 0)

constexpr int D = 1024, SEQ = 4096, NBATCH = 24, NB = 8  , NCHUNK = NBATCH / NB, TC = NB * SEQ;
constexpr int NMEM = 256, DFF = 2816, EVEN_IN = 2304, ODD_IN = 672, ODD_PAD = 768;
constexpr float EPS = 1e-6f, LOG2E = 1.4426950408889634f;
constexpr int THREADS = 512, NWAVE = THREADS / 64;
constexpr size_t LDS_BYTES = 131072;

constexpr size_t al(size_t x) { return (x + 255) & ~(size_t)255; }
constexpr size_t B_BAR = 0;
constexpr size_t B_NORMS = 16384;
constexpr size_t W_EIN = 32768;
constexpr size_t W_EOUT = W_EIN + al((size_t)EVEN_IN * D * 2);
constexpr size_t W_OIN = W_EOUT + al((size_t)D * D * 2);
constexpr size_t W_UQ = W_OIN + al((size_t)ODD_PAD * D * 2);
constexpr size_t W_UKV = W_UQ + al((size_t)1536 * 384 * 2);
constexpr size_t W_OOUT = W_UKV + al((size_t)2048 * 256 * 2);
constexpr size_t W_CQ = W_OOUT + al((size_t)D * D * 2);
constexpr size_t W_CKV = W_CQ + 2 * al((size_t)D * D * 2);
constexpr size_t W_CO = W_CKV + 2 * al((size_t)2048 * D * 2);
constexpr size_t W_GU = W_CO + 2 * al((size_t)D * D * 2);
constexpr size_t W_DOWN = W_GU + 2 * al((size_t)2 * DFF * D * 2);
constexpr size_t T_AX = W_DOWN + 2 * al((size_t)D * DFF * 2);
constexpr size_t T_LIN = T_AX + al((size_t)SEQ * 32 * 8);
constexpr size_t B_MEMN = T_LIN + al((size_t)SEQ * 16 * 8);
constexpr size_t B_KX = B_MEMN + 2 * al((size_t)NBATCH * NMEM * D * 2);
constexpr size_t B_H = B_KX + 2 * al((size_t)NBATCH * NMEM * 2048 * 2);
constexpr size_t B_MIX = B_H + al((size_t)TC * D * 2);
constexpr size_t B_BIG = B_MIX + al((size_t)TC * D * 2);
constexpr size_t E_QKV = B_BIG;
constexpr size_t E_PARK = E_QKV + al((size_t)TC * EVEN_IN * 2);
constexpr size_t E_END = E_PARK + (size_t)256 * THREADS * 64 * 4;
constexpr size_t O_A = B_BIG;
constexpr size_t O_Q = O_A + al((size_t)TC * ODD_PAD * 2);
constexpr size_t O_KV = O_Q + al((size_t)TC * 1536 * 2);
constexpr size_t O_END = O_KV + al((size_t)TC * 2048 * 2);
constexpr size_t X_Q = B_BIG;
constexpr size_t F_ACT = B_BIG;

struct Params {
    const float* in[29];
    float* out;
    char* ws;
};

DI unsigned pack2(float lo, float hi) { f32x2 v = {lo, hi}; bf16x2_t b = __builtin_convertvector(v, bf16x2_t); return __builtin_bit_cast(unsigned, b); }
DI float bflo(unsigned u) { return __uint_as_float(u << 16); }
DI float bfhi(unsigned u) { return __uint_as_float(u & 0xffff0000u); }
DI int crow(int i, int h) { return (i & 3) + 8 * (i >> 2) + 4 * h; }
DI int swap23(int x) { return (x & ~12) | ((x & 4) << 1) | ((x & 8) >> 1); }
DI int otid() { int t = threadIdx.x; asm volatile("" : "+v"(t)); return t; }
DI float wave_sum(float v) {
#pragma unroll
    for (int o = 32; o >= 1; o >>= 1) v += __shfl_xor(v, o);
    return v;
}


#define XB_TMO      128
#define XB_XCNT(j)  (256  + 64 * (j))
#define XB_XSUB(j)  (1280 + 64 * (j))
#define XB_XGEN(j)  (2304 + 64 * (j))
#define XB_TOP      3328
#define XB_TOPGEN   3392
#define XCD_BAR_WORDS 3456
#define XB_SPIN_CAP (1u << 18)
DI unsigned xb_ld(unsigned* p) { return __hip_atomic_load(p, __ATOMIC_RELAXED, __HIP_MEMORY_SCOPE_AGENT); }
DI unsigned xb_add(unsigned* p, unsigned v) { return __hip_atomic_fetch_add(p, v, __ATOMIC_RELAXED, __HIP_MEMORY_SCOPE_AGENT); }
DI unsigned xb_xcc_id() { return (unsigned)__builtin_amdgcn_s_getreg((3 << 11) | 20) & 0xFu; }
#define XB_SPIN(cond, bar) do { unsigned _sp = 0; while (cond) { __builtin_amdgcn_s_sleep(1); \
    if ((++_sp & 255u) == 0u) { if (xb_ld(&(bar)[XB_TMO])) break; if (_sp > XB_SPIN_CAP) { atomicAdd(&(bar)[XB_TMO], 1u); break; } } } } while (0)
struct XcdBarrier { unsigned* bar; unsigned x; volatile LDS_AS unsigned* st; };
DI XcdBarrier xcd_barrier_post(unsigned* bar, volatile LDS_AS unsigned* st) {
    XcdBarrier b; b.bar = bar; b.x = xb_xcc_id(); b.st = st;
    if (threadIdx.x == 0) (void)xb_add(&bar[XB_XCNT(b.x)], 1u);
    return b;
}
DI void xcd_barrier_complete(unsigned* bar, unsigned x, unsigned& nloc, unsigned& nx) {
    const unsigned G = gridDim.x * gridDim.y * gridDim.z;
    unsigned sum, cnt, mine, sp = 0u;
    for (;;) {
        sum = 0u; cnt = 0u; mine = 0u;
#pragma unroll
        for (unsigned j = 0; j < 16; ++j) { const unsigned c = xb_ld(&bar[XB_XCNT(j)]); sum += c; cnt += (c > 0u) ? 1u : 0u; mine = (j == x) ? c : mine; }
        if (sum == G) break;
        __builtin_amdgcn_s_sleep(1);
        if ((++sp & 255u) == 0u) { if (xb_ld(&bar[XB_TMO])) break; if (sp > XB_SPIN_CAP) { atomicAdd(&bar[XB_TMO], 1u); break; } }
    }
    nloc = mine > 0u ? mine : 1u; nx = cnt > 0u ? cnt : 1u;
}
DI void xcd_barrier(const XcdBarrier& b) {
    asm volatile("s_waitcnt vmcnt(0)" ::: "memory");
    __syncthreads();
    if (threadIdx.x == 0) {
        unsigned* bar = b.bar; asm volatile("" : "+s"(bar));
        unsigned bx = b.x; asm volatile("" : "+s"(bx));
        __builtin_amdgcn_s_waitcnt(0);
        unsigned nloc = b.st[0], nx = b.st[1];
        if (nloc == 0u) { xcd_barrier_complete(bar, bx, nloc, nx); b.st[0] = nloc; b.st[1] = nx; }
        const unsigned old = xb_add(&bar[XB_XSUB(bx)], 1u);
        const unsigned gen = old / nloc;
        if (old + 1u == (gen + 1u) * nloc) {
            __builtin_amdgcn_fence(__ATOMIC_RELEASE, "agent");
            asm volatile("s_waitcnt vmcnt(0)" ::: "memory");
            const unsigned og = xb_add(&bar[XB_TOP], 1u);
            const unsigned tg = og / nx;
            if (og + 1u == (tg + 1u) * nx) xb_add(&bar[XB_TOPGEN], 1u);
            else XB_SPIN(xb_ld(&bar[XB_TOPGEN]) == tg, bar);
            __builtin_amdgcn_fence(__ATOMIC_ACQUIRE, "agent");
            xb_add(&bar[XB_XGEN(bx)], 1u);
            asm volatile("s_waitcnt vmcnt(0)" ::: "memory");
        } else {
            XB_SPIN(xb_ld(&bar[XB_XGEN(bx)]) == gen, bar);
            __builtin_amdgcn_fence(__ATOMIC_ACQUIRE, "agent");
            asm volatile("s_waitcnt vmcnt(0)" ::: "memory");
        }
    }
    __syncthreads();
}

DI void convert_weight(const float* __restrict__ src, bf16_t* __restrict__ dst, int K, int N, int Npad, char* smem, int slo = 0, int shi = 0, float scale = 1.0f) {
    float* t = (float*)smem;
    const int tid = otid();
    const int nkt = K / 64, nnt = Npad / 64;
    for (int tile = blockIdx.x; tile < nkt * nnt; tile += gridDim.x) {
        const int k0 = (tile / nnt) * 64, n0 = (tile % nnt) * 64;
#pragma unroll
        for (int i = 0; i < 8; ++i) {
            const int k = i * 8 + (tid >> 6), n = tid & 63;
            const float sc_ = (n0 + n >= slo && n0 + n < shi) ? scale : 1.0f;
            t[k * 65 + n] = (n0 + n < N) ? src[(size_t)(k0 + k) * N + n0 + n] * sc_ : 0.f;
        }
        __syncthreads();
#pragma unroll
        for (int i = 0; i < 4; ++i) {
            const int n = i * 16 + (tid >> 5), k = (tid & 31) * 2;
            *(unsigned*)(dst + (size_t)(n0 + n) * K + k0 + k) = pack2(t[k * 65 + n], t[(k + 1) * 65 + n]);
        }
        __syncthreads();
    }
}

__device__ const float kFreq[16] = {1.000000000e+00f, 5.623413324e-01f, 3.162277639e-01f, 1.778279394e-01f, 1.000000015e-01f, 5.623413250e-02f, 3.162277490e-02f, 1.778279431e-02f,
                                    9.999999776e-03f, 5.623413250e-03f, 3.162277630e-03f, 1.778279431e-03f, 1.000000047e-03f, 5.623413017e-04f, 3.162277571e-04f, 1.778279402e-04f};
DI float2 sincos_acc(float ang) {
    const double x = (double)ang;
    const double n = __builtin_rint(x * 0.15915494309189535);
    double r = __builtin_fma(-n, 6.283185307179586, x);
    r = __builtin_fma(-n, 2.4492935982947064e-16, r);
    const double r2 = r * r;
    double s = 1.0, c = 1.0;
#pragma unroll
    for (int k = 13; k >= 1; --k) {
        s = 1.0 - r2 * s * (1.0 / (double)((2 * k) * (2 * k + 1)));
        c = 1.0 - r2 * c * (1.0 / (double)((2 * k - 1) * (2 * k)));
    }
    return make_float2((float)c, (float)(r * s));
}
DI void build_tables(float2* ax, float2* lin) {
    const int gt = blockIdx.x * THREADS + otid(), gs = gridDim.x * THREADS;
    for (int e = gt; e < SEQ * 32; e += gs) {
        const int pos = e >> 5, p = e & 31;
        const float base = (p < 16) ? (float)(pos >> 6) : (float)(pos & 63);
        ax[e] = sincos_acc(base * kFreq[p & 15]);
    }
    for (int e = gt; e < SEQ * 16; e += gs) {
        const int pos = e >> 4, p = e & 15;
        lin[e] = sincos_acc((float)pos * kFreq[p]);
    }
}

DI void rmsnorm_rows(const float* __restrict__ src, const float* __restrict__ g, bf16_t* __restrict__ dst, int nrows) {
    const int tid_ = otid(), lane = tid_ & 63, wv = blockIdx.x * NWAVE + (tid_ >> 6), nw = gridDim.x * NWAVE;
    for (int row = wv; row < nrows; row += nw) {
        const float4* s = (const float4*)(src + (size_t)row * D);
        float4 v[4]; float ss = 0.f;
#pragma unroll
        for (int i = 0; i < 4; ++i) { v[i] = s[i * 64 + lane]; ss += v[i].x * v[i].x + v[i].y * v[i].y + v[i].z * v[i].z + v[i].w * v[i].w; }
        ss = wave_sum(ss);
        const float rstd = rsqrtf(ss * (1.0f / D) + EPS);
#pragma unroll
        for (int i = 0; i < 4; ++i) {
            const float4 gg = ((const float4*)g)[i * 64 + lane];
            uint2 o; o.x = pack2(v[i].x * rstd * gg.x, v[i].y * rstd * gg.y); o.y = pack2(v[i].z * rstd * gg.z, v[i].w * rstd * gg.w);
            *(uint2*)(dst + (size_t)row * D + (i * 64 + lane) * 4) = o;
        }
    }
}
DI void rmsnorm_final(float* __restrict__ x, const float* __restrict__ g, int nrows) {
    const int tid_ = otid(), lane = tid_ & 63, wv = blockIdx.x * NWAVE + (tid_ >> 6), nw = gridDim.x * NWAVE;
    for (int row = wv; row < nrows; row += nw) {
        float4* s = (float4*)(x + (size_t)row * D);
        float4 v[4]; float ss = 0.f;
#pragma unroll
        for (int i = 0; i < 4; ++i) { v[i] = s[i * 64 + lane]; ss += v[i].x * v[i].x + v[i].y * v[i].y + v[i].z * v[i].z + v[i].w * v[i].w; }
        ss = wave_sum(ss);
        const float rstd = rsqrtf(ss * (1.0f / D) + EPS);
#pragma unroll
        for (int i = 0; i < 4; ++i) {
            const float4 gg = ((const float4*)g)[i * 64 + lane];
            float4 o; o.x = v[i].x * rstd * gg.x; o.y = v[i].y * rstd * gg.y; o.z = v[i].z * rstd * gg.z; o.w = v[i].w * rstd * gg.w;
            s[i * 64 + lane] = o;
        }
    }
}

DI void kprep_even(bf16_t* __restrict__ qkv, const float* __restrict__ gk, const float2* __restrict__ ax) {
    const int tid_ = otid(), gt = blockIdx.x * THREADS + tid_, gs = gridDim.x * THREADS;
    const int p = tid_ & 31;
    for (int v = gt >> 5; v < TC * 2; v += gs >> 5) {
        const int tok = v >> 1, kvh = v & 1;
        unsigned* ptr = (unsigned*)(qkv + (size_t)tok * EVEN_IN + 512 + kvh * 64 + 2 * p);
        const unsigned u = *ptr;
        const float x0 = bflo(u), x1 = bfhi(u);
        float ss = x0 * x0 + x1 * x1;
#pragma unroll
        for (int o = 16; o >= 1; o >>= 1) ss += __shfl_xor(ss, o);
        const float rstd = rsqrtf(ss * (1.0f / 64) + EPS);
        const float y0 = x0 * rstd * gk[2 * p], y1 = x1 * rstd * gk[2 * p + 1];
        const float2 cs = ax[(tok & (SEQ - 1)) * 32 + p];
        *ptr = pack2(y0 * cs.x - y1 * cs.y, y0 * cs.y + y1 * cs.x);
    }
}
DI void prep_odd(bf16_t* __restrict__ a, const float* __restrict__ gq, const float* __restrict__ gkv, const float2* __restrict__ lin) {
    const int tid_ = otid(), lane = tid_ & 63, wv = blockIdx.x * NWAVE + (tid_ >> 6), nw = gridDim.x * NWAVE;
    for (int row = wv; row < TC; row += nw) {
        unsigned* base = (unsigned*)(a + (size_t)row * ODD_PAD);
        unsigned uq[3], uk[2]; float sq = 0.f, sk = 0.f;
#pragma unroll
        for (int i = 0; i < 3; ++i) { uq[i] = base[i * 64 + lane]; const float a0 = bflo(uq[i]), a1 = bfhi(uq[i]); sq += a0 * a0 + a1 * a1; }
#pragma unroll
        for (int i = 0; i < 2; ++i) { uk[i] = base[192 + i * 64 + lane]; const float a0 = bflo(uk[i]), a1 = bfhi(uk[i]); sk += a0 * a0 + a1 * a1; }
        sq = wave_sum(sq); sk = wave_sum(sk);
        const float rq = rsqrtf(sq * (1.0f / 384) + EPS), rk = rsqrtf(sk * (1.0f / 256) + EPS);
#pragma unroll
        for (int i = 0; i < 3; ++i) { const int c = (i * 64 + lane) * 2; base[i * 64 + lane] = pack2(bflo(uq[i]) * rq * gq[c], bfhi(uq[i]) * rq * gq[c + 1]); }
#pragma unroll
        for (int i = 0; i < 2; ++i) { const int c = (i * 64 + lane) * 2; base[192 + i * 64 + lane] = pack2(bflo(uk[i]) * rk * gkv[c], bfhi(uk[i]) * rk * gkv[c + 1]); }
        if (lane < 16) {
            const unsigned u = base[320 + lane];
            const float x0 = bflo(u), x1 = bfhi(u);
            const float2 cs = lin[(row & (SEQ - 1)) * 16 + lane];
            base[320 + lane] = pack2(x0 * cs.x - x1 * cs.y, x0 * cs.y + x1 * cs.x);
        }
    }
}


DI void normmax_even(const bf16_t* __restrict__ qkv, unsigned* __restrict__ nd, char* smem) {
    const int tid = otid(), lane = tid & 63, w = tid >> 6;
    float* red = (float*)smem;
    for (int item = blockIdx.x; item < NB * 32; item += gridDim.x) {
        const int b = item & 7, slab = item >> 3;
        float mq = 0.f, mk = 0.f;
        for (int i = 0; i < 16; ++i) {
            const bf16_t* row = qkv + ((size_t)b * SEQ + slab * 128 + w * 16 + i) * EVEN_IN;
            const u32x4 uq = *(const u32x4*)(row + 768 + 8 * lane), uk = *(const u32x4*)(row + 1280 + 8 * lane);
            float sq = 0.f, sk = 0.f;
#pragma unroll
            for (int j = 0; j < 4; ++j) { const float a0 = bflo(uq[j]), a1 = bfhi(uq[j]), b0 = bflo(uk[j]), b1 = bfhi(uk[j]); sq += a0 * a0 + a1 * a1; sk += b0 * b0 + b1 * b1; }
#pragma unroll
            for (int o = 1; o <= 4; o <<= 1) { sq += __shfl_xor(sq, o); sk += __shfl_xor(sk, o); }
            mq = fmaxf(mq, sq); mk = fmaxf(mk, sk);
        }
        if ((lane & 7) == 0) { red[(w * 8 + (lane >> 3)) * 2] = mq; red[(w * 8 + (lane >> 3)) * 2 + 1] = mk; }
        __syncthreads();
        if (tid < 16) {
            float m = 0.f;
#pragma unroll
            for (int ww = 0; ww < NWAVE; ++ww) m = fmaxf(m, red[ww * 16 + tid]);
            atomicMax(nd + b * 16 + tid, __float_as_uint(m));
        }
        __syncthreads();
    }
}
DI void normmax_mla(const bf16_t* __restrict__ qb, const bf16_t* __restrict__ kv, const bf16_t* __restrict__ a, unsigned* __restrict__ nmx, char* smem) {
    const int tid = otid(), lane = tid & 63, w = tid >> 6;
    float* red = (float*)smem;
    for (int item = blockIdx.x; item < NB * 32; item += gridDim.x) {
        const int b = item & 7, slab = item >> 3;
        float mq = 0.f, mk = 0.f;
        for (int i = 0; i < 16; ++i) {
            const size_t r = (size_t)b * SEQ + slab * 128 + w * 16 + i;
            float sq = 0.f, sk = 0.f, sr = 0.f;
#pragma unroll
            for (int c = 0; c < 3; ++c) {
                const u32x4 u = *(const u32x4*)(qb + r * 1536 + 24 * lane + 8 * c);
#pragma unroll
                for (int j = 0; j < 4; ++j) { const float a0 = bflo(u[j]), a1 = bfhi(u[j]); sq += a0 * a0 + a1 * a1; }
            }
#pragma unroll
            for (int c = 0; c < 4; ++c) {
                const u32x4 u = *(const u32x4*)(kv + r * 2048 + 32 * lane + 8 * c);
#pragma unroll
                for (int j = 0; j < 4; ++j) { const float a0 = bflo(u[j]), a1 = bfhi(u[j]); sk += a0 * a0 + a1 * a1; }
            }
#pragma unroll
            for (int c = 0; c < 4; ++c) {
                const u32x4 u = *(const u32x4*)(a + r * ODD_PAD + 640 + 8 * c);
#pragma unroll
                for (int j = 0; j < 4; ++j) { const float a0 = bflo(u[j]), a1 = bfhi(u[j]); sr += a0 * a0 + a1 * a1; }
            }
            sq += __shfl_xor(sq, 1); sq += __shfl_xor(sq, 2);
            sk += __shfl_xor(sk, 1);
            mq = fmaxf(mq, sq); mk = fmaxf(mk, sk + sr);
        }
        if ((lane & 3) == 0) { red[(w * 16 + (lane >> 2)) * 2] = mq; red[(w * 16 + (lane >> 2)) * 2 + 1] = mk; }
        __syncthreads();
        if (tid < 32) {
            float m = 0.f;
#pragma unroll
            for (int ww = 0; ww < NWAVE; ++ww) m = fmaxf(m, red[ww * 32 + tid]);
            atomicMax(nmx + b * 32 + tid, __float_as_uint(m));
        }
        __syncthreads();
    }
}

namespace pg8 {
constexpr int BM = 256, BK = 64, HALF = 128, HTB = HALF * BK * 2, NXCD = 8, WGM = 8;
DI int lds_byte(int r, int c) { const int st = (r >> 4) * 2 + (c >> 5), rr = r & 15, cc = c & 31, ob = rr * 64 + cc * 2; return st * 1024 + (ob ^ (((ob >> 9) & 1) << 5)); }
DI void stage_rc(int b, int& R, int& C) { const int st = b / 1024, sb = b % 1024, swz = sb ^ (((sb >> 9) & 1) << 5); R = (st >> 1) * 16 + swz / 64; C = (st & 1) * 32 + (swz % 64) / 2; }
DI int perm32(int rho) { const int n = rho >> 4, i = rho & 15; return 8 * (i >> 2) + 4 * n + (i & 3); }
struct Unit { int pm, pn; };
struct Gemm { const bf16_t* A; const bf16_t* Bt; int M, NT, K, lda; size_t hstepB, tstepB; };
struct StaticOrder {
    int nM, nN, nwg, G, c;
    DI void init(int M, int NT, int G_, int c_) { nM = M / BM; nN = NT; nwg = nM * nN; G = G_; c = c_; }
    DI bool next(int i, Unit& u) const {
        const long L = (long)i * G + c; if (L >= nwg) return false;
        int wgid = (int)L; { const int q = nwg / NXCD, r = nwg % NXCD, xcd = wgid % NXCD, off = wgid / NXCD; wgid = (xcd < r ? xcd * (q + 1) : r * (q + 1) + (xcd - r) * q) + off; }
        const int nig = WGM * nN, gid = wgid / nig, fm = gid * WGM, gsz = (nM - fm) < WGM ? (nM - fm) : WGM;
        u.pm = fm + ((wgid % nig) % gsz); u.pn = (wgid % nig) / gsz; return true;
    }
};
template <class Epi>
DI void gemm_phase(LDS_AS unsigned char* lds, const Gemm g, const Epi& E) {
    StaticOrder S; S.init(g.M, g.NT, gridDim.x, blockIdx.x);
    const int tid = otid(), wid = __builtin_amdgcn_readfirstlane(tid >> 6), lane = tid & 63, wr = wid >> 2, wc = wid & 3, fr = lane & 15, fq = lane >> 4;
    const int K = g.K, nt = K / BK;
    unsigned voffA[2], voffB[2];
#pragma unroll
    for (int i = 0; i < 2; ++i) { int R, C; stage_rc(tid * 16 + i * 8192, R, C); const int Rb = Epi::PERM ? ((R & ~31) + perm32(R & 31)) : R;
        voffA[i] = (unsigned)(R * g.lda + C) * 2u; voffB[i] = (unsigned)(Rb * K + C) * 2u; }
    const size_t kstep = (size_t)(BK * 2);
    const size_t hstepA = (size_t)HALF * g.lda * 2, tstepA = 2 * hstepA, hstepB = g.hstepB, tstepB = g.tstepB;
    const unsigned ldsw = (unsigned)wid * 1024u;
    const int aoff = lds_byte(wr * 64 + fr, fq * 8), boff = lds_byte(wc * 32 + fr, fq * 8);
#define PG8_SA(b, h) (((b) * 2 + (h)) * HTB)
#define PG8_SB(b, h) ((4 + (b) * 2 + (h)) * HTB)
#define PG8_STAGE(bufoff, gbase, voff) do { _Pragma("unroll") for (int _i = 0; _i < 2; ++_i) \
        __builtin_amdgcn_global_load_lds((const unsigned*)((const char*)(gbase) + (voff)[_i]), (LDS_AS unsigned*)(lds + (bufoff) + ldsw + _i * 8192), 16, 0, 0); } while (0)
#define PG8_LDA(dst, b, h) do { _Pragma("unroll") for (int m = 0; m < 4; ++m) _Pragma("unroll") for (int k = 0; k < 2; ++k) dst[m][k] = *(const LDS_AS bf16x8*)(lds + PG8_SA(b, h) + aoff + m * 2048 + k * 1024); } while (0)
#define PG8_LDB(dst, b, h) do { _Pragma("unroll") for (int n = 0; n < 2; ++n) _Pragma("unroll") for (int k = 0; k < 2; ++k) dst[n][k] = *(const LDS_AS bf16x8*)(lds + PG8_SB(b, h) + boff + n * 2048 + k * 1024); } while (0)
#define PG8_MMA(ai, bj, At, Bt) do { __builtin_amdgcn_s_setprio(1); _Pragma("unroll") for (int m = 0; m < 4; ++m) _Pragma("unroll") for (int n = 0; n < 2; ++n) _Pragma("unroll") for (int k = 0; k < 2; ++k) \
        acc[ai][bj][m][n] = __builtin_amdgcn_mfma_f32_16x16x32_bf16(Bt[n][k], At[m][k], acc[ai][bj][m][n], 0, 0, 0); __builtin_amdgcn_s_setprio(0); } while (0)
#define PG8_WAIT_V(n) asm volatile("s_waitcnt vmcnt(" #n ")" ::: "memory")
#define PG8_WAIT_L(n) asm volatile("s_waitcnt lgkmcnt(" #n ")" ::: "memory")
#define PG8_BAR __builtin_amdgcn_s_barrier()
#define PG8_SCHED __builtin_amdgcn_sched_barrier(0)
    Unit cur, nxt; int ui = 0;
    if (!S.next(0, cur)) return;
    f32x4 acc[2][2][4][2];
#pragma unroll
    for (int a = 0; a < 2; ++a)
#pragma unroll
        for (int b = 0; b < 2; ++b)
#pragma unroll
            for (int m = 0; m < 4; ++m)
#pragma unroll
                for (int n = 0; n < 2; ++n) acc[a][b][m][n] = (f32x4){0.f, 0.f, 0.f, 0.f};
    bf16x8 At[4][2], B0[2][2], B1[2][2];
    const char* cA = (const char*)g.A + (size_t)cur.pm * tstepA; const char* cB = (const char*)g.Bt + (size_t)cur.pn * tstepB;
    PG8_STAGE(PG8_SB(0, 0), cB, voffB); PG8_STAGE(PG8_SB(0, 1), cB + hstepB, voffB); PG8_STAGE(PG8_SA(0, 0), cA, voffA); PG8_STAGE(PG8_SA(0, 1), cA + hstepA, voffA);
    if (wr == 1) PG8_BAR;
    PG8_WAIT_V(2); PG8_BAR;
    PG8_STAGE(PG8_SB(1, 0), cB + kstep, voffB); PG8_STAGE(PG8_SA(1, 0), cA + kstep, voffA); PG8_STAGE(PG8_SB(1, 1), cB + hstepB + kstep, voffB);
    PG8_WAIT_V(6); PG8_BAR;
    for (;;) {
        const bool has_next = S.next(ui + 1, nxt);
        const char* nA = has_next ? (const char*)g.A + (size_t)nxt.pm * tstepA : cA; const char* nB = has_next ? (const char*)g.Bt + (size_t)nxt.pn * tstepB : cB;
        for (int t = 0; t < nt; t += 2) {
            const bool last = (t == nt - 2);
            const char* a1 = cA + (size_t)(t + 1) * kstep;
            const char* a2 = last ? nA : cA + (size_t)(t + 2) * kstep; const char* b2 = last ? nB : cB + (size_t)(t + 2) * kstep;
            const char* a3 = a2 + kstep; const char* b3 = b2 + kstep;
            PG8_LDB(B0, 0, 0); PG8_LDB(B1, 0, 1); PG8_SCHED; PG8_LDA(At, 0, 0); PG8_STAGE(PG8_SA(1, 1), a1 + hstepA, voffA);
            PG8_WAIT_V(8); PG8_WAIT_L(0); PG8_BAR; PG8_MMA(0, 0, At, B0); PG8_MMA(0, 1, At, B1); PG8_BAR; PG8_SCHED;
            PG8_LDA(At, 0, 1); PG8_STAGE(PG8_SB(0, 0), b2, voffB); PG8_STAGE(PG8_SB(0, 1), b2 + hstepB, voffB); PG8_STAGE(PG8_SA(0, 0), a2, voffA);
            PG8_WAIT_V(8); PG8_WAIT_L(0); PG8_BAR; PG8_MMA(1, 0, At, B0); PG8_MMA(1, 1, At, B1); PG8_BAR; PG8_SCHED;
            PG8_LDB(B0, 1, 0); PG8_LDB(B1, 1, 1); PG8_SCHED; PG8_LDA(At, 1, 0); PG8_STAGE(PG8_SA(0, 1), a2 + hstepA, voffA);
            PG8_WAIT_V(8); PG8_WAIT_L(0); PG8_BAR; PG8_MMA(0, 0, At, B0); PG8_MMA(0, 1, At, B1); PG8_BAR; PG8_SCHED;
            PG8_LDA(At, 1, 1); PG8_STAGE(PG8_SB(1, 0), b3, voffB); PG8_STAGE(PG8_SB(1, 1), b3 + hstepB, voffB); PG8_STAGE(PG8_SA(1, 0), a3, voffA);
            PG8_WAIT_V(8); PG8_WAIT_L(0); PG8_BAR; PG8_MMA(1, 0, At, B0); PG8_MMA(1, 1, At, B1); PG8_BAR; PG8_SCHED;
        }
        if (wr == 0) PG8_BAR;
        E(acc, cur, wr, wc, fr, fq);
        if (!has_next) break;
#pragma unroll
        for (int a = 0; a < 2; ++a)
#pragma unroll
            for (int b = 0; b < 2; ++b)
#pragma unroll
                for (int m = 0; m < 4; ++m)
#pragma unroll
                    for (int n = 0; n < 2; ++n) acc[a][b][m][n] = (f32x4){0.f, 0.f, 0.f, 0.f};
        cur = nxt; cA = nA; cB = nB; ++ui;
        if (wr == 1) PG8_BAR;
    }
    PG8_WAIT_V(0);
    PG8_BAR;
#undef PG8_SA
#undef PG8_SB
#undef PG8_STAGE
#undef PG8_LDA
#undef PG8_LDB
#undef PG8_MMA
#undef PG8_WAIT_V
#undef PG8_WAIT_L
#undef PG8_BAR
#undef PG8_SCHED
}
struct EpiResid {
    static constexpr bool PERM = true;
    const float* res; float* out;
    DI void operator()(const f32x4 (&acc)[2][2][4][2], const Unit& u, int wr, int wc, int fr, int fq) const {
        const int row0 = u.pm * BM + wr * 64 + fr, col0 = u.pn * BM + wc * 32 + 8 * fq;
#pragma unroll
        for (int ai = 0; ai < 2; ++ai)
#pragma unroll
            for (int m = 0; m < 4; ++m) {
                const size_t rb = (size_t)(row0 + ai * HALF + m * 16) * D + col0;
#pragma unroll
                for (int bj = 0; bj < 2; ++bj)
#pragma unroll
                    for (int n = 0; n < 2; ++n) { const size_t idx = rb + bj * HALF + n * 4; *(f32x4*)(out + idx) = *(const f32x4*)(res + idx) + acc[ai][bj][m][n]; }
            }
    }
};
struct EpiBf16 {
    static constexpr bool PERM = true;
    bf16_t* out; int ld;
    DI void operator()(const f32x4 (&acc)[2][2][4][2], const Unit& u, int wr, int wc, int fr, int fq) const {
        const int row0 = u.pm * BM + wr * 64 + fr, col0 = u.pn * BM + wc * 32 + 8 * fq;
#pragma unroll
        for (int ai = 0; ai < 2; ++ai)
#pragma unroll
            for (int m = 0; m < 4; ++m) {
                bf16_t* rowp = out + (size_t)(row0 + ai * HALF + m * 16) * ld + col0;
#pragma unroll
                for (int bj = 0; bj < 2; ++bj) {
                    const f32x4 v0 = acc[ai][bj][m][0], v1 = acc[ai][bj][m][1];
                    u32x4 w; w.x = pack2(v0[0], v0[1]); w.y = pack2(v0[2], v0[3]); w.z = pack2(v1[0], v1[1]); w.w = pack2(v1[2], v1[3]);
                    *(u32x4*)(rowp + bj * HALF) = w;
                }
            }
    }
};
struct EpiSwiglu {
    static constexpr bool PERM = true;
    bf16_t* act;
    DI void operator()(const f32x4 (&acc)[2][2][4][2], const Unit& u, int wr, int wc, int fr, int fq) const {
        const int row0 = u.pm * BM + wr * 64 + fr, col0 = u.pn * HALF + wc * 32 + 8 * fq;
#pragma unroll
        for (int ai = 0; ai < 2; ++ai)
#pragma unroll
            for (int m = 0; m < 4; ++m) {
                float v[8];
#pragma unroll
                for (int n = 0; n < 2; ++n)
#pragma unroll
                    for (int j = 0; j < 4; ++j) { const float gg = acc[ai][0][m][n][j], uu = acc[ai][1][m][n][j]; v[4 * n + j] = gg * uu * __builtin_amdgcn_rcpf(1.0f + __builtin_amdgcn_exp2f(-gg * LOG2E)); }
                u32x4 w; w.x = pack2(v[0], v[1]); w.y = pack2(v[2], v[3]); w.z = pack2(v[4], v[5]); w.w = pack2(v[6], v[7]);
                *(u32x4*)(act + (size_t)(row0 + ai * HALF + m * 16) * DFF + col0) = w;
            }
    }
};
}
DI pg8::Gemm mk_gemm(const bf16_t* A, int lda, const bf16_t* Bt, int M, int N, int K) { return pg8::Gemm{A, Bt, M, N / 256, K, lda, (size_t)128 * K * 2, (size_t)256 * K * 2}; }

template <int DQK, int DV, int KT, int QMODE, bool ALIBI, bool NOMAX>
DI void attn_core(const bf16_t* __restrict__ q, int ldq, const bf16_t* __restrict__ k, int ldk, const bf16_t* __restrict__ k2, int ldk2,
                  const bf16_t* __restrict__ v, int ldv, int nkeys, int qpos0, float qscale, float slope2,
                  const float* __restrict__ qg, const float2* __restrict__ tab, char* smem, f32x16 (&o)[DV / 32], float& lsum) {
    constexpr int KROW = DQK * 2 + 16, VROW = DV * 2 + 64  , KBYTES = KT * KROW, VBYTES = KT * VROW;
    constexpr int KCPR = DQK / 8  , KTOT = KT * KCPR, NKC = (KTOT + THREADS - 1) / THREADS, VCPR = DV / 8, VTOT = KT * VCPR, NVC = (VTOT + THREADS - 1) / THREADS;
    constexpr int NST = KT / 32, NKS = DQK / 16, NDT = DV / 32;
    static_assert(2 * (KBYTES + VBYTES) <= (int)LDS_BYTES, "lds");
    const int tid = otid(), lane = tid & 63, w = tid >> 6, r = lane & 31, h = lane >> 5;
    const int qpos = qpos0 + 32 * w + r;
    bf16x8 qf[NKS];
    {
        const bf16_t* qrow = q + (size_t)(32 * w + r) * ldq + 8 * h;
        u32x4 raw[NKS];
#pragma unroll
        for (int s = 0; s < NKS; ++s) raw[s] = *(const u32x4*)(qrow + 16 * s);
        if (QMODE == 1) {
            float ss = 0.f;
#pragma unroll
            for (int s = 0; s < NKS; ++s) {
                const unsigned u[4] = {raw[s].x, raw[s].y, raw[s].z, raw[s].w};
#pragma unroll
                for (int j = 0; j < 4; ++j) { const float a0 = bflo(u[j]), a1 = bfhi(u[j]); ss += a0 * a0 + a1 * a1; }
            }
            ss += __shfl_xor(ss, 32);
            const float rstd = rsqrtf(ss * (1.0f / 64) + EPS) * qscale;
#pragma unroll
            for (int s = 0; s < NKS; ++s) {
                unsigned u[4] = {raw[s].x, raw[s].y, raw[s].z, raw[s].w};
#pragma unroll
                for (int j = 0; j < 4; ++j) {
                    const int d0 = 16 * s + 8 * h + 2 * j;
                    const float y0 = bflo(u[j]) * rstd * qg[d0], y1 = bfhi(u[j]) * rstd * qg[d0 + 1];
                    const float2 cs = tab[qpos * 32 + (d0 >> 1)];
                    u[j] = pack2(y0 * cs.x - y1 * cs.y, y0 * cs.y + y1 * cs.x);
                }
                raw[s] = u32x4{u[0], u[1], u[2], u[3]};
            }
        } else if (QMODE == 2) {
#pragma unroll
            for (int s = 4; s < NKS; ++s) {
                unsigned u[4] = {raw[s].x, raw[s].y, raw[s].z, raw[s].w};
#pragma unroll
                for (int j = 0; j < 4; ++j) {
                    const int p = 8 * (s - 4) + 4 * h + j;
                    const float y0 = bflo(u[j]), y1 = bfhi(u[j]);
                    const float2 cs = tab[qpos * 16 + p];
                    u[j] = pack2(y0 * cs.x - y1 * cs.y, y0 * cs.y + y1 * cs.x);
                }
                raw[s] = u32x4{u[0], u[1], u[2], u[3]};
            }
        }
#pragma unroll
        for (int s = 0; s < NKS; ++s) qf[s] = __builtin_bit_cast(bf16x8, raw[s]);
    }
    u32x4 rk[NKC], rv[NVC];
    char* const kbuf = smem;
    char* const vbuf = smem + 2 * KBYTES;
#define ATT_GLOADK(key0_)                                                                                             \
    {                                                                                                                 \
        _Pragma("unroll") for (int i = 0; i < NKC; ++i) {                                                             \
            const int cid = tid + THREADS * i, key = cid / KCPR, cc = cid - key * KCPR;                               \
            if (KTOT % THREADS == 0 || cid < KTOT) {                                                                  \
                const bf16_t* src;                                                                                    \
                if (QMODE == 2 && cc >= 8) src = k2 + (size_t)((key0_) + key) * ldk2 + (cc - 8) * 8;                   \
                else src = k + (size_t)((key0_) + key) * ldk + cc * 8;                                                \
                rk[i] = *(const u32x4*)src;                                                                           \
            }                                                                                                         \
        }                                                                                                             \
    }
#define ATT_GLOADV(key0_)                                                                                             \
    {                                                                                                                 \
        _Pragma("unroll") for (int i = 0; i < NVC; ++i) {                                                             \
            const int cid = tid + THREADS * i, key = cid / VCPR, cc = cid - key * VCPR;                               \
            if (VTOT % THREADS == 0 || cid < VTOT) rv[i] = *(const u32x4*)(v + (size_t)((key0_) + key) * ldv + cc * 8); \
        }                                                                                                             \
    }
#define ATT_LSTOREK(buf_)                                                                                             \
    {                                                                                                                 \
        _Pragma("unroll") for (int i = 0; i < NKC; ++i) {                                                             \
            const int cid = tid + THREADS * i, key = cid / KCPR, cc = cid - key * KCPR;                               \
            if (KTOT % THREADS == 0 || cid < KTOT) *(u32x4*)(kbuf + (buf_) * KBYTES + key * KROW + cc * 16) = rk[i];  \
        }                                                                                                             \
    }
#define ATT_LSTOREV(buf_)                                                                                             \
    {                                                                                                                 \
        _Pragma("unroll") for (int i = 0; i < NVC; ++i) {                                                             \
            const int cid = tid + THREADS * i, key = cid / VCPR, cc = cid - key * VCPR;                               \
            if (VTOT % THREADS == 0 || cid < VTOT) *(u32x4*)(vbuf + (buf_) * VBYTES + key * VROW + cc * 16) = rv[i];  \
        }                                                                                                             \
    }
#define ATT_QK(buf_, X_)                                                                                              \
    {                                                                                                                 \
        const char* kb_ = kbuf + (buf_) * KBYTES + r * KROW + h * 16;                                                 \
        _Pragma("unroll") for (int st = 0; st < NST; ++st) {                                                          \
            X_[st] = MFMA(*(const bf16x8*)(kb_ + 32 * st * KROW), qf[0], zero16);                                     \
            _Pragma("unroll") for (int ks = 1; ks < NKS; ++ks) X_[st] = MFMA(*(const bf16x8*)(kb_ + 32 * st * KROW + ks * 32), qf[ks], X_[st]); \
        }                                                                                                             \
    }
#define ATT_SM(t_, X_)                                                                                                \
    {                                                                                                                 \
        if (NOMAX) {                                                                                                  \
            const float dqn = (float)(qpos - ((t_) * KT + 4 * h));                                                    \
            _Pragma("unroll") for (int st = 0; st < NST; ++st)                                                        \
                _Pragma("unroll") for (int i = 0; i < 16; ++i) {                                                      \
                    float xv_ = X_[st][i];                                                                            \
                    if (ALIBI) xv_ = __builtin_fmaf(-slope2, fabsf(dqn - (float)(32 * st + (i & 3) + 8 * (i >> 2))), xv_); \
                    X_[st][i] = __builtin_amdgcn_exp2f(xv_);                                                          \
                    if (!ROWSUM_MFMA) lacc += X_[st][i];                                                              \
                }                                                                                                     \
        } else {                                                                                                      \
            float mx = -1e30f;                                                                                        \
            const float dq = (float)(qpos - ((t_) * KT + 4 * h));                                                     \
            _Pragma("unroll") for (int st = 0; st < NST; ++st)                                                        \
                _Pragma("unroll") for (int i = 0; i < 16; ++i) {                                                      \
                    if (ALIBI) X_[st][i] = __builtin_fmaf(-slope2, fabsf(dq - (float)(32 * st + (i & 3) + 8 * (i >> 2))), X_[st][i]); \
                    mx = fmaxf(mx, X_[st][i]);                                                                        \
                }                                                                                                     \
            mx = fmaxf(mx, __shfl_xor(mx, 32));                                                                       \
            const float mn = fmaxf(m, mx);                                                                            \
            const float alpha = __builtin_amdgcn_exp2f(m - mn);                                                       \
            m = mn;                                                                                                   \
            float rs_ = 0.f;                                                                                          \
            _Pragma("unroll") for (int st = 0; st < NST; ++st)                                                        \
                _Pragma("unroll") for (int i = 0; i < 16; ++i) { X_[st][i] = __builtin_amdgcn_exp2f(X_[st][i] - mn); if (!ROWSUM_MFMA) rs_ += X_[st][i]; } \
            if (__any(alpha != 1.0f)) {                                                                               \
                _Pragma("unroll") for (int dt = 0; dt < NDT; ++dt)                                                    \
                    _Pragma("unroll") for (int i = 0; i < 16; ++i) o[dt][i] *= alpha;                                 \
                _Pragma("unroll") for (int i = 0; i < 16; ++i) ol[i] *= alpha;                                        \
            }                                                                                                         \
            if (!ROWSUM_MFMA) lacc = lacc * alpha + rs_;                                                              \
        }                                                                                         \
    }
#define ATT_SMPV(t_, vb_, X_)                                                                                         \
    {                                                                                                                 \
        ATT_SM(t_, X_)                                                                                                \
        const char* vbp_ = vbuf + (vb_) * VBYTES + vlane;                                                             \
        __builtin_amdgcn_s_setprio(1);     \
        _Pragma("unroll") for (int st = 0; st < NST; ++st)                                                            \
            _Pragma("unroll") for (int s = 0; s < 2; ++s) {                                                           \
                u32x4 pk;                                                                                             \
                pk.x = pack2(X_[st][8 * s + 0], X_[st][8 * s + 1]); pk.y = pack2(X_[st][8 * s + 2], X_[st][8 * s + 3]); \
                pk.z = pack2(X_[st][8 * s + 4], X_[st][8 * s + 5]); pk.w = pack2(X_[st][8 * s + 6], X_[st][8 * s + 7]); \
                const bf16x8 pb = __builtin_bit_cast(bf16x8, pk);                                                     \
                if (ROWSUM_MFMA) ol = MFMA(ones8, pb, ol);                                                            \
                _Pragma("unroll") for (int dt = 0; dt < NDT; ++dt) {                                                  \
                    const char* va = vbp_ + (32 * st + 16 * s) * VROW + 64 * dt;                                      \
                    const s16x4 lo = __builtin_amdgcn_ds_read_tr16_b64_v4i16((LDS_AS s16x4*)(va));                    \
                    const s16x4 hi = __builtin_amdgcn_ds_read_tr16_b64_v4i16((LDS_AS s16x4*)(va + 8 * VROW));        \
                    o[dt] = MFMA(__builtin_shufflevector(lo, hi, 0, 1, 2, 3, 4, 5, 6, 7), pb, o[dt]);                 \
                }                                                                                                     \
            }                                                                                                         \
        __builtin_amdgcn_s_setprio(0);                                                                                \
    }
#define ATT_STEP(t_, PAR_, CUR_, NXT_)                                                                                \
    {                                                                                                                 \
        const int tk_ = ((t_) + 2 < ntiles) ? (t_) + 2 : ntiles - 1, tv_ = ((t_) + 1 < ntiles) ? (t_) + 1 : ntiles - 1; \
        ATT_GLOADK(tk_ * KT)                                                                                          \
        ATT_GLOADV(tv_ * KT)                                                                                          \
        __builtin_amdgcn_sched_barrier(0);                                                                            \
        ATT_QK(1 - (PAR_), NXT_)                                                                                      \
        ATT_SMPV(t_, PAR_, CUR_)                                                                                      \
        __builtin_amdgcn_sched_barrier(0);                                                                            \
        ATT_LSTOREK(PAR_)                                                                                             \
        ATT_LSTOREV(1 - (PAR_))                                                                                       \
        __syncthreads();                                                                                              \
    }
#define ATT_STEP1(t_, PAR_, X_)                                                                                       \
    {                                                                                                                 \
        const int tn_ = ((t_) + 1 < ntiles) ? (t_) + 1 : ntiles - 1;                                                  \
        ATT_GLOADK(tn_ * KT)                                                                                          \
        ATT_GLOADV(tn_ * KT)                                                                                          \
        __builtin_amdgcn_sched_barrier(0);                                                                            \
        ATT_QK(PAR_, X_)                                                                                              \
        ATT_SMPV(t_, PAR_, X_)                                                                                        \
        __builtin_amdgcn_sched_barrier(0);                                                                            \
        ATT_LSTOREK(1 - (PAR_))                                                                                       \
        ATT_LSTOREV(1 - (PAR_))                                                                                       \
        __syncthreads();                                                                                              \
    }
#define ATT_VLOAD(vb_, gi_, DST_)                                                                                     \
    {                                                                                                                 \
        const char* va_ = vbuf + (vb_) * VBYTES + vlane + (16 * (gi_)) * VROW;                                        \
        _Pragma("unroll") for (int dt = 0; dt < NDT; ++dt) {                                                          \
            const s16x4 lo = __builtin_amdgcn_ds_read_tr16_b64_v4i16((LDS_AS s16x4*)(va_ + 64 * dt));                 \
            const s16x4 hi = __builtin_amdgcn_ds_read_tr16_b64_v4i16((LDS_AS s16x4*)(va_ + 64 * dt + 8 * VROW));      \
            DST_[dt] = __builtin_shufflevector(lo, hi, 0, 1, 2, 3, 4, 5, 6, 7);                                       \
        }                                                                                                             \
    }
#define ATT_STEP1P(t_, PAR_, X_)                                                                                      \
    {                                                                                                                 \
        const int tn_ = ((t_) + 1 < ntiles) ? (t_) + 1 : ntiles - 1;                                                  \
        ATT_GLOADK(tn_ * KT)                                                                                          \
        ATT_GLOADV(tn_ * KT)                                                                                          \
        __builtin_amdgcn_sched_barrier(0);                                                                            \
        bf16x8 kfr[NST][NKS], vfr[2 * NST][NDT];                                                                      \
        {                                                                                                             \
            const char* kb_ = kbuf + (PAR_) * KBYTES + r * KROW + h * 16;                                             \
            _Pragma("unroll") for (int st = 0; st < NST; ++st)                                                        \
                _Pragma("unroll") for (int ks = 0; ks < NKS; ++ks) kfr[st][ks] = *(const bf16x8*)(kb_ + 32 * st * KROW + ks * 32); \
        }                                                                                                             \
        ATT_VLOAD(PAR_, 0, vfr[0])                                                                                    \
        ATT_VLOAD(PAR_, 1, vfr[1])                                                                                    \
        __builtin_amdgcn_sched_barrier(0);                                                                            \
        _Pragma("unroll") for (int st = 0; st < NST; ++st) {                                                          \
            X_[st] = MFMA(kfr[st][0], qf[0], zero16);                                                                 \
            _Pragma("unroll") for (int ks = 1; ks < NKS; ++ks) X_[st] = MFMA(kfr[st][ks], qf[ks], X_[st]);            \
        }                                                                                                             \
        ATT_SM(t_, X_)                                                                                                \
        __builtin_amdgcn_s_setprio(1);                                                                                \
        _Pragma("unroll") for (int gi = 0; gi < 2 * NST; ++gi) {                                                      \
            if (gi + 2 < 2 * NST) { ATT_VLOAD(PAR_, gi + 2, vfr[gi + 2]) __builtin_amdgcn_sched_barrier(0); }         \
            const int st = gi >> 1, s = gi & 1;                                                                       \
            u32x4 pk;                                                                                                 \
            pk.x = pack2(X_[st][8 * s + 0], X_[st][8 * s + 1]); pk.y = pack2(X_[st][8 * s + 2], X_[st][8 * s + 3]);   \
            pk.z = pack2(X_[st][8 * s + 4], X_[st][8 * s + 5]); pk.w = pack2(X_[st][8 * s + 6], X_[st][8 * s + 7]);   \
            const bf16x8 pb = __builtin_bit_cast(bf16x8, pk);                                                         \
            _Pragma("unroll") for (int dt = 0; dt < NDT; ++dt) o[dt] = MFMA(vfr[gi][dt], pb, o[dt]);                  \
        }                                                                                                             \
        __builtin_amdgcn_s_setprio(0);                                                                                \
        __builtin_amdgcn_sched_barrier(0);                                                                            \
        ATT_LSTOREK(1 - (PAR_))                                                                                       \
        ATT_LSTOREV(1 - (PAR_))                                                                                       \
        __syncthreads();                                                                                              \
    }
    const f32x16 zero16 = {0.f, 0.f, 0.f, 0.f, 0.f, 0.f, 0.f, 0.f, 0.f, 0.f, 0.f, 0.f, 0.f, 0.f, 0.f, 0.f};
    const bf16x8 ones8 = {0x3F80, 0x3F80, 0x3F80, 0x3F80, 0x3F80, 0x3F80, 0x3F80, 0x3F80};
    constexpr bool ROWSUM_MFMA = false;
    float m = -1e30f, lacc = 0.f;
    f32x16 ol = zero16;
#pragma unroll
    for (int dt = 0; dt < NDT; ++dt) o[dt] = zero16;
    const int ntiles = nkeys / KT;
    const int vlane = (4 * h + ((lane & 15) >> 2)) * VROW + (16 * ((lane >> 4) & 1) + 4 * (lane & 3)) * 2;
    constexpr bool PIPE = false;
    if (PIPE) {
        f32x16 xa[NST], xb[NST];
        ATT_GLOADK(0) ATT_LSTOREK(0)
        ATT_GLOADK(KT) ATT_GLOADV(0)
        __syncthreads();
        ATT_QK(0, xa)
        ATT_LSTOREK(1) ATT_LSTOREV(0)
        __syncthreads();
        for (int t = 0; t < ntiles; t += 2) {
            ATT_STEP(t, 0, xa, xb)
            ATT_STEP(t + 1, 1, xb, xa)
        }
    } else {
        f32x16 xs[NST];
        ATT_GLOADK(0) ATT_GLOADV(0) ATT_LSTOREK(0) ATT_LSTOREV(0)
        __syncthreads();
        if (NKS <= 6) {
            for (int t = 0; t < ntiles; t += 2) {
                ATT_STEP1P(t, 0, xs)
                ATT_STEP1P(t + 1, 1, xs)
            }
        } else {
            for (int t = 0; t < ntiles; t += 2) {
                ATT_STEP1(t, 0, xs)
                ATT_STEP1(t + 1, 1, xs)
            }
        }
    }
    lsum = ROWSUM_MFMA ? ol[0] : lacc + __shfl_xor(lacc, 32);
#undef ATT_GLOADK
#undef ATT_GLOADV
#undef ATT_LSTOREK
#undef ATT_LSTOREV
#undef ATT_QK
#undef ATT_SMPV
#undef ATT_STEP
#undef ATT_STEP1
#undef ATT_STEP1P
#undef ATT_VLOAD
#undef ATT_SM
}
template <int NDT>
DI void store_o(bf16_t* dst, int ld, f32x16 (&o)[NDT], float inv) {
    const int tid_ = otid(), lane = tid_ & 63, w = tid_ >> 6, r = lane & 31, h = lane >> 5;
    bf16_t* row = dst + (size_t)(32 * w + r) * ld + 4 * h;
#pragma unroll
    for (int dt = 0; dt < NDT; ++dt)
#pragma unroll
        for (int g = 0; g < 4; ++g) {
            uint2 vv; vv.x = pack2(o[dt][4 * g] * inv, o[dt][4 * g + 1] * inv); vv.y = pack2(o[dt][4 * g + 2] * inv, o[dt][4 * g + 3] * inv);
            *(uint2*)(row + 32 * dt + 8 * g) = vv;
        }
}
DI int swz_item(int base) {
    const int G = gridDim.x, i = blockIdx.x;
    if (G & 7) return base + i;
    return base + (i & 7) * (G >> 3) + (i >> 3);
}

constexpr int QT = SEQ / 256;
constexpr float NOMAX_BOUND = 90.f;
DI void attn_even(const bf16_t* qkv, float* park, bf16_t* mix, const Params& p, const float2* ax, const unsigned* nd, float lam_init, char* smem) {
    float d1 = 0.f, d2 = 0.f, gq = 0.f, gk = 0.f;
    for (int i = 0; i < 64; ++i) { d1 += p.in[8][i] * p.in[9][i]; d2 += p.in[10][i] * p.in[11][i]; gq = fmaxf(gq, fabsf(p.in[6][i])); gk = fmaxf(gk, fabsf(p.in[7][i])); }
    const float lam = __expf(d1) - __expf(d2) + lam_init;
    const float bound_gqa = 64.f * 0.125f * LOG2E * gq * gk * 1.03f;
    const int tid_ = otid(), lane = tid_ & 63, h = lane >> 5;
    float4* mypark = (float4*)(park + ((size_t)blockIdx.x * THREADS + tid_) * 64);
    constexpr int NDIFF = NB * 4 * QT, NGQA = NB * 8 * QT;
    for (int base = 0; base < NDIFF + NGQA; base += gridDim.x) {
        const int it = swz_item(base);
        if (it >= NDIFF + NGQA) continue;
        if (it < NDIFF) {
            const int b = it / (4 * QT), hd = (it / QT) & 3, qt = it % QT;
            const size_t row0 = (size_t)b * SEQ + qt * 256;
            const float slope2 = exp2f(-2.0f * (hd + 1)) * LOG2E;
            const bf16_t* qp = qkv + row0 * EVEN_IN + 768 + hd * 128;
            const bf16_t* kp = qkv + (size_t)b * SEQ * EVEN_IN + 1280 + hd * 128;
            const bf16_t* vp = qkv + (size_t)b * SEQ * EVEN_IN + 1792 + hd * 128;
            f32x16 o0[4]; float l0 = 1.f;
#pragma unroll 1
            for (int c = 0; c < 2; ++c) {
                const unsigned* nn = nd + (b * 8 + hd * 2 + c) * 2;
                const float bound = sqrtf(__uint_as_float(nn[0]) * __uint_as_float(nn[1])) * 1.03f;
                if (bound < NOMAX_BOUND) attn_core<64, 128, 64, 0, true, true>(qp + 64 * c, EVEN_IN, kp + 64 * c, EVEN_IN, nullptr, 0, vp, EVEN_IN, SEQ, qt * 256, 1.0f, slope2, nullptr, nullptr, smem, o0, l0);
                else attn_core<64, 128, 64, 0, true, false>(qp + 64 * c, EVEN_IN, kp + 64 * c, EVEN_IN, nullptr, 0, vp, EVEN_IN, SEQ, qt * 256, 1.0f, slope2, nullptr, nullptr, smem, o0, l0);
                if (c == 0) {
                    const float i0 = 1.0f / l0;
#pragma unroll
                    for (int dt = 0; dt < 4; ++dt)
#pragma unroll
                        for (int g = 0; g < 4; ++g) mypark[dt * 4 + g] = make_float4(o0[dt][4 * g] * i0, o0[dt][4 * g + 1] * i0, o0[dt][4 * g + 2] * i0, o0[dt][4 * g + 3] * i0);
                    asm volatile("" ::: "memory");
                }
            }
            const float i1 = lam / l0;
            float ss = 0.f;
            asm volatile("" ::: "memory");
#pragma unroll
            for (int dt = 0; dt < 4; ++dt)
#pragma unroll
                for (int g = 0; g < 4; ++g) {
                    const float4 pv = mypark[dt * 4 + g];
                    const float pa[4] = {pv.x, pv.y, pv.z, pv.w};
#pragma unroll
                    for (int e = 0; e < 4; ++e) { const float vv = pa[e] - i1 * o0[dt][4 * g + e]; o0[dt][4 * g + e] = vv; ss += vv * vv; }
                }
            ss += __shfl_xor(ss, 32);
            const float rstd = rsqrtf(ss * (1.0f / 128) + EPS) * (1.0f - lam_init);
#pragma unroll
            for (int dt = 0; dt < 4; ++dt)
#pragma unroll
                for (int i = 0; i < 16; ++i) o0[dt][i] *= p.in[12][32 * dt + crow(i, h)];
            store_o<4>(mix + row0 * D + 512 + hd * 128, D, o0, rstd);
        } else {
            const int j = it - NDIFF;
            const int b = j / (8 * QT), hd = (j / QT) & 7, qt = j % QT, kvh = hd >> 2;
            const size_t row0 = (size_t)b * SEQ + qt * 256;
            const bf16_t* qp = qkv + row0 * EVEN_IN + hd * 64;
            const bf16_t* kp = qkv + (size_t)b * SEQ * EVEN_IN + 512 + kvh * 64;
            const bf16_t* vp = qkv + (size_t)b * SEQ * EVEN_IN + 640 + kvh * 64;
            f32x16 o[2]; float l;
            if (bound_gqa < NOMAX_BOUND) attn_core<64, 64, 64, 1, false, true>(qp, EVEN_IN, kp, EVEN_IN, nullptr, 0, vp, EVEN_IN, SEQ, qt * 256, 0.125f * LOG2E, 0.f, p.in[6], ax, smem, o, l);
            else attn_core<64, 64, 64, 1, false, false>(qp, EVEN_IN, kp, EVEN_IN, nullptr, 0, vp, EVEN_IN, SEQ, qt * 256, 0.125f * LOG2E, 0.f, p.in[6], ax, smem, o, l);
            store_o<2>(mix + row0 * D + hd * 64, D, o, 1.0f / l);
        }
    }
}
DI void attn_mla(const bf16_t* qb, const bf16_t* kv, const bf16_t* a, bf16_t* mix, const float2* lin, const unsigned* nmx, char* smem) {
    constexpr int NIT = NB * 16 * QT;
    for (int base = 0; base < NIT; base += gridDim.x) {
        const int it = swz_item(base);
        if (it >= NIT) continue;
        const int b = it / (16 * QT), hd = (it / QT) & 15, qt = it % QT;
        const size_t row0 = (size_t)b * SEQ + qt * 256;
        const unsigned* nn = nmx + (b * 16 + hd) * 2;
        const float bound = sqrtf(__uint_as_float(nn[0]) * __uint_as_float(nn[1])) * 1.03f;
        const bf16_t* kb_ = kv + (size_t)b * SEQ * 2048 + hd * 128;
        f32x16 o[2]; float l;
        if (bound < NOMAX_BOUND) attn_core<96, 64, 64, 2, false, true>(qb + row0 * 1536 + hd * 96, 1536, kb_, 2048, a + (size_t)b * SEQ * ODD_PAD + 640, ODD_PAD, kb_ + 64, 2048, SEQ, qt * 256, 1.0f, 0.f, nullptr, lin, smem, o, l);
        else attn_core<96, 64, 64, 2, false, false>(qb + row0 * 1536 + hd * 96, 1536, kb_, 2048, a + (size_t)b * SEQ * ODD_PAD + 640, ODD_PAD, kb_ + 64, 2048, SEQ, qt * 256, 1.0f, 0.f, nullptr, lin, smem, o, l);
        store_o<2>(mix + row0 * D + hd * 64, D, o, 1.0f / l);
    }
}
DI void attn_cross(const bf16_t* qx, const bf16_t* kvx, bf16_t* mix, int seq0, char* smem) {
    constexpr int NIT = NB * 4 * QT * 2;
    for (int base = 0; base < NIT; base += gridDim.x) {
        const int it = swz_item(base);
        if (it >= NIT) continue;
        const int b = it / (8 * QT), hd = (it / (2 * QT)) & 3, qt = (it >> 1) % QT, half = it & 1;
        const size_t row0 = (size_t)b * SEQ + qt * 256;
        const bf16_t* kvb = kvx + (size_t)(seq0 + b) * NMEM * 2048;
        f32x16 o[4]; float l;
        attn_core<256, 128, 32, 0, false, false>(qx + row0 * D + hd * 256, D, kvb + hd * 256, 2048, nullptr, 0, kvb + 1024 + hd * 256 + half * 128, 2048, NMEM, 0,
                                          1.0f, 0.f, nullptr, nullptr, smem, o, l);
        store_o<4>(mix + row0 * D + hd * 256 + half * 128, D, o, 1.0f / l);
    }
}

extern "C" __global__ void __launch_bounds__(THREADS, 2) fwd_mega(Params p) {
    extern __shared__ __attribute__((aligned(16))) char smem[];
    LDS_AS unsigned char* lds = (LDS_AS unsigned char*)smem;
    cg::grid_group grid = cg::this_grid();
    char* ws = p.ws;
    __shared__ uint4 xb_words;
    if (threadIdx.x == 0) xb_words = make_uint4(0u, 0u, 0u, 0u);
    __syncthreads();
    const XcdBarrier xb = xcd_barrier_post((unsigned*)(ws + B_BAR), (volatile LDS_AS unsigned*)&xb_words);
    bf16_t* wEin = (bf16_t*)(ws + W_EIN); bf16_t* wEout = (bf16_t*)(ws + W_EOUT); bf16_t* wOin = (bf16_t*)(ws + W_OIN);
    bf16_t* wUq = (bf16_t*)(ws + W_UQ); bf16_t* wUkv = (bf16_t*)(ws + W_UKV); bf16_t* wOout = (bf16_t*)(ws + W_OOUT);
    float2* ax = (float2*)(ws + T_AX); float2* lin = (float2*)(ws + T_LIN);
    bf16_t* H = (bf16_t*)(ws + B_H); bf16_t* MIX = (bf16_t*)(ws + B_MIX);

    convert_weight(p.in[5], wEin, D, EVEN_IN, EVEN_IN, smem, 768, 1280, 0.125f * LOG2E);
    convert_weight(p.in[13], wEout, D, D, D, smem);
    convert_weight(p.in[14], wOin, D, ODD_IN, ODD_PAD, smem);
    convert_weight(p.in[17], wUq, 384, 1536, 1536, smem, 0, 1536, 0.10206207261596575f * LOG2E);
    convert_weight(p.in[18], wUkv, 256, 2048, 2048, smem);
    convert_weight(p.in[19], wOout, D, D, D, smem);
    for (int l = 0; l < 2; ++l) {
        convert_weight(p.in[22] + (size_t)l * D * D, (bf16_t*)(ws + W_CQ) + (size_t)l * D * D, D, D, D, smem, 0, D, 0.0625f * LOG2E);
        convert_weight(p.in[23] + (size_t)l * D * 2048, (bf16_t*)(ws + W_CKV) + (size_t)l * 2048 * D, D, 2048, 2048, smem);
        convert_weight(p.in[24] + (size_t)l * D * D, (bf16_t*)(ws + W_CO) + (size_t)l * D * D, D, D, D, smem);
        convert_weight(p.in[26] + (size_t)l * D * 2 * DFF, (bf16_t*)(ws + W_GU) + (size_t)l * 2 * DFF * D, D, 2 * DFF, 2 * DFF, smem);
        convert_weight(p.in[27] + (size_t)l * DFF * D, (bf16_t*)(ws + W_DOWN) + (size_t)l * D * DFF, DFF, D, D, smem);
        rmsnorm_rows(p.in[2], p.in[21] + l * D, (bf16_t*)(ws + B_MEMN) + (size_t)l * NBATCH * NMEM * D, 8 * NMEM);
        rmsnorm_rows(p.in[3], p.in[21] + l * D, (bf16_t*)(ws + B_MEMN) + (size_t)l * NBATCH * NMEM * D + (size_t)8 * NMEM * D, 16 * NMEM);
    }
    build_tables(ax, lin);
    if (blockIdx.x == 0) for (int i = threadIdx.x; i < 4096; i += THREADS) ((unsigned*)(ws + B_NORMS))[i] = 0u;
    grid.sync();
    for (int l = 0; l < 2; ++l) {
        pg8::EpiBf16 e{(bf16_t*)(ws + B_KX) + (size_t)l * NBATCH * NMEM * 2048, 2048};
        pg8::gemm_phase(lds, mk_gemm((const bf16_t*)(ws + B_MEMN) + (size_t)l * NBATCH * NMEM * D, D, (const bf16_t*)(ws + W_CKV) + (size_t)l * 2048 * D, NBATCH * NMEM, 2048, D), e);
    }
    xcd_barrier(xb);

    for (int ch = 0; ch < NCHUNK; ++ch) {
        const float* xin = (ch == 0) ? p.in[0] : p.in[1] + (size_t)(ch - 1) * TC * D;
        float* xo = p.out + (size_t)ch * TC * D;
        for (int layer = 0; layer < 2; ++layer) {
            const float* xcur = (layer == 0) ? xin : xo;
            for (int rep_ = 0; rep_ < PROBE_NORM; ++rep_) rmsnorm_rows(xcur, p.in[4] + layer * D, H, TC);
            xcd_barrier(xb);
            const bf16_t* wout;
            if (layer == 0) {
                bf16_t* qkv = (bf16_t*)(ws + E_QKV);
                for (int rep_ = 0; rep_ < PROBE_GEMM; ++rep_) { pg8::EpiBf16 e{qkv, EVEN_IN}; pg8::gemm_phase(lds, mk_gemm(H, D, wEin, TC, EVEN_IN, D), e); }
                xcd_barrier(xb);
                kprep_even(qkv, p.in[7], ax);
                normmax_even(qkv, (unsigned*)(ws + B_NORMS) + ch * 128, smem);
                xcd_barrier(xb);
                for (int rep_ = 0; rep_ < PROBE_ATTN; ++rep_) attn_even(qkv, (float*)(ws + E_PARK), MIX, p, ax, (const unsigned*)(ws + B_NORMS) + ch * 128, 0.2f, smem);
                wout = wEout;
            } else {
                bf16_t* a = (bf16_t*)(ws + O_A); bf16_t* qb = (bf16_t*)(ws + O_Q); bf16_t* kv = (bf16_t*)(ws + O_KV);
                for (int rep_ = 0; rep_ < PROBE_GEMM; ++rep_) { pg8::EpiBf16 e{a, ODD_PAD}; pg8::gemm_phase(lds, mk_gemm(H, D, wOin, TC, ODD_PAD, D), e); }
                xcd_barrier(xb);
                prep_odd(a, p.in[15], p.in[16], lin);
                xcd_barrier(xb);
                for (int rep_ = 0; rep_ < PROBE_GEMM; ++rep_) { pg8::EpiBf16 e{qb, 1536}; pg8::gemm_phase(lds, mk_gemm(a, ODD_PAD, wUq, TC, 1536, 384), e); }
                for (int rep_ = 0; rep_ < PROBE_GEMM; ++rep_) { pg8::EpiBf16 e{kv, 2048}; pg8::gemm_phase(lds, mk_gemm(a + 384, ODD_PAD, wUkv, TC, 2048, 256), e); }
                xcd_barrier(xb);
                normmax_mla(qb, kv, a, (unsigned*)(ws + B_NORMS) + 384 + ch * 256, smem);
                xcd_barrier(xb);
                for (int rep_ = 0; rep_ < PROBE_ATTN; ++rep_) attn_mla(qb, kv, a, MIX, lin, (const unsigned*)(ws + B_NORMS) + 384 + ch * 256, smem);
                wout = wOout;
            }
            xcd_barrier(xb);
            { pg8::EpiResid e{xcur, xo}; pg8::gemm_phase(lds, mk_gemm(MIX, D, wout, TC, D, D), e); }
            xcd_barrier(xb);
            for (int rep_ = 0; rep_ < PROBE_NORM; ++rep_) rmsnorm_rows(xo, p.in[20] + layer * D, H, TC);
            xcd_barrier(xb);
            for (int rep_ = 0; rep_ < PROBE_GEMM; ++rep_) { pg8::EpiBf16 e{(bf16_t*)(ws + X_Q), D}; pg8::gemm_phase(lds, mk_gemm(H, D, (const bf16_t*)(ws + W_CQ) + (size_t)layer * D * D, TC, D, D), e); }
            xcd_barrier(xb);
            for (int rep_ = 0; rep_ < PROBE_CROSS; ++rep_) attn_cross((const bf16_t*)(ws + X_Q), (const bf16_t*)(ws + B_KX) + (size_t)layer * NBATCH * NMEM * 2048, MIX, ch * NB, smem);
            xcd_barrier(xb);
            { pg8::EpiResid e{xo, xo}; pg8::gemm_phase(lds, mk_gemm(MIX, D, (const bf16_t*)(ws + W_CO) + (size_t)layer * D * D, TC, D, D), e); }
            xcd_barrier(xb);
            for (int rep_ = 0; rep_ < PROBE_NORM; ++rep_) rmsnorm_rows(xo, p.in[25] + layer * D, H, TC);
            xcd_barrier(xb);
            for (int rep_ = 0; rep_ < PROBE_GEMM; ++rep_) { pg8::EpiSwiglu e{(bf16_t*)(ws + F_ACT)};
              pg8::Gemm g{H, (const bf16_t*)(ws + W_GU) + (size_t)layer * 2 * DFF * D, TC, DFF / 128, D, D, (size_t)DFF * D * 2, (size_t)128 * D * 2};
              pg8::gemm_phase(lds, g, e); }
            xcd_barrier(xb);
            { pg8::EpiResid e{xo, xo}; pg8::gemm_phase(lds, mk_gemm((const bf16_t*)(ws + F_ACT), DFF, (const bf16_t*)(ws + W_DOWN) + (size_t)layer * D * DFF, TC, D, DFF), e); }
            xcd_barrier(xb);
        }
        rmsnorm_final(xo, p.in[28], TC);
    }
}

extern "C" void kernel_launch(void* const* d_in, const int* in_sizes, int n_in, void* d_out, int out_size, void* d_ws, size_t ws_size, hipStream_t stream) {
    static int grid_blocks = 0;
    if (!grid_blocks) {
        int dev = 0, cus = 0, per_cu = 0;
        (void)hipGetDevice(&dev);
        (void)hipDeviceGetAttribute(&cus, hipDeviceAttributeMultiprocessorCount, dev);
        (void)hipFuncSetAttribute((const void*)fwd_mega, hipFuncAttributeMaxDynamicSharedMemorySize, (int)LDS_BYTES);
        (void)hipOccupancyMaxActiveBlocksPerMultiprocessor(&per_cu, fwd_mega, THREADS, LDS_BYTES);
        if (per_cu > 1) per_cu = 1;
        if (per_cu < 1) per_cu = 1;
        grid_blocks = cus * per_cu;
    }
    constexpr size_t WS_END = (O_END > E_END ? O_END : E_END) > (F_ACT + (size_t)TC * DFF * 2) ? (O_END > E_END ? O_END : E_END) : (F_ACT + (size_t)TC * DFF * 2);
    if (ws_size < WS_END) { fprintf(stderr, "workspace too small: %zu < %zu\n", ws_size, (size_t)WS_END); return; }
    if (grid_blocks > 256) grid_blocks = 256;
    Params p{};
    for (int i = 0; i < 29; ++i) p.in[i] = (const float*)d_in[i];
    p.out = (float*)d_out;
    p.ws = (char*)d_ws;
    (void)hipMemsetAsync(d_ws, 0, 16384, stream);
    void* args[] = {&p};
    hipError_t e = hipLaunchCooperativeKernel((void*)fwd_mega, dim3(grid_blocks), dim3(THREADS), args, LDS_BYTES, stream);
    if (e != hipSuccess) fprintf(stderr, "cooperative launch failed: %s (grid %d)\n", hipGetErrorString(e), grid_blocks);
}
```

```cpp
#include <hip/hip_runtime.h>
#include <hip/hip_cooperative_groups.h>
#include <cstdio>
#include <cstdint>
namespace cg = cooperative_groups;
#ifndef IGLP_MODE
#define IGLP_MODE 2
#endif
#ifndef PROBE_GEMM
#define PROBE_GEMM 1
#endif
#ifndef PROBE_NORM
#define PROBE_NORM 1
#endif
#ifndef PROBE_CROSS
#define PROBE_CROSS 1
#endif
#ifndef PROBE_ATTN
#define PROBE_ATTN 1
#endif

typedef unsigned short bf16_t;
typedef short bf16x8 __attribute__((ext_vector_type(8)));
typedef float f32x16 __attribute__((ext_vector_type(16)));
typedef float f32x2 __attribute__((ext_vector_type(2)));
typedef unsigned u32x4 __attribute__((ext_vector_type(4)));
typedef float f32x4 __attribute__((ext_vector_type(4)));
typedef short s16x4 __attribute__((ext_vector_type(4)));
#define LDS_AS __attribute__((address_space(3)))
typedef __bf16 bf16x2_t __attribute__((ext_vector_type(2)));
#define DI __device__ __forceinline__
#define MFMA(a, b, c) __builtin_amdgcn_mfma_f32_32x32x16_bf16((a), (b), (c), 0, 0, 0)

constexpr int D = 1024, SEQ = 4096, NBATCH = 24, NB = 8  , NCHUNK = NBATCH / NB, TC = NB * SEQ;
constexpr int NMEM = 256, DFF = 2816, EVEN_IN = 2304, ODD_IN = 672, ODD_PAD = 768;
constexpr float EPS = 1e-6f, LOG2E = 1.4426950408889634f;
constexpr int THREADS = 512, NWAVE = THREADS / 64;
constexpr size_t LDS_BYTES = 131072;

constexpr size_t al(size_t x) { return (x + 255) & ~(size_t)255; }
constexpr size_t B_BAR = 0;
constexpr size_t B_NORMS = 16384;
constexpr size_t W_EIN = 32768;
constexpr size_t W_EOUT = W_EIN + al((size_t)EVEN_IN * D * 2);
constexpr size_t W_OIN = W_EOUT + al((size_t)D * D * 2);
constexpr size_t W_UQ = W_OIN + al((size_t)ODD_PAD * D * 2);
constexpr size_t W_UKV = W_UQ + al((size_t)1536 * 384 * 2);
constexpr size_t W_OOUT = W_UKV + al((size_t)2048 * 256 * 2);
constexpr size_t W_CQ = W_OOUT + al((size_t)D * D * 2);
constexpr size_t W_CKV = W_CQ + 2 * al((size_t)D * D * 2);
constexpr size_t W_CO = W_CKV + 2 * al((size_t)2048 * D * 2);
constexpr size_t W_GU = W_CO + 2 * al((size_t)D * D * 2);
constexpr size_t W_DOWN = W_GU + 2 * al((size_t)2 * DFF * D * 2);
constexpr size_t T_AX = W_DOWN + 2 * al((size_t)D * DFF * 2);
constexpr size_t T_LIN = T_AX + al((size_t)SEQ * 32 * 8);
constexpr size_t B_MEMN = T_LIN + al((size_t)SEQ * 16 * 8);
constexpr size_t B_KX = B_MEMN + 2 * al((size_t)NBATCH * NMEM * D * 2);
constexpr size_t B_H = B_KX + 2 * al((size_t)NBATCH * NMEM * 2048 * 2);
constexpr size_t B_MIX = B_H + al((size_t)TC * D * 2);
constexpr size_t B_BIG = B_MIX + al((size_t)TC * D * 2);
constexpr size_t E_QKV = B_BIG;
constexpr size_t E_PARK = E_QKV + al((size_t)TC * EVEN_IN * 2);
constexpr size_t E_END = E_PARK + (size_t)256 * THREADS * 64 * 4;
constexpr size_t O_A = B_BIG;
constexpr size_t O_Q = O_A + al((size_t)TC * ODD_PAD * 2);
constexpr size_t O_KV = O_Q + al((size_t)TC * 1536 * 2);
constexpr size_t O_END = O_KV + al((size_t)TC * 2048 * 2);
constexpr size_t X_Q = B_BIG;
constexpr size_t F_ACT = B_BIG;

struct Params {
    const float* in[29];
    float* out;
    char* ws;
};

DI unsigned pack2(float lo, float hi) { f32x2 v = {lo, hi}; bf16x2_t b = __builtin_convertvector(v, bf16x2_t); return __builtin_bit_cast(unsigned, b); }
DI float bflo(unsigned u) { return __uint_as_float(u << 16); }
DI float bfhi(unsigned u) { return __uint_as_float(u & 0xffff0000u); }
DI int crow(int i, int h) { return (i & 3) + 8 * (i >> 2) + 4 * h; }
DI int swap23(int x) { return (x & ~12) | ((x & 4) << 1) | ((x & 8) >> 1); }
DI int otid() { int t = threadIdx.x; asm volatile("" : "+v"(t)); return t; }
DI float wave_sum(float v) {
#pragma unroll
    for (int o = 32; o >= 1; o >>= 1) v += __shfl_xor(v, o);
    return v;
}


#define XB_TMO      128
#define XB_XCNT(j)  (256  + 64 * (j))
#define XB_XSUB(j)  (1280 + 64 * (j))
#define XB_XGEN(j)  (2304 + 64 * (j))
#define XB_TOP      3328
#define XB_TOPGEN   3392
#define XCD_BAR_WORDS 3456
#define XB_SPIN_CAP (1u << 18)
DI unsigned xb_ld(unsigned* p) { return __hip_atomic_load(p, __ATOMIC_RELAXED, __HIP_MEMORY_SCOPE_AGENT); }
DI unsigned xb_add(unsigned* p, unsigned v) { return __hip_atomic_fetch_add(p, v, __ATOMIC_RELAXED, __HIP_MEMORY_SCOPE_AGENT); }
DI unsigned xb_xcc_id() { return (unsigned)__builtin_amdgcn_s_getreg((3 << 11) | 20) & 0xFu; }
#define XB_SPIN(cond, bar) do { unsigned _sp = 0; while (cond) { __builtin_amdgcn_s_sleep(1); \
    if ((++_sp & 255u) == 0u) { if (xb_ld(&(bar)[XB_TMO])) break; if (_sp > XB_SPIN_CAP) { atomicAdd(&(bar)[XB_TMO], 1u); break; } } } } while (0)
struct XcdBarrier { unsigned* bar; unsigned x; volatile LDS_AS unsigned* st; };
DI XcdBarrier xcd_barrier_post(unsigned* bar, volatile LDS_AS unsigned* st) {
    XcdBarrier b; b.bar = bar; b.x = xb_xcc_id(); b.st = st;
    if (threadIdx.x == 0) (void)xb_add(&bar[XB_XCNT(b.x)], 1u);
    return b;
}
DI void xcd_barrier_complete(unsigned* bar, unsigned x, unsigned& nloc, unsigned& nx) {
    const unsigned G = gridDim.x * gridDim.y * gridDim.z;
    unsigned sum, cnt, mine, sp = 0u;
    for (;;) {
        sum = 0u; cnt = 0u; mine = 0u;
#pragma unroll
        for (unsigned j = 0; j < 16; ++j) { const unsigned c = xb_ld(&bar[XB_XCNT(j)]); sum += c; cnt += (c > 0u) ? 1u : 0u; mine = (j == x) ? c : mine; }
        if (sum == G) break;
        __builtin_amdgcn_s_sleep(1);
        if ((++sp & 255u) == 0u) { if (xb_ld(&bar[XB_TMO])) break; if (sp > XB_SPIN_CAP) { atomicAdd(&bar[XB_TMO], 1u); break; } }
    }
    nloc = mine > 0u ? mine : 1u; nx = cnt > 0u ? cnt : 1u;
}
DI void xcd_barrier(const XcdBarrier& b) {
    asm volatile("s_waitcnt vmcnt(0)" ::: "memory");
    __syncthreads();
    if (threadIdx.x == 0) {
        unsigned* bar = b.bar; asm volatile("" : "+s"(bar));
        unsigned bx = b.x; asm volatile("" : "+s"(bx));
        __builtin_amdgcn_s_waitcnt(0);
        unsigned nloc = b.st[0], nx = b.st[1];
        if (nloc == 0u) { xcd_barrier_complete(bar, bx, nloc, nx); b.st[0] = nloc; b.st[1] = nx; }
        const unsigned old = xb_add(&bar[XB_XSUB(bx)], 1u);
        const unsigned gen = old / nloc;
        if (old + 1u == (gen + 1u) * nloc) {
            __builtin_amdgcn_fence(__ATOMIC_RELEASE, "agent");
            asm volatile("s_waitcnt vmcnt(0)" ::: "memory");
            const unsigned og = xb_add(&bar[XB_TOP], 1u);
            const unsigned tg = og / nx;
            if (og + 1u == (tg + 1u) * nx) xb_add(&bar[XB_TOPGEN], 1u);
            else XB_SPIN(xb_ld(&bar[XB_TOPGEN]) == tg, bar);
            __builtin_amdgcn_fence(__ATOMIC_ACQUIRE, "agent");
            xb_add(&bar[XB_XGEN(bx)], 1u);
            asm volatile("s_waitcnt vmcnt(0)" ::: "memory");
        } else {
            XB_SPIN(xb_ld(&bar[XB_XGEN(bx)]) == gen, bar);
            __builtin_amdgcn_fence(__ATOMIC_ACQUIRE, "agent");
            asm volatile("s_waitcnt vmcnt(0)" ::: "memory");
        }
    }
    __syncthreads();
}

DI void convert_weight(const float* __restrict__ src, bf16_t* __restrict__ dst, int K, int N, int Npad, char* smem, int slo = 0, int shi = 0, float scale = 1.0f) {
    float* t = (float*)smem;
    const int tid = otid();
    const int nkt = K / 64, nnt = Npad / 64;
    for (int tile = blockIdx.x; tile < nkt * nnt; tile += gridDim.x) {
        const int k0 = (tile / nnt) * 64, n0 = (tile % nnt) * 64;
#pragma unroll
        for (int i = 0; i < 8; ++i) {
            const int k = i * 8 + (tid >> 6), n = tid & 63;
            const float sc_ = (n0 + n >= slo && n0 + n < shi) ? scale : 1.0f;
            t[k * 65 + n] = (n0 + n < N) ? src[(size_t)(k0 + k) * N + n0 + n] * sc_ : 0.f;
        }
        __syncthreads();
#pragma unroll
        for (int i = 0; i < 4; ++i) {
            const int n = i * 16 + (tid >> 5), k = (tid & 31) * 2;
            *(unsigned*)(dst + (size_t)(n0 + n) * K + k0 + k) = pack2(t[k * 65 + n], t[(k + 1) * 65 + n]);
        }
        __syncthreads();
    }
}

__device__ const float kFreq[16] = {1.000000000e+00f, 5.623413324e-01f, 3.162277639e-01f, 1.778279394e-01f, 1.000000015e-01f, 5.623413250e-02f, 3.162277490e-02f, 1.778279431e-02f,
                                    9.999999776e-03f, 5.623413250e-03f, 3.162277630e-03f, 1.778279431e-03f, 1.000000047e-03f, 5.623413017e-04f, 3.162277571e-04f, 1.778279402e-04f};
DI float2 sincos_acc(float ang) {
    const double x = (double)ang;
    const double n = __builtin_rint(x * 0.15915494309189535);
    double r = __builtin_fma(-n, 6.283185307179586, x);
    r = __builtin_fma(-n, 2.4492935982947064e-16, r);
    const double r2 = r * r;
    double s = 1.0, c = 1.0;
#pragma unroll
    for (int k = 13; k >= 1; --k) {
        s = 1.0 - r2 * s * (1.0 / (double)((2 * k) * (2 * k + 1)));
        c = 1.0 - r2 * c * (1.0 / (double)((2 * k - 1) * (2 * k)));
    }
    return make_float2((float)c, (float)(r * s));
}
DI void build_tables(float2* ax, float2* lin) {
    const int gt = blockIdx.x * THREADS + otid(), gs = gridDim.x * THREADS;
    for (int e = gt; e < SEQ * 32; e += gs) {
        const int pos = e >> 5, p = e & 31;
        const float base = (p < 16) ? (float)(pos >> 6) : (float)(pos & 63);
        ax[e] = sincos_acc(base * kFreq[p & 15]);
    }
    for (int e = gt; e < SEQ * 16; e += gs) {
        const int pos = e >> 4, p = e & 15;
        lin[e] = sincos_acc((float)pos * kFreq[p]);
    }
}

DI void rmsnorm_rows(const float* __restrict__ src, const float* __restrict__ g, bf16_t* __restrict__ dst, int nrows) {
    const int tid_ = otid(), lane = tid_ & 63, wv = blockIdx.x * NWAVE + (tid_ >> 6), nw = gridDim.x * NWAVE;
    for (int row = wv; row < nrows; row += nw) {
        const float4* s = (const float4*)(src + (size_t)row * D);
        float4 v[4]; float ss = 0.f;
#pragma unroll
        for (int i = 0; i < 4; ++i) { v[i] = s[i * 64 + lane]; ss += v[i].x * v[i].x + v[i].y * v[i].y + v[i].z * v[i].z + v[i].w * v[i].w; }
        ss = wave_sum(ss);
        const float rstd = rsqrtf(ss * (1.0f / D) + EPS);
#pragma unroll
        for (int i = 0; i < 4; ++i) {
            const float4 gg = ((const float4*)g)[i * 64 + lane];
            uint2 o; o.x = pack2(v[i].x * rstd * gg.x, v[i].y * rstd * gg.y); o.y = pack2(v[i].z * rstd * gg.z, v[i].w * rstd * gg.w);
            *(uint2*)(dst + (size_t)row * D + (i * 64 + lane) * 4) = o;
        }
    }
}
DI void rmsnorm_final(float* __restrict__ x, const float* __restrict__ g, int nrows) {
    const int tid_ = otid(), lane = tid_ & 63, wv = blockIdx.x * NWAVE + (tid_ >> 6), nw = gridDim.x * NWAVE;
    for (int row = wv; row < nrows; row += nw) {
        float4* s = (float4*)(x + (size_t)row * D);
        float4 v[4]; float ss = 0.f;
#pragma unroll
        for (int i = 0; i < 4; ++i) { v[i] = s[i * 64 + lane]; ss += v[i].x * v[i].x + v[i].y * v[i].y + v[i].z * v[i].z + v[i].w * v[i].w; }
        ss = wave_sum(ss);
        const float rstd = rsqrtf(ss * (1.0f / D) + EPS);
#pragma unroll
        for (int i = 0; i < 4; ++i) {
            const float4 gg = ((const float4*)g)[i * 64 + lane];
            float4 o; o.x = v[i].x * rstd * gg.x; o.y = v[i].y * rstd * gg.y; o.z = v[i].z * rstd * gg.z; o.w = v[i].w * rstd * gg.w;
            s[i * 64 + lane] = o;
        }
    }
}

DI void kprep_even(bf16_t* __restrict__ qkv, const float* __restrict__ gk, const float2* __restrict__ ax) {
    const int tid_ = otid(), gt = blockIdx.x * THREADS + tid_, gs = gridDim.x * THREADS;
    const int p = tid_ & 31;
    for (int v = gt >> 5; v < TC * 2; v += gs >> 5) {
        const int tok = v >> 1, kvh = v & 1;
        unsigned* ptr = (unsigned*)(qkv + (size_t)tok * EVEN_IN + 512 + kvh * 64 + 2 * p);
        const unsigned u = *ptr;
        const float x0 = bflo(u), x1 = bfhi(u);
        float ss = x0 * x0 + x1 * x1;
#pragma unroll
        for (int o = 16; o >= 1; o >>= 1) ss += __shfl_xor(ss, o);
        const float rstd = rsqrtf(ss * (1.0f / 64) + EPS);
        const float y0 = x0 * rstd * gk[2 * p], y1 = x1 * rstd * gk[2 * p + 1];
        const float2 cs = ax[(tok & (SEQ - 1)) * 32 + p];
        *ptr = pack2(y0 * cs.x - y1 * cs.y, y0 * cs.y + y1 * cs.x);
    }
}
DI void prep_odd(bf16_t* __restrict__ a, const float* __restrict__ gq, const float* __restrict__ gkv, const float2* __restrict__ lin) {
    const int tid_ = otid(), lane = tid_ & 63, wv = blockIdx.x * NWAVE + (tid_ >> 6), nw = gridDim.x * NWAVE;
    for (int row = wv; row < TC; row += nw) {
        unsigned* base = (unsigned*)(a + (size_t)row * ODD_PAD);
        unsigned uq[3], uk[2]; float sq = 0.f, sk = 0.f;
#pragma unroll
        for (int i = 0; i < 3; ++i) { uq[i] = base[i * 64 + lane]; const float a0 = bflo(uq[i]), a1 = bfhi(uq[i]); sq += a0 * a0 + a1 * a1; }
#pragma unroll
        for (int i = 0; i < 2; ++i) { uk[i] = base[192 + i * 64 + lane]; const float a0 = bflo(uk[i]), a1 = bfhi(uk[i]); sk += a0 * a0 + a1 * a1; }
        sq = wave_sum(sq); sk = wave_sum(sk);
        const float rq = rsqrtf(sq * (1.0f / 384) + EPS), rk = rsqrtf(sk * (1.0f / 256) + EPS);
#pragma unroll
        for (int i = 0; i < 3; ++i) { const int c = (i * 64 + lane) * 2; base[i * 64 + lane] = pack2(bflo(uq[i]) * rq * gq[c], bfhi(uq[i]) * rq * gq[c + 1]); }
#pragma unroll
        for (int i = 0; i < 2; ++i) { const int c = (i * 64 + lane) * 2; base[192 + i * 64 + lane] = pack2(bflo(uk[i]) * rk * gkv[c], bfhi(uk[i]) * rk * gkv[c + 1]); }
        if (lane < 16) {
            const unsigned u = base[320 + lane];
            const float x0 = bflo(u), x1 = bfhi(u);
            const float2 cs = lin[(row & (SEQ - 1)) * 16 + lane];
            base[320 + lane] = pack2(x0 * cs.x - x1 * cs.y, x0 * cs.y + x1 * cs.x);
        }
    }
}


DI void normmax_even(const bf16_t* __restrict__ qkv, unsigned* __restrict__ nd, char* smem) {
    const int tid = otid(), lane = tid & 63, w = tid >> 6;
    float* red = (float*)smem;
    for (int item = blockIdx.x; item < NB * 32; item += gridDim.x) {
        const int b = item & 7, slab = item >> 3;
        float mq = 0.f, mk = 0.f;
        for (int i = 0; i < 16; ++i) {
            const bf16_t* row = qkv + ((size_t)b * SEQ + slab * 128 + w * 16 + i) * EVEN_IN;
            const u32x4 uq = *(const u32x4*)(row + 768 + 8 * lane), uk = *(const u32x4*)(row + 1280 + 8 * lane);
            float sq = 0.f, sk = 0.f;
#pragma unroll
            for (int j = 0; j < 4; ++j) { const float a0 = bflo(uq[j]), a1 = bfhi(uq[j]), b0 = bflo(uk[j]), b1 = bfhi(uk[j]); sq += a0 * a0 + a1 * a1; sk += b0 * b0 + b1 * b1; }
#pragma unroll
            for (int o = 1; o <= 4; o <<= 1) { sq += __shfl_xor(sq, o); sk += __shfl_xor(sk, o); }
            mq = fmaxf(mq, sq); mk = fmaxf(mk, sk);
        }
        if ((lane & 7) == 0) { red[(w * 8 + (lane >> 3)) * 2] = mq; red[(w * 8 + (lane >> 3)) * 2 + 1] = mk; }
        __syncthreads();
        if (tid < 16) {
            float m = 0.f;
#pragma unroll
            for (int ww = 0; ww < NWAVE; ++ww) m = fmaxf(m, red[ww * 16 + tid]);
            atomicMax(nd + b * 16 + tid, __float_as_uint(m));
        }
        __syncthreads();
    }
}
DI void normmax_mla(const bf16_t* __restrict__ qb, const bf16_t* __restrict__ kv, const bf16_t* __restrict__ a, unsigned* __restrict__ nmx, char* smem) {
    const int tid = otid(), lane = tid & 63, w = tid >> 6;
    float* red = (float*)smem;
    for (int item = blockIdx.x; item < NB * 32; item += gridDim.x) {
        const int b = item & 7, slab = item >> 3;
        float mq = 0.f, mk = 0.f;
        for (int i = 0; i < 16; ++i) {
            const size_t r = (size_t)b * SEQ + slab * 128 + w * 16 + i;
            float sq = 0.f, sk = 0.f, sr = 0.f;
#pragma unroll
            for (int c = 0; c < 3; ++c) {
                const u32x4 u = *(const u32x4*)(qb + r * 1536 + 24 * lane + 8 * c);
#pragma unroll
                for (int j = 0; j < 4; ++j) { const float a0 = bflo(u[j]), a1 = bfhi(u[j]); sq += a0 * a0 + a1 * a1; }
            }
#pragma unroll
            for (int c = 0; c < 4; ++c) {
                const u32x4 u = *(const u32x4*)(kv + r * 2048 + 32 * lane + 8 * c);
#pragma unroll
                for (int j = 0; j < 4; ++j) { const float a0 = bflo(u[j]), a1 = bfhi(u[j]); sk += a0 * a0 + a1 * a1; }
            }
#pragma unroll
            for (int c = 0; c < 4; ++c) {
                const u32x4 u = *(const u32x4*)(a + r * ODD_PAD + 640 + 8 * c);
#pragma unroll
                for (int j = 0; j < 4; ++j) { const float a0 = bflo(u[j]), a1 = bfhi(u[j]); sr += a0 * a0 + a1 * a1; }
            }
            sq += __shfl_xor(sq, 1); sq += __shfl_xor(sq, 2);
            sk += __shfl_xor(sk, 1);
            mq = fmaxf(mq, sq); mk = fmaxf(mk, sk + sr);
        }
        if ((lane & 3) == 0) { red[(w * 16 + (lane >> 2)) * 2] = mq; red[(w * 16 + (lane >> 2)) * 2 + 1] = mk; }
        __syncthreads();
        if (tid < 32) {
            float m = 0.f;
#pragma unroll
            for (int ww = 0; ww < NWAVE; ++ww) m = fmaxf(m, red[ww * 32 + tid]);
            atomicMax(nmx + b * 32 + tid, __float_as_uint(m));
        }
        __syncthreads();
    }
}

namespace pg8 {
constexpr int BM = 256, BK = 64, HALF = 128, HTB = HALF * BK * 2, NXCD = 8, WGM = 8;
DI int lds_byte(int r, int c) { const int st = (r >> 4) * 2 + (c >> 5), rr = r & 15, cc = c & 31, ob = rr * 64 + cc * 2; return st * 1024 + (ob ^ (((ob >> 9) & 1) << 5)); }
DI void stage_rc(int b, int& R, int& C) { const int st = b / 1024, sb = b % 1024, swz = sb ^ (((sb >> 9) & 1) << 5); R = (st >> 1) * 16 + swz / 64; C = (st & 1) * 32 + (swz % 64) / 2; }
DI int perm32(int rho) { const int n = rho >> 4, i = rho & 15; return 8 * (i >> 2) + 4 * n + (i & 3); }
struct Unit { int pm, pn; };
struct Gemm { const bf16_t* A; const bf16_t* Bt; int M, NT, K, lda; size_t hstepB, tstepB; };
struct StaticOrder {
    int nM, nN, nwg, G, c;
    DI void init(int M, int NT, int G_, int c_) { nM = M / BM; nN = NT; nwg = nM * nN; G = G_; c = c_; }
    DI bool next(int i, Unit& u) const {
        const long L = (long)i * G + c; if (L >= nwg) return false;
        int wgid = (int)L; { const int q = nwg / NXCD, r = nwg % NXCD, xcd = wgid % NXCD, off = wgid / NXCD; wgid = (xcd < r ? xcd * (q + 1) : r * (q + 1) + (xcd - r) * q) + off; }
        const int nig = WGM * nN, gid = wgid / nig, fm = gid * WGM, gsz = (nM - fm) < WGM ? (nM - fm) : WGM;
        u.pm = fm + ((wgid % nig) % gsz); u.pn = (wgid % nig) / gsz; return true;
    }
};
template <class Epi>
DI void gemm_phase(LDS_AS unsigned char* lds, const Gemm g, const Epi& E) {
    StaticOrder S; S.init(g.M, g.NT, gridDim.x, blockIdx.x);
    const int tid = otid(), wid = __builtin_amdgcn_readfirstlane(tid >> 6), lane = tid & 63, wr = wid >> 2, wc = wid & 3, fr = lane & 15, fq = lane >> 4;
    const int K = g.K, nt = K / BK;
    unsigned voffA[2], voffB[2];
#pragma unroll
    for (int i = 0; i < 2; ++i) { int R, C; stage_rc(tid * 16 + i * 8192, R, C); const int Rb = Epi::PERM ? ((R & ~31) + perm32(R & 31)) : R;
        voffA[i] = (unsigned)(R * g.lda + C) * 2u; voffB[i] = (unsigned)(Rb * K + C) * 2u; }
    const size_t kstep = (size_t)(BK * 2);
    const size_t hstepA = (size_t)HALF * g.lda * 2, tstepA = 2 * hstepA, hstepB = g.hstepB, tstepB = g.tstepB;
    const unsigned ldsw = (unsigned)wid * 1024u;
    const int aoff = lds_byte(wr * 64 + fr, fq * 8), boff = lds_byte(wc * 32 + fr, fq * 8);
#define PG8_SA(b, h) (((b) * 2 + (h)) * HTB)
#define PG8_SB(b, h) ((4 + (b) * 2 + (h)) * HTB)
#define PG8_STAGE(bufoff, gbase, voff) do { _Pragma("unroll") for (int _i = 0; _i < 2; ++_i) \
        __builtin_amdgcn_global_load_lds((const unsigned*)((const char*)(gbase) + (voff)[_i]), (LDS_AS unsigned*)(lds + (bufoff) + ldsw + _i * 8192), 16, 0, 0); } while (0)
#define PG8_LDA(dst, b, h) do { _Pragma("unroll") for (int m = 0; m < 4; ++m) _Pragma("unroll") for (int k = 0; k < 2; ++k) dst[m][k] = *(const LDS_AS bf16x8*)(lds + PG8_SA(b, h) + aoff + m * 2048 + k * 1024); } while (0)
#define PG8_LDB(dst, b, h) do { _Pragma("unroll") for (int n = 0; n < 2; ++n) _Pragma("unroll") for (int k = 0; k < 2; ++k) dst[n][k] = *(const LDS_AS bf16x8*)(lds + PG8_SB(b, h) + boff + n * 2048 + k * 1024); } while (0)
#define PG8_MMA(ai, bj, At, Bt) do { __builtin_amdgcn_s_setprio(1); _Pragma("unroll") for (int m = 0; m < 4; ++m) _Pragma("unroll") for (int n = 0; n < 2; ++n) _Pragma("unroll") for (int k = 0; k < 2; ++k) \
        acc[ai][bj][m][n] = __builtin_amdgcn_mfma_f32_16x16x32_bf16(Bt[n][k], At[m][k], acc[ai][bj][m][n], 0, 0, 0); __builtin_amdgcn_s_setprio(0); } while (0)
#define PG8_WAIT_V(n) asm volatile("s_waitcnt vmcnt(" #n ")" ::: "memory")
#define PG8_WAIT_L(n) asm volatile("s_waitcnt lgkmcnt(" #n ")" ::: "memory")
#define PG8_BAR __builtin_amdgcn_s_barrier()
#define PG8_SCHED __builtin_amdgcn_sched_barrier(0)
    Unit cur, nxt; int ui = 0;
    if (!S.next(0, cur)) return;
    f32x4 acc[2][2][4][2];
#pragma unroll
    for (int a = 0; a < 2; ++a)
#pragma unroll
        for (int b = 0; b < 2; ++b)
#pragma unroll
            for (int m = 0; m < 4; ++m)
#pragma unroll
                for (int n = 0; n < 2; ++n) acc[a][b][m][n] = (f32x4){0.f, 0.f, 0.f, 0.f};
    bf16x8 At[4][2], B0[2][2], B1[2][2];
    const char* cA = (const char*)g.A + (size_t)cur.pm * tstepA; const char* cB = (const char*)g.Bt + (size_t)cur.pn * tstepB;
    PG8_STAGE(PG8_SB(0, 0), cB, voffB); PG8_STAGE(PG8_SB(0, 1), cB + hstepB, voffB); PG8_STAGE(PG8_SA(0, 0), cA, voffA); PG8_STAGE(PG8_SA(0, 1), cA + hstepA, voffA);
    if (wr == 1) PG8_BAR;
    PG8_WAIT_V(2); PG8_BAR;
    PG8_STAGE(PG8_SB(1, 0), cB + kstep, voffB); PG8_STAGE(PG8_SA(1, 0), cA + kstep, voffA); PG8_STAGE(PG8_SB(1, 1), cB + hstepB + kstep, voffB);
    PG8_WAIT_V(6); PG8_BAR;
    for (;;) {
        const bool has_next = S.next(ui + 1, nxt);
        const char* nA = has_next ? (const char*)g.A + (size_t)nxt.pm * tstepA : cA; const char* nB = has_next ? (const char*)g.Bt + (size_t)nxt.pn * tstepB : cB;
        for (int t = 0; t < nt; t += 2) {
            const bool last = (t == nt - 2);
            const char* a1 = cA + (size_t)(t + 1) * kstep;
            const char* a2 = last ? nA : cA + (size_t)(t + 2) * kstep; const char* b2 = last ? nB : cB + (size_t)(t + 2) * kstep;
            const char* a3 = a2 + kstep; const char* b3 = b2 + kstep;
            PG8_LDB(B0, 0, 0); PG8_LDB(B1, 0, 1); PG8_SCHED; PG8_LDA(At, 0, 0); PG8_STAGE(PG8_SA(1, 1), a1 + hstepA, voffA);
            PG8_WAIT_V(8); PG8_WAIT_L(0); PG8_BAR; PG8_MMA(0, 0, At, B0); PG8_MMA(0, 1, At, B1); PG8_BAR; PG8_SCHED;
            PG8_LDA(At, 0, 1); PG8_STAGE(PG8_SB(0, 0), b2, voffB); PG8_STAGE(PG8_SB(0, 1), b2 + hstepB, voffB); PG8_STAGE(PG8_SA(0, 0), a2, voffA);
            PG8_WAIT_V(8); PG8_WAIT_L(0); PG8_BAR; PG8_MMA(1, 0, At, B0); PG8_MMA(1, 1, At, B1); PG8_BAR; PG8_SCHED;
            PG8_LDB(B0, 1, 0); PG8_LDB(B1, 1, 1); PG8_SCHED; PG8_LDA(At, 1, 0); PG8_STAGE(PG8_SA(0, 1), a2 + hstepA, voffA);
            PG8_WAIT_V(8); PG8_WAIT_L(0); PG8_BAR; PG8_MMA(0, 0, At, B0); PG8_MMA(0, 1, At, B1); PG8_BAR; PG8_SCHED;
            PG8_LDA(At, 1, 1); PG8_STAGE(PG8_SB(1, 0), b3, voffB); PG8_STAGE(PG8_SB(1, 1), b3 + hstepB, voffB); PG8_STAGE(PG8_SA(1, 0), a3, voffA);
            PG8_WAIT_V(8); PG8_WAIT_L(0); PG8_BAR; PG8_MMA(1, 0, At, B0); PG8_MMA(1, 1, At, B1); PG8_BAR; PG8_SCHED;
        }
        if (wr == 0) PG8_BAR;
        E(acc, cur, wr, wc, fr, fq);
        if (!has_next) break;
#pragma unroll
        for (int a = 0; a < 2; ++a)
#pragma unroll
            for (int b = 0; b < 2; ++b)
#pragma unroll
                for (int m = 0; m < 4; ++m)
#pragma unroll
                    for (int n = 0; n < 2; ++n) acc[a][b][m][n] = (f32x4){0.f, 0.f, 0.f, 0.f};
        cur = nxt; cA = nA; cB = nB; ++ui;
        if (wr == 1) PG8_BAR;
    }
    PG8_WAIT_V(0);
    PG8_BAR;
#undef PG8_SA
#undef PG8_SB
#undef PG8_STAGE
#undef PG8_LDA
#undef PG8_LDB
#undef PG8_MMA
#undef PG8_WAIT_V
#undef PG8_WAIT_L
#undef PG8_BAR
#undef PG8_SCHED
}
struct EpiResid {
    static constexpr bool PERM = true;
    const float* res; float* out;
    DI void operator()(const f32x4 (&acc)[2][2][4][2], const Unit& u, int wr, int wc, int fr, int fq) const {
        const int row0 = u.pm * BM + wr * 64 + fr, col0 = u.pn * BM + wc * 32 + 8 * fq;
#pragma unroll
        for (int ai = 0; ai < 2; ++ai)
#pragma unroll
            for (int m = 0; m < 4; ++m) {
                const size_t rb = (size_t)(row0 + ai * HALF + m * 16) * D + col0;
#pragma unroll
                for (int bj = 0; bj < 2; ++bj)
#pragma unroll
                    for (int n = 0; n < 2; ++n) { const size_t idx = rb + bj * HALF + n * 4; *(f32x4*)(out + idx) = *(const f32x4*)(res + idx) + acc[ai][bj][m][n]; }
            }
    }
};
struct EpiBf16 {
    static constexpr bool PERM = true;
    bf16_t* out; int ld;
    DI void operator()(const f32x4 (&acc)[2][2][4][2], const Unit& u, int wr, int wc, int fr, int fq) const {
        const int row0 = u.pm * BM + wr * 64 + fr, col0 = u.pn * BM + wc * 32 + 8 * fq;
#pragma unroll
        for (int ai = 0; ai < 2; ++ai)
#pragma unroll
            for (int m = 0; m < 4; ++m) {
                bf16_t* rowp = out + (size_t)(row0 + ai * HALF + m * 16) * ld + col0;
#pragma unroll
                for (int bj = 0; bj < 2; ++bj) {
                    const f32x4 v0 = acc[ai][bj][m][0], v1 = acc[ai][bj][m][1];
                    u32x4 w; w.x = pack2(v0[0], v0[1]); w.y = pack2(v0[2], v0[3]); w.z = pack2(v1[0], v1[1]); w.w = pack2(v1[2], v1[3]);
                    *(u32x4*)(rowp + bj * HALF) = w;
                }
            }
    }
};
struct EpiSwiglu {
    static constexpr bool PERM = true;
    bf16_t* act;
    DI void operator()(const f32x4 (&acc)[2][2][4][2], const Unit& u, int wr, int wc, int fr, int fq) const {
        const int row0 = u.pm * BM + wr * 64 + fr, col0 = u.pn * HALF + wc * 32 + 8 * fq;
#pragma unroll
        for (int ai = 0; ai < 2; ++ai)
#pragma unroll
            for (int m = 0; m < 4; ++m) {
                float v[8];
#pragma unroll
                for (int n = 0; n < 2; ++n)
#pragma unroll
                    for (int j = 0; j < 4; ++j) { const float gg = acc[ai][0][m][n][j], uu = acc[ai][1][m][n][j]; v[4 * n + j] = gg * uu * __builtin_amdgcn_rcpf(1.0f + __builtin_amdgcn_exp2f(-gg * LOG2E)); }
                u32x4 w; w.x = pack2(v[0], v[1]); w.y = pack2(v[2], v[3]); w.z = pack2(v[4], v[5]); w.w = pack2(v[6], v[7]);
                *(u32x4*)(act + (size_t)(row0 + ai * HALF + m * 16) * DFF + col0) = w;
            }
    }
};
}
DI pg8::Gemm mk_gemm(const bf16_t* A, int lda, const bf16_t* Bt, int M, int N, int K) { return pg8::Gemm{A, Bt, M, N / 256, K, lda, (size_t)128 * K * 2, (size_t)256 * K * 2}; }

template <int DQK, int DV, int KT, int QMODE, bool ALIBI, bool NOMAX>
DI void attn_core(const bf16_t* __restrict__ q, int ldq, const bf16_t* __restrict__ k, int ldk, const bf16_t* __restrict__ k2, int ldk2,
                  const bf16_t* __restrict__ v, int ldv, int nkeys, int qpos0, float qscale, float slope2,
                  const float* __restrict__ qg, const float2* __restrict__ tab, char* smem, f32x16 (&o)[DV / 32], float& lsum) {
    constexpr int KROW = DQK * 2 + 16, VROW = DV * 2 + 64  , KBYTES = KT * KROW, VBYTES = KT * VROW;
    constexpr int KCPR = DQK / 8  , KTOT = KT * KCPR, NKC = (KTOT + THREADS - 1) / THREADS, VCPR = DV / 8, VTOT = KT * VCPR, NVC = (VTOT + THREADS - 1) / THREADS;
    constexpr int NST = KT / 32, NKS = DQK / 16, NDT = DV / 32;
    static_assert(2 * (KBYTES + VBYTES) <= (int)LDS_BYTES, "lds");
    const int tid = otid(), lane = tid & 63, w = tid >> 6, r = lane & 31, h = lane >> 5;
    const int qpos = qpos0 + 32 * w + r;
    bf16x8 qf[NKS];
    {
        const bf16_t* qrow = q + (size_t)(32 * w + r) * ldq + 8 * h;
        u32x4 raw[NKS];
#pragma unroll
        for (int s = 0; s < NKS; ++s) raw[s] = *(const u32x4*)(qrow + 16 * s);
        if (QMODE == 1) {
            float ss = 0.f;
#pragma unroll
            for (int s = 0; s < NKS; ++s) {
                const unsigned u[4] = {raw[s].x, raw[s].y, raw[s].z, raw[s].w};
#pragma unroll
                for (int j = 0; j < 4; ++j) { const float a0 = bflo(u[j]), a1 = bfhi(u[j]); ss += a0 * a0 + a1 * a1; }
            }
            ss += __shfl_xor(ss, 32);
            const float rstd = rsqrtf(ss * (1.0f / 64) + EPS) * qscale;
#pragma unroll
            for (int s = 0; s < NKS; ++s) {
                unsigned u[4] = {raw[s].x, raw[s].y, raw[s].z, raw[s].w};
#pragma unroll
                for (int j = 0; j < 4; ++j) {
                    const int d0 = 16 * s + 8 * h + 2 * j;
                    const float y0 = bflo(u[j]) * rstd * qg[d0], y1 = bfhi(u[j]) * rstd * qg[d0 + 1];
                    const float2 cs = tab[qpos * 32 + (d0 >> 1)];
                    u[j] = pack2(y0 * cs.x - y1 * cs.y, y0 * cs.y + y1 * cs.x);
                }
                raw[s] = u32x4{u[0], u[1], u[2], u[3]};
            }
        } else if (QMODE == 2) {
#pragma unroll
            for (int s = 4; s < NKS; ++s) {
                unsigned u[4] = {raw[s].x, raw[s].y, raw[s].z, raw[s].w};
#pragma unroll
                for (int j = 0; j < 4; ++j) {
                    const int p = 8 * (s - 4) + 4 * h + j;
                    const float y0 = bflo(u[j]), y1 = bfhi(u[j]);
                    const float2 cs = tab[qpos * 16 + p];
                    u[j] = pack2(y0 * cs.x - y1 * cs.y, y0 * cs.y + y1 * cs.x);
                }
                raw[s] = u32x4{u[0], u[1], u[2], u[3]};
            }
        }
#pragma unroll
        for (int s = 0; s < NKS; ++s) qf[s] = __builtin_bit_cast(bf16x8, raw[s]);
    }
    u32x4 rk[NKC], rv[NVC];
    char* const kbuf = smem;
    char* const vbuf = smem + 2 * KBYTES;
#define ATT_GLOADK(key0_)                                                                                             \
    {                                                                                                                 \
        _Pragma("unroll") for (int i = 0; i < NKC; ++i) {                                                             \
            const int cid = tid + THREADS * i, key = cid / KCPR, cc = cid - key * KCPR;                               \
            if (KTOT % THREADS == 0 || cid < KTOT) {                                                                  \
                const bf16_t* src;                                                                                    \
                if (QMODE == 2 && cc >= 8) src = k2 + (size_t)((key0_) + key) * ldk2 + (cc - 8) * 8;                   \
                else src = k + (size_t)((key0_) + key) * ldk + cc * 8;                                                \
                rk[i] = *(const u32x4*)src;                                                                           \
            }                                                                                                         \
        }                                                                                                             \
    }
#define ATT_GLOADV(key0_)                                                                                             \
    {                                                                                                                 \
        _Pragma("unroll") for (int i = 0; i < NVC; ++i) {                                                             \
            const int cid = tid + THREADS * i, key = cid / VCPR, cc = cid - key * VCPR;                               \
            if (VTOT % THREADS == 0 || cid < VTOT) rv[i] = *(const u32x4*)(v + (size_t)((key0_) + key) * ldv + cc * 8); \
        }                                                                                                             \
    }
#define ATT_LSTOREK(buf_)                                                                                             \
    {                                                                                                                 \
        _Pragma("unroll") for (int i = 0; i < NKC; ++i) {                                                             \
            const int cid = tid + THREADS * i, key = cid / KCPR, cc = cid - key * KCPR;                               \
            if (KTOT % THREADS == 0 || cid < KTOT) *(u32x4*)(kbuf + (buf_) * KBYTES + key * KROW + cc * 16) = rk[i];  \
        }                                                                                                             \
    }
#define ATT_LSTOREV(buf_)                                                                                             \
    {                                                                                                                 \
        _Pragma("unroll") for (int i = 0; i < NVC; ++i) {                                                             \
            const int cid = tid + THREADS * i, key = cid / VCPR, cc = cid - key * VCPR;                               \
            if (VTOT % THREADS == 0 || cid < VTOT) *(u32x4*)(vbuf + (buf_) * VBYTES + key * VROW + cc * 16) = rv[i];  \
        }                                                                                                             \
    }
#define ATT_QK(buf_, X_)                                                                                              \
    {                                                                                                                 \
        const char* kb_ = kbuf + (buf_) * KBYTES + r * KROW + h * 16;                                                 \
        _Pragma("unroll") for (int st = 0; st < NST; ++st) {                                                          \
            X_[st] = MFMA(*(const bf16x8*)(kb_ + 32 * st * KROW), qf[0], zero16);                                     \
            _Pragma("unroll") for (int ks = 1; ks < NKS; ++ks) X_[st] = MFMA(*(const bf16x8*)(kb_ + 32 * st * KROW + ks * 32), qf[ks], X_[st]); \
        }                                                                                                             \
    }
#define ATT_SM(t_, X_)                                                                                                \
    {                                                                                                                 \
        if (NOMAX) {                                                                                                  \
            const float dqn = (float)(qpos - ((t_) * KT + 4 * h));                                                    \
            _Pragma("unroll") for (int st = 0; st < NST; ++st)                                                        \
                _Pragma("unroll") for (int i = 0; i < 16; ++i) {                                                      \
                    float xv_ = X_[st][i];                                                                            \
                    if (ALIBI) xv_ = __builtin_fmaf(-slope2, fabsf(dqn - (float)(32 * st + (i & 3) + 8 * (i >> 2))), xv_); \
                    X_[st][i] = __builtin_amdgcn_exp2f(xv_);                                                          \
                    if (!ROWSUM_MFMA) lacc += X_[st][i];                                                              \
                }                                                                                                     \
        } else {                                                                                                      \
            float mx = -1e30f;                                                                                        \
            const float dq = (float)(qpos - ((t_) * KT + 4 * h));                                                     \
            _Pragma("unroll") for (int st = 0; st < NST; ++st)                                                        \
                _Pragma("unroll") for (int i = 0; i < 16; ++i) {                                                      \
                    if (ALIBI) X_[st][i] = __builtin_fmaf(-slope2, fabsf(dq - (float)(32 * st + (i & 3) + 8 * (i >> 2))), X_[st][i]); \
                    mx = fmaxf(mx, X_[st][i]);                                                                        \
                }                                                                                                     \
            mx = fmaxf(mx, __shfl_xor(mx, 32));                                                                       \
            const float mn = fmaxf(m, mx);                                                                            \
            const float alpha = __builtin_amdgcn_exp2f(m - mn);                                                       \
            m = mn;                                                                                                   \
            float rs_ = 0.f;                                                                                          \
            _Pragma("unroll") for (int st = 0; st < NST; ++st)                                                        \
                _Pragma("unroll") for (int i = 0; i < 16; ++i) { X_[st][i] = __builtin_amdgcn_exp2f(X_[st][i] - mn); if (!ROWSUM_MFMA) rs_ += X_[st][i]; } \
            if (__any(alpha != 1.0f)) {                                                                               \
                _Pragma("unroll") for (int dt = 0; dt < NDT; ++dt)                                                    \
                    _Pragma("unroll") for (int i = 0; i < 16; ++i) o[dt][i] *= alpha;                                 \
                _Pragma("unroll") for (int i = 0; i < 16; ++i) ol[i] *= alpha;                                        \
            }                                                                                                         \
            if (!ROWSUM_MFMA) lacc = lacc * alpha + rs_;                                                              \
        }                                                                                         \
    }
#define ATT_SMPV(t_, vb_, X_)                                                                                         \
    {                                                                                                                 \
        ATT_SM(t_, X_)                                                                                                \
        const char* vbp_ = vbuf + (vb_) * VBYTES + vlane;                                                             \
        __builtin_amdgcn_s_setprio(1);     \
        _Pragma("unroll") for (int st = 0; st < NST; ++st)                                                            \
            _Pragma("unroll") for (int s = 0; s < 2; ++s) {                                                           \
                u32x4 pk;                                                                                             \
                pk.x = pack2(X_[st][8 * s + 0], X_[st][8 * s + 1]); pk.y = pack2(X_[st][8 * s + 2], X_[st][8 * s + 3]); \
                pk.z = pack2(X_[st][8 * s + 4], X_[st][8 * s + 5]); pk.w = pack2(X_[st][8 * s + 6], X_[st][8 * s + 7]); \
                const bf16x8 pb = __builtin_bit_cast(bf16x8, pk);                                                     \
                if (ROWSUM_MFMA) ol = MFMA(ones8, pb, ol);                                                            \
                _Pragma("unroll") for (int dt = 0; dt < NDT; ++dt) {                                                  \
                    const char* va = vbp_ + (32 * st + 16 * s) * VROW + 64 * dt;                                      \
                    const s16x4 lo = __builtin_amdgcn_ds_read_tr16_b64_v4i16((LDS_AS s16x4*)(va));                    \
                    const s16x4 hi = __builtin_amdgcn_ds_read_tr16_b64_v4i16((LDS_AS s16x4*)(va + 8 * VROW));        \
                    o[dt] = MFMA(__builtin_shufflevector(lo, hi, 0, 1, 2, 3, 4, 5, 6, 7), pb, o[dt]);                 \
                }                                                                                                     \
            }                                                                                                         \
        __builtin_amdgcn_s_setprio(0);                                                                                \
    }
#define ATT_STEP(t_, PAR_, CUR_, NXT_)                                                                                \
    {                                                                                                                 \
        const int tk_ = ((t_) + 2 < ntiles) ? (t_) + 2 : ntiles - 1, tv_ = ((t_) + 1 < ntiles) ? (t_) + 1 : ntiles - 1; \
        ATT_GLOADK(tk_ * KT)                                                                                          \
        ATT_GLOADV(tv_ * KT)                                                                                          \
        __builtin_amdgcn_sched_barrier(0);                                                                            \
        ATT_QK(1 - (PAR_), NXT_)                                                                                      \
        ATT_SMPV(t_, PAR_, CUR_)                                                                                      \
        __builtin_amdgcn_sched_barrier(0);                                                                            \
        ATT_LSTOREK(PAR_)                                                                                             \
        ATT_LSTOREV(1 - (PAR_))                                                                                       \
        __syncthreads();                                                                                              \
    }
#define ATT_STEP1(t_, PAR_, X_)                                                                                       \
    {                                                                                                                 \
        const int tn_ = ((t_) + 1 < ntiles) ? (t_) + 1 : ntiles - 1;                                                  \
        ATT_GLOADK(tn_ * KT)                                                                                          \
        ATT_GLOADV(tn_ * KT)                                                                                          \
        __builtin_amdgcn_sched_barrier(0);                                                                            \
        ATT_QK(PAR_, X_)                                                                                              \
        ATT_SMPV(t_, PAR_, X_)                                                                                        \
        __builtin_amdgcn_sched_barrier(0);                                                                            \
        ATT_LSTOREK(1 - (PAR_))                                                                                       \
        ATT_LSTOREV(1 - (PAR_))                                                                                       \
        __syncthreads();                                                                                              \
    }
#define ATT_VLOAD(vb_, gi_, DST_)                                                                                     \
    {                                                                                                                 \
        const char* va_ = vbuf + (vb_) * VBYTES + vlane + (16 * (gi_)) * VROW;                                        \
        _Pragma("unroll") for (int dt = 0; dt < NDT; ++dt) {                                                          \
            const s16x4 lo = __builtin_amdgcn_ds_read_tr16_b64_v4i16((LDS_AS s16x4*)(va_ + 64 * dt));                 \
            const s16x4 hi = __builtin_amdgcn_ds_read_tr16_b64_v4i16((LDS_AS s16x4*)(va_ + 64 * dt + 8 * VROW));      \
            DST_[dt] = __builtin_shufflevector(lo, hi, 0, 1, 2, 3, 4, 5, 6, 7);                                       \
        }                                                                                                             \
    }
#define ATT_STEP1P(t_, PAR_, X_)                                                                                      \
    {                                                                                                                 \
        const int tn_ = ((t_) + 1 < ntiles) ? (t_) + 1 : ntiles - 1;                                                  \
        ATT_GLOADK(tn_ * KT)                                                                                          \
        ATT_GLOADV(tn_ * KT)                                                                                          \
        __builtin_amdgcn_sched_barrier(0);                                                                            \
        bf16x8 kfr[NST][NKS], vfr[2 * NST][NDT];                                                                      \
        {                                                                                                             \
            const char* kb_ = kbuf + (PAR_) * KBYTES + r * KROW + h * 16;                                             \
            _Pragma("unroll") for (int st = 0; st < NST; ++st)                                                        \
                _Pragma("unroll") for (int ks = 0; ks < NKS; ++ks) kfr[st][ks] = *(const bf16x8*)(kb_ + 32 * st * KROW + ks * 32); \
        }                                                                                                             \
        ATT_VLOAD(PAR_, 0, vfr[0])                                                                                    \
        ATT_VLOAD(PAR_, 1, vfr[1])                                                                                    \
        __builtin_amdgcn_sched_barrier(0);                                                                            \
        __builtin_amdgcn_iglp_opt(IGLP_MODE);     \
        _Pragma("unroll") for (int st = 0; st < NST; ++st) {                                                          \
            X_[st] = MFMA(kfr[st][0], qf[0], zero16);                                                                 \
            _Pragma("unroll") for (int ks = 1; ks < NKS; ++ks) X_[st] = MFMA(kfr[st][ks], qf[ks], X_[st]);            \
        }                                                                                                             \
        ATT_SM(t_, X_)                                                                                                \
        __builtin_amdgcn_s_setprio(1);                                                                                \
        _Pragma("unroll") for (int gi = 0; gi < 2 * NST; ++gi) {                                                      \
            if (gi + 2 < 2 * NST) { ATT_VLOAD(PAR_, gi + 2, vfr[gi + 2]) }                                            \
            const int st = gi >> 1, s = gi & 1;                                                                       \
            u32x4 pk;                                                                                                 \
            pk.x = pack2(X_[st][8 * s + 0], X_[st][8 * s + 1]); pk.y = pack2(X_[st][8 * s + 2], X_[st][8 * s + 3]);   \
            pk.z = pack2(X_[st][8 * s + 4], X_[st][8 * s + 5]); pk.w = pack2(X_[st][8 * s + 6], X_[st][8 * s + 7]);   \
            const bf16x8 pb = __builtin_bit_cast(bf16x8, pk);                                                         \
            _Pragma("unroll") for (int dt = 0; dt < NDT; ++dt) o[dt] = MFMA(vfr[gi][dt], pb, o[dt]);                  \
        }                                                                                                             \
        __builtin_amdgcn_s_setprio(0);                                                                                \
        __builtin_amdgcn_sched_barrier(0);                                                                            \
        ATT_LSTOREK(1 - (PAR_))                                                                                       \
        ATT_LSTOREV(1 - (PAR_))                                                                                       \
        __syncthreads();                                                                                              \
    }
    const f32x16 zero16 = {0.f, 0.f, 0.f, 0.f, 0.f, 0.f, 0.f, 0.f, 0.f, 0.f, 0.f, 0.f, 0.f, 0.f, 0.f, 0.f};
    const bf16x8 ones8 = {0x3F80, 0x3F80, 0x3F80, 0x3F80, 0x3F80, 0x3F80, 0x3F80, 0x3F80};
    constexpr bool ROWSUM_MFMA = false;
    float m = -1e30f, lacc = 0.f;
    f32x16 ol = zero16;
#pragma unroll
    for (int dt = 0; dt < NDT; ++dt) o[dt] = zero16;
    const int ntiles = nkeys / KT;
    const int vlane = (4 * h + ((lane & 15) >> 2)) * VROW + (16 * ((lane >> 4) & 1) + 4 * (lane & 3)) * 2;
    constexpr bool PIPE = false;
    if (PIPE) {
        f32x16 xa[NST], xb[NST];
        ATT_GLOADK(0) ATT_LSTOREK(0)
        ATT_GLOADK(KT) ATT_GLOADV(0)
        __syncthreads();
        ATT_QK(0, xa)
        ATT_LSTOREK(1) ATT_LSTOREV(0)
        __syncthreads();
        for (int t = 0; t < ntiles; t += 2) {
            ATT_STEP(t, 0, xa, xb)
            ATT_STEP(t + 1, 1, xb, xa)
        }
    } else {
        f32x16 xs[NST];
        ATT_GLOADK(0) ATT_GLOADV(0) ATT_LSTOREK(0) ATT_LSTOREV(0)
        __syncthreads();
        if (NKS <= 6) {
            for (int t = 0; t < ntiles; t += 2) {
                ATT_STEP1P(t, 0, xs)
                ATT_STEP1P(t + 1, 1, xs)
            }
        } else {
            for (int t = 0; t < ntiles; t += 2) {
                ATT_STEP1(t, 0, xs)
                ATT_STEP1(t + 1, 1, xs)
            }
        }
    }
    lsum = ROWSUM_MFMA ? ol[0] : lacc + __shfl_xor(lacc, 32);
#undef ATT_GLOADK
#undef ATT_GLOADV
#undef ATT_LSTOREK
#undef ATT_LSTOREV
#undef ATT_QK
#undef ATT_SMPV
#undef ATT_STEP
#undef ATT_STEP1
#undef ATT_STEP1P
#undef ATT_VLOAD
#undef ATT_SM
}
template <int NDT>
DI void store_o(bf16_t* dst, int ld, f32x16 (&o)[NDT], float inv) {
    const int tid_ = otid(), lane = tid_ & 63, w = tid_ >> 6, r = lane & 31, h = lane >> 5;
    bf16_t* row = dst + (size_t)(32 * w + r) * ld + 4 * h;
#pragma unroll
    for (int dt = 0; dt < NDT; ++dt)
#pragma unroll
        for (int g = 0; g < 4; ++g) {
            uint2 vv; vv.x = pack2(o[dt][4 * g] * inv, o[dt][4 * g + 1] * inv); vv.y = pack2(o[dt][4 * g + 2] * inv, o[dt][4 * g + 3] * inv);
            *(uint2*)(row + 32 * dt + 8 * g) = vv;
        }
}
DI int swz_item(int base) {
    const int G = gridDim.x, i = blockIdx.x;
    if (G & 7) return base + i;
    return base + (i & 7) * (G >> 3) + (i >> 3);
}

constexpr int QT = SEQ / 256;
constexpr float NOMAX_BOUND = 90.f;
DI void attn_even(const bf16_t* qkv, float* park, bf16_t* mix, const Params& p, const float2* ax, const unsigned* nd, float lam_init, char* smem) {
    float d1 = 0.f, d2 = 0.f, gq = 0.f, gk = 0.f;
    for (int i = 0; i < 64; ++i) { d1 += p.in[8][i] * p.in[9][i]; d2 += p.in[10][i] * p.in[11][i]; gq = fmaxf(gq, fabsf(p.in[6][i])); gk = fmaxf(gk, fabsf(p.in[7][i])); }
    const float lam = __expf(d1) - __expf(d2) + lam_init;
    const float bound_gqa = 64.f * 0.125f * LOG2E * gq * gk * 1.03f;
    const int tid_ = otid(), lane = tid_ & 63, h = lane >> 5;
    float4* mypark = (float4*)(park + ((size_t)blockIdx.x * THREADS + tid_) * 64);
    constexpr int NDIFF = NB * 4 * QT, NGQA = NB * 8 * QT;
    for (int base = 0; base < NDIFF + NGQA; base += gridDim.x) {
        const int it = swz_item(base);
        if (it >= NDIFF + NGQA) continue;
        if (it < NDIFF) {
            const int b = it / (4 * QT), hd = (it / QT) & 3, qt = it % QT;
            const size_t row0 = (size_t)b * SEQ + qt * 256;
            const float slope2 = exp2f(-2.0f * (hd + 1)) * LOG2E;
            const bf16_t* qp = qkv + row0 * EVEN_IN + 768 + hd * 128;
            const bf16_t* kp = qkv + (size_t)b * SEQ * EVEN_IN + 1280 + hd * 128;
            const bf16_t* vp = qkv + (size_t)b * SEQ * EVEN_IN + 1792 + hd * 128;
            f32x16 o0[4]; float l0 = 1.f;
#pragma unroll 1
            for (int c = 0; c < 2; ++c) {
                const unsigned* nn = nd + (b * 8 + hd * 2 + c) * 2;
                const float bound = sqrtf(__uint_as_float(nn[0]) * __uint_as_float(nn[1])) * 1.03f;
                if (bound < NOMAX_BOUND) attn_core<64, 128, 64, 0, true, true>(qp + 64 * c, EVEN_IN, kp + 64 * c, EVEN_IN, nullptr, 0, vp, EVEN_IN, SEQ, qt * 256, 1.0f, slope2, nullptr, nullptr, smem, o0, l0);
                else attn_core<64, 128, 64, 0, true, false>(qp + 64 * c, EVEN_IN, kp + 64 * c, EVEN_IN, nullptr, 0, vp, EVEN_IN, SEQ, qt * 256, 1.0f, slope2, nullptr, nullptr, smem, o0, l0);
                if (c == 0) {
                    const float i0 = 1.0f / l0;
#pragma unroll
                    for (int dt = 0; dt < 4; ++dt)
#pragma unroll
                        for (int g = 0; g < 4; ++g) mypark[dt * 4 + g] = make_float4(o0[dt][4 * g] * i0, o0[dt][4 * g + 1] * i0, o0[dt][4 * g + 2] * i0, o0[dt][4 * g + 3] * i0);
                    asm volatile("" ::: "memory");
                }
            }
            const float i1 = lam / l0;
            float ss = 0.f;
            asm volatile("" ::: "memory");
#pragma unroll
            for (int dt = 0; dt < 4; ++dt)
#pragma unroll
                for (int g = 0; g < 4; ++g) {
                    const float4 pv = mypark[dt * 4 + g];
                    const float pa[4] = {pv.x, pv.y, pv.z, pv.w};
#pragma unroll
                    for (int e = 0; e < 4; ++e) { const float vv = pa[e] - i1 * o0[dt][4 * g + e]; o0[dt][4 * g + e] = vv; ss += vv * vv; }
                }
            ss += __shfl_xor(ss, 32);
            const float rstd = rsqrtf(ss * (1.0f / 128) + EPS) * (1.0f - lam_init);
#pragma unroll
            for (int dt = 0; dt < 4; ++dt)
#pragma unroll
                for (int i = 0; i < 16; ++i) o0[dt][i] *= p.in[12][32 * dt + crow(i, h)];
            store_o<4>(mix + row0 * D + 512 + hd * 128, D, o0, rstd);
        } else {
            const int j = it - NDIFF;
            const int b = j / (8 * QT), hd = (j / QT) & 7, qt = j % QT, kvh = hd >> 2;
            const size_t row0 = (size_t)b * SEQ + qt * 256;
            const bf16_t* qp = qkv + row0 * EVEN_IN + hd * 64;
            const bf16_t* kp = qkv + (size_t)b * SEQ * EVEN_IN + 512 + kvh * 64;
            const bf16_t* vp = qkv + (size_t)b * SEQ * EVEN_IN + 640 + kvh * 64;
            f32x16 o[2]; float l;
            if (bound_gqa < NOMAX_BOUND) attn_core<64, 64, 64, 1, false, true>(qp, EVEN_IN, kp, EVEN_IN, nullptr, 0, vp, EVEN_IN, SEQ, qt * 256, 0.125f * LOG2E, 0.f, p.in[6], ax, smem, o, l);
            else attn_core<64, 64, 64, 1, false, false>(qp, EVEN_IN, kp, EVEN_IN, nullptr, 0, vp, EVEN_IN, SEQ, qt * 256, 0.125f * LOG2E, 0.f, p.in[6], ax, smem, o, l);
            store_o<2>(mix + row0 * D + hd * 64, D, o, 1.0f / l);
        }
    }
}
DI void attn_mla(const bf16_t* qb, const bf16_t* kv, const bf16_t* a, bf16_t* mix, const float2* lin, const unsigned* nmx, char* smem) {
    constexpr int NIT = NB * 16 * QT;
    for (int base = 0; base < NIT; base += gridDim.x) {
        const int it = swz_item(base);
        if (it >= NIT) continue;
        const int b = it / (16 * QT), hd = (it / QT) & 15, qt = it % QT;
        const size_t row0 = (size_t)b * SEQ + qt * 256;
        const unsigned* nn = nmx + (b * 16 + hd) * 2;
        const float bound = sqrtf(__uint_as_float(nn[0]) * __uint_as_float(nn[1])) * 1.03f;
        const bf16_t* kb_ = kv + (size_t)b * SEQ * 2048 + hd * 128;
        f32x16 o[2]; float l;
        if (bound < NOMAX_BOUND) attn_core<96, 64, 64, 2, false, true>(qb + row0 * 1536 + hd * 96, 1536, kb_, 2048, a + (size_t)b * SEQ * ODD_PAD + 640, ODD_PAD, kb_ + 64, 2048, SEQ, qt * 256, 1.0f, 0.f, nullptr, lin, smem, o, l);
        else attn_core<96, 64, 64, 2, false, false>(qb + row0 * 1536 + hd * 96, 1536, kb_, 2048, a + (size_t)b * SEQ * ODD_PAD + 640, ODD_PAD, kb_ + 64, 2048, SEQ, qt * 256, 1.0f, 0.f, nullptr, lin, smem, o, l);
        store_o<2>(mix + row0 * D + hd * 64, D, o, 1.0f / l);
    }
}
DI void attn_cross(const bf16_t* qx, const bf16_t* kvx, bf16_t* mix, int seq0, char* smem) {
    constexpr int NIT = NB * 4 * QT * 2;
    for (int base = 0; base < NIT; base += gridDim.x) {
        const int it = swz_item(base);
        if (it >= NIT) continue;
        const int b = it / (8 * QT), hd = (it / (2 * QT)) & 3, qt = (it >> 1) % QT, half = it & 1;
        const size_t row0 = (size_t)b * SEQ + qt * 256;
        const bf16_t* kvb = kvx + (size_t)(seq0 + b) * NMEM * 2048;
        f32x16 o[4]; float l;
        attn_core<256, 128, 32, 0, false, false>(qx + row0 * D + hd * 256, D, kvb + hd * 256, 2048, nullptr, 0, kvb + 1024 + hd * 256 + half * 128, 2048, NMEM, 0,
                                          1.0f, 0.f, nullptr, nullptr, smem, o, l);
        store_o<4>(mix + row0 * D + hd * 256 + half * 128, D, o, 1.0f / l);
    }
}

extern "C" __global__ void __launch_bounds__(THREADS, 2) fwd_mega(Params p) {
    extern __shared__ __attribute__((aligned(16))) char smem[];
    LDS_AS unsigned char* lds = (LDS_AS unsigned char*)smem;
    cg::grid_group grid = cg::this_grid();
    char* ws = p.ws;
    __shared__ uint4 xb_words;
    if (threadIdx.x == 0) xb_words = make_uint4(0u, 0u, 0u, 0u);
    __syncthreads();
    const XcdBarrier xb = xcd_barrier_post((unsigned*)(ws + B_BAR), (volatile LDS_AS unsigned*)&xb_words);
    bf16_t* wEin = (bf16_t*)(ws + W_EIN); bf16_t* wEout = (bf16_t*)(ws + W_EOUT); bf16_t* wOin = (bf16_t*)(ws + W_OIN);
    bf16_t* wUq = (bf16_t*)(ws + W_UQ); bf16_t* wUkv = (bf16_t*)(ws + W_UKV); bf16_t* wOout = (bf16_t*)(ws + W_OOUT);
    float2* ax = (float2*)(ws + T_AX); float2* lin = (float2*)(ws + T_LIN);
    bf16_t* H = (bf16_t*)(ws + B_H); bf16_t* MIX = (bf16_t*)(ws + B_MIX);

    convert_weight(p.in[5], wEin, D, EVEN_IN, EVEN_IN, smem, 768, 1280, 0.125f * LOG2E);
    convert_weight(p.in[13], wEout, D, D, D, smem);
    convert_weight(p.in[14], wOin, D, ODD_IN, ODD_PAD, smem);
    convert_weight(p.in[17], wUq, 384, 1536, 1536, smem, 0, 1536, 0.10206207261596575f * LOG2E);
    convert_weight(p.in[18], wUkv, 256, 2048, 2048, smem);
    convert_weight(p.in[19], wOout, D, D, D, smem);
    for (int l = 0; l < 2; ++l) {
        convert_weight(p.in[22] + (size_t)l * D * D, (bf16_t*)(ws + W_CQ) + (size_t)l * D * D, D, D, D, smem, 0, D, 0.0625f * LOG2E);
        convert_weight(p.in[23] + (size_t)l * D * 2048, (bf16_t*)(ws + W_CKV) + (size_t)l * 2048 * D, D, 2048, 2048, smem);
        convert_weight(p.in[24] + (size_t)l * D * D, (bf16_t*)(ws + W_CO) + (size_t)l * D * D, D, D, D, smem);
        convert_weight(p.in[26] + (size_t)l * D * 2 * DFF, (bf16_t*)(ws + W_GU) + (size_t)l * 2 * DFF * D, D, 2 * DFF, 2 * DFF, smem);
        convert_weight(p.in[27] + (size_t)l * DFF * D, (bf16_t*)(ws + W_DOWN) + (size_t)l * D * DFF, DFF, D, D, smem);
        rmsnorm_rows(p.in[2], p.in[21] + l * D, (bf16_t*)(ws + B_MEMN) + (size_t)l * NBATCH * NMEM * D, 8 * NMEM);
        rmsnorm_rows(p.in[3], p.in[21] + l * D, (bf16_t*)(ws + B_MEMN) + (size_t)l * NBATCH * NMEM * D + (size_t)8 * NMEM * D, 16 * NMEM);
    }
    build_tables(ax, lin);
    if (blockIdx.x == 0) for (int i = threadIdx.x; i < 4096; i += THREADS) ((unsigned*)(ws + B_NORMS))[i] = 0u;
    grid.sync();
    for (int l = 0; l < 2; ++l) {
        pg8::EpiBf16 e{(bf16_t*)(ws + B_KX) + (size_t)l * NBATCH * NMEM * 2048, 2048};
        pg8::gemm_phase(lds, mk_gemm((const bf16_t*)(ws + B_MEMN) + (size_t)l * NBATCH * NMEM * D, D, (const bf16_t*)(ws + W_CKV) + (size_t)l * 2048 * D, NBATCH * NMEM, 2048, D), e);
    }
    xcd_barrier(xb);

    for (int ch = 0; ch < NCHUNK; ++ch) {
        const float* xin = (ch == 0) ? p.in[0] : p.in[1] + (size_t)(ch - 1) * TC * D;
        float* xo = p.out + (size_t)ch * TC * D;
        for (int layer = 0; layer < 2; ++layer) {
            const float* xcur = (layer == 0) ? xin : xo;
            for (int rep_ = 0; rep_ < PROBE_NORM; ++rep_) rmsnorm_rows(xcur, p.in[4] + layer * D, H, TC);
            xcd_barrier(xb);
            const bf16_t* wout;
            if (layer == 0) {
                bf16_t* qkv = (bf16_t*)(ws + E_QKV);
                for (int rep_ = 0; rep_ < PROBE_GEMM; ++rep_) { pg8::EpiBf16 e{qkv, EVEN_IN}; pg8::gemm_phase(lds, mk_gemm(H, D, wEin, TC, EVEN_IN, D), e); }
                xcd_barrier(xb);
                kprep_even(qkv, p.in[7], ax);
                normmax_even(qkv, (unsigned*)(ws + B_NORMS) + ch * 128, smem);
                xcd_barrier(xb);
                for (int rep_ = 0; rep_ < PROBE_ATTN; ++rep_) attn_even(qkv, (float*)(ws + E_PARK), MIX, p, ax, (const unsigned*)(ws + B_NORMS) + ch * 128, 0.2f, smem);
                wout = wEout;
            } else {
                bf16_t* a = (bf16_t*)(ws + O_A); bf16_t* qb = (bf16_t*)(ws + O_Q); bf16_t* kv = (bf16_t*)(ws + O_KV);
                for (int rep_ = 0; rep_ < PROBE_GEMM; ++rep_) { pg8::EpiBf16 e{a, ODD_PAD}; pg8::gemm_phase(lds, mk_gemm(H, D, wOin, TC, ODD_PAD, D), e); }
                xcd_barrier(xb);
                prep_odd(a, p.in[15], p.in[16], lin);
                xcd_barrier(xb);
                for (int rep_ = 0; rep_ < PROBE_GEMM; ++rep_) { pg8::EpiBf16 e{qb, 1536}; pg8::gemm_phase(lds, mk_gemm(a, ODD_PAD, wUq, TC, 1536, 384), e); }
                for (int rep_ = 0; rep_ < PROBE_GEMM; ++rep_) { pg8::EpiBf16 e{kv, 2048}; pg8::gemm_phase(lds, mk_gemm(a + 384, ODD_PAD, wUkv, TC, 2048, 256), e); }
                xcd_barrier(xb);
                normmax_mla(qb, kv, a, (unsigned*)(ws + B_NORMS) + 384 + ch * 256, smem);
                xcd_barrier(xb);
                for (int rep_ = 0; rep_ < PROBE_ATTN; ++rep_) attn_mla(qb, kv, a, MIX, lin, (const unsigned*)(ws + B_NORMS) + 384 + ch * 256, smem);
                wout = wOout;
            }
            xcd_barrier(xb);
            { pg8::EpiResid e{xcur, xo}; pg8::gemm_phase(lds, mk_gemm(MIX, D, wout, TC, D, D), e); }
            xcd_barrier(xb);
            for (int rep_ = 0; rep_ < PROBE_NORM; ++rep_) rmsnorm_rows(xo, p.in[20] + layer * D, H, TC);
            xcd_barrier(xb);
            for (int rep_ = 0; rep_ < PROBE_GEMM; ++rep_) { pg8::EpiBf16 e{(bf16_t*)(ws + X_Q), D}; pg8::gemm_phase(lds, mk_gemm(H, D, (const bf16_t*)(ws + W_CQ) + (size_t)layer * D * D, TC, D, D), e); }
            xcd_barrier(xb);
            for (int rep_ = 0; rep_ < PROBE_CROSS; ++rep_) attn_cross((const bf16_t*)(ws + X_Q), (const bf16_t*)(ws + B_KX) + (size_t)layer * NBATCH * NMEM * 2048, MIX, ch * NB, smem);
            xcd_barrier(xb);
            { pg8::EpiResid e{xo, xo}; pg8::gemm_phase(lds, mk_gemm(MIX, D, (const bf16_t*)(ws + W_CO) + (size_t)layer * D * D, TC, D, D), e); }
            xcd_barrier(xb);
            for (int rep_ = 0; rep_ < PROBE_NORM; ++rep_) rmsnorm_rows(xo, p.in[25] + layer * D, H, TC);
            xcd_barrier(xb);
            for (int rep_ = 0; rep_ < PROBE_GEMM; ++rep_) { pg8::EpiSwiglu e{(bf16_t*)(ws + F_ACT)};
              pg8::Gemm g{H, (const bf16_t*)(ws + W_GU) + (size_t)layer * 2 * DFF * D, TC, DFF / 128, D, D, (size_t)DFF * D * 2, (size_t)128 * D * 2};
              pg8::gemm_phase(lds, g, e); }
            xcd_barrier(xb);
            { pg8::EpiResid e{xo, xo}; pg8::gemm_phase(lds, mk_gemm((const bf16_t*)(ws + F_ACT), DFF, (const bf16_t*)(ws + W_DOWN) + (size_t)layer * D * DFF, TC, D, DFF), e); }
            xcd_barrier(xb);
        }
        rmsnorm_final(xo, p.in[28], TC);
    }
}

extern "C" void kernel_launch(void* const* d_in, const int* in_sizes, int n_in, void* d_out, int out_size, void* d_ws, size_t ws_size, hipStream_t stream) {
    static int grid_blocks = 0;
    if (!grid_blocks) {
        int dev = 0, cus = 0, per_cu = 0;
        (void)hipGetDevice(&dev);
        (void)hipDeviceGetAttribute(&cus, hipDeviceAttributeMultiprocessorCount, dev);
        (void)hipFuncSetAttribute((const void*)fwd_mega, hipFuncAttributeMaxDynamicSharedMemorySize, (int)LDS_BYTES);
        (void)hipOccupancyMaxActiveBlocksPerMultiprocessor(&per_cu, fwd_mega, THREADS, LDS_BYTES);
        if (per_cu > 1) per_cu = 1;
        if (per_cu < 1) per_cu = 1;
        grid_blocks = cus * per_cu;
    }
    constexpr size_t WS_END = (O_END > E_END ? O_END : E_END) > (F_ACT + (size_t)TC * DFF * 2) ? (O_END > E_END ? O_END : E_END) : (F_ACT + (size_t)TC * DFF * 2);
    if (ws_size < WS_END) { fprintf(stderr, "workspace too small: %zu < %zu\n", ws_size, (size_t)WS_END); return; }
    if (grid_blocks > 256) grid_blocks = 256;
    Params p{};
    for (int i = 0; i < 29; ++i) p.in[i] = (const float*)d_in[i];
    p.out = (float*)d_out;
    p.ws = (char*)d_ws;
    (void)hipMemsetAsync(d_ws, 0, 16384, stream);
    void* args[] = {&p};
    hipError_t e = hipLaunchCooperativeKernel((void*)fwd_mega, dim3(grid_blocks), dim3(THREADS), args, LDS_BYTES, stream);
    if (e != hipSuccess) fprintf(stderr, "cooperative launch failed: %s (grid %d)\n", hipGetErrorString(e), grid_blocks);
}
```
